# Optimizing an MI355X kernel written in HIP

```python
import math
import jax, jax.numpy as jnp
from jax import lax
import numpy as np

D_MODEL = 1024
BATCH = 2
SEQ = 16384
DEPTH = 1

N_FOURIER_GROUPS = 4
FOURIER_GROUP_DIM = 128
FOURIER_WIDTH = N_FOURIER_GROUPS * FOURIER_GROUP_DIM
DIL_PATTERNS = ((128, 1), (512, 4), (2048, 16))
N_DIL_GROUPS = 3
HEADS_PER_DIL_GROUP = 4
DIL_HEAD_DIM = 64
DIL_HEADS = N_DIL_GROUPS * HEADS_PER_DIL_GROUP
DIL_WIDTH = DIL_HEADS * DIL_HEAD_DIM
DIL_OUT_WIDTH = HEADS_PER_DIL_GROUP * DIL_HEAD_DIM
MEM_LEN = 256
MEM_HEADS = 4
MEM_HEAD_DIM = 128
MEM_WIDTH = MEM_HEADS * MEM_HEAD_DIM
N_BRANCHES = 3
COL_A_END = FOURIER_WIDTH
COL_B_END = COL_A_END + 3 * DIL_WIDTH
COL_C_END = COL_B_END + MEM_WIDTH
COL_TOTAL = COL_C_END + N_BRANCHES * D_MODEL
REL_BUCKETS = 32
REL_MAX_DIST = 1024
PEER_HEADS = 8
PEER_KEYS = 128
PEER_EXPERTS = PEER_KEYS * PEER_KEYS
PEER_QUERY_DIM = 128
PEER_HALF = PEER_QUERY_DIM // 2
PEER_TOPK = 16
PEER_CHUNK = 128
ALPHA = (2.0 * DEPTH) ** 0.25
BETA = (8.0 * DEPTH) ** -0.25
LN_EPS = 1e-5
NEG_INF = -1e30

kernel_name = "hybrid_fnet_dilated_memattn_peer_deepnorm"


def layer_norm(x, g, b):
    xf = x.astype(jnp.float32)
    mu = jnp.mean(xf, -1, keepdims=True)
    var = jnp.mean(jnp.square(xf - mu), -1, keepdims=True)
    y = (xf - mu) * lax.rsqrt(var + LN_EPS) * g.astype(jnp.float32) + b.astype(jnp.float32)
    return y.astype(x.dtype)


def t5_bucket(rel):
    half = REL_BUCKETS // 2
    max_exact = half // 2
    ret = jnp.where(rel > 0, half, 0)
    n = jnp.abs(rel)
    nf = jnp.maximum(n, 1).astype(jnp.float32)
    large = max_exact + (jnp.log(nf / max_exact) / math.log(REL_MAX_DIST / max_exact)
                         * (half - max_exact)).astype(jnp.int32)
    large = jnp.minimum(large, half - 1)
    return ret + jnp.where(n < max_exact, n, large)


def fourier_mix(u):
    f = jnp.fft.fftn(u.astype(jnp.float32), axes=(1, 3), norm="ortho")
    return jnp.real(f).astype(u.dtype)


def dilated_window_attention(q, k, v, bias_table, window, dilation):
    bsz, seq, heads, hd = q.shape
    steps = window // (2 * dilation)
    blk = steps
    sub_len = seq // dilation
    n_blk = -(-sub_len // blk)
    pad_len = n_blk * blk

    def sub(t):
        return t.reshape(bsz, sub_len, dilation, heads, hd)

    qs = jnp.pad(sub(q), ((0, 0), (0, pad_len - sub_len), (0, 0), (0, 0), (0, 0)))
    qs = qs.reshape(bsz, n_blk, blk, dilation, heads, hd)

    def windows(t):
        tp = jnp.pad(sub(t), ((0, 0), (blk, pad_len - sub_len + blk), (0, 0), (0, 0), (0, 0)))
        tp = tp.reshape(bsz, n_blk + 2, blk, dilation, heads, hd)
        return jnp.concatenate([tp[:, :-2], tp[:, 1:-1], tp[:, 2:]], axis=2)

    kw, vw = windows(k), windows(v)
    s = jnp.einsum('bnqrhc,bnkrhc->bnrhqk', qs, kw,
                   preferred_element_type=jnp.float32) * (hd ** -0.5)
    step_off = jnp.arange(3 * blk)[None, :] - blk - jnp.arange(blk)[:, None]
    band = jnp.abs(step_off) <= steps
    key_step = jnp.arange(n_blk)[:, None] * blk + jnp.arange(3 * blk)[None, :] - blk
    inside = (key_step >= 0) & (key_step < sub_len)
    mask = band[None] & inside[:, None, :]
    bias = jnp.transpose(bias_table[t5_bucket(step_off * dilation)], (2, 0, 1)).astype(jnp.float32)
    s = jnp.where(mask[None, :, None, None], s + bias[None, None, None], NEG_INF)
    m = jnp.max(s, -1, keepdims=True)
    p = jnp.exp(s - m)
    den = jnp.sum(p, -1)
    o = jnp.einsum('bnrhqk,bnkrhc->bnqrhc', p, vw.astype(jnp.float32))
    o = o / jnp.transpose(den, (0, 1, 4, 2, 3))[..., None]
    lse = jnp.transpose(m[..., 0] + jnp.log(den), (0, 1, 4, 2, 3))
    o = o.reshape(bsz, pad_len, dilation, heads, hd)[:, :sub_len].reshape(bsz, seq, heads, hd)
    lse = lse.reshape(bsz, pad_len, dilation, heads)[:, :sub_len].reshape(bsz, seq, heads)
    return o, lse


def mixing_sublayer(h, mem, rel_bias, w_in, b_in, w_a, w_b, w_c, w_mem_kv, w_o, ln_g, ln_b):
    bsz, seq, d = h.shape
    z = h @ w_in + b_in
    za = z[..., :COL_A_END].reshape(bsz, seq, N_FOURIER_GROUPS, FOURIER_GROUP_DIM)
    y_a = fourier_mix(za).reshape(bsz, seq, FOURIER_WIDTH) @ w_a
    qkv = z[..., COL_A_END:COL_B_END].reshape(bsz, seq, 3, N_DIL_GROUPS, HEADS_PER_DIL_GROUP, DIL_HEAD_DIM)
    outs, lses = [], []
    for g, (win, dil) in enumerate(DIL_PATTERNS):
        o, lse = dilated_window_attention(
            qkv[:, :, 0, g], qkv[:, :, 1, g], qkv[:, :, 2, g],
            rel_bias[:, g * HEADS_PER_DIL_GROUP:(g + 1) * HEADS_PER_DIL_GROUP], win, dil)
        outs.append(o)
        lses.append(lse)
    wts = jax.nn.softmax(jnp.stack(lses), axis=0)
    o_b = jnp.einsum('gbsh,gbshc->bshc', wts, jnp.stack(outs)).astype(h.dtype)
    y_b = o_b.reshape(bsz, seq, DIL_OUT_WIDTH) @ w_b
    q_c = z[..., COL_B_END:COL_C_END].reshape(bsz, seq, MEM_HEADS, MEM_HEAD_DIM)
    kv = (mem @ w_mem_kv).reshape(bsz, mem.shape[1], 2, MEM_HEADS, MEM_HEAD_DIM)
    sc = jnp.einsum('bshc,bmhc->bhsm', q_c, kv[:, :, 0],
                    preferred_element_type=jnp.float32) * (MEM_HEAD_DIM ** -0.5)
    pc = jax.nn.softmax(sc, axis=-1).astype(h.dtype)
    y_c = jnp.einsum('bhsm,bmhc->bshc', pc, kv[:, :, 1]).reshape(bsz, seq, MEM_WIDTH) @ w_c
    gates = jax.nn.sigmoid(z[..., COL_C_END:].reshape(bsz, seq, N_BRANCHES, d))
    merged = gates[:, :, 0] * y_a + gates[:, :, 1] * y_b + gates[:, :, 2] * y_c
    return layer_norm(ALPHA * h + merged @ w_o, ln_g, ln_b)


def peer_sublayer(h, w_pq, sub_keys1, sub_keys2, u_tab, v_tab, ln_g, ln_b):
    bsz, seq, d = h.shape
    n_tok = bsz * seq
    xt = h.reshape(n_tok, d)
    q = (xt @ w_pq).reshape(n_tok, PEER_HEADS, 2, PEER_HALF).astype(jnp.float32)
    s1 = jnp.einsum('thc,kc->thk', q[:, :, 0], sub_keys1.astype(jnp.float32))
    s2 = jnp.einsum('thc,kc->thk', q[:, :, 1], sub_keys2.astype(jnp.float32))
    v1, i1 = lax.top_k(s1, PEER_TOPK)
    v2, i2 = lax.top_k(s2, PEER_TOPK)
    cand = (v1[..., :, None] + v2[..., None, :]).reshape(n_tok, PEER_HEADS, PEER_TOPK * PEER_TOPK)
    sc, ic = lax.top_k(cand, PEER_TOPK)
    e1 = jnp.take_along_axis(i1, ic // PEER_TOPK, axis=-1)
    e2 = jnp.take_along_axis(i2, ic % PEER_TOPK, axis=-1)
    experts = (e1 * PEER_KEYS + e2).reshape(n_tok, PEER_HEADS * PEER_TOPK)
    gate = jax.nn.softmax(sc, axis=-1).reshape(n_tok, PEER_HEADS * PEER_TOPK).astype(h.dtype)
    n_chunks = n_tok // PEER_CHUNK

    def chunk_fn(args):
        xc, ec, gc = args
        act = jax.nn.gelu(jnp.einsum('tkd,td->tk', u_tab[ec], xc), approximate=False)
        return jnp.einsum('tk,tkd->td', gc * act, v_tab[ec])

    y = lax.map(chunk_fn, (xt.reshape(n_chunks, PEER_CHUNK, d),
                           experts.reshape(n_chunks, PEER_CHUNK, -1),
                           gate.reshape(n_chunks, PEER_CHUNK, -1)))
    y = y.reshape(bsz, seq, d)
    return layer_norm(ALPHA * h + y, ln_g, ln_b)


def setup_inputs(seed: int = 0) -> dict:
    key = jax.random.key(seed)
    ks = jax.random.split(key, 24)
    f32 = jnp.float32

    def nrm(k, shape, scale):
        return jax.random.normal(k, shape, f32) * scale

    return {
        "x": nrm(ks[0], (BATCH, SEQ, D_MODEL), 1.0),
        "mem": nrm(ks[1], (BATCH, MEM_LEN, D_MODEL), 1.0),
        "rel_bias": nrm(ks[2], (REL_BUCKETS, DIL_HEADS), 0.5),
        "ln0_g": 1.0 + nrm(ks[3], (D_MODEL,), 0.02),
        "ln0_b": nrm(ks[4], (D_MODEL,), 0.02),
        "w_in": nrm(ks[5], (DEPTH, D_MODEL, COL_TOTAL), D_MODEL ** -0.5),
        "b_in": nrm(ks[6], (DEPTH, COL_TOTAL), 0.02),
        "w_a": nrm(ks[7], (DEPTH, FOURIER_WIDTH, D_MODEL), FOURIER_WIDTH ** -0.5),
        "w_b": nrm(ks[8], (DEPTH, DIL_OUT_WIDTH, D_MODEL), DIL_OUT_WIDTH ** -0.5),
        "w_c": nrm(ks[9], (DEPTH, MEM_WIDTH, D_MODEL), MEM_WIDTH ** -0.5),
        "w_mem_kv": nrm(ks[10], (DEPTH, D_MODEL, 2 * MEM_WIDTH), D_MODEL ** -0.5),
        "w_o": nrm(ks[11], (DEPTH, D_MODEL, D_MODEL), BETA * D_MODEL ** -0.5),
        "ln1_g": 1.0 + nrm(ks[12], (DEPTH, D_MODEL), 0.02),
        "ln1_b": nrm(ks[13], (DEPTH, D_MODEL), 0.02),
        "w_pq": nrm(ks[14], (DEPTH, D_MODEL, PEER_HEADS * PEER_QUERY_DIM), D_MODEL ** -0.5),
        "sub_keys1": nrm(ks[15], (DEPTH, PEER_KEYS, PEER_HALF), PEER_HALF ** -0.5),
        "sub_keys2": nrm(ks[16], (DEPTH, PEER_KEYS, PEER_HALF), PEER_HALF ** -0.5),
        "u_tab": nrm(ks[17], (DEPTH, PEER_EXPERTS, D_MODEL), D_MODEL ** -0.5),
        "v_tab": nrm(ks[18], (DEPTH, PEER_EXPERTS, D_MODEL), BETA),
        "ln2_g": 1.0 + nrm(ks[19], (DEPTH, D_MODEL), 0.02),
        "ln2_b": nrm(ks[20], (DEPTH, D_MODEL), 0.02),
    }


def reference(x, mem, rel_bias, ln0_g, ln0_b, w_in, b_in, w_a, w_b, w_c, w_mem_kv, w_o,
              ln1_g, ln1_b, w_pq, sub_keys1, sub_keys2, u_tab, v_tab, ln2_g, ln2_b):
    h = layer_norm(x, ln0_g, ln0_b)
    for l in range(DEPTH):
        h = mixing_sublayer(h, mem, rel_bias, w_in[l], b_in[l], w_a[l], w_b[l], w_c[l],
                            w_mem_kv[l], w_o[l], ln1_g[l], ln1_b[l])
        h = peer_sublayer(h, w_pq[l], sub_keys1[l], sub_keys2[l], u_tab[l], v_tab[l],
                          ln2_g[l], ln2_b[l])
    return h
```

```cpp
#include <hip/hip_runtime.h>
#include <cstdio>
#include <cstdint>

#ifndef TABU_FP4
#define TABU_FP4 0
#endif
#ifndef TABV_FP4
#define TABV_FP4 1
#endif
#ifndef TAB_FP6
#define TAB_FP6 1
#endif
static_assert(TAB_FP6 == 1, "the workspace map assumes 12 MiB fp6 expert tables");
#ifndef TAB_FP8
#define TAB_FP8 1
#endif
#ifndef N_LAUNCHES
#define N_LAUNCHES 1
#endif

#define GAS __attribute__((address_space(1)))
#define LAS __attribute__((address_space(3)))
typedef unsigned short bf16;
typedef unsigned v4u __attribute__((ext_vector_type(4)));
typedef unsigned v2u __attribute__((ext_vector_type(2)));
typedef float f32x4 __attribute__((ext_vector_type(4)));
typedef float f32x2 __attribute__((ext_vector_type(2)));
typedef short bf16x8 __attribute__((ext_vector_type(8)));

constexpr int NT = 32768, SEQ = 16384, D = 1024;
constexpr int NPH = 9;
constexpr float ALPHA = 1.189207115002721f;
constexpr float LN_EPS = 1e-5f;
constexpr int NWAVES = 8;

constexpr size_t MiB = 1u << 20;
constexpr size_t WS_CTL = 0, CTL_ZERO_BYTES = 1 * MiB;
constexpr size_t WS_CPART = 256 * 1024;
constexpr size_t WS_STATS = 512 * 1024;
constexpr size_t WS_CVEC = 768 * 1024, WS_DVEC = 772 * 1024;
constexpr size_t WS_BIASIN = 1 * MiB;
constexpr size_t WS_STATS4 = 4 * MiB;
constexpr size_t WS_BIASTAB = 1 * MiB + 64 * 1024;
constexpr size_t WS_WTIN = 2 * MiB;
constexpr size_t WS_WTA = 16 * MiB, WS_WTB = 17 * MiB, WS_WTC = 18 * MiB, WS_WTO = 19 * MiB, WS_WTPQ = 21 * MiB, WS_WTMKV = 23 * MiB;
constexpr size_t WS_MEMB = 25 * MiB, WS_MEMKV = 26 * MiB;
constexpr size_t WS_MEMF8 = 27 * MiB, WS_WMKVF8 = 28 * MiB;
constexpr size_t WS_UTAB = 32 * MiB, WS_VTAB = 44 * MiB;
constexpr size_t WS_H0F8 = 56 * MiB;
constexpr size_t WS_WF8IN = 88 * MiB;
constexpr size_t WS_H0 = 96 * MiB;
constexpr size_t WS_QK = 160 * MiB;
constexpr size_t WS_VT = 256 * MiB;
constexpr size_t WS_QC = 304 * MiB;
constexpr size_t WS_OG = 336 * MiB;
constexpr size_t WS_LSE = 384 * MiB;
constexpr size_t WS_YCIN = 386 * MiB;
constexpr size_t WS_FA = 418 * MiB;
constexpr size_t WS_OB = 450 * MiB;
constexpr size_t WS_GSCR = 466 * MiB;
constexpr size_t WS_MERGED = WS_QK;
constexpr size_t WS_PRELN = 224 * MiB;
constexpr size_t WS_H1B = WS_H0;
constexpr size_t WS_QP = WS_QK;
constexpr size_t WS_END = 498 * MiB;

constexpr int WR_A = 0, WR_QK = 1024, WR_V = 2560, WR_QC = 3328, WR_GATE = 3840, WR_END = 6912;

constexpr int RING_BYTES = 131072;
constexpr int LDS_BYTES = 147456;
constexpr int MISC_OFF = LDS_BYTES - 256;
static_assert(RING_BYTES + 3840 * 4 <= MISC_OFF, "bias copy fits the spare LDS above the GEMM stage buffers");

#define RLX_AGENT __ATOMIC_RELAXED, __HIP_MEMORY_SCOPE_AGENT
#define LDS_WAIT() asm volatile("s_waitcnt lgkmcnt(0)" ::: "memory")
#define VM_WAIT() asm volatile("s_waitcnt vmcnt(0)" ::: "memory")

__device__ __forceinline__ unsigned f2bf(float f) { unsigned u = __builtin_bit_cast(unsigned, f); return (u + 0x7fffu + ((u >> 16) & 1u)) >> 16; }
__device__ __forceinline__ unsigned pk2(float lo, float hi) { return f2bf(lo) | (f2bf(hi) << 16); }
__device__ __forceinline__ unsigned pk4_fp8(float a, float b, float c, float d) { int p = __builtin_amdgcn_cvt_pk_fp8_f32(a, b, 0, false); p = __builtin_amdgcn_cvt_pk_fp8_f32(c, d, p, true); return (unsigned)p; }
__device__ __forceinline__ float bf2f(unsigned b) { return __builtin_bit_cast(float, b << 16); }
__device__ __forceinline__ float bflo(unsigned w) { return __builtin_bit_cast(float, w << 16); }
__device__ __forceinline__ float bfhi(unsigned w) { return __builtin_bit_cast(float, w & 0xffff0000u); }
__device__ __forceinline__ float wave_sum(float v) {
#pragma unroll
    for (int o = 1; o < 64; o <<= 1) v += __shfl_xor(v, o);
    return v;
}
__device__ __forceinline__ float wave_max(float v) {
#pragma unroll
    for (int o = 1; o < 64; o <<= 1) v = fmaxf(v, __shfl_xor(v, o));
    return v;
}

#define XB_TMO      128
#define XB_XCNT(j)  (256  + 64 * (j))
#define XB_XSUB(j)  (1280 + 64 * (j))
#define XB_XGEN(j)  (2304 + 64 * (j))
#define XB_TOP      3328
#define XB_TOPGEN   3392
#define XCD_BAR_WORDS 3456
#define XB_SPIN_CAP (1u << 18)

__device__ __forceinline__ unsigned xb_ld(unsigned* p)              { return __hip_atomic_load(p, __ATOMIC_RELAXED, __HIP_MEMORY_SCOPE_AGENT); }
__device__ __forceinline__ unsigned xb_add(unsigned* p, unsigned v) { return __hip_atomic_fetch_add(p, v, __ATOMIC_RELAXED, __HIP_MEMORY_SCOPE_AGENT); }
__device__ __forceinline__ unsigned xb_xcc_id() { return (unsigned)__builtin_amdgcn_s_getreg((3 << 11) | 20) & 0xFu; }
#define XB_SPIN(cond, bar) do { unsigned _sp = 0; while (cond) { __builtin_amdgcn_s_sleep(1); \
    if ((++_sp & 255u) == 0u) { if (xb_ld(&(bar)[XB_TMO])) break; if (_sp > XB_SPIN_CAP) { atomicAdd(&(bar)[XB_TMO], 1u); break; } } } } while (0)

struct XcdBarrier {
    unsigned* bar; unsigned x;
    volatile LAS unsigned* st;
};
__device__ __forceinline__ XcdBarrier xcd_barrier_post(unsigned* bar, volatile LAS unsigned* st) {
    XcdBarrier b; b.bar = bar; b.x = xb_xcc_id(); b.st = st;
    if (threadIdx.x == 0) (void)xb_add(&bar[XB_XCNT(b.x)], 1u);
    return b;
}
__device__ __forceinline__ void xcd_barrier_complete(unsigned* bar, unsigned x, unsigned& nloc, unsigned& nx) {
    const unsigned G = gridDim.x * gridDim.y * gridDim.z;
    unsigned sum, cnt, mine, sp = 0u;
    for (;;) {
        sum = 0u; cnt = 0u; mine = 0u;
#pragma unroll
        for (unsigned j = 0; j < 16; ++j) { const unsigned c = xb_ld(&bar[XB_XCNT(j)]); sum += c; cnt += (c > 0u) ? 1u : 0u; mine = (j == x) ? c : mine; }
        if (sum == G) break;
        __builtin_amdgcn_s_sleep(1);
        if ((++sp & 255u) == 0u) { if (xb_ld(&bar[XB_TMO])) break; if (sp > XB_SPIN_CAP) { atomicAdd(&bar[XB_TMO], 1u); break; } }
    }
    nloc = mine > 0u ? mine : 1u; nx = cnt > 0u ? cnt : 1u;
}
__device__ __forceinline__ void xcd_barrier(const XcdBarrier& b) {
    asm volatile("s_waitcnt vmcnt(0)" ::: "memory");
    __syncthreads();
    if (threadIdx.x == 0) {
        unsigned* bar = b.bar;
        __builtin_amdgcn_s_waitcnt(0);
        unsigned nloc = b.st[0], nx = b.st[1];
        if (nloc == 0u) { xcd_barrier_complete(bar, b.x, nloc, nx); b.st[0] = nloc; b.st[1] = nx; }
        const unsigned old = xb_add(&bar[XB_XSUB(b.x)], 1u);
        const unsigned gen = old / nloc;
        if (old + 1u == (gen + 1u) * nloc) {
            __builtin_amdgcn_fence(__ATOMIC_RELEASE, "agent");
            asm volatile("s_waitcnt vmcnt(0)" ::: "memory");
            const unsigned og = xb_add(&bar[XB_TOP], 1u);
            const unsigned tg = og / nx;
            if (og + 1u == (tg + 1u) * nx) xb_add(&bar[XB_TOPGEN], 1u);
            else XB_SPIN(xb_ld(&bar[XB_TOPGEN]) == tg, bar);
            __builtin_amdgcn_fence(__ATOMIC_ACQUIRE, "agent");
            xb_add(&bar[XB_XGEN(b.x)], 1u);
            asm volatile("s_waitcnt vmcnt(0)" ::: "memory");
        } else {
            XB_SPIN(xb_ld(&bar[XB_XGEN(b.x)]) == gen, bar);
            __builtin_amdgcn_fence(__ATOMIC_ACQUIRE, "agent");
            asm volatile("s_waitcnt vmcnt(0)" ::: "memory");
        }
    }
    __syncthreads();
}

namespace pg8 {
constexpr int BM = 256, BK = 64, HALF = 128, HTB = HALF * BK * 2, STAGE_BYTES = 8 * HTB;
__host__ __device__ __forceinline__ int lds_byte(int r, int c) { const int st = (r >> 4) * 2 + (c >> 5), rr = r & 15, cc = c & 31, ob = rr * 64 + cc * 2; return st * 1024 + (ob ^ (((ob >> 9) & 1) << 5)); }
__host__ __device__ __forceinline__ void stage_rc(int b, int& R, int& C) { const int st = b / 1024, sb = b % 1024, swz = sb ^ (((sb >> 9) & 1) << 5); R = (st >> 1) * 16 + swz / 64; C = (st & 1) * 32 + (swz % 64) / 2; }
__host__ __device__ __forceinline__ int perm32(int rho) { const int n = rho >> 4, i = rho & 15; return 8 * (i >> 2) + 4 * n + (i & 3); }

struct GUnit { const char* a; const char* b; unsigned sa, sb; int nt; int pm, pn, kind; };

typedef int v8i __attribute__((ext_vector_type(8)));
constexpr int K_FP8 = 1 << 16;
__device__ __forceinline__ unsigned pg8_rb(unsigned ra) { asm volatile("" : "+v"(ra)); const unsigned rho = ra & 31u, n = rho >> 4, i = rho & 15u; return (ra & ~31u) + 8u * (i >> 2) + 4u * n + (i & 3u); }
template <class Epi, class Sched, int MODE = 0>
__device__ __forceinline__ void gemm_phase(LAS unsigned char* lds, const Sched& S, const Epi& E) {
    const int tid = threadIdx.x, wid = __builtin_amdgcn_readfirstlane(tid >> 6), lane = tid & 63, wr = wid >> 2, wc = wid & 3, fr = lane & 15, fq = lane >> 4;
    int R0, C0; stage_rc(tid * 16, R0, C0);
    const unsigned RA = (unsigned)R0, C2 = (unsigned)C0 * 2u;
#define RB pg8_rb(RA)
    const size_t kstep = (size_t)(BK * 2);
    const unsigned ldsw = (unsigned)wid * 1024u;
    const int aoff = lds_byte(wr * 64 + fr, fq * 8), boff = lds_byte(wc * 32 + fr, fq * 8);
#define PG8_SA(b, h) (((b) * 2 + (h)) * HTB)
#define PG8_SB(b, h) ((4 + (b) * 2 + (h)) * HTB)
#define PG8_STAGE(bufoff, gbase, RR, stride) do { const unsigned _vo = (RR) * (unsigned)(stride) + C2; const char* _g = (const char*)(gbase); \
        __builtin_amdgcn_global_load_lds((const unsigned*)(_g + _vo), (LAS unsigned*)(lds + (bufoff) + ldsw), 16, 0, 0); \
        __builtin_amdgcn_global_load_lds((const unsigned*)(_g + (size_t)64 * (stride) + _vo), (LAS unsigned*)(lds + (bufoff) + ldsw + 8192), 16, 0, 0); } while (0)
#define PG8_LDA(dst, b, h) do { _Pragma("unroll") for (int m = 0; m < 4; ++m) _Pragma("unroll") for (int k = 0; k < 2; ++k) dst[m][k] = *(const LAS bf16x8*)(lds + PG8_SA(b, h) + aoff + m * 2048 + k * 1024); } while (0)
#define PG8_LDB(dst, b, h) do { _Pragma("unroll") for (int n = 0; n < 2; ++n) _Pragma("unroll") for (int k = 0; k < 2; ++k) dst[n][k] = *(const LAS bf16x8*)(lds + PG8_SB(b, h) + boff + n * 2048 + k * 1024); } while (0)
#define PG8_CAT(lo, hi) __builtin_bit_cast(v8i, __builtin_shufflevector(lo, hi, 0, 1, 2, 3, 4, 5, 6, 7, 8, 9, 10, 11, 12, 13, 14, 15))
#define PG8_MMA_BF(ai, bj, At, Bt) do { __builtin_amdgcn_s_setprio(1); _Pragma("unroll") for (int m = 0; m < 4; ++m) _Pragma("unroll") for (int n = 0; n < 2; ++n) _Pragma("unroll") for (int k = 0; k < 2; ++k) \
        acc[ai][bj][m][n] = __builtin_amdgcn_mfma_f32_16x16x32_bf16(Bt[n][k], At[m][k], acc[ai][bj][m][n], 0, 0, 0); __builtin_amdgcn_s_setprio(0); } while (0)
#define PG8_MMA_F8(ai, bj, At, Bt) do { __builtin_amdgcn_s_setprio(1); _Pragma("unroll") for (int m = 0; m < 4; ++m) _Pragma("unroll") for (int n = 0; n < 2; ++n) \
        acc[ai][bj][m][n] = __builtin_amdgcn_mfma_scale_f32_16x16x128_f8f6f4(PG8_CAT(Bt[n][0], Bt[n][1]), PG8_CAT(At[m][0], At[m][1]), acc[ai][bj][m][n], 0, 0, 0, 0x7F7F7F7F, 0, 0x7F7F7F7F); __builtin_amdgcn_s_setprio(0); } while (0)
#define PG8_WAIT_V(n) asm volatile("s_waitcnt vmcnt(" #n ")" ::: "memory")
#define PG8_WAIT_L(n) asm volatile("s_waitcnt lgkmcnt(" #n ")" ::: "memory")
#define PG8_BAR __builtin_amdgcn_s_barrier()
#define PG8_SCHED __builtin_amdgcn_sched_barrier(0)
#define PG8_KLOOP(MMA) \
        for (int t = 0; t < nt; t += 2) { \
            const bool last = (t == nt - 2); \
            const char* a1 = cA + (size_t)(t + 1) * kstep; \
            const char* a2 = last ? nxt.a : cA + (size_t)(t + 2) * kstep; const char* b2 = last ? nxt.b : cB + (size_t)(t + 2) * kstep; \
            const unsigned sa2 = last ? nxt.sa : csa, sb2 = last ? nxt.sb : csb; const size_t hA2 = (size_t)HALF * sa2, hB2 = (size_t)HALF * sb2; \
            const char* a3 = a2 + kstep; const char* b3 = b2 + kstep; \
            PG8_LDB(B0, 0, 0); PG8_LDB(B1, 0, 1); PG8_SCHED; PG8_LDA(At, 0, 0); PG8_STAGE(PG8_SA(1, 1), a1 + hA, RA, csa); \
            PG8_WAIT_V(8); PG8_WAIT_L(0); PG8_BAR; MMA(0, 0, At, B0); MMA(0, 1, At, B1); PG8_BAR; PG8_SCHED; \
            PG8_LDA(At, 0, 1); PG8_STAGE(PG8_SB(0, 0), b2, RB, sb2); PG8_STAGE(PG8_SB(0, 1), b2 + hB2, RB, sb2); PG8_STAGE(PG8_SA(0, 0), a2, RA, sa2); \
            PG8_WAIT_V(8); PG8_WAIT_L(0); PG8_BAR; MMA(1, 0, At, B0); MMA(1, 1, At, B1); PG8_BAR; PG8_SCHED; \
            PG8_LDB(B0, 1, 0); PG8_LDB(B1, 1, 1); PG8_SCHED; PG8_LDA(At, 1, 0); PG8_STAGE(PG8_SA(0, 1), a2 + hA2, RA, sa2); \
            PG8_WAIT_V(8); PG8_WAIT_L(0); PG8_BAR; MMA(0, 0, At, B0); MMA(0, 1, At, B1); PG8_BAR; PG8_SCHED; \
            PG8_LDA(At, 1, 1); PG8_STAGE(PG8_SB(1, 0), b3, RB, sb2); PG8_STAGE(PG8_SB(1, 1), b3 + hB2, RB, sb2); PG8_STAGE(PG8_SA(1, 0), a3, RA, sa2); \
            PG8_WAIT_V(8); PG8_WAIT_L(0); PG8_BAR; MMA(1, 0, At, B0); MMA(1, 1, At, B1); PG8_BAR; PG8_SCHED; \
        }
    GUnit cur, nxt; int ui = 0;
    if (!S.next(0, cur)) return;
    f32x4 acc[2][2][4][2];
#pragma unroll
    for (int a = 0; a < 2; ++a)
#pragma unroll
        for (int b = 0; b < 2; ++b)
#pragma unroll
            for (int m = 0; m < 4; ++m)
#pragma unroll
                for (int n = 0; n < 2; ++n) acc[a][b][m][n] = (f32x4){0.f, 0.f, 0.f, 0.f};
    bf16x8 At[4][2], B0[2][2], B1[2][2];
    unsigned keep[2][2][4][2];
    {
        const char* cA = cur.a; const char* cB = cur.b; const size_t hA = (size_t)HALF * cur.sa, hB = (size_t)HALF * cur.sb;
        PG8_STAGE(PG8_SB(0, 0), cB, RB, cur.sb); PG8_STAGE(PG8_SB(0, 1), cB + hB, RB, cur.sb); PG8_STAGE(PG8_SA(0, 0), cA, RA, cur.sa); PG8_STAGE(PG8_SA(0, 1), cA + hA, RA, cur.sa);
        if (wr == 1) PG8_BAR;
        PG8_WAIT_V(2); PG8_BAR;
        PG8_STAGE(PG8_SB(1, 0), cB + kstep, RB, cur.sb); PG8_STAGE(PG8_SA(1, 0), cA + kstep, RA, cur.sa); PG8_STAGE(PG8_SB(1, 1), cB + hB + kstep, RB, cur.sb);
        PG8_WAIT_V(6); PG8_BAR;
    }
    for (;;) {
        const bool has_next = S.next(ui + 1, nxt);
        if (!has_next) { nxt = cur; }
        const char* cA = cur.a; const char* cB = cur.b; const unsigned csa = cur.sa, csb = cur.sb; const size_t hA = (size_t)HALF * csa, hB = (size_t)HALF * csb;
        const int nt = cur.nt; const bool cur_fp8 = (cur.kind & K_FP8) != 0; (void)cur_fp8;
        if (MODE == 1 || (MODE == 2 && cur_fp8)) { PG8_KLOOP(PG8_MMA_F8) } else { PG8_KLOOP(PG8_MMA_BF) }
        if (wr == 0) PG8_BAR;
        E(acc, keep, cur, wr, wc, fr, fq);
        if (!has_next) break;
#pragma unroll
        for (int a = 0; a < 2; ++a)
#pragma unroll
            for (int b = 0; b < 2; ++b)
#pragma unroll
                for (int m = 0; m < 4; ++m)
#pragma unroll
                    for (int n = 0; n < 2; ++n) acc[a][b][m][n] = (f32x4){0.f, 0.f, 0.f, 0.f};
        cur = nxt; ++ui;
        if (wr == 1) PG8_BAR;
    }
    PG8_WAIT_V(0);
    PG8_BAR;
#undef PG8_SA
#undef PG8_SB
#undef PG8_STAGE
#undef PG8_LDA
#undef PG8_LDB
#undef PG8_MMA_BF
#undef PG8_MMA_F8
#undef PG8_KLOOP
#undef RB
#undef PG8_CAT
#undef PG8_WAIT_V
#undef PG8_WAIT_L
#undef PG8_BAR
#undef PG8_SCHED
}
}
using pg8::GUnit; using pg8::K_FP8;

__device__ __forceinline__ int tok0_of(int p, int g) {
    const int n = p << 8, b = n >> 14, rem = n & 16383, sh = 2 * g;
    const int r = rem >> (14 - sh), l0 = rem & ((16384 >> sh) - 1);
    return (b << 14) + (l0 << sh) + r;
}
__device__ __forceinline__ void tile_of(int t, int nN, int& pm, int& pn) { const int nig = 8 * nN, gid = t / nig, w = t % nig; pm = gid * 8 + (w & 7); pn = w >> 3; }

struct Ptrs {
    const float* in[21]; float* out; unsigned char* ws;
};

enum { K_ZA = 0, K_QK = 1, K_VT = 2, K_QC = 3, K_MKV = 4, K_GATE = 5, K_YA = 6, K_YB = 7, K_YC = 8, K_WO = 9, K_PQ = 10 };
struct SchedP1 {
    const char* wsb; int G, c;
    static constexpr int NLONG = 512, NSHORT = 768 + 384 + 256 + 8;
    __device__ __forceinline__ bool next(int i, GUnit& u) const {
        const char* const h0b = wsb + WS_H0; const char* const wtb = wsb + WS_WTIN; const char* const h0 = wsb + WS_H0F8; const char* const wtin = wsb + WS_WF8IN; const char* const memb = wsb + WS_MEMF8; const char* const wtmkv = wsb + WS_WMKVF8;
        const int nshort = (NSHORT - c + G - 1) / G, nslots = 2 + nshort; if (i >= nslots) return false;
        const int k = (c >> 3) & 3; int pa = k % nslots, pb = (k + 4) % nslots; if (pa > pb) { const int t_ = pa; pa = pb; pb = t_; }
        int j; if (i == pa) j = 0; else if (i == pb) j = 1; else j = 2 + i - (i > pa ? 1 : 0) - (i > pb ? 1 : 0);
        const int L = j * G + c; if (L >= NLONG + NSHORT) return false;
        if (L < NLONG) { const int T = (G % 8 == 0) ? (L % 8) * (NLONG / 8) + L / 8 : L; int pm, pn; tile_of(T, 4, pm, pn);
            u.a = h0b + (size_t)pm * 256 * 2048; u.b = wtb + (size_t)(WR_A + pn * 256) * 2048; u.sa = 2048; u.sb = 2048; u.nt = 16; u.pm = pm; u.pn = pn; u.kind = K_ZA; return true; }
        const int Ls = L - NLONG; int T = (NSHORT % 8 == 0 && G % 8 == 0) ? (Ls % 8) * (NSHORT / 8) + Ls / 8 : Ls;
        u.nt = 8; u.sa = 1024; u.sb = 1024;
        if (T < 768) { const int g = T >> 8; int pm, pn; tile_of(T & 255, 2, pm, pn); u.a = h0 + (size_t)tok0_of(pm, g) * 1024; u.sa = 1024u << (2 * g);
            u.b = wtin + (size_t)(WR_QK + g * 512 + pn * 256) * 1024; u.pm = pm; u.pn = pn; u.kind = K_QK | (g << 8) | K_FP8; return true; }
        T -= 768;
        if (T < 384) { const int g = T >> 7, pn = T & 127; u.a = wtin + (size_t)(WR_V + g * 256) * 1024; u.b = h0 + (size_t)tok0_of(pn, g) * 1024; u.sb = 1024u << (2 * g);
            u.pm = 0; u.pn = pn; u.kind = K_VT | (g << 8) | K_FP8; return true; }
        T -= 384;
        if (T < 256) { int pm, pn; tile_of(T, 2, pm, pn); u.a = h0 + (size_t)pm * 256 * 1024; u.b = wtin + (size_t)(WR_QC + pn * 256) * 1024; u.pm = pm; u.pn = pn; u.kind = K_QC | K_FP8; return true; }
        T -= 256;
        if (T < 4) { const int pm = T >> 1, pn = T & 1; u.a = memb + (size_t)pm * 256 * 1024; u.b = wtmkv + (size_t)pn * 256 * 1024; u.pm = pm; u.pn = pn; u.kind = K_MKV | K_FP8; return true; }
        T -= 4;
        { const int pm = T >> 1, pn = T & 1; u.a = wtmkv + (size_t)(512 + pm * 256) * 1024; u.b = memb + (size_t)pn * 256 * 1024; u.pm = pm; u.pn = pn; u.kind = K_MKV | (1 << 8) | K_FP8; return true; }
    }
};
__device__ __forceinline__ void out_tile_of(int L, int G, int& pm, int& pn) {
    const int T = (G % 8 == 0) ? (L % 8) * 64 + L / 8 : L; tile_of(T, 4, pm, pn);
}
struct SchedP4 {
    const char* wsb; int G, c;
    __device__ __forceinline__ bool next(int i, GUnit& u) const {
        const int io = i / 6, s = i - io * 6; const int L = io * G + c; if (L >= 512) return false;
        int pm, pn; out_tile_of(L, G, pm, pn); u.pm = pm; u.pn = pn;
        if ((s & 1) == 0) { const int gi = s >> 1; u.a = wsb + WS_H0F8 + (size_t)pm * 256 * 1024; u.sa = 1024; u.b = wsb + WS_WF8IN + (size_t)(WR_GATE + gi * 1024 + pn * 256) * 1024; u.sb = 1024; u.nt = 8; u.kind = K_GATE | (gi << 8) | K_FP8; return true; }
        if (s == 1) { u.a = wsb + WS_FA + (size_t)pm * 256 * 1024; u.sa = 1024; u.b = wsb + WS_WTA + (size_t)pn * 256 * 1024; u.sb = 1024; u.nt = 8; u.kind = K_YA; return true; }
        if (s == 3) { u.a = wsb + WS_OB + (size_t)pm * 256 * 256; u.sa = 256; u.b = wsb + WS_WTB + (size_t)pn * 256 * 256; u.sb = 256; u.nt = 2; u.kind = K_YB | K_FP8; return true; }
        u.a = wsb + WS_YCIN + (size_t)pm * 256 * 512; u.sa = 512; u.b = wsb + WS_WTC + (size_t)pn * 256 * 512; u.sb = 512; u.nt = 4; u.kind = K_YC | K_FP8; return true;
    }
};
struct SchedPlain {
    const char* a; const char* b; int G, c, kind;
    __device__ __forceinline__ bool next(int i, GUnit& u) const {
        const int L = i * G + c; if (L >= 512) return false;
        int pm, pn; out_tile_of(L, G, pm, pn); u.pm = pm; u.pn = pn; u.a = a + (size_t)pm * 256 * 2048; u.b = b + (size_t)pn * 256 * 2048; u.sa = 2048; u.sb = 2048; u.nt = 16; u.kind = kind; return true;
    }
};

__device__ __forceinline__ unsigned opq(unsigned x) { asm volatile("" : "+v"(x)); return x; }
__device__ __forceinline__ v4u pack8(f32x4 v0, f32x4 v1) { v4u o; o.x = pk2(v0[0], v0[1]); o.y = pk2(v0[2], v0[3]); o.z = pk2(v1[0], v1[1]); o.w = pk2(v1[2], v1[3]); return o; }
__device__ __forceinline__ void unpack8(v4u w, f32x4& a, f32x4& b) { a[0] = bflo(w.x); a[1] = bfhi(w.x); a[2] = bflo(w.y); a[3] = bfhi(w.y); b[0] = bflo(w.z); b[1] = bfhi(w.z); b[2] = bflo(w.w); b[3] = bfhi(w.w); }
#define EPI_LOOP(ai, m, bj) _Pragma("unroll") for (int ai = 0; ai < 2; ++ai) _Pragma("unroll") for (int m = 0; m < 4; ++m) _Pragma("unroll") for (int bj = 0; bj < 2; ++bj)

constexpr float W8SC = 32.f, W8INV = 1.f / 32.f;
constexpr float SC_WBC = 16.f, SC_ACT = 4.f;
struct EpiP1 {
    bf16* za; unsigned char* wsb; const LAS unsigned char* bias;
    __device__ __forceinline__ void operator()(f32x4 (&acc)[2][2][4][2], unsigned (&keep)[2][2][4][2], const GUnit& u, int wr, int wc, int fr, int fq) const {
        bf16* const qk = (bf16*)(wsb + WS_QK); bf16* const vt = (bf16*)(wsb + WS_VT); bf16* const qc = (bf16*)(wsb + WS_QC); bf16* const memkv = (bf16*)(wsb + WS_MEMKV);
        const int kind = u.kind & 255, g = (u.kind >> 8) & 255; const float asc = (u.kind & K_FP8) ? W8INV : 1.f;
        const unsigned rl0 = opq((unsigned)(wr * 64 + fr)), cl0 = opq((unsigned)(wc * 32 + 8 * fq));
        if (kind == K_VT) {
            char* base = (char*)(vt + (size_t)g * 256 * NT + (size_t)u.pn * 256); const LAS unsigned char* bb = bias + (WR_V + g * 256) * 4;
            const unsigned lo = rl0 * (unsigned)(NT * 2) + cl0 * 2u;
#pragma unroll
            for (int ai = 0; ai < 2; ++ai)
#pragma unroll
                for (int m = 0; m < 4; ++m) { const float br = *(const LAS float*)(bb + (rl0 + ai * 128 + m * 16) * 4u);
#pragma unroll
                    for (int bj = 0; bj < 2; ++bj) *(GAS v4u*)(base + (lo + (unsigned)((ai * 128 + m * 16) * NT * 2 + bj * 256))) = pack8(acc[ai][bj][m][0] * asc + br, acc[ai][bj][m][1] * asc + br);
                    __builtin_amdgcn_sched_barrier(0); }
            return;
        }
        char* base; unsigned ldb; const LAS unsigned char* bb; bool hasb = true;
        if (kind == K_ZA) { base = (char*)(za + (size_t)u.pm * 256 * 1024 + u.pn * 256); ldb = 2048; bb = bias + (WR_A + u.pn * 256) * 4; }
        else if (kind == K_QK) { base = (char*)(qk + (size_t)g * NT * 512 + (size_t)u.pm * 256 * 512 + u.pn * 256); ldb = 1024; bb = bias + (WR_QK + g * 512 + u.pn * 256) * 4; }
        else if (kind == K_QC) { base = (char*)(qc + (size_t)u.pm * 256 * 512 + u.pn * 256); ldb = 1024; bb = bias + (WR_QC + u.pn * 256) * 4; }
        else { base = (char*)(memkv + (size_t)g * 512 * 512 + (size_t)u.pm * 256 * 512 + u.pn * 256); ldb = 1024; bb = bias; hasb = false; }
        f32x4 bv[2][2];
#pragma unroll
        for (int bj = 0; bj < 2; ++bj)
#pragma unroll
            for (int n = 0; n < 2; ++n) bv[bj][n] = hasb ? *(const LAS f32x4*)(bb + (cl0 + bj * 128 + 4 * n) * 4u) : (f32x4){0.f, 0.f, 0.f, 0.f};
        const unsigned lo = rl0 * ldb + cl0 * 2u;
#pragma unroll
        for (int ai = 0; ai < 2; ++ai)
#pragma unroll
            for (int m = 0; m < 4; ++m) {
#pragma unroll
                for (int bj = 0; bj < 2; ++bj) *(GAS v4u*)(base + (lo + (unsigned)(ai * 128 + m * 16) * ldb + (unsigned)(bj * 256))) = pack8(acc[ai][bj][m][0] * asc + bv[bj][0], acc[ai][bj][m][1] * asc + bv[bj][1]);
                __builtin_amdgcn_sched_barrier(0); }
    }
};
struct EpiP4 {
    bf16* merged; const LAS unsigned char* bias;
    __device__ __forceinline__ void operator()(f32x4 (&acc)[2][2][4][2], unsigned (&keep)[2][2][4][2], const GUnit& u, int wr, int wc, int fr, int fq) const {
        const int kind = u.kind & 255, gi = (u.kind >> 8) & 255;
        const unsigned rl0 = opq((unsigned)(wr * 64 + fr)), cl0 = opq((unsigned)(wc * 32 + 8 * fq));
        if (kind == K_GATE) {
            const LAS unsigned char* bb = bias + (gi * 1024 + u.pn * 256) * 4;
#pragma unroll
            for (int bj = 0; bj < 2; ++bj) { const f32x4 b0 = *(const LAS f32x4*)(bb + (cl0 + bj * 128) * 4u), b1 = *(const LAS f32x4*)(bb + (cl0 + bj * 128 + 4) * 4u);
#pragma unroll
                for (int ai = 0; ai < 2; ++ai)
#pragma unroll
                    for (int m = 0; m < 4; ++m)
#pragma unroll
                        for (int n = 0; n < 2; ++n) { const f32x4 v = acc[ai][bj][m][n] * W8INV + (n ? b1 : b0); unsigned pk = 0u;
#pragma unroll
                            for (int e = 0; e < 4; ++e) { const float sg = __builtin_amdgcn_rcpf(1.f + __expf(-v[e])); pk |= (unsigned)(sg * 255.f + 0.5f) << (8 * e); }
                            keep[ai][bj][m][n] = pk; } }
            return;
        }
        char* mb = (char*)(merged + (size_t)u.pm * 256 * 1024 + u.pn * 256); const unsigned mlo = rl0 * 2048u + cl0 * 2u;
        const float ysc = ((kind == K_YA) ? 1.f : 1.f / (SC_WBC * SC_ACT)) * (1.f / 255.f);
#pragma unroll
        for (int ai = 0; ai < 2; ++ai) {
            v4u pw[4][2];
            if (kind != K_YA) {
#pragma unroll
                for (int m = 0; m < 4; ++m)
#pragma unroll
                    for (int bj = 0; bj < 2; ++bj) pw[m][bj] = *(const GAS v4u*)(mb + (mlo + (unsigned)((ai * 128 + m * 16) * 2048 + bj * 256))); }
#pragma unroll
            for (int m = 0; m < 4; ++m)
#pragma unroll
                for (int bj = 0; bj < 2; ++bj) { f32x4 v[2];
#pragma unroll
                    for (int n = 0; n < 2; ++n) { const unsigned pk = keep[ai][bj][m][n];
                        v[n][0] = acc[ai][bj][m][n][0] * ((float)(pk & 255u) * ysc); v[n][1] = acc[ai][bj][m][n][1] * ((float)((pk >> 8) & 255u) * ysc);
                        v[n][2] = acc[ai][bj][m][n][2] * ((float)((pk >> 16) & 255u) * ysc); v[n][3] = acc[ai][bj][m][n][3] * ((float)(pk >> 24) * ysc); }
                    if (kind != K_YA) { f32x4 p0, p1; unpack8(pw[m][bj], p0, p1); v[0] += p0; v[1] += p1; }
                    *(GAS v4u*)(mb + (mlo + (unsigned)((ai * 128 + m * 16) * 2048 + bj * 256))) = pack8(v[0], v[1]); }
            __builtin_amdgcn_sched_barrier(0); }
    }
};
struct EpiP5 {
    bf16* h0; float* preln; float* stats; LAS unsigned char* lds_spare;
    __device__ __forceinline__ void operator()(f32x4 (&acc)[2][2][4][2], unsigned (&keep)[2][2][4][2], const GUnit& u, int wr, int wc, int fr, int fq) const {
        const unsigned rl0 = opq((unsigned)(wr * 64 + fr)), cl0 = opq((unsigned)(wc * 32 + 8 * fq));
        const size_t t0 = (size_t)u.pm * 256 * 1024 + u.pn * 256;
        char* hb = (char*)(h0 + t0);
        const unsigned hlo = rl0 * 2048u + cl0 * 2u;
#pragma unroll
        for (int ai = 0; ai < 2; ++ai) {
            v4u hw[4][2];
#pragma unroll
            for (int m = 0; m < 4; ++m)
#pragma unroll
                for (int bj = 0; bj < 2; ++bj) hw[m][bj] = *(const GAS v4u*)(hb + (hlo + (unsigned)((ai * 128 + m * 16) * 2048 + bj * 256)));
#pragma unroll
            for (int m = 0; m < 4; ++m) { float s1 = 0.f, s2 = 0.f;
#pragma unroll
                for (int bj = 0; bj < 2; ++bj) { f32x4 h0v, h1v; unpack8(hw[m][bj], h0v, h1v);
                    const f32x4 v0 = acc[ai][bj][m][0] + ALPHA * h0v, v1 = acc[ai][bj][m][1] + ALPHA * h1v;
                    *(GAS v4u*)(hb + (hlo + (unsigned)((ai * 128 + m * 16) * 2048 + bj * 256))) = pack8(v0, v1);
                    s1 += (v0[0] + v0[1]) + (v0[2] + v0[3]) + (v1[0] + v1[1]) + (v1[2] + v1[3]);
                    s2 += (v0[0] * v0[0] + v0[1] * v0[1]) + (v0[2] * v0[2] + v0[3] * v0[3]) + (v1[0] * v1[0] + v1[1] * v1[1]) + (v1[2] * v1[2] + v1[3] * v1[3]); }
                s1 += __shfl_xor(s1, 16); s1 += __shfl_xor(s1, 32); s2 += __shfl_xor(s2, 16); s2 += __shfl_xor(s2, 32);
                if (fq == 0) { f32x2 pr; pr.x = s1; pr.y = s2; *(LAS f32x2*)(lds_spare + ((ai * 128 + m * 16 + rl0) * 4 + wc) * 8) = pr; } }
            __builtin_amdgcn_sched_barrier(0); }
        asm volatile("s_waitcnt lgkmcnt(0)" ::: "memory"); __builtin_amdgcn_s_barrier(); asm volatile("" ::: "memory");
        { const int t = threadIdx.x;
          if (t < 256) { const LAS f32x2* pp = (const LAS f32x2*)(lds_spare + t * 32); f32x2 a = pp[0]; a += pp[1]; a += pp[2]; a += pp[3];
              *(GAS f32x2*)(stats + ((size_t)(u.pm * 256 + t) * 4 + u.pn) * 2) = a; } }
    }
};
struct EpiP7 {
    bf16* qp; const float* stats; const float* cvec; const float* dvec;
    __device__ __forceinline__ void operator()(f32x4 (&acc)[2][2][4][2], unsigned (&keep)[2][2][4][2], const GUnit& u, int wr, int wc, int fr, int fq) const {
        const unsigned rl0 = opq((unsigned)(wr * 64 + fr)), cl0 = opq((unsigned)(wc * 32 + 8 * fq));
        char* qb = (char*)(qp + (size_t)u.pm * 256 * 1024 + u.pn * 256); const unsigned lo = rl0 * 2048u + cl0 * 2u;
        f32x4 cv[2][2], dv[2][2];
#pragma unroll
        for (int bj = 0; bj < 2; ++bj)
#pragma unroll
            for (int n = 0; n < 2; ++n) { cv[bj][n] = *(const GAS f32x4*)(cvec + u.pn * 256 + cl0 + bj * 128 + 4 * n); dv[bj][n] = *(const GAS f32x4*)(dvec + u.pn * 256 + cl0 + bj * 128 + 4 * n); }
#pragma unroll
        for (int ai = 0; ai < 2; ++ai)
#pragma unroll
            for (int m = 0; m < 4; ++m) { const GAS f32x4* sp = (const GAS f32x4*)(stats + (size_t)(u.pm * 256 + ai * 128 + m * 16 + rl0) * 8); const f32x4 sa = sp[0], sb = sp[1];
                f32x2 st; st.x = ((sa.x + sa.z) + sb.x) + sb.z; st.y = ((sa.y + sa.w) + sb.y) + sb.w;
                const float mean = st.x * (1.f / D), rstd = 1.f / sqrtf(fmaxf(st.y * (1.f / D) - mean * mean, 0.f) + LN_EPS), mr = mean * rstd;
#pragma unroll
                for (int bj = 0; bj < 2; ++bj) *(GAS v4u*)(qb + (lo + (unsigned)((ai * 128 + m * 16) * 2048 + bj * 256))) = pack8(acc[ai][bj][m][0] * rstd - mr * cv[bj][0] + dv[bj][0], acc[ai][bj][m][1] * rstd - mr * cv[bj][1] + dv[bj][1]); }
    }
};

constexpr float FP6_SU = 60.f, FP6_SV = 3.15f;
__device__ __forceinline__ unsigned fp6_code(float v) {
    const float a = fminf(fabsf(v), 7.5f);
    const float c = a < 2.f ? rintf(a * 8.f) : (a < 4.f ? 16.f + rintf((a - 2.f) * 4.f) : 24.f + rintf((a - 4.f) * 2.f));
    return (unsigned)c | (v < 0.f ? 32u : 0u);
}
constexpr float FP4_SV = 3.36f, FP4_SU = 64.f;
__device__ __forceinline__ unsigned fp4_code(float v) {
    const float a = fminf(fabsf(v), 6.f);
    const float c = a < 2.f ? rintf(a * 2.f) : (a < 4.f ? 4.f + rintf(a - 2.f) : 6.f + rintf((a - 4.f) * 0.5f));
    return (unsigned)c | (v < 0.f ? 8u : 0u);
}
typedef unsigned v6u __attribute__((ext_vector_type(6)));
typedef float v32f __attribute__((ext_vector_type(32)));
__device__ __forceinline__ void p0_transpose_item(const float* W, int K, int ld, int col0, bf16* WT, unsigned char* WT8, float sc8, int row0, LAS float* scr, int item, int lane, int ncols,
                                                  const float* kg = nullptr, const float* kb = nullptr, float* cvec = nullptr, float* dvec = nullptr) {
    const int nblk = ncols / 32, kb_ = item / nblk, nb = item % nblk, k0 = 64 * kb_, n0 = 32 * nb;
    { float wv[32];
#pragma unroll
      for (int i = 0; i < 32; ++i) wv[i] = W[(size_t)(k0 + 2 * i + (lane >> 5)) * ld + col0 + n0 + (lane & 31)];
#pragma unroll
      for (int i = 0; i < 32; ++i) scr[(2 * i + (lane >> 5)) * 33 + (lane & 31)] = wv[i]; }
    LDS_WAIT(); asm volatile("" ::: "memory");
    const int c = lane & 7;
#pragma unroll
    for (int j = 0; j < 4; ++j) { const int n = (lane >> 3) + 8 * j; const LAS float* s = scr + (8 * c) * 33 + n;
        float e[8];
#pragma unroll
        for (int i = 0; i < 8; ++i) e[i] = s[i * 33];
        if (kg) { float pc = 0.f, pd = 0.f;
#pragma unroll
            for (int i = 0; i < 8; ++i) { const float g = kg[k0 + 8 * c + i]; pd += e[i] * kb[k0 + 8 * c + i]; e[i] *= g; pc += e[i]; }
            pc += __shfl_xor(pc, 1); pc += __shfl_xor(pc, 2); pc += __shfl_xor(pc, 4); pd += __shfl_xor(pd, 1); pd += __shfl_xor(pd, 2); pd += __shfl_xor(pd, 4);
            if (c == 0) { cvec[kb_ * 1024 + col0 + n0 + n] = pc; dvec[kb_ * 1024 + col0 + n0 + n] = pd; } }
        if (WT) { v4u o; o.x = pk2(e[0], e[1]); o.y = pk2(e[2], e[3]); o.z = pk2(e[4], e[5]); o.w = pk2(e[6], e[7]); *(GAS v4u*)(WT + (size_t)(row0 + n0 + n) * K + k0 + 8 * c) = o; }
        if (WT8) { v2u o; o.x = pk4_fp8(e[0] * sc8, e[1] * sc8, e[2] * sc8, e[3] * sc8); o.y = pk4_fp8(e[4] * sc8, e[5] * sc8, e[6] * sc8, e[7] * sc8); *(GAS v2u*)(WT8 + (size_t)(row0 + n0 + n) * K + k0 + 8 * c) = o; } }
    LDS_WAIT(); asm volatile("" ::: "memory");
}
__device__ __forceinline__ void ln_row(const float* xrow, const float* g, const float* b, bf16* obf, float* of32, int lane) {
    const GAS f32x4* xr = (const GAS f32x4*)xrow + lane;
    f32x4 v[4]; float s = 0.f;
#pragma unroll
    for (int j = 0; j < 4; ++j) { v[j] = xr[64 * j]; s += (v[j].x + v[j].y) + (v[j].z + v[j].w); }
    const float mean = wave_sum(s) * (1.f / D); float s2 = 0.f;
#pragma unroll
    for (int j = 0; j < 4; ++j) { v[j] = v[j] - mean; s2 += (v[j].x * v[j].x + v[j].y * v[j].y) + (v[j].z * v[j].z + v[j].w * v[j].w); }
    const float rstd = 1.f / sqrtf(wave_sum(s2) * (1.f / D) + LN_EPS);
#pragma unroll
    for (int j = 0; j < 4; ++j) { const f32x4 gg = ((const GAS f32x4*)g)[lane + 64 * j], bb = ((const GAS f32x4*)b)[lane + 64 * j];
        const f32x4 y = v[j] * rstd * gg + bb;
        if (obf) ((GAS unsigned long long*)obf)[lane + 64 * j] = (unsigned long long)pk2(y.x, y.y) | ((unsigned long long)pk2(y.z, y.w) << 32);
        if (of32) ((GAS f32x4*)of32)[lane + 64 * j] = y; }
}
__device__ __forceinline__ void ln_row2(const float* xa, const float* xb, const float* g, const float* b, bf16* oa, bf16* ob, unsigned char* oa8, unsigned char* ob8, int lane) {
    const GAS f32x4* pa = (const GAS f32x4*)xa + lane; const GAS f32x4* pb = (const GAS f32x4*)xb + lane;
    f32x4 va[4], vb[4]; float sa = 0.f, sb = 0.f;
#pragma unroll
    for (int j = 0; j < 4; ++j) { va[j] = pa[64 * j]; vb[j] = pb[64 * j]; }
#pragma unroll
    for (int j = 0; j < 4; ++j) { sa += (va[j].x + va[j].y) + (va[j].z + va[j].w); sb += (vb[j].x + vb[j].y) + (vb[j].z + vb[j].w); }
    const float ma = wave_sum(sa) * (1.f / D), mb = wave_sum(sb) * (1.f / D); float qa = 0.f, qb = 0.f;
#pragma unroll
    for (int j = 0; j < 4; ++j) { va[j] = va[j] - ma; vb[j] = vb[j] - mb; qa += (va[j].x * va[j].x + va[j].y * va[j].y) + (va[j].z * va[j].z + va[j].w * va[j].w); qb += (vb[j].x * vb[j].x + vb[j].y * vb[j].y) + (vb[j].z * vb[j].z + vb[j].w * vb[j].w); }
    const float ra = 1.f / sqrtf(wave_sum(qa) * (1.f / D) + LN_EPS), rb = 1.f / sqrtf(wave_sum(qb) * (1.f / D) + LN_EPS);
#pragma unroll
    for (int j = 0; j < 4; ++j) { const f32x4 gg = ((const GAS f32x4*)g)[lane + 64 * j], bb = ((const GAS f32x4*)b)[lane + 64 * j];
        const f32x4 ya = va[j] * ra * gg + bb, yb = vb[j] * rb * gg + bb;
        ((GAS unsigned long long*)oa)[lane + 64 * j] = (unsigned long long)pk2(ya.x, ya.y) | ((unsigned long long)pk2(ya.z, ya.w) << 32);
        ((GAS unsigned long long*)ob)[lane + 64 * j] = (unsigned long long)pk2(yb.x, yb.y) | ((unsigned long long)pk2(yb.z, yb.w) << 32);
        ((GAS unsigned*)oa8)[lane + 64 * j] = pk4_fp8(ya.x, ya.y, ya.z, ya.w); ((GAS unsigned*)ob8)[lane + 64 * j] = pk4_fp8(yb.x, yb.y, yb.z, yb.w); }
}
__device__ __forceinline__ int t5_bucket(int rel) {
    const int ret = rel > 0 ? 16 : 0; const int n = rel < 0 ? -rel : rel; const float nf = (float)(n > 1 ? n : 1);
    int large = 8 + (int)(logf(nf / 8.f) / 4.852030263919617f * 8.f); large = large < 15 ? large : 15;
    return ret + (n < 8 ? n : large);
}

__device__ __forceinline__ void phase0(const Ptrs& P, LAS unsigned char* lds, int tid, int lane, int wave, int G) {
    unsigned char* ws = P.ws;
    const int gw = blockIdx.x * NWAVES + wave, NGW = G * NWAVES;
    { bf16* h0 = (bf16*)(ws + WS_H0);
      unsigned char* h08 = ws + WS_H0F8;
      for (int m = gw; m < NT; m += 2 * NGW) ln_row2(P.in[0] + (size_t)m * D, P.in[0] + (size_t)(m + NGW) * D, P.in[3], P.in[4], h0 + (size_t)m * D, h0 + (size_t)(m + NGW) * D, h08 + (size_t)m * D, h08 + (size_t)(m + NGW) * D, lane); }
    { LAS float* scr = (LAS float*)(lds + wave * 16384);
      bf16* wtin = (bf16*)(ws + WS_WTIN);
      constexpr int I_IN = 23 * 16 * 8, I_A = 8 * 32, I_B = 4 * 32, I_C = 8 * 32, I_SQ = 16 * 32;
      constexpr int NIT = I_IN + I_A + I_B + I_C + 3 * I_SQ;
      unsigned char* wf8 = ws + WS_WF8IN;
      for (int it = gw; it < NIT; it += NGW) {
          int r = it;
          if (r < I_IN) { const int j = r / 128, q = r % 128; int src;
              if (j < 6) src = ((j & 1) ? 1280 : 512) + (j >> 1) * 256; else if (j < 9) src = 2048 + (j - 6) * 256; else if (j < 11) src = 2816 + (j - 9) * 256; else src = 3328 + (j - 11) * 256;
              p0_transpose_item(P.in[5], 1024, 6400, src, nullptr, wf8, W8SC, 1024 + 256 * j, scr, q, lane, 256); continue; }
          r -= I_IN;
          if (r < I_A) { p0_transpose_item(P.in[7], 512, 1024, 0, (bf16*)(ws + WS_WTA), nullptr, 0.f, 0, scr, r, lane, 1024); continue; } r -= I_A;
          if (r < I_B) { p0_transpose_item(P.in[8], 256, 1024, 0, nullptr, ws + WS_WTB, SC_WBC, 0, scr, r, lane, 1024); continue; } r -= I_B;
          if (r < I_C) { p0_transpose_item(P.in[9], 512, 1024, 0, nullptr, ws + WS_WTC, SC_WBC, 0, scr, r, lane, 1024); continue; } r -= I_C;
          if (r < I_SQ) { p0_transpose_item(P.in[10], 1024, 1024, 0, nullptr, ws + WS_WMKVF8, W8SC, 0, scr, r, lane, 1024); continue; } r -= I_SQ;
          if (r < I_SQ) { p0_transpose_item(P.in[11], 1024, 1024, 0, (bf16*)(ws + WS_WTO), nullptr, 0.f, 0, scr, r, lane, 1024); continue; } r -= I_SQ;
          p0_transpose_item(P.in[14], 1024, 1024, 0, (bf16*)(ws + WS_WTPQ), nullptr, 0.f, 0, scr, r, lane, 1024, P.in[12], P.in[13], (float*)(ws + WS_CPART), (float*)(ws + WS_CPART) + 16 * 1024);
      } }
    __syncthreads();
    { LAS float* wt = (LAS float*)lds;
      LAS float* cs = wt + 64 * 129; LAS float* sn = cs + 128;
      if (tid < 128) { float s, c; sincospif((float)tid / 64.f, &s, &c); cs[tid] = c; sn[tid] = s; }
      bf16* wtin = (bf16*)(ws + WS_WTIN);
      unsigned char* wf8 = ws + WS_WF8IN;
      for (int it = blockIdx.x; it < 256; it += G) {
          const int g = it >> 6, k0 = (it & 63) * 16;
          __syncthreads();
          for (int idx = tid; idx < 16 * 128; idx += 512) { const int kk = idx >> 7, c = idx & 127; wt[kk * 129 + c] = P.in[5][(size_t)(k0 + kk) * 6400 + g * 128 + c]; }
          __syncthreads();
          const int cp = tid & 127, kq = tid >> 7;
          float ac[4] = {0.f, 0.f, 0.f, 0.f}, as[4] = {0.f, 0.f, 0.f, 0.f};
#pragma unroll 4
          for (int c = 0; c < 128; ++c) { const int ix = (c * cp) & 127; const float cv = cs[ix], sv = sn[ix];
#pragma unroll
              for (int i = 0; i < 4; ++i) { const float w = wt[(4 * kq + i) * 129 + c]; ac[i] += w * cv; as[i] += w * sv; } }
          { v2u o; o.x = pk2(ac[0], ac[1]); o.y = pk2(ac[2], ac[3]); *(GAS v2u*)(wtin + (size_t)(g * 256 + cp) * 1024 + k0 + 4 * kq) = o;
            v2u q; q.x = pk2(as[0], as[1]); q.y = pk2(as[2], as[3]); *(GAS v2u*)(wtin + (size_t)(g * 256 + 128 + cp) * 1024 + k0 + 4 * kq) = q; }
      }
      __syncthreads();
      { float* bi = (float*)(ws + WS_BIASIN); const float* b_in = P.in[6];
        for (int r = gw; r < 1024; r += NGW) { const int g = r >> 8, w = r & 255, cp = w & 127; const bool isin = w >= 128;
            const int i0 = (lane * cp) & 127, i1 = ((lane + 64) * cp) & 127;
            float a = b_in[g * 128 + lane] * (isin ? sn[i0] : cs[i0]) + b_in[g * 128 + 64 + lane] * (isin ? sn[i1] : cs[i1]);
            a = wave_sum(a); if (lane == 0) bi[r] = a; }
        const int gtid = blockIdx.x * 512 + tid, nth = G * 512;
        for (int r = 1024 + gtid; r < WR_END; r += nth) { const int j = (r - 1024) >> 8, w = (r - 1024) & 255; int src;
            if (j < 6) src = ((j & 1) ? 1280 : 512) + (j >> 1) * 256; else if (j < 9) src = 2048 + (j - 6) * 256; else if (j < 11) src = 2816 + (j - 9) * 256; else src = 3328 + (j - 11) * 256;
            bi[r] = b_in[src + w]; }
        float* bt = (float*)(ws + WS_BIASTAB);
        for (int r = gtid; r < 3 * 4 * 129; r += nth) { const int g = r / (4 * 129), h = (r / 129) & 3, j = r % 129; const int rel = (j - 64) << (2 * g);
            bt[(g * 4 + h) * 132 + j] = P.in[2][t5_bucket(rel) * 12 + g * 4 + h]; }
      }
    }
    { const size_t gt = (size_t)blockIdx.x * 512 + tid, NTH = (size_t)G * 512;
      const GAS f32x4* us = (const GAS f32x4*)P.in[17]; const GAS f32x4* vs = (const GAS f32x4*)P.in[18];
      GAS v2u* ud = (GAS v2u*)(ws + WS_UTAB); GAS v2u* vd = (GAS v2u*)(ws + WS_VTAB);
#if TAB_FP6
      {
        const int njobs = 2 * 16384 * 16;
        for (int job = (int)gt; job < njobs; job += (int)NTH) { const int tb = job >> 18, e = (job >> 4) & 16383, fr = job & 15;
            const float sc = tb ? (TABV_FP4 ? FP4_SV : FP6_SV) : (TABU_FP4 ? FP4_SU : FP6_SU);
            const GAS f32x4* src = (const GAS f32x4*)((tb ? P.in[18] : P.in[17]) + (size_t)e * 1024 + fr * 16);
            f32x4 v[16];
#pragma unroll
            for (int c = 0; c < 4; ++c)
#pragma unroll
                for (int q4 = 0; q4 < 4; ++q4) v[c * 4 + q4] = src[c * 64 + q4];
            if ((TABV_FP4 && tb) || (TABU_FP4 && !tb)) {
                unsigned wd4[8];
#pragma unroll
                for (int w = 0; w < 8; ++w) { unsigned acc4 = 0u;
#pragma unroll
                    for (int t = 0; t < 8; ++t) acc4 |= fp4_code(v[w * 2 + (t >> 2)][t & 3] * sc) << (4 * t);
                    wd4[w] = acc4; }
                unsigned char* dst4 = ws + (tb ? WS_VTAB : WS_UTAB) + (size_t)e * 512 + fr * 16;
#pragma unroll
                for (int p = 0; p < 2; ++p) { v4u o; o.x = wd4[4 * p]; o.y = wd4[4 * p + 1]; o.z = wd4[4 * p + 2]; o.w = wd4[4 * p + 3]; *(GAS v4u*)(dst4 + p * 256) = o; }
                continue; }
            unsigned wd[12];
#pragma unroll
            for (int h = 0; h < 4; ++h) {
                unsigned cd[16];
#pragma unroll
                for (int q4 = 0; q4 < 4; ++q4)
#pragma unroll
                    for (int t = 0; t < 4; ++t) cd[q4 * 4 + t] = fp6_code(v[h * 4 + q4][t] * sc);
                wd[h * 3 + 0] = cd[0] | (cd[1] << 6) | (cd[2] << 12) | (cd[3] << 18) | (cd[4] << 24) | ((cd[5] & 3u) << 30);
                wd[h * 3 + 1] = (cd[5] >> 2) | (cd[6] << 4) | (cd[7] << 10) | (cd[8] << 16) | (cd[9] << 22) | ((cd[10] & 15u) << 28);
                wd[h * 3 + 2] = (cd[10] >> 4) | (cd[11] << 2) | (cd[12] << 8) | (cd[13] << 14) | (cd[14] << 20) | (cd[15] << 26); }
            unsigned char* dst = ws + (tb ? WS_VTAB : WS_UTAB) + (size_t)e * 768 + fr * 16;
#pragma unroll
            for (int p = 0; p < 3; ++p) { v4u o; o.x = wd[4 * p]; o.y = wd[4 * p + 1]; o.z = wd[4 * p + 2]; o.w = wd[4 * p + 3]; *(GAS v4u*)(dst + p * 256) = o; } } }
#endif
      const GAS f32x4* ms = (const GAS f32x4*)P.in[1]; GAS unsigned* md = (GAS unsigned*)(ws + WS_MEMF8);
      for (size_t i = gt; i < (size_t)512 * 1024 / 4; i += NTH) { const f32x4 a = ms[i]; md[i] = pk4_fp8(a.x, a.y, a.z, a.w); }
    }
}

constexpr int FFT_PITCH = 544, FFT_BUF = 128 * FFT_PITCH;
static_assert(2 * FFT_BUF <= MISC_OFF, "FFT LDS map");
typedef short s16x4 __attribute__((ext_vector_type(4)));
__device__ __forceinline__ s16x4 tr_read(LAS unsigned char* p) { return __builtin_amdgcn_ds_read_tr16_b64_v4i16((LAS s16x4*)p); }
template <int STEP>
__device__ __forceinline__ void fft_step_mfma(const bf16* src, bf16* dst, LAS unsigned char* lds, int tid, int lane, int wave, int G) {
    const int fr = lane & 15, kq = lane >> 4, kout = 16 * wave + fr;
    bf16x8 cf[4], sf[4];
    { LAS float* tab = (LAS float*)(lds + FFT_BUF);
      __syncthreads();
      if (tid < 128) { float sn, cs; sincospif((float)tid / 64.f, &sn, &cs); tab[tid] = cs; tab[128 + tid] = sn; }
      __syncthreads();
#pragma unroll
      for (int kk = 0; kk < 4; ++kk) { v4u cw, sw; unsigned cl[8], sl[8];
#pragma unroll
          for (int j = 0; j < 8; ++j) { const int sv = 32 * kk + (j < 4 ? 4 * kq + j : 16 + 4 * kq + j - 4); const int ix = (kout * sv) & 127; cl[j] = f2bf(tab[ix]); sl[j] = f2bf(tab[128 + ix]); }
          cw.x = cl[0] | (cl[1] << 16); cw.y = cl[2] | (cl[3] << 16); cw.z = cl[4] | (cl[5] << 16); cw.w = cl[6] | (cl[7] << 16);
          sw.x = sl[0] | (sl[1] << 16); sw.y = sl[2] | (sl[3] << 16); sw.z = sl[4] | (sl[5] << 16); sw.w = sl[6] | (sl[7] << 16);
          cf[kk] = __builtin_bit_cast(bf16x8, cw); sf[kk] = __builtin_bit_cast(bf16x8, sw); } }
    v4u iw[8];
#define FFT_LOAD(UN) do { const int b_ = (UN) >> 9, f_ = ((UN) >> 2) & 127, g_ = (UN) & 3; _Pragma("unroll") for (int j = 0; j < 8; ++j) { const int c = tid + 512 * j; const int sr = c >> 5, piece = c & 31; \
            const size_t row = (STEP == 1) ? (size_t)(b_ << 14) + 128 * sr + f_ : (size_t)(b_ << 14) + 128 * f_ + sr; iw[j] = *(const GAS v4u*)(src + row * 1024 + g_ * 256 + piece * 8); } } while (0)
#define FFT_PUT(BUF) do { _Pragma("unroll") for (int j = 0; j < 8; ++j) { const int c = tid + 512 * j; *(LAS v4u*)(lds + (BUF) * FFT_BUF + (c >> 5) * FFT_PITCH + (c & 31) * 16) = iw[j]; } } while (0)
    __syncthreads();
    if (blockIdx.x < 1024) { FFT_LOAD(blockIdx.x); FFT_PUT(0); }
    __syncthreads();
    int cur = 0;
    for (int unit = blockIdx.x; unit < 1024; unit += G) {
        const int b = unit >> 9, f = (unit >> 2) & 127, g = unit & 3;
        const bool more = unit + G < 1024;
        if (more) FFT_LOAD(unit + G);
        LAS unsigned char* img = lds + cur * FFT_BUF;
        f32x4 accR[8], accI[8];
#pragma unroll
        for (int mt = 0; mt < 8; ++mt) { accR[mt] = (f32x4){0.f, 0.f, 0.f, 0.f}; accI[mt] = (f32x4){0.f, 0.f, 0.f, 0.f}; }
#pragma unroll
        for (int mt = 0; mt < 8; ++mt)
#pragma unroll
            for (int kk = 0; kk < 4; ++kk) {
                LAS unsigned char* a1 = img + (32 * kk + 4 * kq + (fr >> 2)) * FFT_PITCH + (16 * mt + 4 * (fr & 3)) * 2;
                LAS unsigned char* a2 = a1 + 16 * FFT_PITCH;
                const s16x4 r0 = tr_read(a1), r1 = tr_read(a2), i0 = tr_read(a1 + 256), i1 = tr_read(a2 + 256);
                const bf16x8 xr = __builtin_shufflevector(r0, r1, 0, 1, 2, 3, 4, 5, 6, 7), xi = __builtin_shufflevector(i0, i1, 0, 1, 2, 3, 4, 5, 6, 7);
                if (STEP == 1) {
                    v4u t = __builtin_bit_cast(v4u, xi); t.x ^= 0x80008000u; t.y ^= 0x80008000u; t.z ^= 0x80008000u; t.w ^= 0x80008000u; const bf16x8 nxi = __builtin_bit_cast(bf16x8, t);
                    accR[mt] = __builtin_amdgcn_mfma_f32_16x16x32_bf16(xr, cf[kk], accR[mt], 0, 0, 0); accR[mt] = __builtin_amdgcn_mfma_f32_16x16x32_bf16(nxi, sf[kk], accR[mt], 0, 0, 0);
                    accI[mt] = __builtin_amdgcn_mfma_f32_16x16x32_bf16(xi, cf[kk], accI[mt], 0, 0, 0); accI[mt] = __builtin_amdgcn_mfma_f32_16x16x32_bf16(xr, sf[kk], accI[mt], 0, 0, 0);
                } else {
                    accR[mt] = __builtin_amdgcn_mfma_f32_16x16x32_bf16(xr, cf[kk], accR[mt], 0, 0, 0); accR[mt] = __builtin_amdgcn_mfma_f32_16x16x32_bf16(xi, sf[kk], accR[mt], 0, 0, 0);
                }
                if (kk == 3) __builtin_amdgcn_sched_barrier(0);
            }
        if (STEP == 1) { float ws_, wc_; sincospif(-(float)(f * kout) / 8192.f, &ws_, &wc_);
            bf16* orow = dst + ((size_t)(b << 14) + kout * 128 + f) * 1024 + g * 256 + 4 * kq;
#pragma unroll
            for (int mt = 0; mt < 8; ++mt) { v2u re, im; re.x = pk2(accR[mt][0] * wc_ + accI[mt][0] * ws_, accR[mt][1] * wc_ + accI[mt][1] * ws_); re.y = pk2(accR[mt][2] * wc_ + accI[mt][2] * ws_, accR[mt][3] * wc_ + accI[mt][3] * ws_);
                im.x = pk2(accR[mt][0] * ws_ - accI[mt][0] * wc_, accR[mt][1] * ws_ - accI[mt][1] * wc_); im.y = pk2(accR[mt][2] * ws_ - accI[mt][2] * wc_, accR[mt][3] * ws_ - accI[mt][3] * wc_);
                *(GAS v2u*)(orow + 16 * mt) = re; *(GAS v2u*)(orow + 128 + 16 * mt) = im; }
        } else { const float scale = 6.905339660024878e-4f;
            bf16* orow = dst + ((size_t)(b << 14) + f + 128 * kout) * 512 + g * 128 + 4 * kq;
#pragma unroll
            for (int mt = 0; mt < 8; ++mt) { v2u re; re.x = pk2(accR[mt][0] * scale, accR[mt][1] * scale); re.y = pk2(accR[mt][2] * scale, accR[mt][3] * scale); *(GAS v2u*)(orow + 16 * mt) = re; }
        }
        if (more) FFT_PUT(cur ^ 1);
        __syncthreads();
        cur ^= 1;
    }
#undef FFT_LOAD
#undef FFT_PUT
}

typedef float f32x16 __attribute__((ext_vector_type(16)));
constexpr int DA_BT = 0, DA_K = 9216, DA_KP = 144, DA_V = DA_K + 384 * DA_KP, DA_VP = 776;
static_assert(DA_V + 64 * DA_VP <= MISC_OFF, "dil-attn LDS map");
template <int T>
__device__ __forceinline__ void dil_tile(LAS unsigned char* lds, int kr0, int r31, int hh, const LAS float* btl, const bf16x8 (&qf)[4], f32x16& o0, f32x16& o1, float& mx, float& den) {
    const LAS unsigned char* kp = lds + DA_K + (kr0 + r31) * DA_KP + 16 * hh;
    f32x16 sacc;
#pragma unroll
    for (int i = 0; i < 16; ++i) sacc[i] = 0.f;
#pragma unroll
    for (int kk = 0; kk < 4; ++kk) { const bf16x8 kf = *(const LAS bf16x8*)(kp + 32 * kk); sacc = __builtin_amdgcn_mfma_f32_32x32x16_bf16(kf, qf[kk], sacc, 0, 0, 0); }
    const LAS float* bl = btl + (32 + 32 * T + 4 * hh - r31);
    float tmax = -INFINITY;
#pragma unroll
    for (int i = 0; i < 16; ++i) { const int krow = (i & 3) + 8 * (i >> 2);
        float sv = sacc[i] * 0.18033688011112042f + bl[krow];
        if (T == 0) sv = (krow + 4 * hh >= r31) ? sv : -INFINITY;
        if (T == 4) sv = (krow + 4 * hh <= r31) ? sv : -INFINITY;
        sacc[i] = sv; tmax = fmaxf(tmax, sv); }
    tmax = fmaxf(tmax, __shfl_xor(tmax, 32));
    const float mn = fmaxf(mx, tmax), corr = __builtin_amdgcn_exp2f(mx - mn); mx = mn;
    float psum = 0.f;
#pragma unroll
    for (int i = 0; i < 16; ++i) { const float p = __builtin_amdgcn_exp2f(sacc[i] - mn); sacc[i] = p; psum += p; }
    den = den * corr + psum;
#pragma unroll
    for (int i = 0; i < 16; ++i) { o0[i] *= corr; o1[i] *= corr; }
#pragma unroll
    for (int s2 = 0; s2 < 2; ++s2) { v4u pw; pw.x = pk2(sacc[8 * s2], sacc[8 * s2 + 1]); pw.y = pk2(sacc[8 * s2 + 2], sacc[8 * s2 + 3]); pw.z = pk2(sacc[8 * s2 + 4], sacc[8 * s2 + 5]); pw.w = pk2(sacc[8 * s2 + 6], sacc[8 * s2 + 7]);
        const bf16x8 pf = __builtin_bit_cast(bf16x8, pw);
        const LAS unsigned char* vp = lds + DA_V + r31 * DA_VP + (kr0 + 16 * s2 + 4 * hh) * 2;
        const v2u lo0 = *(const LAS v2u*)vp, hi0 = *(const LAS v2u*)(vp + 16), lo1 = *(const LAS v2u*)(vp + 32 * DA_VP), hi1 = *(const LAS v2u*)(vp + 32 * DA_VP + 16);
        v4u w0, w1; w0.x = lo0.x; w0.y = lo0.y; w0.z = hi0.x; w0.w = hi0.y; w1.x = lo1.x; w1.y = lo1.y; w1.z = hi1.x; w1.w = hi1.y;
        o0 = __builtin_amdgcn_mfma_f32_32x32x16_bf16(__builtin_bit_cast(bf16x8, w0), pf, o0, 0, 0, 0);
        o1 = __builtin_amdgcn_mfma_f32_32x32x16_bf16(__builtin_bit_cast(bf16x8, w1), pf, o1, 0, 0, 0); }
}
__device__ __forceinline__ void dil_attn_lds(const bf16* qk, const bf16* vt, const float* btab_g, bf16* og, float* lse, LAS unsigned char* lds, int tid, int lane, int wave, int G) {
    LAS float* bt = (LAS float*)(lds + DA_BT);
    __syncthreads();
    for (int i = tid; i < 12 * 192; i += 512) { const int tb = i / 192, j = i - tb * 192 - 32; bt[i] = (j >= 0 && j <= 128) ? btab_g[tb * 132 + j] * 1.4426950408889634f : 0.f; }
    const int r31 = lane & 31, hh = lane >> 5;
    v4u kw[6], vw[6]; bf16x8 qn[4];
#define DIL_UNIT(U) const int blk = (U) & 63, hd = ((U) >> 6) & 3, g = ((U) >> 8) % 3, b = (U) / 768; const int sh = 2 * g, sub = 16384 >> sh; \
        const int nl0 = blk * 256, rr = nl0 >> (14 - sh), l0 = nl0 & (sub - 1); const size_t seq0 = ((size_t)g * NT + (size_t)(b << 14) + (size_t)rr * sub); \
        const bf16* qkg = qk + seq0 * 512; const bf16* vtg = vt + ((size_t)g * 256 + hd * 64) * NT + (size_t)(b << 14) + (size_t)rr * sub;
#define DIL_LOAD() do { _Pragma("unroll") for (int j = 0; j < 6; ++j) { const int c = tid + 512 * j; const int kr = c >> 3, pc = c & 7; const int lk = l0 - 64 + kr; const int lkc = lk < 0 ? 0 : (lk >= sub ? sub - 1 : lk); \
              kw[j] = *(const GAS v4u*)(qkg + (size_t)lkc * 512 + 256 + hd * 64 + pc * 8); \
              const int d = c / 48, pv = c - d * 48; const int lv = l0 - 64 + pv * 8; const int lvc = lv < 0 ? 0 : (lv >= sub ? sub - 8 : lv); \
              vw[j] = *(const GAS v4u*)(vtg + (size_t)d * NT + lvc); } \
          _Pragma("unroll") for (int kk = 0; kk < 4; ++kk) qn[kk] = *(const GAS bf16x8*)(qkg + (size_t)(l0 + 32 * wave + (lane & 31)) * 512 + hd * 64 + 16 * kk + 8 * (lane >> 5)); } while (0)
    if (blockIdx.x < 1536) { DIL_UNIT(blockIdx.x) DIL_LOAD(); }
    for (int u = blockIdx.x; u < 1536; u += G) {
        DIL_UNIT(u)
        __syncthreads();
#pragma unroll
        for (int j = 0; j < 6; ++j) { const int c = tid + 512 * j; const int kr = c >> 3, pc = c & 7;
            *(LAS v4u*)(lds + DA_K + kr * DA_KP + pc * 16) = kw[j];
            const int d = c / 48, pv = c - d * 48;
            v2u lo, hi; lo.x = vw[j].x; lo.y = vw[j].y; hi.x = vw[j].z; hi.y = vw[j].w;
            *(LAS v2u*)(lds + DA_V + d * DA_VP + pv * 16) = lo; *(LAS v2u*)(lds + DA_V + d * DA_VP + pv * 16 + 8) = hi; }
        __syncthreads();
        bf16x8 qf[4];
#pragma unroll
        for (int kk = 0; kk < 4; ++kk) qf[kk] = qn[kk];
        if (u + G < 1536) { const int un = u + G; const int blkn = un & 63, hdn = (un >> 6) & 3, gn = (un >> 8) % 3, bn = un / 768; const int shn = 2 * gn, subn = 16384 >> shn;
            const int nl0n = blkn * 256, rrn = nl0n >> (14 - shn), l0n = nl0n & (subn - 1); const size_t seq0n = ((size_t)gn * NT + (size_t)(bn << 14) + (size_t)rrn * subn);
            const bf16* qkgn = qk + seq0n * 512; const bf16* vtgn = vt + ((size_t)gn * 256 + hdn * 64) * NT + (size_t)(bn << 14) + (size_t)rrn * subn;
#pragma unroll
            for (int j = 0; j < 6; ++j) { const int c = tid + 512 * j; const int kr = c >> 3, pc = c & 7; const int lk = l0n - 64 + kr; const int lkc = lk < 0 ? 0 : (lk >= subn ? subn - 1 : lk);
                kw[j] = *(const GAS v4u*)(qkgn + (size_t)lkc * 512 + 256 + hdn * 64 + pc * 8);
                const int d = c / 48, pv = c - d * 48; const int lv = l0n - 64 + pv * 8; const int lvc = lv < 0 ? 0 : (lv >= subn ? subn - 8 : lv);
                vw[j] = *(const GAS v4u*)(vtgn + (size_t)d * NT + lvc); }
#pragma unroll
            for (int kk = 0; kk < 4; ++kk) qn[kk] = *(const GAS bf16x8*)(qkgn + (size_t)(l0n + 32 * wave + (lane & 31)) * 512 + hdn * 64 + 16 * kk + 8 * (lane >> 5)); }
        const int lq0 = l0 + 32 * wave;
        const LAS float* btl = bt + (g * 4 + hd) * 192;
        f32x16 o0, o1;
#pragma unroll
        for (int i = 0; i < 16; ++i) { o0[i] = 0.f; o1[i] = 0.f; }
        float mx = -1e30f, den = 0.f;
        if (lq0 - 64 >= 0) dil_tile<0>(lds, 32 * wave, r31, hh, btl, qf, o0, o1, mx, den);
        if (lq0 - 32 >= 0) dil_tile<1>(lds, 32 * wave + 32, r31, hh, btl, qf, o0, o1, mx, den);
        dil_tile<2>(lds, 32 * wave + 64, r31, hh, btl, qf, o0, o1, mx, den);
        if (lq0 + 32 < sub) dil_tile<3>(lds, 32 * wave + 96, r31, hh, btl, qf, o0, o1, mx, den);
        if (lq0 + 64 < sub) dil_tile<4>(lds, 32 * wave + 128, r31, hh, btl, qf, o0, o1, mx, den);
        den += __shfl_xor(den, 32);
        const float inv = 1.f / den;
        const size_t n = seq0 + lq0 + r31;
        bf16* orow = og + n * 256 + hd * 64 + 4 * hh;
#pragma unroll
        for (int q4 = 0; q4 < 4; ++q4) { v2u w0, w1; w0.x = pk2(o0[4 * q4] * inv, o0[4 * q4 + 1] * inv); w0.y = pk2(o0[4 * q4 + 2] * inv, o0[4 * q4 + 3] * inv);
            w1.x = pk2(o1[4 * q4] * inv, o1[4 * q4 + 1] * inv); w1.y = pk2(o1[4 * q4 + 2] * inv, o1[4 * q4 + 3] * inv);
            *(GAS v2u*)(orow + 8 * q4) = w0; *(GAS v2u*)(orow + 32 + 8 * q4) = w1; }
        if (hh == 0) lse[n * 4 + hd] = (mx + __builtin_amdgcn_logf(den)) * 0.6931471805599453f;
    }
    __syncthreads();
#undef DIL_UNIT
#undef DIL_LOAD
}
constexpr int MA_KP = 272, MA_VP = 520, MA_V = 256 * MA_KP;
static_assert(MA_V + 128 * MA_VP <= MISC_OFF, "mem-attn LDS map");
__device__ __forceinline__ void mem_attn_lds(const bf16* qc, const bf16* memk, const bf16* vtm, bf16* ycin, LAS unsigned char* lds, int tid, int lane, int wave, int G) {
    const int r31 = lane & 31, hh = lane >> 5;
    for (int wu = blockIdx.x; wu < 256; wu += G) {
        const int combo = wu & 7, b = combo >> 2, hd = combo & 3, chunk = wu >> 3;
        __syncthreads();
        { v4u kw[8], vw[8];
#pragma unroll
          for (int j = 0; j < 8; ++j) { const int c = tid + 512 * j; kw[j] = *(const GAS v4u*)(memk + (size_t)(b * 256 + (c >> 4)) * 512 + hd * 128 + (c & 15) * 8);
              vw[j] = *(const GAS v4u*)(vtm + (size_t)(hd * 128 + (c >> 5)) * 512 + b * 256 + (c & 31) * 8); }
#pragma unroll
          for (int j = 0; j < 8; ++j) { const int c = tid + 512 * j; *(LAS v4u*)(lds + (c >> 4) * MA_KP + (c & 15) * 16) = kw[j];
              v2u lo, hi; lo.x = vw[j].x; lo.y = vw[j].y; hi.x = vw[j].z; hi.y = vw[j].w;
              *(LAS v2u*)(lds + MA_V + (c >> 5) * MA_VP + (c & 31) * 16) = lo; *(LAS v2u*)(lds + MA_V + (c >> 5) * MA_VP + (c & 31) * 16 + 8) = hi; } }
        __syncthreads();
#pragma unroll 1
        for (int qi = 0; qi < 2; ++qi) {
            const int blk = chunk * 16 + wave * 2 + qi;
            const size_t tok = (size_t)(b << 14) + blk * 32 + r31;
            const bf16* qrow = qc + tok * 512 + hd * 128 + 8 * hh;
            bf16x8 qf[8];
#pragma unroll
            for (int kk = 0; kk < 8; ++kk) qf[kk] = *(const GAS bf16x8*)(qrow + 16 * kk);
            f32x16 o[4];
#pragma unroll
            for (int mt = 0; mt < 4; ++mt)
#pragma unroll
                for (int i = 0; i < 16; ++i) o[mt][i] = 0.f;
            float mx = -1e30f, den = 0.f;
            const LAS unsigned char* kb = lds + r31 * MA_KP + 16 * hh;
            const LAS unsigned char* vb = lds + MA_V + r31 * MA_VP + 8 * hh;
#pragma unroll 1
            for (int t = 0; t < 8; ++t) {
                f32x16 sacc;
#pragma unroll
                for (int i = 0; i < 16; ++i) sacc[i] = 0.f;
#pragma unroll
                for (int kk = 0; kk < 8; ++kk) { const bf16x8 kf = *(const LAS bf16x8*)(kb + (32 * t) * MA_KP + 32 * kk); sacc = __builtin_amdgcn_mfma_f32_32x32x16_bf16(kf, qf[kk], sacc, 0, 0, 0); }
                float tmax = -INFINITY;
#pragma unroll
                for (int i = 0; i < 16; ++i) { sacc[i] *= 0.08838834764831845f; tmax = fmaxf(tmax, sacc[i]); }
                tmax = fmaxf(tmax, __shfl_xor(tmax, 32));
                const float mn = fmaxf(mx, tmax), corr = __expf(mx - mn); mx = mn;
                float psum = 0.f;
#pragma unroll
                for (int i = 0; i < 16; ++i) { const float p = __expf(sacc[i] - mn); sacc[i] = p; psum += p; }
                den = den * corr + psum;
#pragma unroll
                for (int mt = 0; mt < 4; ++mt)
#pragma unroll
                    for (int i = 0; i < 16; ++i) o[mt][i] *= corr;
#pragma unroll
                for (int s2 = 0; s2 < 2; ++s2) { v4u pw; pw.x = pk2(sacc[8 * s2], sacc[8 * s2 + 1]); pw.y = pk2(sacc[8 * s2 + 2], sacc[8 * s2 + 3]); pw.z = pk2(sacc[8 * s2 + 4], sacc[8 * s2 + 5]); pw.w = pk2(sacc[8 * s2 + 6], sacc[8 * s2 + 7]);
                    const bf16x8 pf = __builtin_bit_cast(bf16x8, pw);
#pragma unroll
                    for (int mt = 0; mt < 4; ++mt) { const LAS unsigned char* vp = vb + (32 * mt) * MA_VP + (32 * t + 16 * s2) * 2;
                        const v2u lo = *(const LAS v2u*)vp, hi = *(const LAS v2u*)(vp + 16);
                        v4u w; w.x = lo.x; w.y = lo.y; w.z = hi.x; w.w = hi.y;
                        o[mt] = __builtin_amdgcn_mfma_f32_32x32x16_bf16(__builtin_bit_cast(bf16x8, w), pf, o[mt], 0, 0, 0); } }
            }
            den += __shfl_xor(den, 32);
            const float inv = 1.f / den;
            unsigned char* orow = (unsigned char*)ycin + tok * 512 + hd * 128 + 4 * hh; const float inv4 = inv * SC_ACT;
#pragma unroll
            for (int mt = 0; mt < 4; ++mt)
#pragma unroll
                for (int q4 = 0; q4 < 4; ++q4) *(GAS unsigned*)(orow + 32 * mt + 8 * q4) = pk4_fp8(o[mt][4 * q4] * inv4, o[mt][4 * q4 + 1] * inv4, o[mt][4 * q4 + 2] * inv4, o[mt][4 * q4 + 3] * inv4);
        }
    }
    __syncthreads();
}
__device__ __forceinline__ void combine_groups(const bf16* og, const float* lse, bf16* ob, int tid, int G) {
    for (size_t idx = (size_t)blockIdx.x * 512 + tid; idx < (size_t)NT * 32; idx += (size_t)G * 512) {
        const int t = (int)(idx >> 5), ch = (int)(idx & 31), h = ch >> 3, d0 = (ch & 7) * 8, b = t >> 14, s = t & 16383;
        float l[3]; size_t n[3];
#pragma unroll
        for (int g = 0; g < 3; ++g) { const int sh = 2 * g; n[g] = (size_t)(b << 14) + (size_t)(s & ((1 << sh) - 1)) * (16384 >> sh) + (s >> sh); l[g] = lse[((size_t)g * NT + n[g]) * 4 + h]; }
        const float mx = fmaxf(l[0], fmaxf(l[1], l[2])); float w[3], sum = 0.f;
#pragma unroll
        for (int g = 0; g < 3; ++g) { w[g] = __expf(l[g] - mx); sum += w[g]; }
        float o[8] = {0, 0, 0, 0, 0, 0, 0, 0};
#pragma unroll
        for (int g = 0; g < 3; ++g) { const float wg = w[g] / sum; const v4u v = *(const GAS v4u*)(og + ((size_t)g * NT + n[g]) * 256 + h * 64 + d0);
            o[0] += wg * bflo(v.x); o[1] += wg * bfhi(v.x); o[2] += wg * bflo(v.y); o[3] += wg * bfhi(v.y); o[4] += wg * bflo(v.z); o[5] += wg * bfhi(v.z); o[6] += wg * bflo(v.w); o[7] += wg * bfhi(v.w); }
        v2u r; r.x = pk4_fp8(o[0] * SC_ACT, o[1] * SC_ACT, o[2] * SC_ACT, o[3] * SC_ACT); r.y = pk4_fp8(o[4] * SC_ACT, o[5] * SC_ACT, o[6] * SC_ACT, o[7] * SC_ACT);
        *(GAS v2u*)((unsigned char*)ob + (size_t)t * 256 + h * 64 + d0) = r;
    }
}

template <int C> __device__ __forceinline__ unsigned dppu(unsigned v) { return (unsigned)__builtin_amdgcn_update_dpp(0, (int)v, C, 0xF, 0xF, true); }
template <int C> __device__ __forceinline__ float dppf(float v) { return __builtin_bit_cast(float, __builtin_amdgcn_update_dpp(0, __builtin_bit_cast(int, v), C, 0xF, 0xF, true)); }
__device__ __forceinline__ unsigned umax2(unsigned a, unsigned b) { return a > b ? a : b; }
__device__ __forceinline__ unsigned row_max_u(unsigned v) { v = umax2(v, dppu<0xB1>(v)); v = umax2(v, dppu<0x4E>(v)); v = umax2(v, dppu<0x141>(v)); v = umax2(v, dppu<0x140>(v)); return v; }
__device__ __forceinline__ float row_max_f(float v) { v = fmaxf(v, dppf<0xB1>(v)); v = fmaxf(v, dppf<0x4E>(v)); v = fmaxf(v, dppf<0x141>(v)); v = fmaxf(v, dppf<0x140>(v)); return v; }
__device__ __forceinline__ float row_sum_f(float v) { v += dppf<0xB1>(v); v += dppf<0x4E>(v); v += dppf<0x141>(v); v += dppf<0x140>(v); return v; }
__device__ __forceinline__ unsigned ordf(float f) { const unsigned b = __builtin_bit_cast(unsigned, f); return b ^ ((unsigned)((int)b >> 31) | 0x80000000u); }
__device__ __forceinline__ float decf(unsigned k) { const unsigned b = (k & 0x80000000u) ? (k ^ 0x80000000u) : ~k; return __builtin_bit_cast(float, b); }
__device__ __forceinline__ unsigned bperm(unsigned v, int src_lane) { return (unsigned)__builtin_amdgcn_ds_bpermute(src_lane * 4, (int)v); }
typedef __bf16 bf16x2_t __attribute__((ext_vector_type(2)));
__device__ __forceinline__ float dot2bf(unsigned a, unsigned b, float c) { return __builtin_amdgcn_fdot2_f32_bf16(__builtin_bit_cast(bf16x2_t, a), __builtin_bit_cast(bf16x2_t, b), c, false); }

__device__ __forceinline__ float gelu_as(float v) {
    const float av = fabsf(v), t = __builtin_amdgcn_rcpf(av * 0.2316418882f + 1.0f);
    float q = t * 0.5307027145f + (-0.7265760135f); q = q * t + 0.7107068705f; q = q * t + (-0.142248368f); q = q * t + 0.127414796f; q = q * t;
    const float e = __builtin_amdgcn_exp2f((v * v) * (-0.72134752044f));
    const float m = v * (q * e);
    return v < 0.f ? m : v - m;
}
constexpr int PEER_SKB = 0, PEER_EL = 36864, PEER_PTAB = PEER_EL + 32768;
__device__ __forceinline__ void peer_scores_top16(const bf16* qp, LAS unsigned char* lds, int tokb, int hf, int fr, int fq, unsigned& o0, unsigned& o1, unsigned& o2, unsigned& o3) {
    const bf16* arow = qp + (size_t)(tokb + (fr >> 3)) * 1024 + (fr & 7) * 128 + hf * 64 + 8 * fq;
    const bf16x8 a0 = *(const GAS bf16x8*)arow, a1 = *(const GAS bf16x8*)(arow + 32);
    unsigned e0[8], e1[8], e2[8], e3[8];
#pragma unroll
    for (int nb = 0; nb < 8; ++nb) {
        const LAS unsigned char* bp = lds + PEER_SKB + hf * 18432 + (fr + 16 * nb) * 144 + fq * 16;
        const bf16x8 b0 = *(const LAS bf16x8*)bp, b1 = *(const LAS bf16x8*)(bp + 64);
        f32x4 acc = (f32x4){0.f, 0.f, 0.f, 0.f};
        acc = __builtin_amdgcn_mfma_f32_16x16x32_bf16(a0, b0, acc, 0, 0, 0);
        acc = __builtin_amdgcn_mfma_f32_16x16x32_bf16(a1, b1, acc, 0, 0, 0);
        const unsigned ix = (unsigned)(127 - (fr + 16 * nb));
        e0[nb] = (ordf(acc[0]) & ~127u) | ix; e1[nb] = (ordf(acc[1]) & ~127u) | ix; e2[nb] = (ordf(acc[2]) & ~127u) | ix; e3[nb] = (ordf(acc[3]) & ~127u) | ix;
    }
    o0 = 0u; o1 = 0u; o2 = 0u; o3 = 0u;
#define PEER_CE(E, A, B) do { const unsigned hi_ = umax2(E[A], E[B]), lo_ = E[A] < E[B] ? E[A] : E[B]; E[A] = hi_; E[B] = lo_; } while (0)
#define PEER_SORT8(E) do { PEER_CE(E, 0, 1); PEER_CE(E, 2, 3); PEER_CE(E, 4, 5); PEER_CE(E, 6, 7); PEER_CE(E, 0, 2); PEER_CE(E, 1, 3); PEER_CE(E, 4, 6); PEER_CE(E, 5, 7); PEER_CE(E, 1, 2); PEER_CE(E, 5, 6); \
        PEER_CE(E, 0, 4); PEER_CE(E, 1, 5); PEER_CE(E, 2, 6); PEER_CE(E, 3, 7); PEER_CE(E, 2, 4); PEER_CE(E, 3, 5); PEER_CE(E, 1, 2); PEER_CE(E, 3, 4); PEER_CE(E, 5, 6); } while (0)
#define PEER_ROUND(E, O) do { const unsigned m = row_max_u(E[0]); const bool win = (E[0] == m); \
        E[0] = win ? E[1] : E[0]; E[1] = win ? E[2] : E[1]; E[2] = win ? E[3] : E[2]; E[3] = win ? E[4] : E[3]; E[4] = win ? E[5] : E[4]; E[5] = win ? E[6] : E[5]; E[6] = win ? E[7] : E[6]; E[7] = win ? 0u : E[7]; \
        O = (fr == r) ? m : O; } while (0)
    PEER_SORT8(e0); PEER_SORT8(e1); PEER_SORT8(e2); PEER_SORT8(e3);
#pragma unroll 1
    for (int r = 0; r < 16; ++r) { PEER_ROUND(e0, o0); PEER_ROUND(e1, o1); PEER_ROUND(e2, o2); PEER_ROUND(e3, o3); }
#undef PEER_ROUND
#undef PEER_SORT8
#undef PEER_CE
}
__device__ __forceinline__ void peer_cand(LAS unsigned char* lds, LAS unsigned char* el, unsigned ptab, unsigned L1, unsigned L2, int lane, int fr, int slot) {
    unsigned c0, c1, c2, c3;
#define PEER_CK(SL, C) do { const unsigned byte = (ptab >> (8 * SL)) & 255u; const int a = byte >> 4, b = byte & 15; \
        const unsigned k1 = bperm(L1, (lane & 48) + a), k2 = bperm(L2, (lane & 48) + b); const float sum = decf(k1 & ~127u) + decf(k2 & ~127u); \
        C = (byte != 255u) ? ((ordf(sum) & ~63u) | (unsigned)(fr * 4 + SL)) : 0u; } while (0)
    PEER_CK(0, c0); PEER_CK(1, c1); PEER_CK(2, c2); PEER_CK(3, c3);
#undef PEER_CK
    unsigned co = 0u;
#define PEER_CE2(A, B) do { const unsigned hi_ = umax2(A, B), lo_ = A < B ? A : B; A = hi_; B = lo_; } while (0)
    PEER_CE2(c0, c1); PEER_CE2(c2, c3); PEER_CE2(c0, c2); PEER_CE2(c1, c3); PEER_CE2(c1, c2);
#undef PEER_CE2
#pragma unroll 1
    for (int r = 0; r < 16; ++r) { const unsigned m = row_max_u(c0); const bool win = (c0 == m);
        c0 = win ? c1 : c0; c1 = win ? c2 : c1; c2 = win ? c3 : c2; c3 = win ? 0u : c3;
        co = (fr == r) ? m : co; }
    const unsigned pb = *(LAS unsigned char*)(lds + PEER_PTAB + (co & 63u));
    const unsigned k1 = bperm(L1, (lane & 48) + (int)(pb >> 4)), k2 = bperm(L2, (lane & 48) + (int)(pb & 15u));
    const unsigned expert = (127u - (k1 & 127u)) * 128u + (127u - (k2 & 127u));
    const float sc = decf(co & ~63u);
    const float ex = __expf(sc - row_max_f(sc));
    const float gate = ex / row_sum_f(ex);
    v2u rec; rec.x = expert; rec.y = __builtin_bit_cast(unsigned, gate);
    *(LAS v2u*)(el + slot * 8) = rec;
}
__device__ __forceinline__ void peer_v2(const Ptrs& P, LAS unsigned char* lds, int tid, int lane, int wave, int G) {
    unsigned char* ws = P.ws;
    const bf16* qp = (const bf16*)(ws + WS_QP); const bf16* utab = (const bf16*)(ws + WS_UTAB); const bf16* vtab = (const bf16*)(ws + WS_VTAB);
    const bf16* h1b = (const bf16*)(ws + WS_H1B);
    const int fr = lane & 15, fq = lane >> 4;
    for (int idx = tid; idx < 2 * 128 * 32; idx += 512) { const int hf = idx >> 12, k = (idx >> 5) & 127, c2 = idx & 31; const float* sk = (hf ? P.in[16] : P.in[15]) + k * 64 + c2 * 2;
        *(LAS unsigned*)(lds + PEER_SKB + hf * 18432 + k * 144 + c2 * 4) = pk2(sk[0], sk[1]); }
    if (tid < 64) { int q = 0, a = 0, b = 0; unsigned char val = 0xFF;
        for (a = 0; a < 16 && val == 0xFF; ++a) for (b = 0; b < 16 && (a + 1) * (b + 1) <= 16; ++b) { if (q == tid) { val = (unsigned char)((a << 4) | b); break; } ++q; }
        *(LAS unsigned char*)(lds + PEER_PTAB + tid) = val; }
    __syncthreads();
    const unsigned ptab = *(LAS unsigned*)(lds + PEER_PTAB + fr * 4);
    LAS unsigned char* el = lds + PEER_EL + wave * 4096;
    for (int tile = blockIdx.x; tile < NT / 32; tile += G) {
        const int tok0 = tile * 32 + wave * 4;
#pragma unroll 1
        for (int mt = 0; mt < 2; ++mt) {
            unsigned L00, L01, L02, L03, L10, L11, L12, L13;
            peer_scores_top16(qp, lds, tok0 + 2 * mt, 0, fr, fq, L00, L01, L02, L03);
            peer_scores_top16(qp, lds, tok0 + 2 * mt, 1, fr, fq, L10, L11, L12, L13);
            peer_cand(lds, el, ptab, L00, L10, lane, fr, (2 * mt + (fq >> 1)) * 128 + ((fq & 1) * 4 + 0) * 16 + fr);
            peer_cand(lds, el, ptab, L01, L11, lane, fr, (2 * mt + (fq >> 1)) * 128 + ((fq & 1) * 4 + 1) * 16 + fr);
            peer_cand(lds, el, ptab, L02, L12, lane, fr, (2 * mt + (fq >> 1)) * 128 + ((fq & 1) * 4 + 2) * 16 + fr);
            peer_cand(lds, el, ptab, L03, L13, lane, fr, (2 * mt + (fq >> 1)) * 128 + ((fq & 1) * 4 + 3) * 16 + fr);
        }
        asm volatile("s_waitcnt lgkmcnt(0)" ::: "memory");
#if TAB_FP6
        const int tok = tok0 + fq;
        const unsigned char* u6 = (const unsigned char*)utab; const unsigned char* v6 = (const unsigned char*)vtab;
        float xf[64], yf[64];
        { const bf16* prow = (const bf16*)(ws + WS_H0) + (size_t)tok * 1024 + fr * 16;
          const GAS f32x4* sp = (const GAS f32x4*)((const float*)(ws + WS_STATS4) + (size_t)tok * 8); const f32x4 sa = sp[0], sb = sp[1];
          f32x2 st; st.x = ((sa.x + sa.z) + sb.x) + sb.z; st.y = ((sa.y + sa.w) + sb.y) + sb.w;
          const float mean1 = st.x * (1.f / D), rstd1 = 1.f / sqrtf(fmaxf(st.y * (1.f / D) - mean1 * mean1, 0.f) + LN_EPS);
#pragma unroll
          for (int c = 0; c < 4; ++c)
#pragma unroll
            for (int q8 = 0; q8 < 2; ++q8) { const v4u pw = *(const GAS v4u*)(prow + c * 256 + q8 * 8); f32x4 pa, pb2; unpack8(pw, pa, pb2);
#pragma unroll
                for (int hq = 0; hq < 2; ++hq) { const int q4 = q8 * 2 + hq; const f32x4 pv = hq ? pb2 : pa;
                    const f32x4 gv = *(const GAS f32x4*)(P.in[12] + c * 256 + fr * 16 + q4 * 4), bv = *(const GAS f32x4*)(P.in[13] + c * 256 + fr * 16 + q4 * 4);
                    const f32x4 xv = (pv - mean1) * rstd1 * gv + bv;
                    xf[c * 16 + q4 * 4] = xv.x; xf[c * 16 + q4 * 4 + 1] = xv.y; xf[c * 16 + q4 * 4 + 2] = xv.z; xf[c * 16 + q4 * 4 + 3] = xv.w; } } }
#pragma unroll
        for (int j = 0; j < 64; ++j) yf[j] = 0.f;
#pragma unroll 1
        for (int sidx = 0; sidx < 128; ++sidx) {
            const unsigned rec_e = *(const LAS unsigned*)(el + (fq * 128 + sidx) * 8);
            const float rec_g = *(const LAS float*)(el + (fq * 128 + sidx) * 8 + 4);
#if TABU_FP4
            const unsigned char* ur = u6 + (size_t)rec_e * 512 + fr * 16;
            const v4u ua = *(const GAS v4u*)ur, ub = *(const GAS v4u*)(ur + 256);
#else
            const unsigned char* ur = u6 + (size_t)rec_e * 768 + fr * 16;
            const v4u ua = *(const GAS v4u*)ur, ub = *(const GAS v4u*)(ur + 256), uc = *(const GAS v4u*)(ur + 512);
#endif
#if TABV_FP4
            const unsigned char* vr = v6 + (size_t)rec_e * 512 + fr * 16;
            const v4u va = *(const GAS v4u*)vr, vb = *(const GAS v4u*)(vr + 256);
#else
            const unsigned char* vr = v6 + (size_t)rec_e * 768 + fr * 16;
            const v4u va = *(const GAS v4u*)vr, vb = *(const GAS v4u*)(vr + 256), vc = *(const GAS v4u*)(vr + 512);
#endif
            float d0 = 0.f, d1 = 0.f;
#if TABU_FP4
#define PEER_U4B(DW, BASE, BB) do { const f32x2 f2 = __builtin_amdgcn_cvt_scalef32_pk_f32_fp4((DW), 1.0f, BB); d0 += f2.x * xf[(BASE) + 2 * BB]; d1 += f2.y * xf[(BASE) + 2 * BB + 1]; } while (0)
#define PEER_U4(DW, BASE) do { PEER_U4B(DW, BASE, 0); PEER_U4B(DW, BASE, 1); PEER_U4B(DW, BASE, 2); PEER_U4B(DW, BASE, 3); } while (0)
            PEER_U4(ua.x, 0); PEER_U4(ua.y, 8); PEER_U4(ua.z, 16); PEER_U4(ua.w, 24); PEER_U4(ub.x, 32); PEER_U4(ub.y, 40); PEER_U4(ub.z, 48); PEER_U4(ub.w, 56);
#undef PEER_U4
#undef PEER_U4B
            const float dot = row_sum_f(d0 + d1) * (1.f / FP4_SU);
#else
            { v6u g; g[0] = ua.x; g[1] = ua.y; g[2] = ua.z; g[3] = ua.w; g[4] = ub.x; g[5] = ub.y;
              const v32f f = __builtin_amdgcn_cvt_scalef32_pk32_f32_fp6(g, 1.0f);
#pragma unroll
              for (int i = 0; i < 32; i += 2) { d0 += f[i] * xf[i]; d1 += f[i + 1] * xf[i + 1]; } }
            { v6u g; g[0] = ub.z; g[1] = ub.w; g[2] = uc.x; g[3] = uc.y; g[4] = uc.z; g[5] = uc.w;
              const v32f f = __builtin_amdgcn_cvt_scalef32_pk32_f32_fp6(g, 1.0f);
#pragma unroll
              for (int i = 0; i < 32; i += 2) { d0 += f[i] * xf[32 + i]; d1 += f[i + 1] * xf[32 + i + 1]; } }
            const float dot = row_sum_f(d0 + d1) * (1.f / FP6_SU);
#endif
#if TABV_FP4
            const float w = rec_g * gelu_as(dot) * (1.f / FP4_SV);
#define PEER_V4B(DW, BASE, BB) do { const f32x2 f2 = __builtin_amdgcn_cvt_scalef32_pk_f32_fp4((DW), 1.0f, BB); yf[(BASE) + 2 * BB] += w * f2.x; yf[(BASE) + 2 * BB + 1] += w * f2.y; } while (0)
#define PEER_V4(DW, BASE) do { PEER_V4B(DW, BASE, 0); PEER_V4B(DW, BASE, 1); PEER_V4B(DW, BASE, 2); PEER_V4B(DW, BASE, 3); } while (0)
            PEER_V4(va.x, 0); PEER_V4(va.y, 8); PEER_V4(va.z, 16); PEER_V4(va.w, 24); PEER_V4(vb.x, 32); PEER_V4(vb.y, 40); PEER_V4(vb.z, 48); PEER_V4(vb.w, 56);
#undef PEER_V4
#undef PEER_V4B
#else
            const float w = rec_g * gelu_as(dot) * (1.f / FP6_SV);
            { v6u g; g[0] = va.x; g[1] = va.y; g[2] = va.z; g[3] = va.w; g[4] = vb.x; g[5] = vb.y;
              const v32f f = __builtin_amdgcn_cvt_scalef32_pk32_f32_fp6(g, 1.0f);
#pragma unroll
              for (int i = 0; i < 32; ++i) yf[i] += w * f[i]; }
            { v6u g; g[0] = vb.z; g[1] = vb.w; g[2] = vc.x; g[3] = vc.y; g[4] = vc.z; g[5] = vc.w;
              const v32f f = __builtin_amdgcn_cvt_scalef32_pk32_f32_fp6(g, 1.0f);
#pragma unroll
              for (int i = 0; i < 32; ++i) yf[32 + i] += w * f[i]; }
#endif
        }
        float ssum = 0.f;
#pragma unroll
        for (int j = 0; j < 64; ++j) { yf[j] += ALPHA * xf[j]; ssum += yf[j]; }
        const float mean = row_sum_f(ssum) * (1.f / D);
        float s2 = 0.f;
#pragma unroll
        for (int j = 0; j < 64; ++j) { yf[j] -= mean; s2 += yf[j] * yf[j]; }
        const float rstd = 1.f / sqrtf(row_sum_f(s2) * (1.f / D) + LN_EPS);
        float* orow = P.out + (size_t)tok * 1024 + fr * 16;
#pragma unroll
        for (int c = 0; c < 4; ++c)
#pragma unroll
            for (int q4 = 0; q4 < 4; ++q4) { const f32x4 g0 = *(const GAS f32x4*)(P.in[19] + c * 256 + fr * 16 + q4 * 4), b0 = *(const GAS f32x4*)(P.in[20] + c * 256 + fr * 16 + q4 * 4);
                f32x4 o; o.x = yf[c * 16 + q4 * 4] * rstd * g0.x + b0.x; o.y = yf[c * 16 + q4 * 4 + 1] * rstd * g0.y + b0.y; o.z = yf[c * 16 + q4 * 4 + 2] * rstd * g0.z + b0.z; o.w = yf[c * 16 + q4 * 4 + 3] * rstd * g0.w + b0.w;
                *(GAS f32x4*)(orow + c * 256 + q4 * 4) = o; }
#endif
        asm volatile("s_waitcnt lgkmcnt(0)" ::: "memory");
    }
}

struct Args { const float* in[21]; float* out; unsigned char* ws; int ph_lo, ph_hi; };
__global__ void __launch_bounds__(NWAVES * 64, 2) fwd_kernel(Args args) {
    extern __shared__ __attribute__((aligned(16))) unsigned char lds_raw[];
    LAS unsigned char* lds = (LAS unsigned char*)lds_raw;
    volatile LAS unsigned* MISC = (volatile LAS unsigned*)(lds + MISC_OFF);
    const int tid = threadIdx.x, lane = tid & 63, wave = __builtin_amdgcn_readfirstlane(tid >> 6);
    const int G = gridDim.x;
    Ptrs P;
#pragma unroll
    for (int i = 0; i < 21; ++i) P.in[i] = args.in[i];
    P.out = args.out; P.ws = args.ws;
    unsigned char* ws = args.ws;
    if (tid < 16) MISC[tid] = 0u;
    __syncthreads();
    XcdBarrier bar; bar.bar = (unsigned*)(ws + WS_CTL) + 4096; bar.x = 0; bar.st = nullptr;
    if (N_LAUNCHES == 1) bar = xcd_barrier_post((unsigned*)(ws + WS_CTL) + 4096, MISC + 8);
    const int lo = args.ph_lo, hi = args.ph_hi;
#ifndef PHMASK
#define PHMASK 0x1ff
#endif
#define IN(k) (((PHMASK >> (k)) & 1) && lo <= (k) && (k) < hi)
#define SEAM(k) do { if (IN(k) && IN((k) + 1)) xcd_barrier(bar); } while (0)

    if (IN(0)) { phase0(P, lds, tid, lane, wave, G); } SEAM(0);

    if (IN(1)) {
        if (blockIdx.x < 4) { const int n = blockIdx.x * 256 + (tid & 255); const float* part = (const float*)(ws + WS_CPART) + (tid >> 8) * 16 * 1024; float a = 0.f;
#pragma unroll
            for (int kb = 0; kb < 16; ++kb) a += part[kb * 1024 + n];
            ((float*)(ws + ((tid >> 8) ? WS_DVEC : WS_CVEC)))[n] = a; }
        for (int i = tid; i < WR_GATE; i += 512) ((LAS float*)(lds + RING_BYTES))[i] = ((const float*)(ws + WS_BIASIN))[i];
        __syncthreads();
        SchedP1 S{(const char*)ws, G, (int)blockIdx.x};
        EpiP1 E{(bf16*)P.out, ws, lds + RING_BYTES};
        pg8::gemm_phase<EpiP1, SchedP1, 2>(lds, S, E);
    } SEAM(1);

    if (IN(2)) {
        fft_step_mfma<1>((const bf16*)P.out, (bf16*)P.out + (size_t)NT * 1024, lds, tid, lane, wave, G);
        dil_attn_lds((const bf16*)(ws + WS_QK), (const bf16*)(ws + WS_VT), (const float*)(ws + WS_BIASTAB), (bf16*)(ws + WS_OG), (float*)(ws + WS_LSE), lds, tid, lane, wave, G);
        mem_attn_lds((const bf16*)(ws + WS_QC), (const bf16*)(ws + WS_MEMKV), (const bf16*)(ws + WS_MEMKV) + 512 * 512, (bf16*)(ws + WS_YCIN), lds, tid, lane, wave, G);
    } SEAM(2);

    if (IN(3)) {
        fft_step_mfma<2>((const bf16*)P.out + (size_t)NT * 1024, (bf16*)(ws + WS_FA), lds, tid, lane, wave, G);
        combine_groups((const bf16*)(ws + WS_OG), (const float*)(ws + WS_LSE), (bf16*)(ws + WS_OB), tid, G);
    } SEAM(3);

    if (IN(4)) {
        SchedP4 S{(const char*)ws, G, (int)blockIdx.x};
        for (int i = tid; i < 3072; i += 512) ((LAS float*)(lds + RING_BYTES))[i] = ((const float*)(ws + WS_BIASIN))[WR_GATE + i];
        __syncthreads();
        EpiP4 E{(bf16*)(ws + WS_MERGED), lds + RING_BYTES};
        pg8::gemm_phase<EpiP4, SchedP4, 2>(lds, S, E);
    } SEAM(4);

    if (IN(5)) {
        SchedPlain S{(const char*)(ws + WS_MERGED), (const char*)(ws + WS_WTO), G, (int)blockIdx.x, K_WO};
        EpiP5 E{(bf16*)(ws + WS_H0), (float*)(ws + WS_PRELN), (float*)(ws + WS_STATS4), lds + RING_BYTES};
        pg8::gemm_phase<EpiP5, SchedPlain>(lds, S, E);
    } SEAM(5);


    if (IN(7)) {
        SchedPlain S{(const char*)(ws + WS_H0), (const char*)(ws + WS_WTPQ), G, (int)blockIdx.x, K_PQ};
        EpiP7 E{(bf16*)(ws + WS_QP), (const float*)(ws + WS_STATS4), (const float*)(ws + WS_CVEC), (const float*)(ws + WS_DVEC)};
        pg8::gemm_phase<EpiP7, SchedPlain>(lds, S, E);
    } SEAM(7);

    if (IN(8)) {
        peer_v2(P, lds, tid, lane, wave, G);
    }
#undef IN
#undef SEAM
}

extern "C" void kernel_launch(void* const* d_in, const int* in_sizes, int n_in, void* d_out, int out_size, void* d_ws, size_t ws_size, hipStream_t stream) {
    static int grid = 0;
    if (grid == 0) {
        if (n_in != 21 || out_size != NT * D || ws_size < WS_END) { fprintf(stderr, "kernel_launch: unexpected shapes (n_in %d, out %d, ws %zu); nothing launched\n", n_in, out_size, ws_size); grid = -1; return; }
        int dev = 0, cus = 0, per_cu = 0;
        if (hipGetDevice(&dev) != hipSuccess || hipDeviceGetAttribute(&cus, hipDeviceAttributeMultiprocessorCount, dev) != hipSuccess) { grid = -1; return; }
        if (hipFuncSetAttribute((const void*)fwd_kernel, hipFuncAttributeMaxDynamicSharedMemorySize, LDS_BYTES) != hipSuccess) { fprintf(stderr, "kernel_launch: hipFuncSetAttribute failed\n"); grid = -1; return; }
        if (hipOccupancyMaxActiveBlocksPerMultiprocessor(&per_cu, (const void*)fwd_kernel, NWAVES * 64, LDS_BYTES) != hipSuccess || per_cu < 1) { fprintf(stderr, "kernel_launch: occupancy query says %d\n", per_cu); }
        (void)hipGetLastError();
        grid = cus;
    }
    if (grid < 0) return;
    (void)hipMemsetAsync((char*)d_ws + WS_CTL, 0, CTL_ZERO_BYTES, stream);
    Args a{};
    for (int i = 0; i < 21; ++i) a.in[i] = (const float*)d_in[i];
    a.out = (float*)d_out; a.ws = (unsigned char*)d_ws;
    if (N_LAUNCHES == 1) { a.ph_lo = 0; a.ph_hi = NPH; hipLaunchKernelGGL(fwd_kernel, dim3(grid), dim3(NWAVES * 64), LDS_BYTES, stream, a); }
    else for (int ph = 0; ph < NPH; ++ph) { a.ph_lo = ph; a.ph_hi = ph + 1; hipLaunchKernelGGL(fwd_kernel, dim3(grid), dim3(NWAVES * 64), LDS_BYTES, stream, a); }
}
```

```cpp
#include <hip/hip_runtime.h>
#include <cstdio>
#include <cstdint>

#ifndef TABU_FP4
#define TABU_FP4 0
#endif
#ifndef TABV_FP4
#define TABV_FP4 1
#endif
#ifndef TAB_FP6
#define TAB_FP6 1
#endif
static_assert(TAB_FP6 == 1, "the workspace map assumes 12 MiB fp6 expert tables");
#ifndef TAB_FP8
#define TAB_FP8 1
#endif
#ifndef N_LAUNCHES
#define N_LAUNCHES 1
#endif

#define GAS __attribute__((address_space(1)))
#define LAS __attribute__((address_space(3)))
typedef unsigned short bf16;
typedef unsigned v4u __attribute__((ext_vector_type(4)));
typedef unsigned v2u __attribute__((ext_vector_type(2)));
typedef float f32x4 __attribute__((ext_vector_type(4)));
typedef float f32x2 __attribute__((ext_vector_type(2)));
typedef short bf16x8 __attribute__((ext_vector_type(8)));

constexpr int NT = 32768, SEQ = 16384, D = 1024;
constexpr int NPH = 9;
constexpr float ALPHA = 1.189207115002721f;
constexpr float LN_EPS = 1e-5f;
constexpr int NWAVES = 8;

constexpr size_t MiB = 1u << 20;
constexpr size_t WS_CTL = 0, CTL_ZERO_BYTES = 1 * MiB;
constexpr size_t WS_CPART = 256 * 1024;
constexpr size_t WS_STATS = 512 * 1024;
constexpr size_t WS_CVEC = 768 * 1024, WS_DVEC = 772 * 1024;
constexpr size_t WS_BIASIN = 1 * MiB;
constexpr size_t WS_STATS4 = 4 * MiB;
constexpr size_t WS_BIASTAB = 1 * MiB + 64 * 1024;
constexpr size_t WS_WTIN = 2 * MiB;
constexpr size_t WS_WTA = 16 * MiB, WS_WTB = 17 * MiB, WS_WTC = 18 * MiB, WS_WTO = 19 * MiB, WS_WTPQ = 21 * MiB, WS_WTMKV = 23 * MiB;
constexpr size_t WS_MEMB = 25 * MiB, WS_MEMKV = 26 * MiB;
constexpr size_t WS_MEMF8 = 27 * MiB, WS_WMKVF8 = 28 * MiB;
constexpr size_t WS_UTAB = 32 * MiB, WS_VTAB = 44 * MiB;
constexpr size_t WS_H0F8 = 56 * MiB;
constexpr size_t WS_WF8IN = 88 * MiB;
constexpr size_t WS_H0 = 96 * MiB;
constexpr size_t WS_QK = 160 * MiB;
constexpr size_t WS_VT = 256 * MiB;
constexpr size_t WS_QC = 304 * MiB;
constexpr size_t WS_OG = 336 * MiB;
constexpr size_t WS_LSE = 384 * MiB;
constexpr size_t WS_YCIN = 386 * MiB;
constexpr size_t WS_FA = 418 * MiB;
constexpr size_t WS_OB = 450 * MiB;
constexpr size_t WS_GSCR = 466 * MiB;
constexpr size_t WS_MERGED = WS_QK;
constexpr size_t WS_PRELN = 224 * MiB;
constexpr size_t WS_H1B = WS_H0;
constexpr size_t WS_QP = WS_QK;
constexpr size_t WS_END = 498 * MiB;

constexpr int WR_A = 0, WR_QK = 1024, WR_V = 2560, WR_QC = 3328, WR_GATE = 3840, WR_END = 6912;

constexpr int RING_BYTES = 131072;
constexpr int LDS_BYTES = 147456;
constexpr int MISC_OFF = LDS_BYTES - 256;
static_assert(RING_BYTES + 3840 * 4 <= MISC_OFF, "bias copy fits the spare LDS above the GEMM stage buffers");

#define RLX_AGENT __ATOMIC_RELAXED, __HIP_MEMORY_SCOPE_AGENT
#define LDS_WAIT() asm volatile("s_waitcnt lgkmcnt(0)" ::: "memory")
#define VM_WAIT() asm volatile("s_waitcnt vmcnt(0)" ::: "memory")

__device__ __forceinline__ unsigned f2bf(float f) { unsigned u = __builtin_bit_cast(unsigned, f); return (u + 0x7fffu + ((u >> 16) & 1u)) >> 16; }
__device__ __forceinline__ unsigned pk2(float lo, float hi) { return f2bf(lo) | (f2bf(hi) << 16); }
__device__ __forceinline__ unsigned pk4_fp8(float a, float b, float c, float d) { int p = __builtin_amdgcn_cvt_pk_fp8_f32(a, b, 0, false); p = __builtin_amdgcn_cvt_pk_fp8_f32(c, d, p, true); return (unsigned)p; }
__device__ __forceinline__ float bf2f(unsigned b) { return __builtin_bit_cast(float, b << 16); }
__device__ __forceinline__ float bflo(unsigned w) { return __builtin_bit_cast(float, w << 16); }
__device__ __forceinline__ float bfhi(unsigned w) { return __builtin_bit_cast(float, w & 0xffff0000u); }
__device__ __forceinline__ float wave_sum(float v) {
#pragma unroll
    for (int o = 1; o < 64; o <<= 1) v += __shfl_xor(v, o);
    return v;
}
__device__ __forceinline__ float wave_max(float v) {
#pragma unroll
    for (int o = 1; o < 64; o <<= 1) v = fmaxf(v, __shfl_xor(v, o));
    return v;
}

#define XB_TMO      128
#define XB_XCNT(j)  (256  + 64 * (j))
#define XB_XSUB(j)  (1280 + 64 * (j))
#define XB_XGEN(j)  (2304 + 64 * (j))
#define XB_TOP      3328
#define XB_TOPGEN   3392
#define XCD_BAR_WORDS 3456
#define XB_SPIN_CAP (1u << 18)

__device__ __forceinline__ unsigned xb_ld(unsigned* p)              { return __hip_atomic_load(p, __ATOMIC_RELAXED, __HIP_MEMORY_SCOPE_AGENT); }
__device__ __forceinline__ unsigned xb_add(unsigned* p, unsigned v) { return __hip_atomic_fetch_add(p, v, __ATOMIC_RELAXED, __HIP_MEMORY_SCOPE_AGENT); }
__device__ __forceinline__ unsigned xb_xcc_id() { return (unsigned)__builtin_amdgcn_s_getreg((3 << 11) | 20) & 0xFu; }
#define XB_SPIN(cond, bar) do { unsigned _sp = 0; while (cond) { __builtin_amdgcn_s_sleep(1); \
    if ((++_sp & 255u) == 0u) { if (xb_ld(&(bar)[XB_TMO])) break; if (_sp > XB_SPIN_CAP) { atomicAdd(&(bar)[XB_TMO], 1u); break; } } } } while (0)

struct XcdBarrier {
    unsigned* bar; unsigned x;
    volatile LAS unsigned* st;
};
__device__ __forceinline__ XcdBarrier xcd_barrier_post(unsigned* bar, volatile LAS unsigned* st) {
    XcdBarrier b; b.bar = bar; b.x = xb_xcc_id(); b.st = st;
    if (threadIdx.x == 0) (void)xb_add(&bar[XB_XCNT(b.x)], 1u);
    return b;
}
__device__ __forceinline__ void xcd_barrier_complete(unsigned* bar, unsigned x, unsigned& nloc, unsigned& nx) {
    const unsigned G = gridDim.x * gridDim.y * gridDim.z;
    unsigned sum, cnt, mine, sp = 0u;
    for (;;) {
        sum = 0u; cnt = 0u; mine = 0u;
#pragma unroll
        for (unsigned j = 0; j < 16; ++j) { const unsigned c = xb_ld(&bar[XB_XCNT(j)]); sum += c; cnt += (c > 0u) ? 1u : 0u; mine = (j == x) ? c : mine; }
        if (sum == G) break;
        __builtin_amdgcn_s_sleep(1);
        if ((++sp & 255u) == 0u) { if (xb_ld(&bar[XB_TMO])) break; if (sp > XB_SPIN_CAP) { atomicAdd(&bar[XB_TMO], 1u); break; } }
    }
    nloc = mine > 0u ? mine : 1u; nx = cnt > 0u ? cnt : 1u;
}
__device__ __forceinline__ void xcd_barrier(const XcdBarrier& b) {
    asm volatile("s_waitcnt vmcnt(0)" ::: "memory");
    __syncthreads();
    if (threadIdx.x == 0) {
        unsigned* bar = b.bar;
        __builtin_amdgcn_s_waitcnt(0);
        unsigned nloc = b.st[0], nx = b.st[1];
        if (nloc == 0u) { xcd_barrier_complete(bar, b.x, nloc, nx); b.st[0] = nloc; b.st[1] = nx; }
        const unsigned old = xb_add(&bar[XB_XSUB(b.x)], 1u);
        const unsigned gen = old / nloc;
        if (old + 1u == (gen + 1u) * nloc) {
            __builtin_amdgcn_fence(__ATOMIC_RELEASE, "agent");
            asm volatile("s_waitcnt vmcnt(0)" ::: "memory");
            const unsigned og = xb_add(&bar[XB_TOP], 1u);
            const unsigned tg = og / nx;
            if (og + 1u == (tg + 1u) * nx) xb_add(&bar[XB_TOPGEN], 1u);
            else XB_SPIN(xb_ld(&bar[XB_TOPGEN]) == tg, bar);
            __builtin_amdgcn_fence(__ATOMIC_ACQUIRE, "agent");
            xb_add(&bar[XB_XGEN(b.x)], 1u);
            asm volatile("s_waitcnt vmcnt(0)" ::: "memory");
        } else {
            XB_SPIN(xb_ld(&bar[XB_XGEN(b.x)]) == gen, bar);
            __builtin_amdgcn_fence(__ATOMIC_ACQUIRE, "agent");
            asm volatile("s_waitcnt vmcnt(0)" ::: "memory");
        }
    }
    __syncthreads();
}

namespace pg8 {
constexpr int BM = 256, BK = 64, HALF = 128, HTB = HALF * BK * 2, STAGE_BYTES = 8 * HTB;
__host__ __device__ __forceinline__ int lds_byte(int r, int c) { const int st = (r >> 4) * 2 + (c >> 5), rr = r & 15, cc = c & 31, ob = rr * 64 + cc * 2; return st * 1024 + (ob ^ (((ob >> 9) & 1) << 5)); }
__host__ __device__ __forceinline__ void stage_rc(int b, int& R, int& C) { const int st = b / 1024, sb = b % 1024, swz = sb ^ (((sb >> 9) & 1) << 5); R = (st >> 1) * 16 + swz / 64; C = (st & 1) * 32 + (swz % 64) / 2; }
__host__ __device__ __forceinline__ int perm32(int rho) { const int n = rho >> 4, i = rho & 15; return 8 * (i >> 2) + 4 * n + (i & 3); }

struct GUnit { const char* a; const char* b; unsigned sa, sb; int nt; int pm, pn, kind; };

typedef int v8i __attribute__((ext_vector_type(8)));
constexpr int K_FP8 = 1 << 16;
__device__ __forceinline__ unsigned pg8_rb(unsigned ra) { asm volatile("" : "+v"(ra)); const unsigned rho = ra & 31u, n = rho >> 4, i = rho & 15u; return (ra & ~31u) + 8u * (i >> 2) + 4u * n + (i & 3u); }
template <class Epi, class Sched, int MODE = 0>
__device__ __forceinline__ void gemm_phase(LAS unsigned char* lds, const Sched& S, const Epi& E) {
    const int tid = threadIdx.x, wid = __builtin_amdgcn_readfirstlane(tid >> 6), lane = tid & 63, wr = wid >> 2, wc = wid & 3, fr = lane & 15, fq = lane >> 4;
    int R0, C0; stage_rc(tid * 16, R0, C0);
    const unsigned RA = (unsigned)R0, C2 = (unsigned)C0 * 2u;
#define RB pg8_rb(RA)
    const size_t kstep = (size_t)(BK * 2);
    const unsigned ldsw = (unsigned)wid * 1024u;
    const int aoff = lds_byte(wr * 64 + fr, fq * 8), boff = lds_byte(wc * 32 + fr, fq * 8);
#define PG8_SA(b, h) (((b) * 2 + (h)) * HTB)
#define PG8_SB(b, h) ((4 + (b) * 2 + (h)) * HTB)
#define PG8_STAGE(bufoff, gbase, RR, stride) do { const unsigned _vo = (RR) * (unsigned)(stride) + C2; const char* _g = (const char*)(gbase); \
        __builtin_amdgcn_global_load_lds((const unsigned*)(_g + _vo), (LAS unsigned*)(lds + (bufoff) + ldsw), 16, 0, 0); \
        __builtin_amdgcn_global_load_lds((const unsigned*)(_g + (size_t)64 * (stride) + _vo), (LAS unsigned*)(lds + (bufoff) + ldsw + 8192), 16, 0, 0); } while (0)
#define PG8_LDA(dst, b, h) do { _Pragma("unroll") for (int m = 0; m < 4; ++m) _Pragma("unroll") for (int k = 0; k < 2; ++k) dst[m][k] = *(const LAS bf16x8*)(lds + PG8_SA(b, h) + aoff + m * 2048 + k * 1024); } while (0)
#define PG8_LDB(dst, b, h) do { _Pragma("unroll") for (int n = 0; n < 2; ++n) _Pragma("unroll") for (int k = 0; k < 2; ++k) dst[n][k] = *(const LAS bf16x8*)(lds + PG8_SB(b, h) + boff + n * 2048 + k * 1024); } while (0)
#define PG8_CAT(lo, hi) __builtin_bit_cast(v8i, __builtin_shufflevector(lo, hi, 0, 1, 2, 3, 4, 5, 6, 7, 8, 9, 10, 11, 12, 13, 14, 15))
#define PG8_MMA_BF(ai, bj, At, Bt) do { __builtin_amdgcn_s_setprio(1); _Pragma("unroll") for (int m = 0; m < 4; ++m) _Pragma("unroll") for (int n = 0; n < 2; ++n) _Pragma("unroll") for (int k = 0; k < 2; ++k) \
        acc[ai][bj][m][n] = __builtin_amdgcn_mfma_f32_16x16x32_bf16(Bt[n][k], At[m][k], acc[ai][bj][m][n], 0, 0, 0); __builtin_amdgcn_s_setprio(0); } while (0)
#define PG8_MMA_F8(ai, bj, At, Bt) do { __builtin_amdgcn_s_setprio(1); _Pragma("unroll") for (int m = 0; m < 4; ++m) _Pragma("unroll") for (int n = 0; n < 2; ++n) \
        acc[ai][bj][m][n] = __builtin_amdgcn_mfma_scale_f32_16x16x128_f8f6f4(PG8_CAT(Bt[n][0], Bt[n][1]), PG8_CAT(At[m][0], At[m][1]), acc[ai][bj][m][n], 0, 0, 0, 0x7F7F7F7F, 0, 0x7F7F7F7F); __builtin_amdgcn_s_setprio(0); } while (0)
#define PG8_WAIT_V(n) asm volatile("s_waitcnt vmcnt(" #n ")" ::: "memory")
#define PG8_WAIT_L(n) asm volatile("s_waitcnt lgkmcnt(" #n ")" ::: "memory")
#define PG8_BAR __builtin_amdgcn_s_barrier()
#define PG8_SCHED __builtin_amdgcn_sched_barrier(0)
#define PG8_KLOOP(MMA) \
        for (int t = 0; t < nt; t += 2) { \
            const bool last = (t == nt - 2); \
            const char* a1 = cA + (size_t)(t + 1) * kstep; \
            const char* a2 = last ? nxt.a : cA + (size_t)(t + 2) * kstep; const char* b2 = last ? nxt.b : cB + (size_t)(t + 2) * kstep; \
            const unsigned sa2 = last ? nxt.sa : csa, sb2 = last ? nxt.sb : csb; const size_t hA2 = (size_t)HALF * sa2, hB2 = (size_t)HALF * sb2; \
            const char* a3 = a2 + kstep; const char* b3 = b2 + kstep; \
            PG8_LDB(B0, 0, 0); PG8_LDB(B1, 0, 1); PG8_SCHED; PG8_LDA(At, 0, 0); PG8_STAGE(PG8_SA(1, 1), a1 + hA, RA, csa); \
            PG8_WAIT_V(8); PG8_WAIT_L(0); PG8_BAR; MMA(0, 0, At, B0); MMA(0, 1, At, B1); PG8_BAR; PG8_SCHED; \
            PG8_LDA(At, 0, 1); PG8_STAGE(PG8_SB(0, 0), b2, RB, sb2); PG8_STAGE(PG8_SB(0, 1), b2 + hB2, RB, sb2); PG8_STAGE(PG8_SA(0, 0), a2, RA, sa2); \
            PG8_WAIT_V(8); PG8_WAIT_L(0); PG8_BAR; MMA(1, 0, At, B0); MMA(1, 1, At, B1); PG8_BAR; PG8_SCHED; \
            PG8_LDB(B0, 1, 0); PG8_LDB(B1, 1, 1); PG8_SCHED; PG8_LDA(At, 1, 0); PG8_STAGE(PG8_SA(0, 1), a2 + hA2, RA, sa2); \
            PG8_WAIT_V(8); PG8_WAIT_L(0); PG8_BAR; MMA(0, 0, At, B0); MMA(0, 1, At, B1); PG8_BAR; PG8_SCHED; \
            PG8_LDA(At, 1, 1); PG8_STAGE(PG8_SB(1, 0), b3, RB, sb2); PG8_STAGE(PG8_SB(1, 1), b3 + hB2, RB, sb2); PG8_STAGE(PG8_SA(1, 0), a3, RA, sa2); \
            PG8_WAIT_V(8); PG8_WAIT_L(0); PG8_BAR; MMA(1, 0, At, B0); MMA(1, 1, At, B1); PG8_BAR; PG8_SCHED; \
        }
    GUnit cur, nxt; int ui = 0;
    if (!S.next(0, cur)) return;
    f32x4 acc[2][2][4][2];
#pragma unroll
    for (int a = 0; a < 2; ++a)
#pragma unroll
        for (int b = 0; b < 2; ++b)
#pragma unroll
            for (int m = 0; m < 4; ++m)
#pragma unroll
                for (int n = 0; n < 2; ++n) acc[a][b][m][n] = (f32x4){0.f, 0.f, 0.f, 0.f};
    bf16x8 At[4][2], B0[2][2], B1[2][2];
    unsigned keep[2][2][4][2];
    {
        const char* cA = cur.a; const char* cB = cur.b; const size_t hA = (size_t)HALF * cur.sa, hB = (size_t)HALF * cur.sb;
        PG8_STAGE(PG8_SB(0, 0), cB, RB, cur.sb); PG8_STAGE(PG8_SB(0, 1), cB + hB, RB, cur.sb); PG8_STAGE(PG8_SA(0, 0), cA, RA, cur.sa); PG8_STAGE(PG8_SA(0, 1), cA + hA, RA, cur.sa);
        if (wr == 1) PG8_BAR;
        PG8_WAIT_V(2); PG8_BAR;
        PG8_STAGE(PG8_SB(1, 0), cB + kstep, RB, cur.sb); PG8_STAGE(PG8_SA(1, 0), cA + kstep, RA, cur.sa); PG8_STAGE(PG8_SB(1, 1), cB + hB + kstep, RB, cur.sb);
        PG8_WAIT_V(6); PG8_BAR;
    }
    for (;;) {
        const bool has_next = S.next(ui + 1, nxt);
        if (!has_next) { nxt = cur; }
        const char* cA = cur.a; const char* cB = cur.b; const unsigned csa = cur.sa, csb = cur.sb; const size_t hA = (size_t)HALF * csa, hB = (size_t)HALF * csb;
        const int nt = cur.nt; const bool cur_fp8 = (cur.kind & K_FP8) != 0; (void)cur_fp8;
        if (MODE == 1 || (MODE == 2 && cur_fp8)) { PG8_KLOOP(PG8_MMA_F8) } else { PG8_KLOOP(PG8_MMA_BF) }
        if (wr == 0) PG8_BAR;
        E(acc, keep, cur, wr, wc, fr, fq);
        if (!has_next) break;
#pragma unroll
        for (int a = 0; a < 2; ++a)
#pragma unroll
            for (int b = 0; b < 2; ++b)
#pragma unroll
                for (int m = 0; m < 4; ++m)
#pragma unroll
                    for (int n = 0; n < 2; ++n) acc[a][b][m][n] = (f32x4){0.f, 0.f, 0.f, 0.f};
        cur = nxt; ++ui;
        if (wr == 1) PG8_BAR;
    }
    PG8_WAIT_V(0);
    PG8_BAR;
#undef PG8_SA
#undef PG8_SB
#undef PG8_STAGE
#undef PG8_LDA
#undef PG8_LDB
#undef PG8_MMA_BF
#undef PG8_MMA_F8
#undef PG8_KLOOP
#undef RB
#undef PG8_CAT
#undef PG8_WAIT_V
#undef PG8_WAIT_L
#undef PG8_BAR
#undef PG8_SCHED
}
}
using pg8::GUnit; using pg8::K_FP8;

__device__ __forceinline__ int tok0_of(int p, int g) {
    const int n = p << 8, b = n >> 14, rem = n & 16383, sh = 2 * g;
    const int r = rem >> (14 - sh), l0 = rem & ((16384 >> sh) - 1);
    return (b << 14) + (l0 << sh) + r;
}
__device__ __forceinline__ void tile_of(int t, int nN, int& pm, int& pn) { const int nig = 8 * nN, gid = t / nig, w = t % nig; pm = gid * 8 + (w & 7); pn = w >> 3; }

struct Ptrs {
    const float* in[21]; float* out; unsigned char* ws;
};

enum { K_ZA = 0, K_QK = 1, K_VT = 2, K_QC = 3, K_MKV = 4, K_GATE = 5, K_YA = 6, K_YB = 7, K_YC = 8, K_WO = 9, K_PQ = 10 };
struct SchedP1 {
    const char* wsb; int G, c;
    static constexpr int NLONG = 512, NSHORT = 768 + 384 + 256 + 8;
    __device__ __forceinline__ bool next(int i, GUnit& u) const {
        const char* const h0b = wsb + WS_H0; const char* const wtb = wsb + WS_WTIN; const char* const h0 = wsb + WS_H0F8; const char* const wtin = wsb + WS_WF8IN; const char* const memb = wsb + WS_MEMF8; const char* const wtmkv = wsb + WS_WMKVF8;
        const int nshort = (NSHORT - c + G - 1) / G, nslots = 2 + nshort; if (i >= nslots) return false;
        const int k = (c >> 3) & 3; int pa = k % nslots, pb = (k + 4) % nslots; if (pa > pb) { const int t_ = pa; pa = pb; pb = t_; }
        int j; if (i == pa) j = 0; else if (i == pb) j = 1; else j = 2 + i - (i > pa ? 1 : 0) - (i > pb ? 1 : 0);
        const int L = j * G + c; if (L >= NLONG + NSHORT) return false;
        if (L < NLONG) { const int T = (G % 8 == 0) ? (L % 8) * (NLONG / 8) + L / 8 : L; int pm, pn; tile_of(T, 4, pm, pn);
            u.a = h0b + (size_t)pm * 256 * 2048; u.b = wtb + (size_t)(WR_A + pn * 256) * 2048; u.sa = 2048; u.sb = 2048; u.nt = 16; u.pm = pm; u.pn = pn; u.kind = K_ZA; return true; }
        const int Ls = L - NLONG; int T = (NSHORT % 8 == 0 && G % 8 == 0) ? (Ls % 8) * (NSHORT / 8) + Ls / 8 : Ls;
        u.nt = 8; u.sa = 1024; u.sb = 1024;
        if (T < 768) { const int g = T >> 8; int pm, pn; tile_of(T & 255, 2, pm, pn); u.a = h0 + (size_t)tok0_of(pm, g) * 1024; u.sa = 1024u << (2 * g);
            u.b = wtin + (size_t)(WR_QK + g * 512 + pn * 256) * 1024; u.pm = pm; u.pn = pn; u.kind = K_QK | (g << 8) | K_FP8; return true; }
        T -= 768;
        if (T < 384) { const int g = T >> 7, pn = T & 127; u.a = wtin + (size_t)(WR_V + g * 256) * 1024; u.b = h0 + (size_t)tok0_of(pn, g) * 1024; u.sb = 1024u << (2 * g);
            u.pm = 0; u.pn = pn; u.kind = K_VT | (g << 8) | K_FP8; return true; }
        T -= 384;
        if (T < 256) { int pm, pn; tile_of(T, 2, pm, pn); u.a = h0 + (size_t)pm * 256 * 1024; u.b = wtin + (size_t)(WR_QC + pn * 256) * 1024; u.pm = pm; u.pn = pn; u.kind = K_QC | K_FP8; return true; }
        T -= 256;
        if (T < 4) { const int pm = T >> 1, pn = T & 1; u.a = memb + (size_t)pm * 256 * 1024; u.b = wtmkv + (size_t)pn * 256 * 1024; u.pm = pm; u.pn = pn; u.kind = K_MKV | K_FP8; return true; }
        T -= 4;
        { const int pm = T >> 1, pn = T & 1; u.a = wtmkv + (size_t)(512 + pm * 256) * 1024; u.b = memb + (size_t)pn * 256 * 1024; u.pm = pm; u.pn = pn; u.kind = K_MKV | (1 << 8) | K_FP8; return true; }
    }
};
__device__ __forceinline__ void out_tile_of(int L, int G, int& pm, int& pn) {
    const int T = (G % 8 == 0) ? (L % 8) * 64 + L / 8 : L; tile_of(T, 4, pm, pn);
}
struct SchedP4 {
    const char* wsb; int G, c;
    __device__ __forceinline__ bool next(int i, GUnit& u) const {
        const int io = i / 6, s = i - io * 6; const int L = io * G + c; if (L >= 512) return false;
        int pm, pn; out_tile_of(L, G, pm, pn); u.pm = pm; u.pn = pn;
        if ((s & 1) == 0) { const int gi = s >> 1; u.a = wsb + WS_H0F8 + (size_t)pm * 256 * 1024; u.sa = 1024; u.b = wsb + WS_WF8IN + (size_t)(WR_GATE + gi * 1024 + pn * 256) * 1024; u.sb = 1024; u.nt = 8; u.kind = K_GATE | (gi << 8) | K_FP8; return true; }
        if (s == 1) { u.a = wsb + WS_FA + (size_t)pm * 256 * 1024; u.sa = 1024; u.b = wsb + WS_WTA + (size_t)pn * 256 * 1024; u.sb = 1024; u.nt = 8; u.kind = K_YA; return true; }
        if (s == 3) { u.a = wsb + WS_OB + (size_t)pm * 256 * 256; u.sa = 256; u.b = wsb + WS_WTB + (size_t)pn * 256 * 256; u.sb = 256; u.nt = 2; u.kind = K_YB | K_FP8; return true; }
        u.a = wsb + WS_YCIN + (size_t)pm * 256 * 512; u.sa = 512; u.b = wsb + WS_WTC + (size_t)pn * 256 * 512; u.sb = 512; u.nt = 4; u.kind = K_YC | K_FP8; return true;
    }
};
struct SchedPlain {
    const char* a; const char* b; int G, c, kind;
    __device__ __forceinline__ bool next(int i, GUnit& u) const {
        const int L = i * G + c; if (L >= 512) return false;
        int pm, pn; out_tile_of(L, G, pm, pn); u.pm = pm; u.pn = pn; u.a = a + (size_t)pm * 256 * 2048; u.b = b + (size_t)pn * 256 * 2048; u.sa = 2048; u.sb = 2048; u.nt = 16; u.kind = kind; return true;
    }
};

__device__ __forceinline__ unsigned opq(unsigned x) { asm volatile("" : "+v"(x)); return x; }
__device__ __forceinline__ v4u pack8(f32x4 v0, f32x4 v1) { v4u o; o.x = pk2(v0[0], v0[1]); o.y = pk2(v0[2], v0[3]); o.z = pk2(v1[0], v1[1]); o.w = pk2(v1[2], v1[3]); return o; }
__device__ __forceinline__ void unpack8(v4u w, f32x4& a, f32x4& b) { a[0] = bflo(w.x); a[1] = bfhi(w.x); a[2] = bflo(w.y); a[3] = bfhi(w.y); b[0] = bflo(w.z); b[1] = bfhi(w.z); b[2] = bflo(w.w); b[3] = bfhi(w.w); }
#define EPI_LOOP(ai, m, bj) _Pragma("unroll") for (int ai = 0; ai < 2; ++ai) _Pragma("unroll") for (int m = 0; m < 4; ++m) _Pragma("unroll") for (int bj = 0; bj < 2; ++bj)

constexpr float W8SC = 32.f, W8INV = 1.f / 32.f;
constexpr float SC_WBC = 16.f, SC_ACT = 4.f;
struct EpiP1 {
    bf16* za; unsigned char* wsb; const LAS unsigned char* bias;
    __device__ __forceinline__ void operator()(f32x4 (&acc)[2][2][4][2], unsigned (&keep)[2][2][4][2], const GUnit& u, int wr, int wc, int fr, int fq) const {
        bf16* const qk = (bf16*)(wsb + WS_QK); bf16* const vt = (bf16*)(wsb + WS_VT); bf16* const qc = (bf16*)(wsb + WS_QC); bf16* const memkv = (bf16*)(wsb + WS_MEMKV);
        const int kind = u.kind & 255, g = (u.kind >> 8) & 255; const float asc = (u.kind & K_FP8) ? W8INV : 1.f;
        const unsigned rl0 = opq((unsigned)(wr * 64 + fr)), cl0 = opq((unsigned)(wc * 32 + 8 * fq));
        if (kind == K_VT) {
            char* base = (char*)(vt + (size_t)g * 256 * NT + (size_t)u.pn * 256); const LAS unsigned char* bb = bias + (WR_V + g * 256) * 4;
            const unsigned lo = rl0 * (unsigned)(NT * 2) + cl0 * 2u;
#pragma unroll
            for (int ai = 0; ai < 2; ++ai)
#pragma unroll
                for (int m = 0; m < 4; ++m) { const float br = *(const LAS float*)(bb + (rl0 + ai * 128 + m * 16) * 4u);
#pragma unroll
                    for (int bj = 0; bj < 2; ++bj) *(GAS v4u*)(base + (lo + (unsigned)((ai * 128 + m * 16) * NT * 2 + bj * 256))) = pack8(acc[ai][bj][m][0] * asc + br, acc[ai][bj][m][1] * asc + br);
                    __builtin_amdgcn_sched_barrier(0); }
            return;
        }
        char* base; unsigned ldb; const LAS unsigned char* bb; bool hasb = true;
        if (kind == K_ZA) { base = (char*)(za + (size_t)u.pm * 256 * 1024 + u.pn * 256); ldb = 2048; bb = bias + (WR_A + u.pn * 256) * 4; }
        else if (kind == K_QK) { base = (char*)(qk + (size_t)g * NT * 512 + (size_t)u.pm * 256 * 512 + u.pn * 256); ldb = 1024; bb = bias + (WR_QK + g * 512 + u.pn * 256) * 4; }
        else if (kind == K_QC) { base = (char*)(qc + (size_t)u.pm * 256 * 512 + u.pn * 256); ldb = 1024; bb = bias + (WR_QC + u.pn * 256) * 4; }
        else { base = (char*)(memkv + (size_t)g * 512 * 512 + (size_t)u.pm * 256 * 512 + u.pn * 256); ldb = 1024; bb = bias; hasb = false; }
        f32x4 bv[2][2];
#pragma unroll
        for (int bj = 0; bj < 2; ++bj)
#pragma unroll
            for (int n = 0; n < 2; ++n) bv[bj][n] = hasb ? *(const LAS f32x4*)(bb + (cl0 + bj * 128 + 4 * n) * 4u) : (f32x4){0.f, 0.f, 0.f, 0.f};
        const unsigned lo = rl0 * ldb + cl0 * 2u;
#pragma unroll
        for (int ai = 0; ai < 2; ++ai)
#pragma unroll
            for (int m = 0; m < 4; ++m) {
#pragma unroll
                for (int bj = 0; bj < 2; ++bj) *(GAS v4u*)(base + (lo + (unsigned)(ai * 128 + m * 16) * ldb + (unsigned)(bj * 256))) = pack8(acc[ai][bj][m][0] * asc + bv[bj][0], acc[ai][bj][m][1] * asc + bv[bj][1]);
                __builtin_amdgcn_sched_barrier(0); }
    }
};
struct EpiP4 {
    bf16* merged; const LAS unsigned char* bias;
    __device__ __forceinline__ void operator()(f32x4 (&acc)[2][2][4][2], unsigned (&keep)[2][2][4][2], const GUnit& u, int wr, int wc, int fr, int fq) const {
        const int kind = u.kind & 255, gi = (u.kind >> 8) & 255;
        const unsigned rl0 = opq((unsigned)(wr * 64 + fr)), cl0 = opq((unsigned)(wc * 32 + 8 * fq));
        if (kind == K_GATE) {
            const LAS unsigned char* bb = bias + (gi * 1024 + u.pn * 256) * 4;
#pragma unroll
            for (int bj = 0; bj < 2; ++bj) { const f32x4 b0 = *(const LAS f32x4*)(bb + (cl0 + bj * 128) * 4u), b1 = *(const LAS f32x4*)(bb + (cl0 + bj * 128 + 4) * 4u);
#pragma unroll
                for (int ai = 0; ai < 2; ++ai)
#pragma unroll
                    for (int m = 0; m < 4; ++m)
#pragma unroll
                        for (int n = 0; n < 2; ++n) { const f32x4 v = acc[ai][bj][m][n] * W8INV + (n ? b1 : b0); unsigned pk = 0u;
#pragma unroll
                            for (int e = 0; e < 4; ++e) { const float sg = __builtin_amdgcn_rcpf(1.f + __expf(-v[e])); pk |= (unsigned)(sg * 255.f + 0.5f) << (8 * e); }
                            keep[ai][bj][m][n] = pk; } }
            return;
        }
        char* mb = (char*)(merged + (size_t)u.pm * 256 * 1024 + u.pn * 256); const unsigned mlo = rl0 * 2048u + cl0 * 2u;
        const float ysc = ((kind == K_YA) ? 1.f : 1.f / (SC_WBC * SC_ACT)) * (1.f / 255.f);
#pragma unroll
        for (int ai = 0; ai < 2; ++ai) {
            v4u pw[4][2];
            if (kind != K_YA) {
#pragma unroll
                for (int m = 0; m < 4; ++m)
#pragma unroll
                    for (int bj = 0; bj < 2; ++bj) pw[m][bj] = *(const GAS v4u*)(mb + (mlo + (unsigned)((ai * 128 + m * 16) * 2048 + bj * 256))); }
#pragma unroll
            for (int m = 0; m < 4; ++m)
#pragma unroll
                for (int bj = 0; bj < 2; ++bj) { f32x4 v[2];
#pragma unroll
                    for (int n = 0; n < 2; ++n) { const unsigned pk = keep[ai][bj][m][n];
                        v[n][0] = acc[ai][bj][m][n][0] * ((float)(pk & 255u) * ysc); v[n][1] = acc[ai][bj][m][n][1] * ((float)((pk >> 8) & 255u) * ysc);
                        v[n][2] = acc[ai][bj][m][n][2] * ((float)((pk >> 16) & 255u) * ysc); v[n][3] = acc[ai][bj][m][n][3] * ((float)(pk >> 24) * ysc); }
                    if (kind != K_YA) { f32x4 p0, p1; unpack8(pw[m][bj], p0, p1); v[0] += p0; v[1] += p1; }
                    *(GAS v4u*)(mb + (mlo + (unsigned)((ai * 128 + m * 16) * 2048 + bj * 256))) = pack8(v[0], v[1]); }
            __builtin_amdgcn_sched_barrier(0); }
    }
};
struct EpiP5 {
    bf16* h0; float* preln; float* stats; LAS unsigned char* lds_spare;
    __device__ __forceinline__ void operator()(f32x4 (&acc)[2][2][4][2], unsigned (&keep)[2][2][4][2], const GUnit& u, int wr, int wc, int fr, int fq) const {
        const unsigned rl0 = opq((unsigned)(wr * 64 + fr)), cl0 = opq((unsigned)(wc * 32 + 8 * fq));
        const size_t t0 = (size_t)u.pm * 256 * 1024 + u.pn * 256;
        char* hb = (char*)(h0 + t0);
        const unsigned hlo = rl0 * 2048u + cl0 * 2u;
#pragma unroll
        for (int ai = 0; ai < 2; ++ai) {
            v4u hw[4][2];
#pragma unroll
            for (int m = 0; m < 4; ++m)
#pragma unroll
                for (int bj = 0; bj < 2; ++bj) hw[m][bj] = *(const GAS v4u*)(hb + (hlo + (unsigned)((ai * 128 + m * 16) * 2048 + bj * 256)));
#pragma unroll
            for (int m = 0; m < 4; ++m) { float s1 = 0.f, s2 = 0.f;
#pragma unroll
                for (int bj = 0; bj < 2; ++bj) { f32x4 h0v, h1v; unpack8(hw[m][bj], h0v, h1v);
                    const f32x4 v0 = acc[ai][bj][m][0] + ALPHA * h0v, v1 = acc[ai][bj][m][1] + ALPHA * h1v;
                    *(GAS v4u*)(hb + (hlo + (unsigned)((ai * 128 + m * 16) * 2048 + bj * 256))) = pack8(v0, v1);
                    s1 += (v0[0] + v0[1]) + (v0[2] + v0[3]) + (v1[0] + v1[1]) + (v1[2] + v1[3]);
                    s2 += (v0[0] * v0[0] + v0[1] * v0[1]) + (v0[2] * v0[2] + v0[3] * v0[3]) + (v1[0] * v1[0] + v1[1] * v1[1]) + (v1[2] * v1[2] + v1[3] * v1[3]); }
                s1 += __shfl_xor(s1, 16); s1 += __shfl_xor(s1, 32); s2 += __shfl_xor(s2, 16); s2 += __shfl_xor(s2, 32);
                if (fq == 0) { f32x2 pr; pr.x = s1; pr.y = s2; *(LAS f32x2*)(lds_spare + ((ai * 128 + m * 16 + rl0) * 4 + wc) * 8) = pr; } }
            __builtin_amdgcn_sched_barrier(0); }
        asm volatile("s_waitcnt lgkmcnt(0)" ::: "memory"); __builtin_amdgcn_s_barrier(); asm volatile("" ::: "memory");
        { const int t = threadIdx.x;
          if (t < 256) { const LAS f32x2* pp = (const LAS f32x2*)(lds_spare + t * 32); f32x2 a = pp[0]; a += pp[1]; a += pp[2]; a += pp[3];
              *(GAS f32x2*)(stats + ((size_t)(u.pm * 256 + t) * 4 + u.pn) * 2) = a; } }
    }
};
struct EpiP7 {
    bf16* qp; const float* stats; const float* cvec; const float* dvec;
    __device__ __forceinline__ void operator()(f32x4 (&acc)[2][2][4][2], unsigned (&keep)[2][2][4][2], const GUnit& u, int wr, int wc, int fr, int fq) const {
        const unsigned rl0 = opq((unsigned)(wr * 64 + fr)), cl0 = opq((unsigned)(wc * 32 + 8 * fq));
        char* qb = (char*)(qp + (size_t)u.pm * 256 * 1024 + u.pn * 256); const unsigned lo = rl0 * 2048u + cl0 * 2u;
        f32x4 cv[2][2], dv[2][2];
#pragma unroll
        for (int bj = 0; bj < 2; ++bj)
#pragma unroll
            for (int n = 0; n < 2; ++n) { cv[bj][n] = *(const GAS f32x4*)(cvec + u.pn * 256 + cl0 + bj * 128 + 4 * n); dv[bj][n] = *(const GAS f32x4*)(dvec + u.pn * 256 + cl0 + bj * 128 + 4 * n); }
#pragma unroll
        for (int ai = 0; ai < 2; ++ai)
#pragma unroll
            for (int m = 0; m < 4; ++m) { const GAS f32x4* sp = (const GAS f32x4*)(stats + (size_t)(u.pm * 256 + ai * 128 + m * 16 + rl0) * 8); const f32x4 sa = sp[0], sb = sp[1];
                f32x2 st; st.x = ((sa.x + sa.z) + sb.x) + sb.z; st.y = ((sa.y + sa.w) + sb.y) + sb.w;
                const float mean = st.x * (1.f / D), rstd = 1.f / sqrtf(fmaxf(st.y * (1.f / D) - mean * mean, 0.f) + LN_EPS), mr = mean * rstd;
#pragma unroll
                for (int bj = 0; bj < 2; ++bj) *(GAS v4u*)(qb + (lo + (unsigned)((ai * 128 + m * 16) * 2048 + bj * 256))) = pack8(acc[ai][bj][m][0] * rstd - mr * cv[bj][0] + dv[bj][0], acc[ai][bj][m][1] * rstd - mr * cv[bj][1] + dv[bj][1]); }
    }
};

constexpr float FP6_SU = 60.f, FP6_SV = 3.15f;
__device__ __forceinline__ unsigned fp6_code(float v) {
    const float a = fminf(fabsf(v), 7.5f);
    const float c = a < 2.f ? rintf(a * 8.f) : (a < 4.f ? 16.f + rintf((a - 2.f) * 4.f) : 24.f + rintf((a - 4.f) * 2.f));
    return (unsigned)c | (v < 0.f ? 32u : 0u);
}
constexpr float FP4_SV = 3.36f, FP4_SU = 64.f;
__device__ __forceinline__ unsigned fp4_code(float v) {
    const float a = fminf(fabsf(v), 6.f);
    const float c = a < 2.f ? rintf(a * 2.f) : (a < 4.f ? 4.f + rintf(a - 2.f) : 6.f + rintf((a - 4.f) * 0.5f));
    return (unsigned)c | (v < 0.f ? 8u : 0u);
}
typedef unsigned v6u __attribute__((ext_vector_type(6)));
typedef float v32f __attribute__((ext_vector_type(32)));
__device__ __forceinline__ void p0_transpose_item(const float* W, int K, int ld, int col0, bf16* WT, unsigned char* WT8, float sc8, int row0, LAS float* scr, int item, int lane, int ncols,
                                                  const float* kg = nullptr, const float* kb = nullptr, float* cvec = nullptr, float* dvec = nullptr) {
    const int nblk = ncols / 32, kb_ = item / nblk, nb = item % nblk, k0 = 64 * kb_, n0 = 32 * nb;
    { float wv[32];
#pragma unroll
      for (int i = 0; i < 32; ++i) wv[i] = W[(size_t)(k0 + 2 * i + (lane >> 5)) * ld + col0 + n0 + (lane & 31)];
#pragma unroll
      for (int i = 0; i < 32; ++i) scr[(2 * i + (lane >> 5)) * 33 + (lane & 31)] = wv[i]; }
    LDS_WAIT(); asm volatile("" ::: "memory");
    const int c = lane & 7;
#pragma unroll
    for (int j = 0; j < 4; ++j) { const int n = (lane >> 3) + 8 * j; const LAS float* s = scr + (8 * c) * 33 + n;
        float e[8];
#pragma unroll
        for (int i = 0; i < 8; ++i) e[i] = s[i * 33];
        if (kg) { float pc = 0.f, pd = 0.f;
#pragma unroll
            for (int i = 0; i < 8; ++i) { const float g = kg[k0 + 8 * c + i]; pd += e[i] * kb[k0 + 8 * c + i]; e[i] *= g; pc += e[i]; }
            pc += __shfl_xor(pc, 1); pc += __shfl_xor(pc, 2); pc += __shfl_xor(pc, 4); pd += __shfl_xor(pd, 1); pd += __shfl_xor(pd, 2); pd += __shfl_xor(pd, 4);
            if (c == 0) { cvec[kb_ * 1024 + col0 + n0 + n] = pc; dvec[kb_ * 1024 + col0 + n0 + n] = pd; } }
        if (WT) { v4u o; o.x = pk2(e[0], e[1]); o.y = pk2(e[2], e[3]); o.z = pk2(e[4], e[5]); o.w = pk2(e[6], e[7]); *(GAS v4u*)(WT + (size_t)(row0 + n0 + n) * K + k0 + 8 * c) = o; }
        if (WT8) { v2u o; o.x = pk4_fp8(e[0] * sc8, e[1] * sc8, e[2] * sc8, e[3] * sc8); o.y = pk4_fp8(e[4] * sc8, e[5] * sc8, e[6] * sc8, e[7] * sc8); *(GAS v2u*)(WT8 + (size_t)(row0 + n0 + n) * K + k0 + 8 * c) = o; } }
    LDS_WAIT(); asm volatile("" ::: "memory");
}
__device__ __forceinline__ void ln_row(const float* xrow, const float* g, const float* b, bf16* obf, float* of32, int lane) {
    const GAS f32x4* xr = (const GAS f32x4*)xrow + lane;
    f32x4 v[4]; float s = 0.f;
#pragma unroll
    for (int j = 0; j < 4; ++j) { v[j] = xr[64 * j]; s += (v[j].x + v[j].y) + (v[j].z + v[j].w); }
    const float mean = wave_sum(s) * (1.f / D); float s2 = 0.f;
#pragma unroll
    for (int j = 0; j < 4; ++j) { v[j] = v[j] - mean; s2 += (v[j].x * v[j].x + v[j].y * v[j].y) + (v[j].z * v[j].z + v[j].w * v[j].w); }
    const float rstd = 1.f / sqrtf(wave_sum(s2) * (1.f / D) + LN_EPS);
#pragma unroll
    for (int j = 0; j < 4; ++j) { const f32x4 gg = ((const GAS f32x4*)g)[lane + 64 * j], bb = ((const GAS f32x4*)b)[lane + 64 * j];
        const f32x4 y = v[j] * rstd * gg + bb;
        if (obf) ((GAS unsigned long long*)obf)[lane + 64 * j] = (unsigned long long)pk2(y.x, y.y) | ((unsigned long long)pk2(y.z, y.w) << 32);
        if (of32) ((GAS f32x4*)of32)[lane + 64 * j] = y; }
}
__device__ __forceinline__ void ln_row2(const float* xa, const float* xb, const float* g, const float* b, bf16* oa, bf16* ob, unsigned char* oa8, unsigned char* ob8, int lane) {
    const GAS f32x4* pa = (const GAS f32x4*)xa + lane; const GAS f32x4* pb = (const GAS f32x4*)xb + lane;
    f32x4 va[4], vb[4]; float sa = 0.f, sb = 0.f;
#pragma unroll
    for (int j = 0; j < 4; ++j) { va[j] = pa[64 * j]; vb[j] = pb[64 * j]; }
#pragma unroll
    for (int j = 0; j < 4; ++j) { sa += (va[j].x + va[j].y) + (va[j].z + va[j].w); sb += (vb[j].x + vb[j].y) + (vb[j].z + vb[j].w); }
    const float ma = wave_sum(sa) * (1.f / D), mb = wave_sum(sb) * (1.f / D); float qa = 0.f, qb = 0.f;
#pragma unroll
    for (int j = 0; j < 4; ++j) { va[j] = va[j] - ma; vb[j] = vb[j] - mb; qa += (va[j].x * va[j].x + va[j].y * va[j].y) + (va[j].z * va[j].z + va[j].w * va[j].w); qb += (vb[j].x * vb[j].x + vb[j].y * vb[j].y) + (vb[j].z * vb[j].z + vb[j].w * vb[j].w); }
    const float ra = 1.f / sqrtf(wave_sum(qa) * (1.f / D) + LN_EPS), rb = 1.f / sqrtf(wave_sum(qb) * (1.f / D) + LN_EPS);
#pragma unroll
    for (int j = 0; j < 4; ++j) { const f32x4 gg = ((const GAS f32x4*)g)[lane + 64 * j], bb = ((const GAS f32x4*)b)[lane + 64 * j];
        const f32x4 ya = va[j] * ra * gg + bb, yb = vb[j] * rb * gg + bb;
        ((GAS unsigned long long*)oa)[lane + 64 * j] = (unsigned long long)pk2(ya.x, ya.y) | ((unsigned long long)pk2(ya.z, ya.w) << 32);
        ((GAS unsigned long long*)ob)[lane + 64 * j] = (unsigned long long)pk2(yb.x, yb.y) | ((unsigned long long)pk2(yb.z, yb.w) << 32);
        ((GAS unsigned*)oa8)[lane + 64 * j] = pk4_fp8(ya.x, ya.y, ya.z, ya.w); ((GAS unsigned*)ob8)[lane + 64 * j] = pk4_fp8(yb.x, yb.y, yb.z, yb.w); }
}
__device__ __forceinline__ int t5_bucket(int rel) {
    const int ret = rel > 0 ? 16 : 0; const int n = rel < 0 ? -rel : rel; const float nf = (float)(n > 1 ? n : 1);
    int large = 8 + (int)(logf(nf / 8.f) / 4.852030263919617f * 8.f); large = large < 15 ? large : 15;
    return ret + (n < 8 ? n : large);
}

__device__ __forceinline__ void phase0(const Ptrs& P, LAS unsigned char* lds, int tid, int lane, int wave, int G) {
    unsigned char* ws = P.ws;
    const int gw = blockIdx.x * NWAVES + wave, NGW = G * NWAVES;
    { bf16* h0 = (bf16*)(ws + WS_H0);
      unsigned char* h08 = ws + WS_H0F8;
      for (int m = gw; m < NT; m += 2 * NGW) ln_row2(P.in[0] + (size_t)m * D, P.in[0] + (size_t)(m + NGW) * D, P.in[3], P.in[4], h0 + (size_t)m * D, h0 + (size_t)(m + NGW) * D, h08 + (size_t)m * D, h08 + (size_t)(m + NGW) * D, lane); }
    { LAS float* scr = (LAS float*)(lds + wave * 16384);
      bf16* wtin = (bf16*)(ws + WS_WTIN);
      constexpr int I_IN = 23 * 16 * 8, I_A = 8 * 32, I_B = 4 * 32, I_C = 8 * 32, I_SQ = 16 * 32;
      constexpr int NIT = I_IN + I_A + I_B + I_C + 3 * I_SQ;
      unsigned char* wf8 = ws + WS_WF8IN;
      for (int it = gw; it < NIT; it += NGW) {
          int r = it;
          if (r < I_IN) { const int j = r / 128, q = r % 128; int src;
              if (j < 6) src = ((j & 1) ? 1280 : 512) + (j >> 1) * 256; else if (j < 9) src = 2048 + (j - 6) * 256; else if (j < 11) src = 2816 + (j - 9) * 256; else src = 3328 + (j - 11) * 256;
              p0_transpose_item(P.in[5], 1024, 6400, src, nullptr, wf8, W8SC, 1024 + 256 * j, scr, q, lane, 256); continue; }
          r -= I_IN;
          if (r < I_A) { p0_transpose_item(P.in[7], 512, 1024, 0, (bf16*)(ws + WS_WTA), nullptr, 0.f, 0, scr, r, lane, 1024); continue; } r -= I_A;
          if (r < I_B) { p0_transpose_item(P.in[8], 256, 1024, 0, nullptr, ws + WS_WTB, SC_WBC, 0, scr, r, lane, 1024); continue; } r -= I_B;
          if (r < I_C) { p0_transpose_item(P.in[9], 512, 1024, 0, nullptr, ws + WS_WTC, SC_WBC, 0, scr, r, lane, 1024); continue; } r -= I_C;
          if (r < I_SQ) { p0_transpose_item(P.in[10], 1024, 1024, 0, nullptr, ws + WS_WMKVF8, W8SC, 0, scr, r, lane, 1024); continue; } r -= I_SQ;
          if (r < I_SQ) { p0_transpose_item(P.in[11], 1024, 1024, 0, (bf16*)(ws + WS_WTO), nullptr, 0.f, 0, scr, r, lane, 1024); continue; } r -= I_SQ;
          p0_transpose_item(P.in[14], 1024, 1024, 0, (bf16*)(ws + WS_WTPQ), nullptr, 0.f, 0, scr, r, lane, 1024, P.in[12], P.in[13], (float*)(ws + WS_CPART), (float*)(ws + WS_CPART) + 16 * 1024);
      } }
    __syncthreads();
    { LAS float* wt = (LAS float*)lds;
      LAS float* cs = wt + 64 * 129; LAS float* sn = cs + 128;
      if (tid < 128) { float s, c; sincospif((float)tid / 64.f, &s, &c); cs[tid] = c; sn[tid] = s; }
      bf16* wtin = (bf16*)(ws + WS_WTIN);
      unsigned char* wf8 = ws + WS_WF8IN;
      for (int it = blockIdx.x; it < 256; it += G) {
          const int g = it >> 6, k0 = (it & 63) * 16;
          __syncthreads();
          for (int idx = tid; idx < 16 * 128; idx += 512) { const int kk = idx >> 7, c = idx & 127; wt[kk * 129 + c] = P.in[5][(size_t)(k0 + kk) * 6400 + g * 128 + c]; }
          __syncthreads();
          const int cp = tid & 127, kq = tid >> 7;
          float ac[4] = {0.f, 0.f, 0.f, 0.f}, as[4] = {0.f, 0.f, 0.f, 0.f};
#pragma unroll 4
          for (int c = 0; c < 128; ++c) { const int ix = (c * cp) & 127; const float cv = cs[ix], sv = sn[ix];
#pragma unroll
              for (int i = 0; i < 4; ++i) { const float w = wt[(4 * kq + i) * 129 + c]; ac[i] += w * cv; as[i] += w * sv; } }
          { v2u o; o.x = pk2(ac[0], ac[1]); o.y = pk2(ac[2], ac[3]); *(GAS v2u*)(wtin + (size_t)(g * 256 + cp) * 1024 + k0 + 4 * kq) = o;
            v2u q; q.x = pk2(as[0], as[1]); q.y = pk2(as[2], as[3]); *(GAS v2u*)(wtin + (size_t)(g * 256 + 128 + cp) * 1024 + k0 + 4 * kq) = q; }
      }
      __syncthreads();
      { float* bi = (float*)(ws + WS_BIASIN); const float* b_in = P.in[6];
        for (int r = gw; r < 1024; r += NGW) { const int g = r >> 8, w = r & 255, cp = w & 127; const bool isin = w >= 128;
            const int i0 = (lane * cp) & 127, i1 = ((lane + 64) * cp) & 127;
            float a = b_in[g * 128 + lane] * (isin ? sn[i0] : cs[i0]) + b_in[g * 128 + 64 + lane] * (isin ? sn[i1] : cs[i1]);
            a = wave_sum(a); if (lane == 0) bi[r] = a; }
        const int gtid = blockIdx.x * 512 + tid, nth = G * 512;
        for (int r = 1024 + gtid; r < WR_END; r += nth) { const int j = (r - 1024) >> 8, w = (r - 1024) & 255; int src;
            if (j < 6) src = ((j & 1) ? 1280 : 512) + (j >> 1) * 256; else if (j < 9) src = 2048 + (j - 6) * 256; else if (j < 11) src = 2816 + (j - 9) * 256; else src = 3328 + (j - 11) * 256;
            bi[r] = b_in[src + w]; }
        float* bt = (float*)(ws + WS_BIASTAB);
        for (int r = gtid; r < 3 * 4 * 129; r += nth) { const int g = r / (4 * 129), h = (r / 129) & 3, j = r % 129; const int rel = (j - 64) << (2 * g);
            bt[(g * 4 + h) * 132 + j] = P.in[2][t5_bucket(rel) * 12 + g * 4 + h]; }
      }
    }
    { const size_t gt = (size_t)blockIdx.x * 512 + tid, NTH = (size_t)G * 512;
      const GAS f32x4* us = (const GAS f32x4*)P.in[17]; const GAS f32x4* vs = (const GAS f32x4*)P.in[18];
      GAS v2u* ud = (GAS v2u*)(ws + WS_UTAB); GAS v2u* vd = (GAS v2u*)(ws + WS_VTAB);
#if TAB_FP6
      {
        const int njobs = 2 * 16384 * 16;
        for (int job = (int)gt; job < njobs; job += (int)NTH) { const int tb = job >> 18, e = (job >> 4) & 16383, fr = job & 15;
            const float sc = tb ? (TABV_FP4 ? FP4_SV : FP6_SV) : (TABU_FP4 ? FP4_SU : FP6_SU);
            const GAS f32x4* src = (const GAS f32x4*)((tb ? P.in[18] : P.in[17]) + (size_t)e * 1024 + fr * 16);
            f32x4 v[16];
#pragma unroll
            for (int c = 0; c < 4; ++c)
#pragma unroll
                for (int q4 = 0; q4 < 4; ++q4) v[c * 4 + q4] = src[c * 64 + q4];
            if ((TABV_FP4 && tb) || (TABU_FP4 && !tb)) {
                unsigned wd4[8];
#pragma unroll
                for (int w = 0; w < 8; ++w) { unsigned acc4 = 0u;
#pragma unroll
                    for (int t = 0; t < 8; ++t) acc4 |= fp4_code(v[w * 2 + (t >> 2)][t & 3] * sc) << (4 * t);
                    wd4[w] = acc4; }
                unsigned char* dst4 = ws + (tb ? WS_VTAB : WS_UTAB) + (size_t)e * 512 + fr * 16;
#pragma unroll
                for (int p = 0; p < 2; ++p) { v4u o; o.x = wd4[4 * p]; o.y = wd4[4 * p + 1]; o.z = wd4[4 * p + 2]; o.w = wd4[4 * p + 3]; *(GAS v4u*)(dst4 + p * 256) = o; }
                continue; }
            unsigned wd[12];
#pragma unroll
            for (int h = 0; h < 4; ++h) {
                unsigned cd[16];
#pragma unroll
                for (int q4 = 0; q4 < 4; ++q4)
#pragma unroll
                    for (int t = 0; t < 4; ++t) cd[q4 * 4 + t] = fp6_code(v[h * 4 + q4][t] * sc);
                wd[h * 3 + 0] = cd[0] | (cd[1] << 6) | (cd[2] << 12) | (cd[3] << 18) | (cd[4] << 24) | ((cd[5] & 3u) << 30);
                wd[h * 3 + 1] = (cd[5] >> 2) | (cd[6] << 4) | (cd[7] << 10) | (cd[8] << 16) | (cd[9] << 22) | ((cd[10] & 15u) << 28);
                wd[h * 3 + 2] = (cd[10] >> 4) | (cd[11] << 2) | (cd[12] << 8) | (cd[13] << 14) | (cd[14] << 20) | (cd[15] << 26); }
            unsigned char* dst = ws + (tb ? WS_VTAB : WS_UTAB) + (size_t)e * 768 + fr * 16;
#pragma unroll
            for (int p = 0; p < 3; ++p) { v4u o; o.x = wd[4 * p]; o.y = wd[4 * p + 1]; o.z = wd[4 * p + 2]; o.w = wd[4 * p + 3]; *(GAS v4u*)(dst + p * 256) = o; } } }
#endif
      const GAS f32x4* ms = (const GAS f32x4*)P.in[1]; GAS unsigned* md = (GAS unsigned*)(ws + WS_MEMF8);
      for (size_t i = gt; i < (size_t)512 * 1024 / 4; i += NTH) { const f32x4 a = ms[i]; md[i] = pk4_fp8(a.x, a.y, a.z, a.w); }
    }
}

constexpr int FFT_PITCH = 544, FFT_BUF = 128 * FFT_PITCH;
static_assert(2 * FFT_BUF <= MISC_OFF, "FFT LDS map");
typedef short s16x4 __attribute__((ext_vector_type(4)));
__device__ __forceinline__ s16x4 tr_read(LAS unsigned char* p) { return __builtin_amdgcn_ds_read_tr16_b64_v4i16((LAS s16x4*)p); }
template <int STEP>
__device__ __forceinline__ void fft_step_mfma(const bf16* src, bf16* dst, LAS unsigned char* lds, int tid, int lane, int wave, int G) {
    const int fr = lane & 15, kq = lane >> 4, kout = 16 * wave + fr;
    bf16x8 cf[4], sf[4];
    { LAS float* tab = (LAS float*)(lds + FFT_BUF);
      __syncthreads();
      if (tid < 128) { float sn, cs; sincospif((float)tid / 64.f, &sn, &cs); tab[tid] = cs; tab[128 + tid] = sn; }
      __syncthreads();
#pragma unroll
      for (int kk = 0; kk < 4; ++kk) { v4u cw, sw; unsigned cl[8], sl[8];
#pragma unroll
          for (int j = 0; j < 8; ++j) { const int sv = 32 * kk + (j < 4 ? 4 * kq + j : 16 + 4 * kq + j - 4); const int ix = (kout * sv) & 127; cl[j] = f2bf(tab[ix]); sl[j] = f2bf(tab[128 + ix]); }
          cw.x = cl[0] | (cl[1] << 16); cw.y = cl[2] | (cl[3] << 16); cw.z = cl[4] | (cl[5] << 16); cw.w = cl[6] | (cl[7] << 16);
          sw.x = sl[0] | (sl[1] << 16); sw.y = sl[2] | (sl[3] << 16); sw.z = sl[4] | (sl[5] << 16); sw.w = sl[6] | (sl[7] << 16);
          cf[kk] = __builtin_bit_cast(bf16x8, cw); sf[kk] = __builtin_bit_cast(bf16x8, sw); } }
    v4u iw[8];
#define FFT_LOAD(UN) do { const int b_ = (UN) >> 9, f_ = ((UN) >> 2) & 127, g_ = (UN) & 3; _Pragma("unroll") for (int j = 0; j < 8; ++j) { const int c = tid + 512 * j; const int sr = c >> 5, piece = c & 31; \
            const size_t row = (STEP == 1) ? (size_t)(b_ << 14) + 128 * sr + f_ : (size_t)(b_ << 14) + 128 * f_ + sr; iw[j] = *(const GAS v4u*)(src + row * 1024 + g_ * 256 + piece * 8); } } while (0)
#define FFT_PUT(BUF) do { _Pragma("unroll") for (int j = 0; j < 8; ++j) { const int c = tid + 512 * j; *(LAS v4u*)(lds + (BUF) * FFT_BUF + (c >> 5) * FFT_PITCH + (c & 31) * 16) = iw[j]; } } while (0)
    __syncthreads();
    if (blockIdx.x < 1024) { FFT_LOAD(blockIdx.x); FFT_PUT(0); }
    __syncthreads();
    int cur = 0;
    for (int unit = blockIdx.x; unit < 1024; unit += G) {
        const int b = unit >> 9, f = (unit >> 2) & 127, g = unit & 3;
        const bool more = unit + G < 1024;
        if (more) FFT_LOAD(unit + G);
        LAS unsigned char* img = lds + cur * FFT_BUF;
        f32x4 accR[8], accI[8];
#pragma unroll
        for (int mt = 0; mt < 8; ++mt) { accR[mt] = (f32x4){0.f, 0.f, 0.f, 0.f}; accI[mt] = (f32x4){0.f, 0.f, 0.f, 0.f}; }
#pragma unroll
        for (int mt = 0; mt < 8; ++mt)
#pragma unroll
            for (int kk = 0; kk < 4; ++kk) {
                LAS unsigned char* a1 = img + (32 * kk + 4 * kq + (fr >> 2)) * FFT_PITCH + (16 * mt + 4 * (fr & 3)) * 2;
                LAS unsigned char* a2 = a1 + 16 * FFT_PITCH;
                const s16x4 r0 = tr_read(a1), r1 = tr_read(a2), i0 = tr_read(a1 + 256), i1 = tr_read(a2 + 256);
                const bf16x8 xr = __builtin_shufflevector(r0, r1, 0, 1, 2, 3, 4, 5, 6, 7), xi = __builtin_shufflevector(i0, i1, 0, 1, 2, 3, 4, 5, 6, 7);
                if (STEP == 1) {
                    v4u t = __builtin_bit_cast(v4u, xi); t.x ^= 0x80008000u; t.y ^= 0x80008000u; t.z ^= 0x80008000u; t.w ^= 0x80008000u; const bf16x8 nxi = __builtin_bit_cast(bf16x8, t);
                    accR[mt] = __builtin_amdgcn_mfma_f32_16x16x32_bf16(xr, cf[kk], accR[mt], 0, 0, 0); accR[mt] = __builtin_amdgcn_mfma_f32_16x16x32_bf16(nxi, sf[kk], accR[mt], 0, 0, 0);
                    accI[mt] = __builtin_amdgcn_mfma_f32_16x16x32_bf16(xi, cf[kk], accI[mt], 0, 0, 0); accI[mt] = __builtin_amdgcn_mfma_f32_16x16x32_bf16(xr, sf[kk], accI[mt], 0, 0, 0);
                } else {
                    accR[mt] = __builtin_amdgcn_mfma_f32_16x16x32_bf16(xr, cf[kk], accR[mt], 0, 0, 0); accR[mt] = __builtin_amdgcn_mfma_f32_16x16x32_bf16(xi, sf[kk], accR[mt], 0, 0, 0);
                }
                if (kk == 3) __builtin_amdgcn_sched_barrier(0);
            }
        if (STEP == 1) { float ws_, wc_; sincospif(-(float)(f * kout) / 8192.f, &ws_, &wc_);
            bf16* orow = dst + ((size_t)(b << 14) + kout * 128 + f) * 1024 + g * 256 + 4 * kq;
#pragma unroll
            for (int mt = 0; mt < 8; ++mt) { v2u re, im; re.x = pk2(accR[mt][0] * wc_ + accI[mt][0] * ws_, accR[mt][1] * wc_ + accI[mt][1] * ws_); re.y = pk2(accR[mt][2] * wc_ + accI[mt][2] * ws_, accR[mt][3] * wc_ + accI[mt][3] * ws_);
                im.x = pk2(accR[mt][0] * ws_ - accI[mt][0] * wc_, accR[mt][1] * ws_ - accI[mt][1] * wc_); im.y = pk2(accR[mt][2] * ws_ - accI[mt][2] * wc_, accR[mt][3] * ws_ - accI[mt][3] * wc_);
                *(GAS v2u*)(orow + 16 * mt) = re; *(GAS v2u*)(orow + 128 + 16 * mt) = im; }
        } else { const float scale = 6.905339660024878e-4f;
            bf16* orow = dst + ((size_t)(b << 14) + f + 128 * kout) * 512 + g * 128 + 4 * kq;
#pragma unroll
            for (int mt = 0; mt < 8; ++mt) { v2u re; re.x = pk2(accR[mt][0] * scale, accR[mt][1] * scale); re.y = pk2(accR[mt][2] * scale, accR[mt][3] * scale); *(GAS v2u*)(orow + 16 * mt) = re; }
        }
        if (more) FFT_PUT(cur ^ 1);
        __syncthreads();
        cur ^= 1;
    }
#undef FFT_LOAD
#undef FFT_PUT
}

typedef float f32x16 __attribute__((ext_vector_type(16)));
constexpr int DA_BT = 0, DA_K = 9216, DA_KP = 144, DA_V = DA_K + 384 * DA_KP, DA_VP = 776;
static_assert(DA_V + 64 * DA_VP <= MISC_OFF, "dil-attn LDS map");
template <int T>
__device__ __forceinline__ void dil_tile(LAS unsigned char* lds, int kr0, int r31, int hh, const LAS float* btl, const bf16x8 (&qf)[4], f32x16& o0, f32x16& o1, float& mx, float& den) {
    const LAS unsigned char* kp = lds + DA_K + (kr0 + r31) * DA_KP + 16 * hh;
    f32x16 sacc;
#pragma unroll
    for (int i = 0; i < 16; ++i) sacc[i] = 0.f;
#pragma unroll
    for (int kk = 0; kk < 4; ++kk) { const bf16x8 kf = *(const LAS bf16x8*)(kp + 32 * kk); sacc = __builtin_amdgcn_mfma_f32_32x32x16_bf16(kf, qf[kk], sacc, 0, 0, 0); }
    const LAS float* bl = btl + (32 + 32 * T + 4 * hh - r31);
    float tmax = -INFINITY;
#pragma unroll
    for (int i = 0; i < 16; ++i) { const int krow = (i & 3) + 8 * (i >> 2);
        float sv = sacc[i] * 0.18033688011112042f + bl[krow];
        if (T == 0) sv = (krow + 4 * hh >= r31) ? sv : -INFINITY;
        if (T == 4) sv = (krow + 4 * hh <= r31) ? sv : -INFINITY;
        sacc[i] = sv; tmax = fmaxf(tmax, sv); }
    tmax = fmaxf(tmax, __shfl_xor(tmax, 32));
    const float mn = fmaxf(mx, tmax), corr = __builtin_amdgcn_exp2f(mx - mn); mx = mn;
    float psum = 0.f;
#pragma unroll
    for (int i = 0; i < 16; ++i) { const float p = __builtin_amdgcn_exp2f(sacc[i] - mn); sacc[i] = p; psum += p; }
    den = den * corr + psum;
#pragma unroll
    for (int i = 0; i < 16; ++i) { o0[i] *= corr; o1[i] *= corr; }
#pragma unroll
    for (int s2 = 0; s2 < 2; ++s2) { v4u pw; pw.x = pk2(sacc[8 * s2], sacc[8 * s2 + 1]); pw.y = pk2(sacc[8 * s2 + 2], sacc[8 * s2 + 3]); pw.z = pk2(sacc[8 * s2 + 4], sacc[8 * s2 + 5]); pw.w = pk2(sacc[8 * s2 + 6], sacc[8 * s2 + 7]);
        const bf16x8 pf = __builtin_bit_cast(bf16x8, pw);
        const LAS unsigned char* vp = lds + DA_V + r31 * DA_VP + (kr0 + 16 * s2 + 4 * hh) * 2;
        const v2u lo0 = *(const LAS v2u*)vp, hi0 = *(const LAS v2u*)(vp + 16), lo1 = *(const LAS v2u*)(vp + 32 * DA_VP), hi1 = *(const LAS v2u*)(vp + 32 * DA_VP + 16);
        v4u w0, w1; w0.x = lo0.x; w0.y = lo0.y; w0.z = hi0.x; w0.w = hi0.y; w1.x = lo1.x; w1.y = lo1.y; w1.z = hi1.x; w1.w = hi1.y;
        o0 = __builtin_amdgcn_mfma_f32_32x32x16_bf16(__builtin_bit_cast(bf16x8, w0), pf, o0, 0, 0, 0);
        o1 = __builtin_amdgcn_mfma_f32_32x32x16_bf16(__builtin_bit_cast(bf16x8, w1), pf, o1, 0, 0, 0); }
}
__device__ __forceinline__ void dil_attn_lds(const bf16* qk, const bf16* vt, const float* btab_g, bf16* og, float* lse, LAS unsigned char* lds, int tid, int lane, int wave, int G) {
    LAS float* bt = (LAS float*)(lds + DA_BT);
    __syncthreads();
    for (int i = tid; i < 12 * 192; i += 512) { const int tb = i / 192, j = i - tb * 192 - 32; bt[i] = (j >= 0 && j <= 128) ? btab_g[tb * 132 + j] * 1.4426950408889634f : 0.f; }
    const int r31 = lane & 31, hh = lane >> 5;
    v4u kw[6], vw[6]; bf16x8 qn[4];
#define DIL_UNIT(U) const int blk = (U) & 63, hd = ((U) >> 6) & 3, g = ((U) >> 8) % 3, b = (U) / 768; const int sh = 2 * g, sub = 16384 >> sh; \
        const int nl0 = blk * 256, rr = nl0 >> (14 - sh), l0 = nl0 & (sub - 1); const size_t seq0 = ((size_t)g * NT + (size_t)(b << 14) + (size_t)rr * sub); \
        const bf16* qkg = qk + seq0 * 512; const bf16* vtg = vt + ((size_t)g * 256 + hd * 64) * NT + (size_t)(b << 14) + (size_t)rr * sub;
#define DIL_LOAD() do { _Pragma("unroll") for (int j = 0; j < 6; ++j) { const int c = tid + 512 * j; const int kr = c >> 3, pc = c & 7; const int lk = l0 - 64 + kr; const int lkc = lk < 0 ? 0 : (lk >= sub ? sub - 1 : lk); \
              kw[j] = *(const GAS v4u*)(qkg + (size_t)lkc * 512 + 256 + hd * 64 + pc * 8); \
              const int d = c / 48, pv = c - d * 48; const int lv = l0 - 64 + pv * 8; const int lvc = lv < 0 ? 0 : (lv >= sub ? sub - 8 : lv); \
              vw[j] = *(const GAS v4u*)(vtg + (size_t)d * NT + lvc); } \
          _Pragma("unroll") for (int kk = 0; kk < 4; ++kk) qn[kk] = *(const GAS bf16x8*)(qkg + (size_t)(l0 + 32 * wave + (lane & 31)) * 512 + hd * 64 + 16 * kk + 8 * (lane >> 5)); } while (0)
    if (blockIdx.x < 1536) { DIL_UNIT(blockIdx.x) DIL_LOAD(); }
    for (int u = blockIdx.x; u < 1536; u += G) {
        DIL_UNIT(u)
        __syncthreads();
#pragma unroll
        for (int j = 0; j < 6; ++j) { const int c = tid + 512 * j; const int kr = c >> 3, pc = c & 7;
            *(LAS v4u*)(lds + DA_K + kr * DA_KP + pc * 16) = kw[j];
            const int d = c / 48, pv = c - d * 48;
            v2u lo, hi; lo.x = vw[j].x; lo.y = vw[j].y; hi.x = vw[j].z; hi.y = vw[j].w;
            *(LAS v2u*)(lds + DA_V + d * DA_VP + pv * 16) = lo; *(LAS v2u*)(lds + DA_V + d * DA_VP + pv * 16 + 8) = hi; }
        __syncthreads();
        bf16x8 qf[4];
#pragma unroll
        for (int kk = 0; kk < 4; ++kk) qf[kk] = qn[kk];
        if (u + G < 1536) { const int un = u + G; const int blkn = un & 63, hdn = (un >> 6) & 3, gn = (un >> 8) % 3, bn = un / 768; const int shn = 2 * gn, subn = 16384 >> shn;
            const int nl0n = blkn * 256, rrn = nl0n >> (14 - shn), l0n = nl0n & (subn - 1); const size_t seq0n = ((size_t)gn * NT + (size_t)(bn << 14) + (size_t)rrn * subn);
            const bf16* qkgn = qk + seq0n * 512; const bf16* vtgn = vt + ((size_t)gn * 256 + hdn * 64) * NT + (size_t)(bn << 14) + (size_t)rrn * subn;
#pragma unroll
            for (int j = 0; j < 6; ++j) { const int c = tid + 512 * j; const int kr = c >> 3, pc = c & 7; const int lk = l0n - 64 + kr; const int lkc = lk < 0 ? 0 : (lk >= subn ? subn - 1 : lk);
                kw[j] = *(const GAS v4u*)(qkgn + (size_t)lkc * 512 + 256 + hdn * 64 + pc * 8);
                const int d = c / 48, pv = c - d * 48; const int lv = l0n - 64 + pv * 8; const int lvc = lv < 0 ? 0 : (lv >= subn ? subn - 8 : lv);
                vw[j] = *(const GAS v4u*)(vtgn + (size_t)d * NT + lvc); }
#pragma unroll
            for (int kk = 0; kk < 4; ++kk) qn[kk] = *(const GAS bf16x8*)(qkgn + (size_t)(l0n + 32 * wave + (lane & 31)) * 512 + hdn * 64 + 16 * kk + 8 * (lane >> 5)); }
        const int lq0 = l0 + 32 * wave;
        const LAS float* btl = bt + (g * 4 + hd) * 192;
        f32x16 o0, o1;
#pragma unroll
        for (int i = 0; i < 16; ++i) { o0[i] = 0.f; o1[i] = 0.f; }
        float mx = -1e30f, den = 0.f;
        if (lq0 - 64 >= 0) dil_tile<0>(lds, 32 * wave, r31, hh, btl, qf, o0, o1, mx, den);
        if (lq0 - 32 >= 0) dil_tile<1>(lds, 32 * wave + 32, r31, hh, btl, qf, o0, o1, mx, den);
        dil_tile<2>(lds, 32 * wave + 64, r31, hh, btl, qf, o0, o1, mx, den);
        if (lq0 + 32 < sub) dil_tile<3>(lds, 32 * wave + 96, r31, hh, btl, qf, o0, o1, mx, den);
        if (lq0 + 64 < sub) dil_tile<4>(lds, 32 * wave + 128, r31, hh, btl, qf, o0, o1, mx, den);
        den += __shfl_xor(den, 32);
        const float inv = 1.f / den;
        const size_t n = seq0 + lq0 + r31;
        bf16* orow = og + n * 256 + hd * 64 + 4 * hh;
#pragma unroll
        for (int q4 = 0; q4 < 4; ++q4) { v2u w0, w1; w0.x = pk2(o0[4 * q4] * inv, o0[4 * q4 + 1] * inv); w0.y = pk2(o0[4 * q4 + 2] * inv, o0[4 * q4 + 3] * inv);
            w1.x = pk2(o1[4 * q4] * inv, o1[4 * q4 + 1] * inv); w1.y = pk2(o1[4 * q4 + 2] * inv, o1[4 * q4 + 3] * inv);
            *(GAS v2u*)(orow + 8 * q4) = w0; *(GAS v2u*)(orow + 32 + 8 * q4) = w1; }
        if (hh == 0) lse[n * 4 + hd] = (mx + __builtin_amdgcn_logf(den)) * 0.6931471805599453f;
    }
    __syncthreads();
#undef DIL_UNIT
#undef DIL_LOAD
}
constexpr int MA_KP = 272, MA_VP = 520, MA_V = 256 * MA_KP;
static_assert(MA_V + 128 * MA_VP <= MISC_OFF, "mem-attn LDS map");
__device__ __forceinline__ void mem_attn_lds(const bf16* qc, const bf16* memk, const bf16* vtm, bf16* ycin, LAS unsigned char* lds, int tid, int lane, int wave, int G) {
    const int r31 = lane & 31, hh = lane >> 5;
    for (int wu = blockIdx.x; wu < 256; wu += G) {
        const int combo = wu & 7, b = combo >> 2, hd = combo & 3, chunk = wu >> 3;
        __syncthreads();
        { v4u kw[8], vw[8];
#pragma unroll
          for (int j = 0; j < 8; ++j) { const int c = tid + 512 * j; kw[j] = *(const GAS v4u*)(memk + (size_t)(b * 256 + (c >> 4)) * 512 + hd * 128 + (c & 15) * 8);
              vw[j] = *(const GAS v4u*)(vtm + (size_t)(hd * 128 + (c >> 5)) * 512 + b * 256 + (c & 31) * 8); }
#pragma unroll
          for (int j = 0; j < 8; ++j) { const int c = tid + 512 * j; *(LAS v4u*)(lds + (c >> 4) * MA_KP + (c & 15) * 16) = kw[j];
              v2u lo, hi; lo.x = vw[j].x; lo.y = vw[j].y; hi.x = vw[j].z; hi.y = vw[j].w;
              *(LAS v2u*)(lds + MA_V + (c >> 5) * MA_VP + (c & 31) * 16) = lo; *(LAS v2u*)(lds + MA_V + (c >> 5) * MA_VP + (c & 31) * 16 + 8) = hi; } }
        __syncthreads();
#pragma unroll 1
        for (int qi = 0; qi < 2; ++qi) {
            const int blk = chunk * 16 + wave * 2 + qi;
            const size_t tok = (size_t)(b << 14) + blk * 32 + r31;
            const bf16* qrow = qc + tok * 512 + hd * 128 + 8 * hh;
            bf16x8 qf[8];
#pragma unroll
            for (int kk = 0; kk < 8; ++kk) qf[kk] = *(const GAS bf16x8*)(qrow + 16 * kk);
            f32x16 o[4];
#pragma unroll
            for (int mt = 0; mt < 4; ++mt)
#pragma unroll
                for (int i = 0; i < 16; ++i) o[mt][i] = 0.f;
            float mx = -1e30f, den = 0.f;
            const LAS unsigned char* kb = lds + r31 * MA_KP + 16 * hh;
            const LAS unsigned char* vb = lds + MA_V + r31 * MA_VP + 8 * hh;
#pragma unroll 1
            for (int t = 0; t < 8; ++t) {
                f32x16 sacc;
#pragma unroll
                for (int i = 0; i < 16; ++i) sacc[i] = 0.f;
#pragma unroll
                for (int kk = 0; kk < 8; ++kk) { const bf16x8 kf = *(const LAS bf16x8*)(kb + (32 * t) * MA_KP + 32 * kk); sacc = __builtin_amdgcn_mfma_f32_32x32x16_bf16(kf, qf[kk], sacc, 0, 0, 0); }
                float tmax = -INFINITY;
#pragma unroll
                for (int i = 0; i < 16; ++i) { sacc[i] *= 0.08838834764831845f; tmax = fmaxf(tmax, sacc[i]); }
                tmax = fmaxf(tmax, __shfl_xor(tmax, 32));
                const float mn = fmaxf(mx, tmax), corr = __expf(mx - mn); mx = mn;
                float psum = 0.f;
#pragma unroll
                for (int i = 0; i < 16; ++i) { const float p = __expf(sacc[i] - mn); sacc[i] = p; psum += p; }
                den = den * corr + psum;
#pragma unroll
                for (int mt = 0; mt < 4; ++mt)
#pragma unroll
                    for (int i = 0; i < 16; ++i) o[mt][i] *= corr;
#pragma unroll
                for (int s2 = 0; s2 < 2; ++s2) { v4u pw; pw.x = pk2(sacc[8 * s2], sacc[8 * s2 + 1]); pw.y = pk2(sacc[8 * s2 + 2], sacc[8 * s2 + 3]); pw.z = pk2(sacc[8 * s2 + 4], sacc[8 * s2 + 5]); pw.w = pk2(sacc[8 * s2 + 6], sacc[8 * s2 + 7]);
                    const bf16x8 pf = __builtin_bit_cast(bf16x8, pw);
#pragma unroll
                    for (int mt = 0; mt < 4; ++mt) { const LAS unsigned char* vp = vb + (32 * mt) * MA_VP + (32 * t + 16 * s2) * 2;
                        const v2u lo = *(const LAS v2u*)vp, hi = *(const LAS v2u*)(vp + 16);
                        v4u w; w.x = lo.x; w.y = lo.y; w.z = hi.x; w.w = hi.y;
                        o[mt] = __builtin_amdgcn_mfma_f32_32x32x16_bf16(__builtin_bit_cast(bf16x8, w), pf, o[mt], 0, 0, 0); } }
            }
            den += __shfl_xor(den, 32);
            const float inv = 1.f / den;
            unsigned char* orow = (unsigned char*)ycin + tok * 512 + hd * 128 + 4 * hh; const float inv4 = inv * SC_ACT;
#pragma unroll
            for (int mt = 0; mt < 4; ++mt)
#pragma unroll
                for (int q4 = 0; q4 < 4; ++q4) *(GAS unsigned*)(orow + 32 * mt + 8 * q4) = pk4_fp8(o[mt][4 * q4] * inv4, o[mt][4 * q4 + 1] * inv4, o[mt][4 * q4 + 2] * inv4, o[mt][4 * q4 + 3] * inv4);
        }
    }
    __syncthreads();
}
__device__ __forceinline__ void combine_groups(const bf16* og, const float* lse, bf16* ob, int tid, int G) {
    for (size_t idx = (size_t)blockIdx.x * 512 + tid; idx < (size_t)NT * 32; idx += (size_t)G * 512) {
        const int t = (int)(idx >> 5), ch = (int)(idx & 31), h = ch >> 3, d0 = (ch & 7) * 8, b = t >> 14, s = t & 16383;
        float l[3]; size_t n[3];
#pragma unroll
        for (int g = 0; g < 3; ++g) { const int sh = 2 * g; n[g] = (size_t)(b << 14) + (size_t)(s & ((1 << sh) - 1)) * (16384 >> sh) + (s >> sh); l[g] = lse[((size_t)g * NT + n[g]) * 4 + h]; }
        const float mx = fmaxf(l[0], fmaxf(l[1], l[2])); float w[3], sum = 0.f;
#pragma unroll
        for (int g = 0; g < 3; ++g) { w[g] = __expf(l[g] - mx); sum += w[g]; }
        float o[8] = {0, 0, 0, 0, 0, 0, 0, 0};
#pragma unroll
        for (int g = 0; g < 3; ++g) { const float wg = w[g] / sum; const v4u v = *(const GAS v4u*)(og + ((size_t)g * NT + n[g]) * 256 + h * 64 + d0);
            o[0] += wg * bflo(v.x); o[1] += wg * bfhi(v.x); o[2] += wg * bflo(v.y); o[3] += wg * bfhi(v.y); o[4] += wg * bflo(v.z); o[5] += wg * bfhi(v.z); o[6] += wg * bflo(v.w); o[7] += wg * bfhi(v.w); }
        v2u r; r.x = pk4_fp8(o[0] * SC_ACT, o[1] * SC_ACT, o[2] * SC_ACT, o[3] * SC_ACT); r.y = pk4_fp8(o[4] * SC_ACT, o[5] * SC_ACT, o[6] * SC_ACT, o[7] * SC_ACT);
        *(GAS v2u*)((unsigned char*)ob + (size_t)t * 256 + h * 64 + d0) = r;
    }
}

template <int C> __device__ __forceinline__ unsigned dppu(unsigned v) { return (unsigned)__builtin_amdgcn_update_dpp(0, (int)v, C, 0xF, 0xF, true); }
template <int C> __device__ __forceinline__ float dppf(float v) { return __builtin_bit_cast(float, __builtin_amdgcn_update_dpp(0, __builtin_bit_cast(int, v), C, 0xF, 0xF, true)); }
__device__ __forceinline__ unsigned umax2(unsigned a, unsigned b) { return a > b ? a : b; }
__device__ __forceinline__ unsigned row_max_u(unsigned v) { v = umax2(v, dppu<0xB1>(v)); v = umax2(v, dppu<0x4E>(v)); v = umax2(v, dppu<0x141>(v)); v = umax2(v, dppu<0x140>(v)); return v; }
__device__ __forceinline__ float row_max_f(float v) { v = fmaxf(v, dppf<0xB1>(v)); v = fmaxf(v, dppf<0x4E>(v)); v = fmaxf(v, dppf<0x141>(v)); v = fmaxf(v, dppf<0x140>(v)); return v; }
__device__ __forceinline__ float row_sum_f(float v) { v += dppf<0xB1>(v); v += dppf<0x4E>(v); v += dppf<0x141>(v); v += dppf<0x140>(v); return v; }
__device__ __forceinline__ unsigned ordf(float f) { const unsigned b = __builtin_bit_cast(unsigned, f); return b ^ ((unsigned)((int)b >> 31) | 0x80000000u); }
__device__ __forceinline__ float decf(unsigned k) { const unsigned b = (k & 0x80000000u) ? (k ^ 0x80000000u) : ~k; return __builtin_bit_cast(float, b); }
__device__ __forceinline__ unsigned bperm(unsigned v, int src_lane) { return (unsigned)__builtin_amdgcn_ds_bpermute(src_lane * 4, (int)v); }
typedef __bf16 bf16x2_t __attribute__((ext_vector_type(2)));
__device__ __forceinline__ float dot2bf(unsigned a, unsigned b, float c) { return __builtin_amdgcn_fdot2_f32_bf16(__builtin_bit_cast(bf16x2_t, a), __builtin_bit_cast(bf16x2_t, b), c, false); }

__device__ __forceinline__ float gelu_as(float v) {
    const float av = fabsf(v), t = __builtin_amdgcn_rcpf(av * 0.2316418882f + 1.0f);
    float q = t * 0.5307027145f + (-0.7265760135f); q = q * t + 0.7107068705f; q = q * t + (-0.142248368f); q = q * t + 0.127414796f; q = q * t;
    const float e = __builtin_amdgcn_exp2f((v * v) * (-0.72134752044f));
    const float m = v * (q * e);
    return v < 0.f ? m : v - m;
}
constexpr int PEER_SKB = 0, PEER_EL = 36864, PEER_PTAB = PEER_EL + 32768, PEER_EL2 = PEER_PTAB + 256;
__device__ __forceinline__ void peer_scores_top16(const bf16* qp, LAS unsigned char* lds, int tokb, int hf, int fr, int fq, unsigned& o0, unsigned& o1, unsigned& o2, unsigned& o3) {
    const bf16* arow = qp + (size_t)(tokb + (fr >> 3)) * 1024 + (fr & 7) * 128 + hf * 64 + 8 * fq;
    const bf16x8 a0 = *(const GAS bf16x8*)arow, a1 = *(const GAS bf16x8*)(arow + 32);
    unsigned e0[8], e1[8], e2[8], e3[8];
#pragma unroll
    for (int nb = 0; nb < 8; ++nb) {
        const LAS unsigned char* bp = lds + PEER_SKB + hf * 18432 + (fr + 16 * nb) * 144 + fq * 16;
        const bf16x8 b0 = *(const LAS bf16x8*)bp, b1 = *(const LAS bf16x8*)(bp + 64);
        f32x4 acc = (f32x4){0.f, 0.f, 0.f, 0.f};
        acc = __builtin_amdgcn_mfma_f32_16x16x32_bf16(a0, b0, acc, 0, 0, 0);
        acc = __builtin_amdgcn_mfma_f32_16x16x32_bf16(a1, b1, acc, 0, 0, 0);
        const unsigned ix = (unsigned)(127 - (fr + 16 * nb));
        e0[nb] = (ordf(acc[0]) & ~127u) | ix; e1[nb] = (ordf(acc[1]) & ~127u) | ix; e2[nb] = (ordf(acc[2]) & ~127u) | ix; e3[nb] = (ordf(acc[3]) & ~127u) | ix;
    }
    o0 = 0u; o1 = 0u; o2 = 0u; o3 = 0u;
#define PEER_CE(E, A, B) do { const unsigned hi_ = umax2(E[A], E[B]), lo_ = E[A] < E[B] ? E[A] : E[B]; E[A] = hi_; E[B] = lo_; } while (0)
#define PEER_SORT8(E) do { PEER_CE(E, 0, 1); PEER_CE(E, 2, 3); PEER_CE(E, 4, 5); PEER_CE(E, 6, 7); PEER_CE(E, 0, 2); PEER_CE(E, 1, 3); PEER_CE(E, 4, 6); PEER_CE(E, 5, 7); PEER_CE(E, 1, 2); PEER_CE(E, 5, 6); \
        PEER_CE(E, 0, 4); PEER_CE(E, 1, 5); PEER_CE(E, 2, 6); PEER_CE(E, 3, 7); PEER_CE(E, 2, 4); PEER_CE(E, 3, 5); PEER_CE(E, 1, 2); PEER_CE(E, 3, 4); PEER_CE(E, 5, 6); } while (0)
#define PEER_ROUND(E, O) do { const unsigned m = row_max_u(E[0]); const bool win = (E[0] == m); \
        E[0] = win ? E[1] : E[0]; E[1] = win ? E[2] : E[1]; E[2] = win ? E[3] : E[2]; E[3] = win ? E[4] : E[3]; E[4] = win ? E[5] : E[4]; E[5] = win ? E[6] : E[5]; E[6] = win ? E[7] : E[6]; E[7] = win ? 0u : E[7]; \
        O = (fr == r) ? m : O; } while (0)
    PEER_SORT8(e0); PEER_SORT8(e1); PEER_SORT8(e2); PEER_SORT8(e3);
#pragma unroll 1
    for (int r = 0; r < 16; ++r) { PEER_ROUND(e0, o0); PEER_ROUND(e1, o1); PEER_ROUND(e2, o2); PEER_ROUND(e3, o3); }
#undef PEER_ROUND
#undef PEER_SORT8
#undef PEER_CE
}
__device__ __forceinline__ void peer_cand(LAS unsigned char* lds, LAS unsigned char* el, unsigned ptab, unsigned L1, unsigned L2, int lane, int fr, int slot) {
    unsigned c0, c1, c2, c3;
#define PEER_CK(SL, C) do { const unsigned byte = (ptab >> (8 * SL)) & 255u; const int a = byte >> 4, b = byte & 15; \
        const unsigned k1 = bperm(L1, (lane & 48) + a), k2 = bperm(L2, (lane & 48) + b); const float sum = decf(k1 & ~127u) + decf(k2 & ~127u); \
        C = (byte != 255u) ? ((ordf(sum) & ~63u) | (unsigned)(fr * 4 + SL)) : 0u; } while (0)
    PEER_CK(0, c0); PEER_CK(1, c1); PEER_CK(2, c2); PEER_CK(3, c3);
#undef PEER_CK
    unsigned co = 0u;
#define PEER_CE2(A, B) do { const unsigned hi_ = umax2(A, B), lo_ = A < B ? A : B; A = hi_; B = lo_; } while (0)
    PEER_CE2(c0, c1); PEER_CE2(c2, c3); PEER_CE2(c0, c2); PEER_CE2(c1, c3); PEER_CE2(c1, c2);
#undef PEER_CE2
#pragma unroll 1
    for (int r = 0; r < 16; ++r) { const unsigned m = row_max_u(c0); const bool win = (c0 == m);
        c0 = win ? c1 : c0; c1 = win ? c2 : c1; c2 = win ? c3 : c2; c3 = win ? 0u : c3;
        co = (fr == r) ? m : co; }
    const unsigned pb = *(LAS unsigned char*)(lds + PEER_PTAB + (co & 63u));
    const unsigned k1 = bperm(L1, (lane & 48) + (int)(pb >> 4)), k2 = bperm(L2, (lane & 48) + (int)(pb & 15u));
    const unsigned expert = (127u - (k1 & 127u)) * 128u + (127u - (k2 & 127u));
    const float sc = decf(co & ~63u);
    const float ex = __expf(sc - row_max_f(sc));
    const float gate = ex / row_sum_f(ex);
    v2u rec; rec.x = expert; rec.y = __builtin_bit_cast(unsigned, gate);
    *(LAS v2u*)(el + slot * 8) = rec;
}
__device__ __forceinline__ void peer_v2(const Ptrs& P, LAS unsigned char* lds, int tid, int lane, int wave, int G) {
    unsigned char* ws = P.ws;
    const bf16* qp = (const bf16*)(ws + WS_QP); const bf16* utab = (const bf16*)(ws + WS_UTAB); const bf16* vtab = (const bf16*)(ws + WS_VTAB);
    const bf16* h1b = (const bf16*)(ws + WS_H1B);
    const int fr = lane & 15, fq = lane >> 4;
    for (int idx = tid; idx < 2 * 128 * 32; idx += 512) { const int hf = idx >> 12, k = (idx >> 5) & 127, c2 = idx & 31; const float* sk = (hf ? P.in[16] : P.in[15]) + k * 64 + c2 * 2;
        *(LAS unsigned*)(lds + PEER_SKB + hf * 18432 + k * 144 + c2 * 4) = pk2(sk[0], sk[1]); }
    if (tid < 64) { int q = 0, a = 0, b = 0; unsigned char val = 0xFF;
        for (a = 0; a < 16 && val == 0xFF; ++a) for (b = 0; b < 16 && (a + 1) * (b + 1) <= 16; ++b) { if (q == tid) { val = (unsigned char)((a << 4) | b); break; } ++q; }
        *(LAS unsigned char*)(lds + PEER_PTAB + tid) = val; }
    __syncthreads();
    const unsigned ptab = *(LAS unsigned*)(lds + PEER_PTAB + fr * 4);
    LAS unsigned char* el = lds + PEER_EL + wave * 4096;
    const int lane_k = lane;
    for (int tile = blockIdx.x; tile < NT / 32; tile += G) {
        const int lane = (int)opq((unsigned)lane_k), fr = lane & 15, fq = lane >> 4;
        const int tok0 = tile * 32 + wave * 4;
#pragma unroll 1
        for (int mt = 0; mt < 2; ++mt) {
            unsigned L00, L01, L02, L03, L10, L11, L12, L13;
            peer_scores_top16(qp, lds, tok0 + 2 * mt, 0, fr, fq, L00, L01, L02, L03);
            peer_scores_top16(qp, lds, tok0 + 2 * mt, 1, fr, fq, L10, L11, L12, L13);
            peer_cand(lds, el, ptab, L00, L10, lane, fr, (2 * mt + (fq >> 1)) * 128 + ((fq & 1) * 4 + 0) * 16 + fr);
            peer_cand(lds, el, ptab, L01, L11, lane, fr, (2 * mt + (fq >> 1)) * 128 + ((fq & 1) * 4 + 1) * 16 + fr);
            peer_cand(lds, el, ptab, L02, L12, lane, fr, (2 * mt + (fq >> 1)) * 128 + ((fq & 1) * 4 + 2) * 16 + fr);
            peer_cand(lds, el, ptab, L03, L13, lane, fr, (2 * mt + (fq >> 1)) * 128 + ((fq & 1) * 4 + 3) * 16 + fr);
        }
        asm volatile("s_waitcnt lgkmcnt(0)" ::: "memory");
#if TAB_FP6
        const int tok = tok0 + fq;
        const unsigned char* u6 = (const unsigned char*)utab; const unsigned char* v6 = (const unsigned char*)vtab;
        float xf[64], yf[64];
        { const bf16* prow = (const bf16*)(ws + WS_H0) + (size_t)tok * 1024 + fr * 16;
          const GAS f32x4* sp = (const GAS f32x4*)((const float*)(ws + WS_STATS4) + (size_t)tok * 8); const f32x4 sa = sp[0], sb = sp[1];
          f32x2 st; st.x = ((sa.x + sa.z) + sb.x) + sb.z; st.y = ((sa.y + sa.w) + sb.y) + sb.w;
          const float mean1 = st.x * (1.f / D), rstd1 = 1.f / sqrtf(fmaxf(st.y * (1.f / D) - mean1 * mean1, 0.f) + LN_EPS);
#pragma unroll
          for (int c = 0; c < 4; ++c)
#pragma unroll
            for (int q8 = 0; q8 < 2; ++q8) { const v4u pw = *(const GAS v4u*)(prow + c * 256 + q8 * 8); f32x4 pa, pb2; unpack8(pw, pa, pb2);
#pragma unroll
                for (int hq = 0; hq < 2; ++hq) { const int q4 = q8 * 2 + hq; const f32x4 pv = hq ? pb2 : pa;
                    const f32x4 gv = *(const GAS f32x4*)(P.in[12] + c * 256 + fr * 16 + q4 * 4), bv = *(const GAS f32x4*)(P.in[13] + c * 256 + fr * 16 + q4 * 4);
                    const f32x4 xv = (pv - mean1) * rstd1 * gv + bv;
                    xf[c * 16 + q4 * 4] = xv.x; xf[c * 16 + q4 * 4 + 1] = xv.y; xf[c * 16 + q4 * 4 + 2] = xv.z; xf[c * 16 + q4 * 4 + 3] = xv.w; } } }
#pragma unroll
        for (int j = 0; j < 64; ++j) yf[j] = 0.f;
        LAS unsigned char* el2 = lds + PEER_EL2 + wave * 4096;
        { v2u rc[8]; unsigned c0 = 0u, c1 = 0u, c2 = 0u, c3 = 0u;
#pragma unroll
          for (int j = 0; j < 8; ++j) { rc[j] = *(const LAS v2u*)(el + (fq * 128 + fr * 8 + j) * 8); const unsigned bk = rc[j].x >> 10, one = 1u << (8 * (bk & 3u)), w = bk >> 2;
              c0 += (w == 0u) ? one : 0u; c1 += (w == 1u) ? one : 0u; c2 += (w == 2u) ? one : 0u; c3 += (w == 3u) ? one : 0u; }
          unsigned i0 = c0, i1 = c1, i2 = c2, i3 = c3;
          i0 += dppu<0x111>(i0); i1 += dppu<0x111>(i1); i2 += dppu<0x111>(i2); i3 += dppu<0x111>(i3);
          i0 += dppu<0x112>(i0); i1 += dppu<0x112>(i1); i2 += dppu<0x112>(i2); i3 += dppu<0x112>(i3);
          i0 += dppu<0x114>(i0); i1 += dppu<0x114>(i1); i2 += dppu<0x114>(i2); i3 += dppu<0x114>(i3);
          i0 += dppu<0x118>(i0); i1 += dppu<0x118>(i1); i2 += dppu<0x118>(i2); i3 += dppu<0x118>(i3);
          const int l15 = (lane & 48) + 15;
          const unsigned t0 = bperm(i0, l15), t1 = bperm(i1, l15), t2 = bperm(i2, l15), t3 = bperm(i3, l15);
          const unsigned s0 = (t0 * 0x01010101u) >> 24, s1 = (t1 * 0x01010101u) >> 24, s2 = (t2 * 0x01010101u) >> 24;
          unsigned p0 = (i0 - c0) + (t0 * 0x01010100u), p1 = (i1 - c1) + (t1 * 0x01010100u) + s0 * 0x01010101u, p2 = (i2 - c2) + (t2 * 0x01010100u) + (s0 + s1) * 0x01010101u,
                   p3 = (i3 - c3) + (t3 * 0x01010100u) + (s0 + s1 + s2) * 0x01010101u;
#pragma unroll
          for (int j = 0; j < 8; ++j) { const unsigned bk = rc[j].x >> 10, q8 = 8 * (bk & 3u), w = bk >> 2, one = 1u << q8;
              const unsigned pw = (w == 0u) ? p0 : ((w == 1u) ? p1 : ((w == 2u) ? p2 : p3));
              *(LAS v2u*)(el2 + (fq * 128 + ((pw >> q8) & 255u)) * 8) = rc[j];
              p0 += (w == 0u) ? one : 0u; p1 += (w == 1u) ? one : 0u; p2 += (w == 2u) ? one : 0u; p3 += (w == 3u) ? one : 0u; } }
        asm volatile("s_waitcnt lgkmcnt(0)" ::: "memory");
#pragma unroll 1
        for (int sidx = 0; sidx < 128; ++sidx) {
            const unsigned rec_e = *(const LAS unsigned*)(el2 + (fq * 128 + sidx) * 8);
            const float rec_g = *(const LAS float*)(el2 + (fq * 128 + sidx) * 8 + 4);
#if TABU_FP4
            const unsigned char* ur = u6 + (size_t)rec_e * 512 + fr * 16;
            const v4u ua = *(const GAS v4u*)ur, ub = *(const GAS v4u*)(ur + 256);
#else
            const unsigned char* ur = u6 + (size_t)rec_e * 768 + fr * 16;
            const v4u ua = *(const GAS v4u*)ur, ub = *(const GAS v4u*)(ur + 256), uc = *(const GAS v4u*)(ur + 512);
#endif
#if TABV_FP4
            const unsigned char* vr = v6 + (size_t)rec_e * 512 + fr * 16;
            const v4u va = *(const GAS v4u*)vr, vb = *(const GAS v4u*)(vr + 256);
#else
            const unsigned char* vr = v6 + (size_t)rec_e * 768 + fr * 16;
            const v4u va = *(const GAS v4u*)vr, vb = *(const GAS v4u*)(vr + 256), vc = *(const GAS v4u*)(vr + 512);
#endif
            float d0 = 0.f, d1 = 0.f;
#if TABU_FP4
#define PEER_U4B(DW, BASE, BB) do { const f32x2 f2 = __builtin_amdgcn_cvt_scalef32_pk_f32_fp4((DW), 1.0f, BB); d0 += f2.x * xf[(BASE) + 2 * BB]; d1 += f2.y * xf[(BASE) + 2 * BB + 1]; } while (0)
#define PEER_U4(DW, BASE) do { PEER_U4B(DW, BASE, 0); PEER_U4B(DW, BASE, 1); PEER_U4B(DW, BASE, 2); PEER_U4B(DW, BASE, 3); } while (0)
            PEER_U4(ua.x, 0); PEER_U4(ua.y, 8); PEER_U4(ua.z, 16); PEER_U4(ua.w, 24); PEER_U4(ub.x, 32); PEER_U4(ub.y, 40); PEER_U4(ub.z, 48); PEER_U4(ub.w, 56);
#undef PEER_U4
#undef PEER_U4B
            const float dot = row_sum_f(d0 + d1) * (1.f / FP4_SU);
#else
            { v6u g; g[0] = ua.x; g[1] = ua.y; g[2] = ua.z; g[3] = ua.w; g[4] = ub.x; g[5] = ub.y;
              const v32f f = __builtin_amdgcn_cvt_scalef32_pk32_f32_fp6(g, 1.0f);
#pragma unroll
              for (int i = 0; i < 32; i += 2) { d0 += f[i] * xf[i]; d1 += f[i + 1] * xf[i + 1]; } }
            { v6u g; g[0] = ub.z; g[1] = ub.w; g[2] = uc.x; g[3] = uc.y; g[4] = uc.z; g[5] = uc.w;
              const v32f f = __builtin_amdgcn_cvt_scalef32_pk32_f32_fp6(g, 1.0f);
#pragma unroll
              for (int i = 0; i < 32; i += 2) { d0 += f[i] * xf[32 + i]; d1 += f[i + 1] * xf[32 + i + 1]; } }
            const float dot = row_sum_f(d0 + d1) * (1.f / FP6_SU);
#endif
#if TABV_FP4
            const float w = rec_g * gelu_as(dot) * (1.f / FP4_SV);
#define PEER_V4B(DW, BASE, BB) do { const f32x2 f2 = __builtin_amdgcn_cvt_scalef32_pk_f32_fp4((DW), 1.0f, BB); yf[(BASE) + 2 * BB] += w * f2.x; yf[(BASE) + 2 * BB + 1] += w * f2.y; } while (0)
#define PEER_V4(DW, BASE) do { PEER_V4B(DW, BASE, 0); PEER_V4B(DW, BASE, 1); PEER_V4B(DW, BASE, 2); PEER_V4B(DW, BASE, 3); } while (0)
            PEER_V4(va.x, 0); PEER_V4(va.y, 8); PEER_V4(va.z, 16); PEER_V4(va.w, 24); PEER_V4(vb.x, 32); PEER_V4(vb.y, 40); PEER_V4(vb.z, 48); PEER_V4(vb.w, 56);
#undef PEER_V4
#undef PEER_V4B
#else
            const float w = rec_g * gelu_as(dot) * (1.f / FP6_SV);
            { v6u g; g[0] = va.x; g[1] = va.y; g[2] = va.z; g[3] = va.w; g[4] = vb.x; g[5] = vb.y;
              const v32f f = __builtin_amdgcn_cvt_scalef32_pk32_f32_fp6(g, 1.0f);
#pragma unroll
              for (int i = 0; i < 32; ++i) yf[i] += w * f[i]; }
            { v6u g; g[0] = vb.z; g[1] = vb.w; g[2] = vc.x; g[3] = vc.y; g[4] = vc.z; g[5] = vc.w;
              const v32f f = __builtin_amdgcn_cvt_scalef32_pk32_f32_fp6(g, 1.0f);
#pragma unroll
              for (int i = 0; i < 32; ++i) yf[32 + i] += w * f[i]; }
#endif
        }
        float ssum = 0.f;
#pragma unroll
        for (int j = 0; j < 64; ++j) { yf[j] += ALPHA * xf[j]; ssum += yf[j]; }
        const float mean = row_sum_f(ssum) * (1.f / D);
        float s2 = 0.f;
#pragma unroll
        for (int j = 0; j < 64; ++j) { yf[j] -= mean; s2 += yf[j] * yf[j]; }
        const float rstd = 1.f / sqrtf(row_sum_f(s2) * (1.f / D) + LN_EPS);
        float* orow = P.out + (size_t)tok * 1024 + fr * 16;
#pragma unroll
        for (int c = 0; c < 4; ++c)
#pragma unroll
            for (int q4 = 0; q4 < 4; ++q4) { const f32x4 g0 = *(const GAS f32x4*)(P.in[19] + c * 256 + fr * 16 + q4 * 4), b0 = *(const GAS f32x4*)(P.in[20] + c * 256 + fr * 16 + q4 * 4);
                f32x4 o; o.x = yf[c * 16 + q4 * 4] * rstd * g0.x + b0.x; o.y = yf[c * 16 + q4 * 4 + 1] * rstd * g0.y + b0.y; o.z = yf[c * 16 + q4 * 4 + 2] * rstd * g0.z + b0.z; o.w = yf[c * 16 + q4 * 4 + 3] * rstd * g0.w + b0.w;
                *(GAS f32x4*)(orow + c * 256 + q4 * 4) = o; }
#endif
        asm volatile("s_waitcnt lgkmcnt(0)" ::: "memory");
    }
}

struct Args { const float* in[21]; float* out; unsigned char* ws; int ph_lo, ph_hi; };
__global__ void __launch_bounds__(NWAVES * 64, 2) fwd_kernel(Args args) {
    extern __shared__ __attribute__((aligned(16))) unsigned char lds_raw[];
    LAS unsigned char* lds = (LAS unsigned char*)lds_raw;
    volatile LAS unsigned* MISC = (volatile LAS unsigned*)(lds + MISC_OFF);
    const int tid = threadIdx.x, lane = tid & 63, wave = __builtin_amdgcn_readfirstlane(tid >> 6);
    const int G = gridDim.x;
    Ptrs P;
#pragma unroll
    for (int i = 0; i < 21; ++i) P.in[i] = args.in[i];
    P.out = args.out; P.ws = args.ws;
    unsigned char* ws = args.ws;
    if (tid < 16) MISC[tid] = 0u;
    __syncthreads();
    XcdBarrier bar; bar.bar = (unsigned*)(ws + WS_CTL) + 4096; bar.x = 0; bar.st = nullptr;
    if (N_LAUNCHES == 1) bar = xcd_barrier_post((unsigned*)(ws + WS_CTL) + 4096, MISC + 8);
    const int lo = args.ph_lo, hi = args.ph_hi;
#ifndef PHMASK
#define PHMASK 0x1ff
#endif
#define IN(k) (((PHMASK >> (k)) & 1) && lo <= (k) && (k) < hi)
#define SEAM(k) do { if (IN(k) && IN((k) + 1)) xcd_barrier(bar); } while (0)

    if (IN(0)) { phase0(P, lds, tid, lane, wave, G); } SEAM(0);

    if (IN(1)) {
        if (blockIdx.x < 4) { const int n = blockIdx.x * 256 + (tid & 255); const float* part = (const float*)(ws + WS_CPART) + (tid >> 8) * 16 * 1024; float a = 0.f;
#pragma unroll
            for (int kb = 0; kb < 16; ++kb) a += part[kb * 1024 + n];
            ((float*)(ws + ((tid >> 8) ? WS_DVEC : WS_CVEC)))[n] = a; }
        for (int i = tid; i < WR_GATE; i += 512) ((LAS float*)(lds + RING_BYTES))[i] = ((const float*)(ws + WS_BIASIN))[i];
        __syncthreads();
        SchedP1 S{(const char*)ws, G, (int)blockIdx.x};
        EpiP1 E{(bf16*)P.out, ws, lds + RING_BYTES};
        pg8::gemm_phase<EpiP1, SchedP1, 2>(lds, S, E);
    } SEAM(1);

    if (IN(2)) {
        fft_step_mfma<1>((const bf16*)P.out, (bf16*)P.out + (size_t)NT * 1024, lds, tid, lane, wave, G);
        dil_attn_lds((const bf16*)(ws + WS_QK), (const bf16*)(ws + WS_VT), (const float*)(ws + WS_BIASTAB), (bf16*)(ws + WS_OG), (float*)(ws + WS_LSE), lds, tid, lane, wave, G);
        mem_attn_lds((const bf16*)(ws + WS_QC), (const bf16*)(ws + WS_MEMKV), (const bf16*)(ws + WS_MEMKV) + 512 * 512, (bf16*)(ws + WS_YCIN), lds, tid, lane, wave, G);
    } SEAM(2);

    if (IN(3)) {
        fft_step_mfma<2>((const bf16*)P.out + (size_t)NT * 1024, (bf16*)(ws + WS_FA), lds, tid, lane, wave, G);
        combine_groups((const bf16*)(ws + WS_OG), (const float*)(ws + WS_LSE), (bf16*)(ws + WS_OB), tid, G);
    } SEAM(3);

    if (IN(4)) {
        SchedP4 S{(const char*)ws, G, (int)blockIdx.x};
        for (int i = tid; i < 3072; i += 512) ((LAS float*)(lds + RING_BYTES))[i] = ((const float*)(ws + WS_BIASIN))[WR_GATE + i];
        __syncthreads();
        EpiP4 E{(bf16*)(ws + WS_MERGED), lds + RING_BYTES};
        pg8::gemm_phase<EpiP4, SchedP4, 2>(lds, S, E);
    } SEAM(4);

    if (IN(5)) {
        SchedPlain S{(const char*)(ws + WS_MERGED), (const char*)(ws + WS_WTO), G, (int)blockIdx.x, K_WO};
        EpiP5 E{(bf16*)(ws + WS_H0), (float*)(ws + WS_PRELN), (float*)(ws + WS_STATS4), lds + RING_BYTES};
        pg8::gemm_phase<EpiP5, SchedPlain>(lds, S, E);
    } SEAM(5);


    if (IN(7)) {
        SchedPlain S{(const char*)(ws + WS_H0), (const char*)(ws + WS_WTPQ), G, (int)blockIdx.x, K_PQ};
        EpiP7 E{(bf16*)(ws + WS_QP), (const float*)(ws + WS_STATS4), (const float*)(ws + WS_CVEC), (const float*)(ws + WS_DVEC)};
        pg8::gemm_phase<EpiP7, SchedPlain>(lds, S, E);
    } SEAM(7);

    if (IN(8)) {
        peer_v2(P, lds, tid, lane, wave, G);
    }
#undef IN
#undef SEAM
}

extern "C" void kernel_launch(void* const* d_in, const int* in_sizes, int n_in, void* d_out, int out_size, void* d_ws, size_t ws_size, hipStream_t stream) {
    static int grid = 0;
    if (grid == 0) {
        if (n_in != 21 || out_size != NT * D || ws_size < WS_END) { fprintf(stderr, "kernel_launch: unexpected shapes (n_in %d, out %d, ws %zu); nothing launched\n", n_in, out_size, ws_size); grid = -1; return; }
        int dev = 0, cus = 0, per_cu = 0;
        if (hipGetDevice(&dev) != hipSuccess || hipDeviceGetAttribute(&cus, hipDeviceAttributeMultiprocessorCount, dev) != hipSuccess) { grid = -1; return; }
        if (hipFuncSetAttribute((const void*)fwd_kernel, hipFuncAttributeMaxDynamicSharedMemorySize, LDS_BYTES) != hipSuccess) { fprintf(stderr, "kernel_launch: hipFuncSetAttribute failed\n"); grid = -1; return; }
        if (hipOccupancyMaxActiveBlocksPerMultiprocessor(&per_cu, (const void*)fwd_kernel, NWAVES * 64, LDS_BYTES) != hipSuccess || per_cu < 1) { fprintf(stderr, "kernel_launch: occupancy query says %d\n", per_cu); }
        (void)hipGetLastError();
        grid = cus;
    }
    if (grid < 0) return;
    (void)hipMemsetAsync((char*)d_ws + WS_CTL, 0, CTL_ZERO_BYTES, stream);
    Args a{};
    for (int i = 0; i < 21; ++i) a.in[i] = (const float*)d_in[i];
    a.out = (float*)d_out; a.ws = (unsigned char*)d_ws;
    if (N_LAUNCHES == 1) { a.ph_lo = 0; a.ph_hi = NPH; hipLaunchKernelGGL(fwd_kernel, dim3(grid), dim3(NWAVES * 64), LDS_BYTES, stream, a); }
    else for (int ph = 0; ph < NPH; ++ph) { a.ph_lo = ph; a.ph_hi = ph + 1; hipLaunchKernelGGL(fwd_kernel, dim3(grid), dim3(NWAVES * 64), LDS_BYTES, stream, a); }
}
```

```cpp
#include <hip/hip_runtime.h>
#include <cstdio>
#include <cstdint>

#ifndef TABU_FP4
#define TABU_FP4 0
#endif
#ifndef TABV_FP4
#define TABV_FP4 1
#endif
#ifndef TAB_FP6
#define TAB_FP6 1
#endif
static_assert(TAB_FP6 == 1, "the workspace map assumes 12 MiB fp6 expert tables");
#ifndef TAB_FP8
#define TAB_FP8 1
#endif
#ifndef N_LAUNCHES
#define N_LAUNCHES 1
#endif

#define GAS __attribute__((address_space(1)))
#define LAS __attribute__((address_space(3)))
typedef unsigned short bf16;
typedef unsigned v4u __attribute__((ext_vector_type(4)));
typedef unsigned v2u __attribute__((ext_vector_type(2)));
typedef float f32x4 __attribute__((ext_vector_type(4)));
typedef float f32x2 __attribute__((ext_vector_type(2)));
typedef short bf16x8 __attribute__((ext_vector_type(8)));

constexpr int NT = 32768, SEQ = 16384, D = 1024;
constexpr int NPH = 9;
constexpr float ALPHA = 1.189207115002721f;
constexpr float LN_EPS = 1e-5f;
constexpr int NWAVES = 8;

constexpr size_t MiB = 1u << 20;
constexpr size_t WS_CTL = 0, CTL_ZERO_BYTES = 1 * MiB;
constexpr size_t WS_CPART = 256 * 1024;
constexpr size_t WS_STATS = 512 * 1024;
constexpr size_t WS_CVEC = 768 * 1024, WS_DVEC = 772 * 1024;
constexpr size_t WS_BIASIN = 1 * MiB;
constexpr size_t WS_STATS4 = 4 * MiB;
constexpr size_t WS_BIASTAB = 1 * MiB + 64 * 1024;
constexpr size_t WS_WTIN = 2 * MiB;
constexpr size_t WS_WTA = 16 * MiB, WS_WTB = 17 * MiB, WS_WTC = 18 * MiB, WS_WTO = 19 * MiB, WS_WTPQ = 21 * MiB, WS_WTMKV = 23 * MiB;
constexpr size_t WS_MEMB = 25 * MiB, WS_MEMKV = 26 * MiB;
constexpr size_t WS_MEMF8 = 27 * MiB, WS_WMKVF8 = 28 * MiB;
constexpr size_t WS_UTAB = 32 * MiB, WS_VTAB = 44 * MiB;
constexpr size_t WS_H0F8 = 56 * MiB;
constexpr size_t WS_WF8IN = 88 * MiB;
constexpr size_t WS_H0 = 96 * MiB;
constexpr size_t WS_QK = 160 * MiB;
constexpr size_t WS_VT = 256 * MiB;
constexpr size_t WS_QC = 304 * MiB;
constexpr size_t WS_OG = 336 * MiB;
constexpr size_t WS_LSE = 384 * MiB;
constexpr size_t WS_YCIN = 386 * MiB;
constexpr size_t WS_FA = 418 * MiB;
constexpr size_t WS_OB = 450 * MiB;
constexpr size_t WS_GSCR = 466 * MiB;
constexpr size_t WS_MERGED = WS_QK;
constexpr size_t WS_PRELN = 224 * MiB;
constexpr size_t WS_H1B = WS_H0;
constexpr size_t WS_QP = WS_QK;
constexpr size_t WS_END = 498 * MiB;

constexpr int WR_A = 0, WR_QK = 1024, WR_V = 2560, WR_QC = 3328, WR_GATE = 3840, WR_END = 6912;

constexpr int RING_BYTES = 131072;
constexpr int LDS_BYTES = 147456;
constexpr int MISC_OFF = LDS_BYTES - 256;
static_assert(RING_BYTES + 3840 * 4 <= MISC_OFF, "bias copy fits the spare LDS above the GEMM stage buffers");

#define RLX_AGENT __ATOMIC_RELAXED, __HIP_MEMORY_SCOPE_AGENT
#define LDS_WAIT() asm volatile("s_waitcnt lgkmcnt(0)" ::: "memory")
#define VM_WAIT() asm volatile("s_waitcnt vmcnt(0)" ::: "memory")

__device__ __forceinline__ unsigned f2bf(float f) { unsigned u = __builtin_bit_cast(unsigned, f); return (u + 0x7fffu + ((u >> 16) & 1u)) >> 16; }
__device__ __forceinline__ unsigned pk2(float lo, float hi) { return f2bf(lo) | (f2bf(hi) << 16); }
__device__ __forceinline__ unsigned pk4_fp8(float a, float b, float c, float d) { int p = __builtin_amdgcn_cvt_pk_fp8_f32(a, b, 0, false); p = __builtin_amdgcn_cvt_pk_fp8_f32(c, d, p, true); return (unsigned)p; }
__device__ __forceinline__ float bf2f(unsigned b) { return __builtin_bit_cast(float, b << 16); }
__device__ __forceinline__ float bflo(unsigned w) { return __builtin_bit_cast(float, w << 16); }
__device__ __forceinline__ float bfhi(unsigned w) { return __builtin_bit_cast(float, w & 0xffff0000u); }
__device__ __forceinline__ float wave_sum(float v) {
#pragma unroll
    for (int o = 1; o < 64; o <<= 1) v += __shfl_xor(v, o);
    return v;
}
__device__ __forceinline__ float wave_max(float v) {
#pragma unroll
    for (int o = 1; o < 64; o <<= 1) v = fmaxf(v, __shfl_xor(v, o));
    return v;
}

#define XB_TMO      128
#define XB_XCNT(j)  (256  + 64 * (j))
#define XB_XSUB(j)  (1280 + 64 * (j))
#define XB_XGEN(j)  (2304 + 64 * (j))
#define XB_TOP      3328
#define XB_TOPGEN   3392
#define XCD_BAR_WORDS 3456
#define XB_SPIN_CAP (1u << 18)

__device__ __forceinline__ unsigned xb_ld(unsigned* p)              { return __hip_atomic_load(p, __ATOMIC_RELAXED, __HIP_MEMORY_SCOPE_AGENT); }
__device__ __forceinline__ unsigned xb_add(unsigned* p, unsigned v) { return __hip_atomic_fetch_add(p, v, __ATOMIC_RELAXED, __HIP_MEMORY_SCOPE_AGENT); }
__device__ __forceinline__ unsigned xb_xcc_id() { return (unsigned)__builtin_amdgcn_s_getreg((3 << 11) | 20) & 0xFu; }
#define XB_SPIN(cond, bar) do { unsigned _sp = 0; while (cond) { __builtin_amdgcn_s_sleep(1); \
    if ((++_sp & 255u) == 0u) { if (xb_ld(&(bar)[XB_TMO])) break; if (_sp > XB_SPIN_CAP) { atomicAdd(&(bar)[XB_TMO], 1u); break; } } } } while (0)

struct XcdBarrier {
    unsigned* bar; unsigned x;
    volatile LAS unsigned* st;
};
__device__ __forceinline__ XcdBarrier xcd_barrier_post(unsigned* bar, volatile LAS unsigned* st) {
    XcdBarrier b; b.bar = bar; b.x = xb_xcc_id(); b.st = st;
    if (threadIdx.x == 0) (void)xb_add(&bar[XB_XCNT(b.x)], 1u);
    return b;
}
__device__ __forceinline__ void xcd_barrier_complete(unsigned* bar, unsigned x, unsigned& nloc, unsigned& nx) {
    const unsigned G = gridDim.x * gridDim.y * gridDim.z;
    unsigned sum, cnt, mine, sp = 0u;
    for (;;) {
        sum = 0u; cnt = 0u; mine = 0u;
#pragma unroll
        for (unsigned j = 0; j < 16; ++j) { const unsigned c = xb_ld(&bar[XB_XCNT(j)]); sum += c; cnt += (c > 0u) ? 1u : 0u; mine = (j == x) ? c : mine; }
        if (sum == G) break;
        __builtin_amdgcn_s_sleep(1);
        if ((++sp & 255u) == 0u) { if (xb_ld(&bar[XB_TMO])) break; if (sp > XB_SPIN_CAP) { atomicAdd(&bar[XB_TMO], 1u); break; } }
    }
    nloc = mine > 0u ? mine : 1u; nx = cnt > 0u ? cnt : 1u;
}
__device__ __forceinline__ void xcd_barrier(const XcdBarrier& b) {
    asm volatile("s_waitcnt vmcnt(0)" ::: "memory");
    __syncthreads();
    if (threadIdx.x == 0) {
        unsigned* bar = b.bar;
        __builtin_amdgcn_s_waitcnt(0);
        unsigned nloc = b.st[0], nx = b.st[1];
        if (nloc == 0u) { xcd_barrier_complete(bar, b.x, nloc, nx); b.st[0] = nloc; b.st[1] = nx; }
        const unsigned old = xb_add(&bar[XB_XSUB(b.x)], 1u);
        const unsigned gen = old / nloc;
        if (old + 1u == (gen + 1u) * nloc) {
            __builtin_amdgcn_fence(__ATOMIC_RELEASE, "agent");
            asm volatile("s_waitcnt vmcnt(0)" ::: "memory");
            const unsigned og = xb_add(&bar[XB_TOP], 1u);
            const unsigned tg = og / nx;
            if (og + 1u == (tg + 1u) * nx) xb_add(&bar[XB_TOPGEN], 1u);
            else XB_SPIN(xb_ld(&bar[XB_TOPGEN]) == tg, bar);
            __builtin_amdgcn_fence(__ATOMIC_ACQUIRE, "agent");
            xb_add(&bar[XB_XGEN(b.x)], 1u);
            asm volatile("s_waitcnt vmcnt(0)" ::: "memory");
        } else {
            XB_SPIN(xb_ld(&bar[XB_XGEN(b.x)]) == gen, bar);
            __builtin_amdgcn_fence(__ATOMIC_ACQUIRE, "agent");
            asm volatile("s_waitcnt vmcnt(0)" ::: "memory");
        }
    }
    __syncthreads();
}

namespace pg8 {
constexpr int BM = 256, BK = 64, HALF = 128, HTB = HALF * BK * 2, STAGE_BYTES = 8 * HTB;
__host__ __device__ __forceinline__ int lds_byte(int r, int c) { const int st = (r >> 4) * 2 + (c >> 5), rr = r & 15, cc = c & 31, ob = rr * 64 + cc * 2; return st * 1024 + (ob ^ (((ob >> 9) & 1) << 5)); }
__host__ __device__ __forceinline__ void stage_rc(int b, int& R, int& C) { const int st = b / 1024, sb = b % 1024, swz = sb ^ (((sb >> 9) & 1) << 5); R = (st >> 1) * 16 + swz / 64; C = (st & 1) * 32 + (swz % 64) / 2; }
__host__ __device__ __forceinline__ int perm32(int rho) { const int n = rho >> 4, i = rho & 15; return 8 * (i >> 2) + 4 * n + (i & 3); }

struct GUnit { const char* a; const char* b; unsigned sa, sb; int nt; int pm, pn, kind; };

typedef int v8i __attribute__((ext_vector_type(8)));
constexpr int K_FP8 = 1 << 16;
__device__ __forceinline__ unsigned pg8_rb(unsigned ra) { asm volatile("" : "+v"(ra)); const unsigned rho = ra & 31u, n = rho >> 4, i = rho & 15u; return (ra & ~31u) + 8u * (i >> 2) + 4u * n + (i & 3u); }
template <class Epi, class Sched, int MODE = 0>
__device__ __forceinline__ void gemm_phase(LAS unsigned char* lds, const Sched& S, const Epi& E) {
    const int tid = threadIdx.x, wid = __builtin_amdgcn_readfirstlane(tid >> 6), lane = tid & 63, wr = wid >> 2, wc = wid & 3, fr = lane & 15, fq = lane >> 4;
    int R0, C0; stage_rc(tid * 16, R0, C0);
    const unsigned RA = (unsigned)R0, C2 = (unsigned)C0 * 2u;
#define RB pg8_rb(RA)
    const size_t kstep = (size_t)(BK * 2);
    const unsigned ldsw = (unsigned)wid * 1024u;
    const int aoff = lds_byte(wr * 64 + fr, fq * 8), boff = lds_byte(wc * 32 + fr, fq * 8);
#define PG8_SA(b, h) (((b) * 2 + (h)) * HTB)
#define PG8_SB(b, h) ((4 + (b) * 2 + (h)) * HTB)
#define PG8_STAGE(bufoff, gbase, RR, stride) do { const unsigned _vo = (RR) * (unsigned)(stride) + C2; const char* _g = (const char*)(gbase); \
        __builtin_amdgcn_global_load_lds((const unsigned*)(_g + _vo), (LAS unsigned*)(lds + (bufoff) + ldsw), 16, 0, 0); \
        __builtin_amdgcn_global_load_lds((const unsigned*)(_g + (size_t)64 * (stride) + _vo), (LAS unsigned*)(lds + (bufoff) + ldsw + 8192), 16, 0, 0); } while (0)
#define PG8_LDA(dst, b, h) do { _Pragma("unroll") for (int m = 0; m < 4; ++m) _Pragma("unroll") for (int k = 0; k < 2; ++k) dst[m][k] = *(const LAS bf16x8*)(lds + PG8_SA(b, h) + aoff + m * 2048 + k * 1024); } while (0)
#define PG8_LDB(dst, b, h) do { _Pragma("unroll") for (int n = 0; n < 2; ++n) _Pragma("unroll") for (int k = 0; k < 2; ++k) dst[n][k] = *(const LAS bf16x8*)(lds + PG8_SB(b, h) + boff + n * 2048 + k * 1024); } while (0)
#define PG8_CAT(lo, hi) __builtin_bit_cast(v8i, __builtin_shufflevector(lo, hi, 0, 1, 2, 3, 4, 5, 6, 7, 8, 9, 10, 11, 12, 13, 14, 15))
#define PG8_MMA_BF(ai, bj, At, Bt) do { __builtin_amdgcn_s_setprio(1); _Pragma("unroll") for (int m = 0; m < 4; ++m) _Pragma("unroll") for (int n = 0; n < 2; ++n) _Pragma("unroll") for (int k = 0; k < 2; ++k) \
        acc[ai][bj][m][n] = __builtin_amdgcn_mfma_f32_16x16x32_bf16(Bt[n][k], At[m][k], acc[ai][bj][m][n], 0, 0, 0); __builtin_amdgcn_s_setprio(0); } while (0)
#define PG8_MMA_F8(ai, bj, At, Bt) do { __builtin_amdgcn_s_setprio(1); _Pragma("unroll") for (int m = 0; m < 4; ++m) _Pragma("unroll") for (int n = 0; n < 2; ++n) \
        acc[ai][bj][m][n] = __builtin_amdgcn_mfma_scale_f32_16x16x128_f8f6f4(PG8_CAT(Bt[n][0], Bt[n][1]), PG8_CAT(At[m][0], At[m][1]), acc[ai][bj][m][n], 0, 0, 0, 0x7F7F7F7F, 0, 0x7F7F7F7F); __builtin_amdgcn_s_setprio(0); } while (0)
#define PG8_WAIT_V(n) asm volatile("s_waitcnt vmcnt(" #n ")" ::: "memory")
#define PG8_WAIT_L(n) asm volatile("s_waitcnt lgkmcnt(" #n ")" ::: "memory")
#define PG8_BAR __builtin_amdgcn_s_barrier()
#define PG8_SCHED __builtin_amdgcn_sched_barrier(0)
#define PG8_KLOOP(MMA) \
        for (int t = 0; t < nt; t += 2) { \
            const bool last = (t == nt - 2); \
            const char* a1 = cA + (size_t)(t + 1) * kstep; \
            const char* a2 = last ? nxt.a : cA + (size_t)(t + 2) * kstep; const char* b2 = last ? nxt.b : cB + (size_t)(t + 2) * kstep; \
            const unsigned sa2 = last ? nxt.sa : csa, sb2 = last ? nxt.sb : csb; const size_t hA2 = (size_t)HALF * sa2, hB2 = (size_t)HALF * sb2; \
            const char* a3 = a2 + kstep; const char* b3 = b2 + kstep; \
            PG8_LDB(B0, 0, 0); PG8_LDB(B1, 0, 1); PG8_SCHED; PG8_LDA(At, 0, 0); PG8_STAGE(PG8_SA(1, 1), a1 + hA, RA, csa); \
            PG8_WAIT_V(8); PG8_WAIT_L(0); PG8_BAR; MMA(0, 0, At, B0); MMA(0, 1, At, B1); PG8_BAR; PG8_SCHED; \
            PG8_LDA(At, 0, 1); PG8_STAGE(PG8_SB(0, 0), b2, RB, sb2); PG8_STAGE(PG8_SB(0, 1), b2 + hB2, RB, sb2); PG8_STAGE(PG8_SA(0, 0), a2, RA, sa2); \
            PG8_WAIT_V(8); PG8_WAIT_L(0); PG8_BAR; MMA(1, 0, At, B0); MMA(1, 1, At, B1); PG8_BAR; PG8_SCHED; \
            PG8_LDB(B0, 1, 0); PG8_LDB(B1, 1, 1); PG8_SCHED; PG8_LDA(At, 1, 0); PG8_STAGE(PG8_SA(0, 1), a2 + hA2, RA, sa2); \
            PG8_WAIT_V(8); PG8_WAIT_L(0); PG8_BAR; MMA(0, 0, At, B0); MMA(0, 1, At, B1); PG8_BAR; PG8_SCHED; \
            PG8_LDA(At, 1, 1); PG8_STAGE(PG8_SB(1, 0), b3, RB, sb2); PG8_STAGE(PG8_SB(1, 1), b3 + hB2, RB, sb2); PG8_STAGE(PG8_SA(1, 0), a3, RA, sa2); \
            PG8_WAIT_V(8); PG8_WAIT_L(0); PG8_BAR; MMA(1, 0, At, B0); MMA(1, 1, At, B1); PG8_BAR; PG8_SCHED; \
        }
    GUnit cur, nxt; int ui = 0;
    if (!S.next(0, cur)) return;
    f32x4 acc[2][2][4][2];
#pragma unroll
    for (int a = 0; a < 2; ++a)
#pragma unroll
        for (int b = 0; b < 2; ++b)
#pragma unroll
            for (int m = 0; m < 4; ++m)
#pragma unroll
                for (int n = 0; n < 2; ++n) acc[a][b][m][n] = (f32x4){0.f, 0.f, 0.f, 0.f};
    bf16x8 At[4][2], B0[2][2], B1[2][2];
    unsigned keep[2][2][4][2];
    {
        const char* cA = cur.a; const char* cB = cur.b; const size_t hA = (size_t)HALF * cur.sa, hB = (size_t)HALF * cur.sb;
        PG8_STAGE(PG8_SB(0, 0), cB, RB, cur.sb); PG8_STAGE(PG8_SB(0, 1), cB + hB, RB, cur.sb); PG8_STAGE(PG8_SA(0, 0), cA, RA, cur.sa); PG8_STAGE(PG8_SA(0, 1), cA + hA, RA, cur.sa);
        if (wr == 1) PG8_BAR;
        PG8_WAIT_V(2); PG8_BAR;
        PG8_STAGE(PG8_SB(1, 0), cB + kstep, RB, cur.sb); PG8_STAGE(PG8_SA(1, 0), cA + kstep, RA, cur.sa); PG8_STAGE(PG8_SB(1, 1), cB + hB + kstep, RB, cur.sb);
        PG8_WAIT_V(6); PG8_BAR;
    }
    for (;;) {
        const bool has_next = S.next(ui + 1, nxt);
        if (!has_next) { nxt = cur; }
        const char* cA = cur.a; const char* cB = cur.b; const unsigned csa = cur.sa, csb = cur.sb; const size_t hA = (size_t)HALF * csa, hB = (size_t)HALF * csb;
        const int nt = cur.nt; const bool cur_fp8 = (cur.kind & K_FP8) != 0; (void)cur_fp8;
        if (MODE == 1 || (MODE == 2 && cur_fp8)) { PG8_KLOOP(PG8_MMA_F8) } else { PG8_KLOOP(PG8_MMA_BF) }
        if (wr == 0) PG8_BAR;
        E(acc, keep, cur, wr, wc, fr, fq);
        if (!has_next) break;
#pragma unroll
        for (int a = 0; a < 2; ++a)
#pragma unroll
            for (int b = 0; b < 2; ++b)
#pragma unroll
                for (int m = 0; m < 4; ++m)
#pragma unroll
                    for (int n = 0; n < 2; ++n) acc[a][b][m][n] = (f32x4){0.f, 0.f, 0.f, 0.f};
        cur = nxt; ++ui;
        if (wr == 1) PG8_BAR;
    }
    PG8_WAIT_V(0);
    PG8_BAR;
#undef PG8_SA
#undef PG8_SB
#undef PG8_STAGE
#undef PG8_LDA
#undef PG8_LDB
#undef PG8_MMA_BF
#undef PG8_MMA_F8
#undef PG8_KLOOP
#undef RB
#undef PG8_CAT
#undef PG8_WAIT_V
#undef PG8_WAIT_L
#undef PG8_BAR
#undef PG8_SCHED
}
}
using pg8::GUnit; using pg8::K_FP8;

__device__ __forceinline__ int tok0_of(int p, int g) {
    const int n = p << 8, b = n >> 14, rem = n & 16383, sh = 2 * g;
    const int r = rem >> (14 - sh), l0 = rem & ((16384 >> sh) - 1);
    return (b << 14) + (l0 << sh) + r;
}
__device__ __forceinline__ void tile_of(int t, int nN, int& pm, int& pn) { const int nig = 8 * nN, gid = t / nig, w = t % nig; pm = gid * 8 + (w & 7); pn = w >> 3; }

struct Ptrs {
    const float* in[21]; float* out; unsigned char* ws;
};

enum { K_ZA = 0, K_QK = 1, K_VT = 2, K_QC = 3, K_MKV = 4, K_GATE = 5, K_YA = 6, K_YB = 7, K_YC = 8, K_WO = 9, K_PQ = 10 };
struct SchedP1 {
    const char* wsb; int G, c;
    static constexpr int NLONG = 512, NSHORT = 768 + 384 + 256 + 8;
    __device__ __forceinline__ bool next(int i, GUnit& u) const {
        const char* const h0b = wsb + WS_H0; const char* const wtb = wsb + WS_WTIN; const char* const h0 = wsb + WS_H0F8; const char* const wtin = wsb + WS_WF8IN; const char* const memb = wsb + WS_MEMF8; const char* const wtmkv = wsb + WS_WMKVF8;
        const int nshort = (NSHORT - c + G - 1) / G, nslots = 2 + nshort; if (i >= nslots) return false;
        const int k = (c >> 3) & 3; int pa = k % nslots, pb = (k + 4) % nslots; if (pa > pb) { const int t_ = pa; pa = pb; pb = t_; }
        int j; if (i == pa) j = 0; else if (i == pb) j = 1; else j = 2 + i - (i > pa ? 1 : 0) - (i > pb ? 1 : 0);
        const int L = j * G + c; if (L >= NLONG + NSHORT) return false;
        if (L < NLONG) { const int T = (G % 8 == 0) ? (L % 8) * (NLONG / 8) + L / 8 : L; int pm, pn; tile_of(T, 4, pm, pn);
            u.a = h0b + (size_t)pm * 256 * 2048; u.b = wtb + (size_t)(WR_A + pn * 256) * 2048; u.sa = 2048; u.sb = 2048; u.nt = 16; u.pm = pm; u.pn = pn; u.kind = K_ZA; return true; }
        const int Ls = L - NLONG; int T = (NSHORT % 8 == 0 && G % 8 == 0) ? (Ls % 8) * (NSHORT / 8) + Ls / 8 : Ls;
        u.nt = 8; u.sa = 1024; u.sb = 1024;
        if (T < 768) { const int g = T >> 8; int pm, pn; tile_of(T & 255, 2, pm, pn); u.a = h0 + (size_t)tok0_of(pm, g) * 1024; u.sa = 1024u << (2 * g);
            u.b = wtin + (size_t)(WR_QK + g * 512 + pn * 256) * 1024; u.pm = pm; u.pn = pn; u.kind = K_QK | (g << 8) | K_FP8; return true; }
        T -= 768;
        if (T < 384) { const int g = T >> 7, pn = T & 127; u.a = wtin + (size_t)(WR_V + g * 256) * 1024; u.b = h0 + (size_t)tok0_of(pn, g) * 1024; u.sb = 1024u << (2 * g);
            u.pm = 0; u.pn = pn; u.kind = K_VT | (g << 8) | K_FP8; return true; }
        T -= 384;
        if (T < 256) { int pm, pn; tile_of(T, 2, pm, pn); u.a = h0 + (size_t)pm * 256 * 1024; u.b = wtin + (size_t)(WR_QC + pn * 256) * 1024; u.pm = pm; u.pn = pn; u.kind = K_QC | K_FP8; return true; }
        T -= 256;
        if (T < 4) { const int pm = T >> 1, pn = T & 1; u.a = memb + (size_t)pm * 256 * 1024; u.b = wtmkv + (size_t)pn * 256 * 1024; u.pm = pm; u.pn = pn; u.kind = K_MKV | K_FP8; return true; }
        T -= 4;
        { const int pm = T >> 1, pn = T & 1; u.a = wtmkv + (size_t)(512 + pm * 256) * 1024; u.b = memb + (size_t)pn * 256 * 1024; u.pm = pm; u.pn = pn; u.kind = K_MKV | (1 << 8) | K_FP8; return true; }
    }
};
__device__ __forceinline__ void out_tile_of(int L, int G, int& pm, int& pn) {
    const int T = (G % 8 == 0) ? (L % 8) * 64 + L / 8 : L; tile_of(T, 4, pm, pn);
}
struct SchedP4 {
    const char* wsb; int G, c;
    __device__ __forceinline__ bool next(int i, GUnit& u) const {
        const int io = i / 6, s = i - io * 6; const int L = io * G + c; if (L >= 512) return false;
        int pm, pn; out_tile_of(L, G, pm, pn); u.pm = pm; u.pn = pn;
        if ((s & 1) == 0) { const int gi = s >> 1; u.a = wsb + WS_H0F8 + (size_t)pm * 256 * 1024; u.sa = 1024; u.b = wsb + WS_WF8IN + (size_t)(WR_GATE + gi * 1024 + pn * 256) * 1024; u.sb = 1024; u.nt = 8; u.kind = K_GATE | (gi << 8) | K_FP8; return true; }
        if (s == 1) { u.a = wsb + WS_FA + (size_t)pm * 256 * 1024; u.sa = 1024; u.b = wsb + WS_WTA + (size_t)pn * 256 * 1024; u.sb = 1024; u.nt = 8; u.kind = K_YA; return true; }
        if (s == 3) { u.a = wsb + WS_OB + (size_t)pm * 256 * 256; u.sa = 256; u.b = wsb + WS_WTB + (size_t)pn * 256 * 256; u.sb = 256; u.nt = 2; u.kind = K_YB | K_FP8; return true; }
        u.a = wsb + WS_YCIN + (size_t)pm * 256 * 512; u.sa = 512; u.b = wsb + WS_WTC + (size_t)pn * 256 * 512; u.sb = 512; u.nt = 4; u.kind = K_YC | K_FP8; return true;
    }
};
struct SchedPlain {
    const char* a; const char* b; int G, c, kind;
    __device__ __forceinline__ bool next(int i, GUnit& u) const {
        const int L = i * G + c; if (L >= 512) return false;
        int pm, pn; out_tile_of(L, G, pm, pn); u.pm = pm; u.pn = pn; u.a = a + (size_t)pm * 256 * 2048; u.b = b + (size_t)pn * 256 * 2048; u.sa = 2048; u.sb = 2048; u.nt = 16; u.kind = kind; return true;
    }
};

__device__ __forceinline__ unsigned opq(unsigned x) { asm volatile("" : "+v"(x)); return x; }
__device__ __forceinline__ v4u pack8(f32x4 v0, f32x4 v1) { v4u o; o.x = pk2(v0[0], v0[1]); o.y = pk2(v0[2], v0[3]); o.z = pk2(v1[0], v1[1]); o.w = pk2(v1[2], v1[3]); return o; }
__device__ __forceinline__ void unpack8(v4u w, f32x4& a, f32x4& b) { a[0] = bflo(w.x); a[1] = bfhi(w.x); a[2] = bflo(w.y); a[3] = bfhi(w.y); b[0] = bflo(w.z); b[1] = bfhi(w.z); b[2] = bflo(w.w); b[3] = bfhi(w.w); }
#define EPI_LOOP(ai, m, bj) _Pragma("unroll") for (int ai = 0; ai < 2; ++ai) _Pragma("unroll") for (int m = 0; m < 4; ++m) _Pragma("unroll") for (int bj = 0; bj < 2; ++bj)

constexpr float W8SC = 32.f, W8INV = 1.f / 32.f;
constexpr float SC_WBC = 16.f, SC_ACT = 4.f;
struct EpiP1 {
    bf16* za; unsigned char* wsb; const LAS unsigned char* bias;
    __device__ __forceinline__ void operator()(f32x4 (&acc)[2][2][4][2], unsigned (&keep)[2][2][4][2], const GUnit& u, int wr, int wc, int fr, int fq) const {
        bf16* const qk = (bf16*)(wsb + WS_QK); bf16* const vt = (bf16*)(wsb + WS_VT); bf16* const qc = (bf16*)(wsb + WS_QC); bf16* const memkv = (bf16*)(wsb + WS_MEMKV);
        const int kind = u.kind & 255, g = (u.kind >> 8) & 255; const float asc = (u.kind & K_FP8) ? W8INV : 1.f;
        const unsigned rl0 = opq((unsigned)(wr * 64 + fr)), cl0 = opq((unsigned)(wc * 32 + 8 * fq));
        if (kind == K_VT) {
            char* base = (char*)(vt + (size_t)g * 256 * NT + (size_t)u.pn * 256); const LAS unsigned char* bb = bias + (WR_V + g * 256) * 4;
            const unsigned lo = rl0 * (unsigned)(NT * 2) + cl0 * 2u;
#pragma unroll
            for (int ai = 0; ai < 2; ++ai)
#pragma unroll
                for (int m = 0; m < 4; ++m) { const float br = *(const LAS float*)(bb + (rl0 + ai * 128 + m * 16) * 4u);
#pragma unroll
                    for (int bj = 0; bj < 2; ++bj) *(GAS v4u*)(base + (lo + (unsigned)((ai * 128 + m * 16) * NT * 2 + bj * 256))) = pack8(acc[ai][bj][m][0] * asc + br, acc[ai][bj][m][1] * asc + br);
                    __builtin_amdgcn_sched_barrier(0); }
            return;
        }
        char* base; unsigned ldb; const LAS unsigned char* bb; bool hasb = true;
        if (kind == K_ZA) { base = (char*)(za + (size_t)u.pm * 256 * 1024 + u.pn * 256); ldb = 2048; bb = bias + (WR_A + u.pn * 256) * 4; }
        else if (kind == K_QK) { base = (char*)(qk + (size_t)g * NT * 512 + (size_t)u.pm * 256 * 512 + u.pn * 256); ldb = 1024; bb = bias + (WR_QK + g * 512 + u.pn * 256) * 4; }
        else if (kind == K_QC) { base = (char*)(qc + (size_t)u.pm * 256 * 512 + u.pn * 256); ldb = 1024; bb = bias + (WR_QC + u.pn * 256) * 4; }
        else { base = (char*)(memkv + (size_t)g * 512 * 512 + (size_t)u.pm * 256 * 512 + u.pn * 256); ldb = 1024; bb = bias; hasb = false; }
        f32x4 bv[2][2];
#pragma unroll
        for (int bj = 0; bj < 2; ++bj)
#pragma unroll
            for (int n = 0; n < 2; ++n) bv[bj][n] = hasb ? *(const LAS f32x4*)(bb + (cl0 + bj * 128 + 4 * n) * 4u) : (f32x4){0.f, 0.f, 0.f, 0.f};
        const unsigned lo = rl0 * ldb + cl0 * 2u;
#pragma unroll
        for (int ai = 0; ai < 2; ++ai)
#pragma unroll
            for (int m = 0; m < 4; ++m) {
#pragma unroll
                for (int bj = 0; bj < 2; ++bj) *(GAS v4u*)(base + (lo + (unsigned)(ai * 128 + m * 16) * ldb + (unsigned)(bj * 256))) = pack8(acc[ai][bj][m][0] * asc + bv[bj][0], acc[ai][bj][m][1] * asc + bv[bj][1]);
                __builtin_amdgcn_sched_barrier(0); }
    }
};
struct EpiP4 {
    bf16* merged; const LAS unsigned char* bias;
    __device__ __forceinline__ void operator()(f32x4 (&acc)[2][2][4][2], unsigned (&keep)[2][2][4][2], const GUnit& u, int wr, int wc, int fr, int fq) const {
        const int kind = u.kind & 255, gi = (u.kind >> 8) & 255;
        const unsigned rl0 = opq((unsigned)(wr * 64 + fr)), cl0 = opq((unsigned)(wc * 32 + 8 * fq));
        if (kind == K_GATE) {
            const LAS unsigned char* bb = bias + (gi * 1024 + u.pn * 256) * 4;
#pragma unroll
            for (int bj = 0; bj < 2; ++bj) { const f32x4 b0 = *(const LAS f32x4*)(bb + (cl0 + bj * 128) * 4u), b1 = *(const LAS f32x4*)(bb + (cl0 + bj * 128 + 4) * 4u);
#pragma unroll
                for (int ai = 0; ai < 2; ++ai)
#pragma unroll
                    for (int m = 0; m < 4; ++m)
#pragma unroll
                        for (int n = 0; n < 2; ++n) { const f32x4 v = acc[ai][bj][m][n] * W8INV + (n ? b1 : b0); unsigned pk = 0u;
#pragma unroll
                            for (int e = 0; e < 4; ++e) { const float sg = __builtin_amdgcn_rcpf(1.f + __expf(-v[e])); pk |= (unsigned)(sg * 255.f + 0.5f) << (8 * e); }
                            keep[ai][bj][m][n] = pk; } }
            return;
        }
        char* mb = (char*)(merged + (size_t)u.pm * 256 * 1024 + u.pn * 256); const unsigned mlo = rl0 * 2048u + cl0 * 2u;
        const float ysc = ((kind == K_YA) ? 1.f : 1.f / (SC_WBC * SC_ACT)) * (1.f / 255.f);
#pragma unroll
        for (int ai = 0; ai < 2; ++ai) {
            v4u pw[4][2];
            if (kind != K_YA) {
#pragma unroll
                for (int m = 0; m < 4; ++m)
#pragma unroll
                    for (int bj = 0; bj < 2; ++bj) pw[m][bj] = *(const GAS v4u*)(mb + (mlo + (unsigned)((ai * 128 + m * 16) * 2048 + bj * 256))); }
#pragma unroll
            for (int m = 0; m < 4; ++m)
#pragma unroll
                for (int bj = 0; bj < 2; ++bj) { f32x4 v[2];
#pragma unroll
                    for (int n = 0; n < 2; ++n) { const unsigned pk = keep[ai][bj][m][n];
                        v[n][0] = acc[ai][bj][m][n][0] * ((float)(pk & 255u) * ysc); v[n][1] = acc[ai][bj][m][n][1] * ((float)((pk >> 8) & 255u) * ysc);
                        v[n][2] = acc[ai][bj][m][n][2] * ((float)((pk >> 16) & 255u) * ysc); v[n][3] = acc[ai][bj][m][n][3] * ((float)(pk >> 24) * ysc); }
                    if (kind != K_YA) { f32x4 p0, p1; unpack8(pw[m][bj], p0, p1); v[0] += p0; v[1] += p1; }
                    *(GAS v4u*)(mb + (mlo + (unsigned)((ai * 128 + m * 16) * 2048 + bj * 256))) = pack8(v[0], v[1]); }
            __builtin_amdgcn_sched_barrier(0); }
    }
};
struct EpiP5 {
    bf16* h0; float* preln; float* stats; LAS unsigned char* lds_spare;
    __device__ __forceinline__ void operator()(f32x4 (&acc)[2][2][4][2], unsigned (&keep)[2][2][4][2], const GUnit& u, int wr, int wc, int fr, int fq) const {
        const unsigned rl0 = opq((unsigned)(wr * 64 + fr)), cl0 = opq((unsigned)(wc * 32 + 8 * fq));
        const size_t t0 = (size_t)u.pm * 256 * 1024 + u.pn * 256;
        char* hb = (char*)(h0 + t0);
        const unsigned hlo = rl0 * 2048u + cl0 * 2u;
#pragma unroll
        for (int ai = 0; ai < 2; ++ai) {
            v4u hw[4][2];
#pragma unroll
            for (int m = 0; m < 4; ++m)
#pragma unroll
                for (int bj = 0; bj < 2; ++bj) hw[m][bj] = *(const GAS v4u*)(hb + (hlo + (unsigned)((ai * 128 + m * 16) * 2048 + bj * 256)));
#pragma unroll
            for (int m = 0; m < 4; ++m) { float s1 = 0.f, s2 = 0.f;
#pragma unroll
                for (int bj = 0; bj < 2; ++bj) { f32x4 h0v, h1v; unpack8(hw[m][bj], h0v, h1v);
                    const f32x4 v0 = acc[ai][bj][m][0] + ALPHA * h0v, v1 = acc[ai][bj][m][1] + ALPHA * h1v;
                    *(GAS v4u*)(hb + (hlo + (unsigned)((ai * 128 + m * 16) * 2048 + bj * 256))) = pack8(v0, v1);
                    s1 += (v0[0] + v0[1]) + (v0[2] + v0[3]) + (v1[0] + v1[1]) + (v1[2] + v1[3]);
                    s2 += (v0[0] * v0[0] + v0[1] * v0[1]) + (v0[2] * v0[2] + v0[3] * v0[3]) + (v1[0] * v1[0] + v1[1] * v1[1]) + (v1[2] * v1[2] + v1[3] * v1[3]); }
                s1 += __shfl_xor(s1, 16); s1 += __shfl_xor(s1, 32); s2 += __shfl_xor(s2, 16); s2 += __shfl_xor(s2, 32);
                if (fq == 0) { f32x2 pr; pr.x = s1; pr.y = s2; *(LAS f32x2*)(lds_spare + ((ai * 128 + m * 16 + rl0) * 4 + wc) * 8) = pr; } }
            __builtin_amdgcn_sched_barrier(0); }
        asm volatile("s_waitcnt lgkmcnt(0)" ::: "memory"); __builtin_amdgcn_s_barrier(); asm volatile("" ::: "memory");
        { const int t = threadIdx.x;
          if (t < 256) { const LAS f32x2* pp = (const LAS f32x2*)(lds_spare + t * 32); f32x2 a = pp[0]; a += pp[1]; a += pp[2]; a += pp[3];
              *(GAS f32x2*)(stats + ((size_t)(u.pm * 256 + t) * 4 + u.pn) * 2) = a; } }
    }
};
struct EpiP7 {
    bf16* qp; const float* stats; const float* cvec; const float* dvec;
    __device__ __forceinline__ void operator()(f32x4 (&acc)[2][2][4][2], unsigned (&keep)[2][2][4][2], const GUnit& u, int wr, int wc, int fr, int fq) const {
        const unsigned rl0 = opq((unsigned)(wr * 64 + fr)), cl0 = opq((unsigned)(wc * 32 + 8 * fq));
        char* qb = (char*)(qp + (size_t)u.pm * 256 * 1024 + u.pn * 256); const unsigned lo = rl0 * 2048u + cl0 * 2u;
        f32x4 cv[2][2], dv[2][2];
#pragma unroll
        for (int bj = 0; bj < 2; ++bj)
#pragma unroll
            for (int n = 0; n < 2; ++n) { cv[bj][n] = *(const GAS f32x4*)(cvec + u.pn * 256 + cl0 + bj * 128 + 4 * n); dv[bj][n] = *(const GAS f32x4*)(dvec + u.pn * 256 + cl0 + bj * 128 + 4 * n); }
#pragma unroll
        for (int ai = 0; ai < 2; ++ai)
#pragma unroll
            for (int m = 0; m < 4; ++m) { const GAS f32x4* sp = (const GAS f32x4*)(stats + (size_t)(u.pm * 256 + ai * 128 + m * 16 + rl0) * 8); const f32x4 sa = sp[0], sb = sp[1];
                f32x2 st; st.x = ((sa.x + sa.z) + sb.x) + sb.z; st.y = ((sa.y + sa.w) + sb.y) + sb.w;
                const float mean = st.x * (1.f / D), rstd = 1.f / sqrtf(fmaxf(st.y * (1.f / D) - mean * mean, 0.f) + LN_EPS), mr = mean * rstd;
#pragma unroll
                for (int bj = 0; bj < 2; ++bj) *(GAS v4u*)(qb + (lo + (unsigned)((ai * 128 + m * 16) * 2048 + bj * 256))) = pack8(acc[ai][bj][m][0] * rstd - mr * cv[bj][0] + dv[bj][0], acc[ai][bj][m][1] * rstd - mr * cv[bj][1] + dv[bj][1]); }
    }
};

constexpr float FP6_SU = 60.f, FP6_SV = 3.15f;
__device__ __forceinline__ unsigned fp6_code(float v) {
    const float a = fminf(fabsf(v), 7.5f);
    const float c = a < 2.f ? rintf(a * 8.f) : (a < 4.f ? 16.f + rintf((a - 2.f) * 4.f) : 24.f + rintf((a - 4.f) * 2.f));
    return (unsigned)c | (v < 0.f ? 32u : 0u);
}
constexpr float FP4_SV = 3.36f, FP4_SU = 64.f;
__device__ __forceinline__ unsigned fp4_code(float v) {
    const float a = fminf(fabsf(v), 6.f);
    const float c = a < 2.f ? rintf(a * 2.f) : (a < 4.f ? 4.f + rintf(a - 2.f) : 6.f + rintf((a - 4.f) * 0.5f));
    return (unsigned)c | (v < 0.f ? 8u : 0u);
}
typedef unsigned v6u __attribute__((ext_vector_type(6)));
typedef float v32f __attribute__((ext_vector_type(32)));
__device__ __forceinline__ void p0_transpose_item(const float* W, int K, int ld, int col0, bf16* WT, unsigned char* WT8, float sc8, int row0, LAS float* scr, int item, int lane, int ncols,
                                                  const float* kg = nullptr, const float* kb = nullptr, float* cvec = nullptr, float* dvec = nullptr) {
    const int nblk = ncols / 32, kb_ = item / nblk, nb = item % nblk, k0 = 64 * kb_, n0 = 32 * nb;
    { float wv[32];
#pragma unroll
      for (int i = 0; i < 32; ++i) wv[i] = W[(size_t)(k0 + 2 * i + (lane >> 5)) * ld + col0 + n0 + (lane & 31)];
#pragma unroll
      for (int i = 0; i < 32; ++i) scr[(2 * i + (lane >> 5)) * 33 + (lane & 31)] = wv[i]; }
    LDS_WAIT(); asm volatile("" ::: "memory");
    const int c = lane & 7;
#pragma unroll
    for (int j = 0; j < 4; ++j) { const int n = (lane >> 3) + 8 * j; const LAS float* s = scr + (8 * c) * 33 + n;
        float e[8];
#pragma unroll
        for (int i = 0; i < 8; ++i) e[i] = s[i * 33];
        if (kg) { float pc = 0.f, pd = 0.f;
#pragma unroll
            for (int i = 0; i < 8; ++i) { const float g = kg[k0 + 8 * c + i]; pd += e[i] * kb[k0 + 8 * c + i]; e[i] *= g; pc += e[i]; }
            pc += __shfl_xor(pc, 1); pc += __shfl_xor(pc, 2); pc += __shfl_xor(pc, 4); pd += __shfl_xor(pd, 1); pd += __shfl_xor(pd, 2); pd += __shfl_xor(pd, 4);
            if (c == 0) { cvec[kb_ * 1024 + col0 + n0 + n] = pc; dvec[kb_ * 1024 + col0 + n0 + n] = pd; } }
        if (WT) { v4u o; o.x = pk2(e[0], e[1]); o.y = pk2(e[2], e[3]); o.z = pk2(e[4], e[5]); o.w = pk2(e[6], e[7]); *(GAS v4u*)(WT + (size_t)(row0 + n0 + n) * K + k0 + 8 * c) = o; }
        if (WT8) { v2u o; o.x = pk4_fp8(e[0] * sc8, e[1] * sc8, e[2] * sc8, e[3] * sc8); o.y = pk4_fp8(e[4] * sc8, e[5] * sc8, e[6] * sc8, e[7] * sc8); *(GAS v2u*)(WT8 + (size_t)(row0 + n0 + n) * K + k0 + 8 * c) = o; } }
    LDS_WAIT(); asm volatile("" ::: "memory");
}
__device__ __forceinline__ void ln_row(const float* xrow, const float* g, const float* b, bf16* obf, float* of32, int lane) {
    const GAS f32x4* xr = (const GAS f32x4*)xrow + lane;
    f32x4 v[4]; float s = 0.f;
#pragma unroll
    for (int j = 0; j < 4; ++j) { v[j] = xr[64 * j]; s += (v[j].x + v[j].y) + (v[j].z + v[j].w); }
    const float mean = wave_sum(s) * (1.f / D); float s2 = 0.f;
#pragma unroll
    for (int j = 0; j < 4; ++j) { v[j] = v[j] - mean; s2 += (v[j].x * v[j].x + v[j].y * v[j].y) + (v[j].z * v[j].z + v[j].w * v[j].w); }
    const float rstd = 1.f / sqrtf(wave_sum(s2) * (1.f / D) + LN_EPS);
#pragma unroll
    for (int j = 0; j < 4; ++j) { const f32x4 gg = ((const GAS f32x4*)g)[lane + 64 * j], bb = ((const GAS f32x4*)b)[lane + 64 * j];
        const f32x4 y = v[j] * rstd * gg + bb;
        if (obf) ((GAS unsigned long long*)obf)[lane + 64 * j] = (unsigned long long)pk2(y.x, y.y) | ((unsigned long long)pk2(y.z, y.w) << 32);
        if (of32) ((GAS f32x4*)of32)[lane + 64 * j] = y; }
}
__device__ __forceinline__ void ln_row2(const float* xa, const float* xb, const float* g, const float* b, bf16* oa, bf16* ob, unsigned char* oa8, unsigned char* ob8, int lane) {
    const GAS f32x4* pa = (const GAS f32x4*)xa + lane; const GAS f32x4* pb = (const GAS f32x4*)xb + lane;
    f32x4 va[4], vb[4]; float sa = 0.f, sb = 0.f;
#pragma unroll
    for (int j = 0; j < 4; ++j) { va[j] = pa[64 * j]; vb[j] = pb[64 * j]; }
#pragma unroll
    for (int j = 0; j < 4; ++j) { sa += (va[j].x + va[j].y) + (va[j].z + va[j].w); sb += (vb[j].x + vb[j].y) + (vb[j].z + vb[j].w); }
    const float ma = wave_sum(sa) * (1.f / D), mb = wave_sum(sb) * (1.f / D); float qa = 0.f, qb = 0.f;
#pragma unroll
    for (int j = 0; j < 4; ++j) { va[j] = va[j] - ma; vb[j] = vb[j] - mb; qa += (va[j].x * va[j].x + va[j].y * va[j].y) + (va[j].z * va[j].z + va[j].w * va[j].w); qb += (vb[j].x * vb[j].x + vb[j].y * vb[j].y) + (vb[j].z * vb[j].z + vb[j].w * vb[j].w); }
    const float ra = 1.f / sqrtf(wave_sum(qa) * (1.f / D) + LN_EPS), rb = 1.f / sqrtf(wave_sum(qb) * (1.f / D) + LN_EPS);
#pragma unroll
    for (int j = 0; j < 4; ++j) { const f32x4 gg = ((const GAS f32x4*)g)[lane + 64 * j], bb = ((const GAS f32x4*)b)[lane + 64 * j];
        const f32x4 ya = va[j] * ra * gg + bb, yb = vb[j] * rb * gg + bb;
        ((GAS unsigned long long*)oa)[lane + 64 * j] = (unsigned long long)pk2(ya.x, ya.y) | ((unsigned long long)pk2(ya.z, ya.w) << 32);
        ((GAS unsigned long long*)ob)[lane + 64 * j] = (unsigned long long)pk2(yb.x, yb.y) | ((unsigned long long)pk2(yb.z, yb.w) << 32);
        ((GAS unsigned*)oa8)[lane + 64 * j] = pk4_fp8(ya.x, ya.y, ya.z, ya.w); ((GAS unsigned*)ob8)[lane + 64 * j] = pk4_fp8(yb.x, yb.y, yb.z, yb.w); }
}
__device__ __forceinline__ int t5_bucket(int rel) {
    const int ret = rel > 0 ? 16 : 0; const int n = rel < 0 ? -rel : rel; const float nf = (float)(n > 1 ? n : 1);
    int large = 8 + (int)(logf(nf / 8.f) / 4.852030263919617f * 8.f); large = large < 15 ? large : 15;
    return ret + (n < 8 ? n : large);
}

__device__ __forceinline__ void phase0(const Ptrs& P, LAS unsigned char* lds, int tid, int lane, int wave, int G) {
    unsigned char* ws = P.ws;
    const int gw = blockIdx.x * NWAVES + wave, NGW = G * NWAVES;
    { bf16* h0 = (bf16*)(ws + WS_H0);
      unsigned char* h08 = ws + WS_H0F8;
      for (int m = gw; m < NT; m += 2 * NGW) ln_row2(P.in[0] + (size_t)m * D, P.in[0] + (size_t)(m + NGW) * D, P.in[3], P.in[4], h0 + (size_t)m * D, h0 + (size_t)(m + NGW) * D, h08 + (size_t)m * D, h08 + (size_t)(m + NGW) * D, lane); }
    { LAS float* scr = (LAS float*)(lds + wave * 16384);
      bf16* wtin = (bf16*)(ws + WS_WTIN);
      constexpr int I_IN = 23 * 16 * 8, I_A = 8 * 32, I_B = 4 * 32, I_C = 8 * 32, I_SQ = 16 * 32;
      constexpr int NIT = I_IN + I_A + I_B + I_C + 3 * I_SQ;
      unsigned char* wf8 = ws + WS_WF8IN;
      for (int it = gw; it < NIT; it += NGW) {
          int r = it;
          if (r < I_IN) { const int j = r / 128, q = r % 128; int src;
              if (j < 6) src = ((j & 1) ? 1280 : 512) + (j >> 1) * 256; else if (j < 9) src = 2048 + (j - 6) * 256; else if (j < 11) src = 2816 + (j - 9) * 256; else src = 3328 + (j - 11) * 256;
              p0_transpose_item(P.in[5], 1024, 6400, src, nullptr, wf8, W8SC, 1024 + 256 * j, scr, q, lane, 256); continue; }
          r -= I_IN;
          if (r < I_A) { p0_transpose_item(P.in[7], 512, 1024, 0, (bf16*)(ws + WS_WTA), nullptr, 0.f, 0, scr, r, lane, 1024); continue; } r -= I_A;
          if (r < I_B) { p0_transpose_item(P.in[8], 256, 1024, 0, nullptr, ws + WS_WTB, SC_WBC, 0, scr, r, lane, 1024); continue; } r -= I_B;
          if (r < I_C) { p0_transpose_item(P.in[9], 512, 1024, 0, nullptr, ws + WS_WTC, SC_WBC, 0, scr, r, lane, 1024); continue; } r -= I_C;
          if (r < I_SQ) { p0_transpose_item(P.in[10], 1024, 1024, 0, nullptr, ws + WS_WMKVF8, W8SC, 0, scr, r, lane, 1024); continue; } r -= I_SQ;
          if (r < I_SQ) { p0_transpose_item(P.in[11], 1024, 1024, 0, (bf16*)(ws + WS_WTO), nullptr, 0.f, 0, scr, r, lane, 1024); continue; } r -= I_SQ;
          p0_transpose_item(P.in[14], 1024, 1024, 0, (bf16*)(ws + WS_WTPQ), nullptr, 0.f, 0, scr, r, lane, 1024, P.in[12], P.in[13], (float*)(ws + WS_CPART), (float*)(ws + WS_CPART) + 16 * 1024);
      } }
    __syncthreads();
    { LAS float* wt = (LAS float*)lds;
      LAS float* cs = wt + 64 * 129; LAS float* sn = cs + 128;
      if (tid < 128) { float s, c; sincospif((float)tid / 64.f, &s, &c); cs[tid] = c; sn[tid] = s; }
      bf16* wtin = (bf16*)(ws + WS_WTIN);
      unsigned char* wf8 = ws + WS_WF8IN;
      for (int it = blockIdx.x; it < 256; it += G) {
          const int g = it >> 6, k0 = (it & 63) * 16;
          __syncthreads();
          for (int idx = tid; idx < 16 * 128; idx += 512) { const int kk = idx >> 7, c = idx & 127; wt[kk * 129 + c] = P.in[5][(size_t)(k0 + kk) * 6400 + g * 128 + c]; }
          __syncthreads();
          const int cp = tid & 127, kq = tid >> 7;
          float ac[4] = {0.f, 0.f, 0.f, 0.f}, as[4] = {0.f, 0.f, 0.f, 0.f};
#pragma unroll 4
          for (int c = 0; c < 128; ++c) { const int ix = (c * cp) & 127; const float cv = cs[ix], sv = sn[ix];
#pragma unroll
              for (int i = 0; i < 4; ++i) { const float w = wt[(4 * kq + i) * 129 + c]; ac[i] += w * cv; as[i] += w * sv; } }
          { v2u o; o.x = pk2(ac[0], ac[1]); o.y = pk2(ac[2], ac[3]); *(GAS v2u*)(wtin + (size_t)(g * 256 + cp) * 1024 + k0 + 4 * kq) = o;
            v2u q; q.x = pk2(as[0], as[1]); q.y = pk2(as[2], as[3]); *(GAS v2u*)(wtin + (size_t)(g * 256 + 128 + cp) * 1024 + k0 + 4 * kq) = q; }
      }
      __syncthreads();
      { float* bi = (float*)(ws + WS_BIASIN); const float* b_in = P.in[6];
        for (int r = gw; r < 1024; r += NGW) { const int g = r >> 8, w = r & 255, cp = w & 127; const bool isin = w >= 128;
            const int i0 = (lane * cp) & 127, i1 = ((lane + 64) * cp) & 127;
            float a = b_in[g * 128 + lane] * (isin ? sn[i0] : cs[i0]) + b_in[g * 128 + 64 + lane] * (isin ? sn[i1] : cs[i1]);
            a = wave_sum(a); if (lane == 0) bi[r] = a; }
        const int gtid = blockIdx.x * 512 + tid, nth = G * 512;
        for (int r = 1024 + gtid; r < WR_END; r += nth) { const int j = (r - 1024) >> 8, w = (r - 1024) & 255; int src;
            if (j < 6) src = ((j & 1) ? 1280 : 512) + (j >> 1) * 256; else if (j < 9) src = 2048 + (j - 6) * 256; else if (j < 11) src = 2816 + (j - 9) * 256; else src = 3328 + (j - 11) * 256;
            bi[r] = b_in[src + w]; }
        float* bt = (float*)(ws + WS_BIASTAB);
        for (int r = gtid; r < 3 * 4 * 129; r += nth) { const int g = r / (4 * 129), h = (r / 129) & 3, j = r % 129; const int rel = (j - 64) << (2 * g);
            bt[(g * 4 + h) * 132 + j] = P.in[2][t5_bucket(rel) * 12 + g * 4 + h]; }
      }
    }
    { const size_t gt = (size_t)blockIdx.x * 512 + tid, NTH = (size_t)G * 512;
      const GAS f32x4* us = (const GAS f32x4*)P.in[17]; const GAS f32x4* vs = (const GAS f32x4*)P.in[18];
      GAS v2u* ud = (GAS v2u*)(ws + WS_UTAB); GAS v2u* vd = (GAS v2u*)(ws + WS_VTAB);
#if TAB_FP6
      {
        const int njobs = 2 * 16384 * 16;
        for (int job = (int)gt; job < njobs; job += (int)NTH) { const int tb = job >> 18, e = (job >> 4) & 16383, fr = job & 15;
            const float sc = tb ? (TABV_FP4 ? FP4_SV : FP6_SV) : (TABU_FP4 ? FP4_SU : FP6_SU);
            const GAS f32x4* src = (const GAS f32x4*)((tb ? P.in[18] : P.in[17]) + (size_t)e * 1024 + fr * 16);
            f32x4 v[16];
#pragma unroll
            for (int c = 0; c < 4; ++c)
#pragma unroll
                for (int q4 = 0; q4 < 4; ++q4) v[c * 4 + q4] = src[c * 64 + q4];
            if ((TABV_FP4 && tb) || (TABU_FP4 && !tb)) {
                unsigned wd4[8];
#pragma unroll
                for (int w = 0; w < 8; ++w) { unsigned acc4 = 0u;
#pragma unroll
                    for (int t = 0; t < 8; ++t) acc4 |= fp4_code(v[w * 2 + (t >> 2)][t & 3] * sc) << (4 * t);
                    wd4[w] = acc4; }
                unsigned char* dst4 = ws + (tb ? WS_VTAB : WS_UTAB) + (size_t)e * 512 + fr * 16;
#pragma unroll
                for (int p = 0; p < 2; ++p) { v4u o; o.x = wd4[4 * p]; o.y = wd4[4 * p + 1]; o.z = wd4[4 * p + 2]; o.w = wd4[4 * p + 3]; *(GAS v4u*)(dst4 + p * 256) = o; }
                continue; }
            unsigned wd[12];
#pragma unroll
            for (int h = 0; h < 4; ++h) {
                unsigned cd[16];
#pragma unroll
                for (int q4 = 0; q4 < 4; ++q4)
#pragma unroll
                    for (int t = 0; t < 4; ++t) cd[q4 * 4 + t] = fp6_code(v[h * 4 + q4][t] * sc);
                wd[h * 3 + 0] = cd[0] | (cd[1] << 6) | (cd[2] << 12) | (cd[3] << 18) | (cd[4] << 24) | ((cd[5] & 3u) << 30);
                wd[h * 3 + 1] = (cd[5] >> 2) | (cd[6] << 4) | (cd[7] << 10) | (cd[8] << 16) | (cd[9] << 22) | ((cd[10] & 15u) << 28);
                wd[h * 3 + 2] = (cd[10] >> 4) | (cd[11] << 2) | (cd[12] << 8) | (cd[13] << 14) | (cd[14] << 20) | (cd[15] << 26); }
            unsigned char* dst = ws + (tb ? WS_VTAB : WS_UTAB) + (size_t)e * 768 + fr * 16;
#pragma unroll
            for (int p = 0; p < 3; ++p) { v4u o; o.x = wd[4 * p]; o.y = wd[4 * p + 1]; o.z = wd[4 * p + 2]; o.w = wd[4 * p + 3]; *(GAS v4u*)(dst + p * 256) = o; } } }
#endif
      const GAS f32x4* ms = (const GAS f32x4*)P.in[1]; GAS unsigned* md = (GAS unsigned*)(ws + WS_MEMF8);
      for (size_t i = gt; i < (size_t)512 * 1024 / 4; i += NTH) { const f32x4 a = ms[i]; md[i] = pk4_fp8(a.x, a.y, a.z, a.w); }
    }
}

constexpr int FFT_PITCH = 544, FFT_BUF = 128 * FFT_PITCH;
static_assert(2 * FFT_BUF <= MISC_OFF, "FFT LDS map");
typedef short s16x4 __attribute__((ext_vector_type(4)));
__device__ __forceinline__ s16x4 tr_read(LAS unsigned char* p) { return __builtin_amdgcn_ds_read_tr16_b64_v4i16((LAS s16x4*)p); }
template <int STEP>
__device__ __forceinline__ void fft_step_mfma(const bf16* src, bf16* dst, LAS unsigned char* lds, int tid, int lane, int wave, int G) {
    const int fr = lane & 15, kq = lane >> 4, kout = 16 * wave + fr;
    bf16x8 cf[4], sf[4];
    { LAS float* tab = (LAS float*)(lds + FFT_BUF);
      __syncthreads();
      if (tid < 128) { float sn, cs; sincospif((float)tid / 64.f, &sn, &cs); tab[tid] = cs; tab[128 + tid] = sn; }
      __syncthreads();
#pragma unroll
      for (int kk = 0; kk < 4; ++kk) { v4u cw, sw; unsigned cl[8], sl[8];
#pragma unroll
          for (int j = 0; j < 8; ++j) { const int sv = 32 * kk + (j < 4 ? 4 * kq + j : 16 + 4 * kq + j - 4); const int ix = (kout * sv) & 127; cl[j] = f2bf(tab[ix]); sl[j] = f2bf(tab[128 + ix]); }
          cw.x = cl[0] | (cl[1] << 16); cw.y = cl[2] | (cl[3] << 16); cw.z = cl[4] | (cl[5] << 16); cw.w = cl[6] | (cl[7] << 16);
          sw.x = sl[0] | (sl[1] << 16); sw.y = sl[2] | (sl[3] << 16); sw.z = sl[4] | (sl[5] << 16); sw.w = sl[6] | (sl[7] << 16);
          cf[kk] = __builtin_bit_cast(bf16x8, cw); sf[kk] = __builtin_bit_cast(bf16x8, sw); } }
    v4u iw[8];
#define FFT_LOAD(UN) do { const int b_ = (UN) >> 9, f_ = ((UN) >> 2) & 127, g_ = (UN) & 3; _Pragma("unroll") for (int j = 0; j < 8; ++j) { const int c = tid + 512 * j; const int sr = c >> 5, piece = c & 31; \
            const size_t row = (STEP == 1) ? (size_t)(b_ << 14) + 128 * sr + f_ : (size_t)(b_ << 14) + 128 * f_ + sr; iw[j] = *(const GAS v4u*)(src + row * 1024 + g_ * 256 + piece * 8); } } while (0)
#define FFT_PUT(BUF) do { _Pragma("unroll") for (int j = 0; j < 8; ++j) { const int c = tid + 512 * j; *(LAS v4u*)(lds + (BUF) * FFT_BUF + (c >> 5) * FFT_PITCH + (c & 31) * 16) = iw[j]; } } while (0)
    __syncthreads();
    if (blockIdx.x < 1024) { FFT_LOAD(blockIdx.x); FFT_PUT(0); }
    __syncthreads();
    int cur = 0;
    for (int unit = blockIdx.x; unit < 1024; unit += G) {
        const int b = unit >> 9, f = (unit >> 2) & 127, g = unit & 3;
        const bool more = unit + G < 1024;
        if (more) FFT_LOAD(unit + G);
        LAS unsigned char* img = lds + cur * FFT_BUF;
        f32x4 accR[8], accI[8];
#pragma unroll
        for (int mt = 0; mt < 8; ++mt) { accR[mt] = (f32x4){0.f, 0.f, 0.f, 0.f}; accI[mt] = (f32x4){0.f, 0.f, 0.f, 0.f}; }
#pragma unroll
        for (int mt = 0; mt < 8; ++mt)
#pragma unroll
            for (int kk = 0; kk < 4; ++kk) {
                LAS unsigned char* a1 = img + (32 * kk + 4 * kq + (fr >> 2)) * FFT_PITCH + (16 * mt + 4 * (fr & 3)) * 2;
                LAS unsigned char* a2 = a1 + 16 * FFT_PITCH;
                const s16x4 r0 = tr_read(a1), r1 = tr_read(a2), i0 = tr_read(a1 + 256), i1 = tr_read(a2 + 256);
                const bf16x8 xr = __builtin_shufflevector(r0, r1, 0, 1, 2, 3, 4, 5, 6, 7), xi = __builtin_shufflevector(i0, i1, 0, 1, 2, 3, 4, 5, 6, 7);
                if (STEP == 1) {
                    v4u t = __builtin_bit_cast(v4u, xi); t.x ^= 0x80008000u; t.y ^= 0x80008000u; t.z ^= 0x80008000u; t.w ^= 0x80008000u; const bf16x8 nxi = __builtin_bit_cast(bf16x8, t);
                    accR[mt] = __builtin_amdgcn_mfma_f32_16x16x32_bf16(xr, cf[kk], accR[mt], 0, 0, 0); accR[mt] = __builtin_amdgcn_mfma_f32_16x16x32_bf16(nxi, sf[kk], accR[mt], 0, 0, 0);
                    accI[mt] = __builtin_amdgcn_mfma_f32_16x16x32_bf16(xi, cf[kk], accI[mt], 0, 0, 0); accI[mt] = __builtin_amdgcn_mfma_f32_16x16x32_bf16(xr, sf[kk], accI[mt], 0, 0, 0);
                } else {
                    accR[mt] = __builtin_amdgcn_mfma_f32_16x16x32_bf16(xr, cf[kk], accR[mt], 0, 0, 0); accR[mt] = __builtin_amdgcn_mfma_f32_16x16x32_bf16(xi, sf[kk], accR[mt], 0, 0, 0);
                }
                if (kk == 3) __builtin_amdgcn_sched_barrier(0);
            }
        if (STEP == 1) { float ws_, wc_; sincospif(-(float)(f * kout) / 8192.f, &ws_, &wc_);
            bf16* orow = dst + ((size_t)(b << 14) + kout * 128 + f) * 1024 + g * 256 + 4 * kq;
#pragma unroll
            for (int mt = 0; mt < 8; ++mt) { v2u re, im; re.x = pk2(accR[mt][0] * wc_ + accI[mt][0] * ws_, accR[mt][1] * wc_ + accI[mt][1] * ws_); re.y = pk2(accR[mt][2] * wc_ + accI[mt][2] * ws_, accR[mt][3] * wc_ + accI[mt][3] * ws_);
                im.x = pk2(accR[mt][0] * ws_ - accI[mt][0] * wc_, accR[mt][1] * ws_ - accI[mt][1] * wc_); im.y = pk2(accR[mt][2] * ws_ - accI[mt][2] * wc_, accR[mt][3] * ws_ - accI[mt][3] * wc_);
                *(GAS v2u*)(orow + 16 * mt) = re; *(GAS v2u*)(orow + 128 + 16 * mt) = im; }
        } else { const float scale = 6.905339660024878e-4f;
            bf16* orow = dst + ((size_t)(b << 14) + f + 128 * kout) * 512 + g * 128 + 4 * kq;
#pragma unroll
            for (int mt = 0; mt < 8; ++mt) { v2u re; re.x = pk2(accR[mt][0] * scale, accR[mt][1] * scale); re.y = pk2(accR[mt][2] * scale, accR[mt][3] * scale); *(GAS v2u*)(orow + 16 * mt) = re; }
        }
        if (more) FFT_PUT(cur ^ 1);
        __syncthreads();
        cur ^= 1;
    }
#undef FFT_LOAD
#undef FFT_PUT
}

typedef float f32x16 __attribute__((ext_vector_type(16)));
constexpr int DA_BT = 0, DA_K = 9216, DA_KP = 144, DA_V = DA_K + 384 * DA_KP, DA_VP = 776;
static_assert(DA_V + 64 * DA_VP <= MISC_OFF, "dil-attn LDS map");
template <int T>
__device__ __forceinline__ void dil_tile(LAS unsigned char* lds, int kr0, int r31, int hh, const LAS float* btl, const bf16x8 (&qf)[4], f32x16& o0, f32x16& o1, float& mx, float& den) {
    const LAS unsigned char* kp = lds + DA_K + (kr0 + r31) * DA_KP + 16 * hh;
    f32x16 sacc;
#pragma unroll
    for (int i = 0; i < 16; ++i) sacc[i] = 0.f;
#pragma unroll
    for (int kk = 0; kk < 4; ++kk) { const bf16x8 kf = *(const LAS bf16x8*)(kp + 32 * kk); sacc = __builtin_amdgcn_mfma_f32_32x32x16_bf16(kf, qf[kk], sacc, 0, 0, 0); }
    const LAS float* bl = btl + (32 + 32 * T + 4 * hh - r31);
    float tmax = -INFINITY;
#pragma unroll
    for (int i = 0; i < 16; ++i) { const int krow = (i & 3) + 8 * (i >> 2);
        float sv = sacc[i] * 0.18033688011112042f + bl[krow];
        if (T == 0) sv = (krow + 4 * hh >= r31) ? sv : -INFINITY;
        if (T == 4) sv = (krow + 4 * hh <= r31) ? sv : -INFINITY;
        sacc[i] = sv; tmax = fmaxf(tmax, sv); }
    tmax = fmaxf(tmax, __shfl_xor(tmax, 32));
    const float mn = fmaxf(mx, tmax), corr = __builtin_amdgcn_exp2f(mx - mn); mx = mn;
    float psum = 0.f;
#pragma unroll
    for (int i = 0; i < 16; ++i) { const float p = __builtin_amdgcn_exp2f(sacc[i] - mn); sacc[i] = p; psum += p; }
    den = den * corr + psum;
#pragma unroll
    for (int i = 0; i < 16; ++i) { o0[i] *= corr; o1[i] *= corr; }
#pragma unroll
    for (int s2 = 0; s2 < 2; ++s2) { v4u pw; pw.x = pk2(sacc[8 * s2], sacc[8 * s2 + 1]); pw.y = pk2(sacc[8 * s2 + 2], sacc[8 * s2 + 3]); pw.z = pk2(sacc[8 * s2 + 4], sacc[8 * s2 + 5]); pw.w = pk2(sacc[8 * s2 + 6], sacc[8 * s2 + 7]);
        const bf16x8 pf = __builtin_bit_cast(bf16x8, pw);
        const LAS unsigned char* vp = lds + DA_V + r31 * DA_VP + (kr0 + 16 * s2 + 4 * hh) * 2;
        const v2u lo0 = *(const LAS v2u*)vp, hi0 = *(const LAS v2u*)(vp + 16), lo1 = *(const LAS v2u*)(vp + 32 * DA_VP), hi1 = *(const LAS v2u*)(vp + 32 * DA_VP + 16);
        v4u w0, w1; w0.x = lo0.x; w0.y = lo0.y; w0.z = hi0.x; w0.w = hi0.y; w1.x = lo1.x; w1.y = lo1.y; w1.z = hi1.x; w1.w = hi1.y;
        o0 = __builtin_amdgcn_mfma_f32_32x32x16_bf16(__builtin_bit_cast(bf16x8, w0), pf, o0, 0, 0, 0);
        o1 = __builtin_amdgcn_mfma_f32_32x32x16_bf16(__builtin_bit_cast(bf16x8, w1), pf, o1, 0, 0, 0); }
}
__device__ __forceinline__ void dil_attn_lds(const bf16* qk, const bf16* vt, const float* btab_g, bf16* og, float* lse, LAS unsigned char* lds, int tid, int lane, int wave, int G) {
    LAS float* bt = (LAS float*)(lds + DA_BT);
    __syncthreads();
    for (int i = tid; i < 12 * 192; i += 512) { const int tb = i / 192, j = i - tb * 192 - 32; bt[i] = (j >= 0 && j <= 128) ? btab_g[tb * 132 + j] * 1.4426950408889634f : 0.f; }
    const int r31 = lane & 31, hh = lane >> 5;
    v4u kw[6], vw[6]; bf16x8 qn[4];
#define DIL_UNIT(U) const int blk = (U) & 63, hd = ((U) >> 6) & 3, g = ((U) >> 8) % 3, b = (U) / 768; const int sh = 2 * g, sub = 16384 >> sh; \
        const int nl0 = blk * 256, rr = nl0 >> (14 - sh), l0 = nl0 & (sub - 1); const size_t seq0 = ((size_t)g * NT + (size_t)(b << 14) + (size_t)rr * sub); \
        const bf16* qkg = qk + seq0 * 512; const bf16* vtg = vt + ((size_t)g * 256 + hd * 64) * NT + (size_t)(b << 14) + (size_t)rr * sub;
#define DIL_LOAD() do { _Pragma("unroll") for (int j = 0; j < 6; ++j) { const int c = tid + 512 * j; const int kr = c >> 3, pc = c & 7; const int lk = l0 - 64 + kr; const int lkc = lk < 0 ? 0 : (lk >= sub ? sub - 1 : lk); \
              kw[j] = *(const GAS v4u*)(qkg + (size_t)lkc * 512 + 256 + hd * 64 + pc * 8); \
              const int d = c / 48, pv = c - d * 48; const int lv = l0 - 64 + pv * 8; const int lvc = lv < 0 ? 0 : (lv >= sub ? sub - 8 : lv); \
              vw[j] = *(const GAS v4u*)(vtg + (size_t)d * NT + lvc); } \
          _Pragma("unroll") for (int kk = 0; kk < 4; ++kk) qn[kk] = *(const GAS bf16x8*)(qkg + (size_t)(l0 + 32 * wave + (lane & 31)) * 512 + hd * 64 + 16 * kk + 8 * (lane >> 5)); } while (0)
    if (blockIdx.x < 1536) { DIL_UNIT(blockIdx.x) DIL_LOAD(); }
    for (int u = blockIdx.x; u < 1536; u += G) {
        DIL_UNIT(u)
        __syncthreads();
#pragma unroll
        for (int j = 0; j < 6; ++j) { const int c = tid + 512 * j; const int kr = c >> 3, pc = c & 7;
            *(LAS v4u*)(lds + DA_K + kr * DA_KP + pc * 16) = kw[j];
            const int d = c / 48, pv = c - d * 48;
            v2u lo, hi; lo.x = vw[j].x; lo.y = vw[j].y; hi.x = vw[j].z; hi.y = vw[j].w;
            *(LAS v2u*)(lds + DA_V + d * DA_VP + pv * 16) = lo; *(LAS v2u*)(lds + DA_V + d * DA_VP + pv * 16 + 8) = hi; }
        __syncthreads();
        bf16x8 qf[4];
#pragma unroll
        for (int kk = 0; kk < 4; ++kk) qf[kk] = qn[kk];
        if (u + G < 1536) { const int un = u + G; const int blkn = un & 63, hdn = (un >> 6) & 3, gn = (un >> 8) % 3, bn = un / 768; const int shn = 2 * gn, subn = 16384 >> shn;
            const int nl0n = blkn * 256, rrn = nl0n >> (14 - shn), l0n = nl0n & (subn - 1); const size_t seq0n = ((size_t)gn * NT + (size_t)(bn << 14) + (size_t)rrn * subn);
            const bf16* qkgn = qk + seq0n * 512; const bf16* vtgn = vt + ((size_t)gn * 256 + hdn * 64) * NT + (size_t)(bn << 14) + (size_t)rrn * subn;
#pragma unroll
            for (int j = 0; j < 6; ++j) { const int c = tid + 512 * j; const int kr = c >> 3, pc = c & 7; const int lk = l0n - 64 + kr; const int lkc = lk < 0 ? 0 : (lk >= subn ? subn - 1 : lk);
                kw[j] = *(const GAS v4u*)(qkgn + (size_t)lkc * 512 + 256 + hdn * 64 + pc * 8);
                const int d = c / 48, pv = c - d * 48; const int lv = l0n - 64 + pv * 8; const int lvc = lv < 0 ? 0 : (lv >= subn ? subn - 8 : lv);
                vw[j] = *(const GAS v4u*)(vtgn + (size_t)d * NT + lvc); }
#pragma unroll
            for (int kk = 0; kk < 4; ++kk) qn[kk] = *(const GAS bf16x8*)(qkgn + (size_t)(l0n + 32 * wave + (lane & 31)) * 512 + hdn * 64 + 16 * kk + 8 * (lane >> 5)); }
        const int lq0 = l0 + 32 * wave;
        const LAS float* btl = bt + (g * 4 + hd) * 192;
        f32x16 o0, o1;
#pragma unroll
        for (int i = 0; i < 16; ++i) { o0[i] = 0.f; o1[i] = 0.f; }
        float mx = -1e30f, den = 0.f;
        if (lq0 - 64 >= 0) dil_tile<0>(lds, 32 * wave, r31, hh, btl, qf, o0, o1, mx, den);
        if (lq0 - 32 >= 0) dil_tile<1>(lds, 32 * wave + 32, r31, hh, btl, qf, o0, o1, mx, den);
        dil_tile<2>(lds, 32 * wave + 64, r31, hh, btl, qf, o0, o1, mx, den);
        if (lq0 + 32 < sub) dil_tile<3>(lds, 32 * wave + 96, r31, hh, btl, qf, o0, o1, mx, den);
        if (lq0 + 64 < sub) dil_tile<4>(lds, 32 * wave + 128, r31, hh, btl, qf, o0, o1, mx, den);
        den += __shfl_xor(den, 32);
        const float inv = 1.f / den;
        const size_t n = seq0 + lq0 + r31;
        bf16* orow = og + n * 256 + hd * 64 + 4 * hh;
#pragma unroll
        for (int q4 = 0; q4 < 4; ++q4) { v2u w0, w1; w0.x = pk2(o0[4 * q4] * inv, o0[4 * q4 + 1] * inv); w0.y = pk2(o0[4 * q4 + 2] * inv, o0[4 * q4 + 3] * inv);
            w1.x = pk2(o1[4 * q4] * inv, o1[4 * q4 + 1] * inv); w1.y = pk2(o1[4 * q4 + 2] * inv, o1[4 * q4 + 3] * inv);
            *(GAS v2u*)(orow + 8 * q4) = w0; *(GAS v2u*)(orow + 32 + 8 * q4) = w1; }
        if (hh == 0) lse[n * 4 + hd] = (mx + __builtin_amdgcn_logf(den)) * 0.6931471805599453f;
    }
    __syncthreads();
#undef DIL_UNIT
#undef DIL_LOAD
}
constexpr int MA_KP = 272, MA_VP = 520, MA_V = 256 * MA_KP;
static_assert(MA_V + 128 * MA_VP <= MISC_OFF, "mem-attn LDS map");
__device__ __forceinline__ void mem_attn_lds(const bf16* qc, const bf16* memk, const bf16* vtm, bf16* ycin, LAS unsigned char* lds, int tid, int lane, int wave, int G) {
    const int r31 = lane & 31, hh = lane >> 5;
    for (int wu = blockIdx.x; wu < 256; wu += G) {
        const int combo = wu & 7, b = combo >> 2, hd = combo & 3, chunk = wu >> 3;
        __syncthreads();
        { v4u kw[8], vw[8];
#pragma unroll
          for (int j = 0; j < 8; ++j) { const int c = tid + 512 * j; kw[j] = *(const GAS v4u*)(memk + (size_t)(b * 256 + (c >> 4)) * 512 + hd * 128 + (c & 15) * 8);
              vw[j] = *(const GAS v4u*)(vtm + (size_t)(hd * 128 + (c >> 5)) * 512 + b * 256 + (c & 31) * 8); }
#pragma unroll
          for (int j = 0; j < 8; ++j) { const int c = tid + 512 * j; *(LAS v4u*)(lds + (c >> 4) * MA_KP + (c & 15) * 16) = kw[j];
              v2u lo, hi; lo.x = vw[j].x; lo.y = vw[j].y; hi.x = vw[j].z; hi.y = vw[j].w;
              *(LAS v2u*)(lds + MA_V + (c >> 5) * MA_VP + (c & 31) * 16) = lo; *(LAS v2u*)(lds + MA_V + (c >> 5) * MA_VP + (c & 31) * 16 + 8) = hi; } }
        __syncthreads();
#pragma unroll 1
        for (int qi = 0; qi < 2; ++qi) {
            const int blk = chunk * 16 + wave * 2 + qi;
            const size_t tok = (size_t)(b << 14) + blk * 32 + r31;
            const bf16* qrow = qc + tok * 512 + hd * 128 + 8 * hh;
            bf16x8 qf[8];
#pragma unroll
            for (int kk = 0; kk < 8; ++kk) qf[kk] = *(const GAS bf16x8*)(qrow + 16 * kk);
            f32x16 o[4];
#pragma unroll
            for (int mt = 0; mt < 4; ++mt)
#pragma unroll
                for (int i = 0; i < 16; ++i) o[mt][i] = 0.f;
            float mx = -1e30f, den = 0.f;
            const LAS unsigned char* kb = lds + r31 * MA_KP + 16 * hh;
            const LAS unsigned char* vb = lds + MA_V + r31 * MA_VP + 8 * hh;
#pragma unroll 1
            for (int t = 0; t < 8; ++t) {
                f32x16 sacc;
#pragma unroll
                for (int i = 0; i < 16; ++i) sacc[i] = 0.f;
#pragma unroll
                for (int kk = 0; kk < 8; ++kk) { const bf16x8 kf = *(const LAS bf16x8*)(kb + (32 * t) * MA_KP + 32 * kk); sacc = __builtin_amdgcn_mfma_f32_32x32x16_bf16(kf, qf[kk], sacc, 0, 0, 0); }
                float tmax = -INFINITY;
#pragma unroll
                for (int i = 0; i < 16; ++i) { sacc[i] *= 0.08838834764831845f; tmax = fmaxf(tmax, sacc[i]); }
                tmax = fmaxf(tmax, __shfl_xor(tmax, 32));
                const float mn = fmaxf(mx, tmax), corr = __expf(mx - mn); mx = mn;
                float psum = 0.f;
#pragma unroll
                for (int i = 0; i < 16; ++i) { const float p = __expf(sacc[i] - mn); sacc[i] = p; psum += p; }
                den = den * corr + psum;
#pragma unroll
                for (int mt = 0; mt < 4; ++mt)
#pragma unroll
                    for (int i = 0; i < 16; ++i) o[mt][i] *= corr;
#pragma unroll
                for (int s2 = 0; s2 < 2; ++s2) { v4u pw; pw.x = pk2(sacc[8 * s2], sacc[8 * s2 + 1]); pw.y = pk2(sacc[8 * s2 + 2], sacc[8 * s2 + 3]); pw.z = pk2(sacc[8 * s2 + 4], sacc[8 * s2 + 5]); pw.w = pk2(sacc[8 * s2 + 6], sacc[8 * s2 + 7]);
                    const bf16x8 pf = __builtin_bit_cast(bf16x8, pw);
#pragma unroll
                    for (int mt = 0; mt < 4; ++mt) { const LAS unsigned char* vp = vb + (32 * mt) * MA_VP + (32 * t + 16 * s2) * 2;
                        const v2u lo = *(const LAS v2u*)vp, hi = *(const LAS v2u*)(vp + 16);
                        v4u w; w.x = lo.x; w.y = lo.y; w.z = hi.x; w.w = hi.y;
                        o[mt] = __builtin_amdgcn_mfma_f32_32x32x16_bf16(__builtin_bit_cast(bf16x8, w), pf, o[mt], 0, 0, 0); } }
            }
            den += __shfl_xor(den, 32);
            const float inv = 1.f / den;
            unsigned char* orow = (unsigned char*)ycin + tok * 512 + hd * 128 + 4 * hh; const float inv4 = inv * SC_ACT;
#pragma unroll
            for (int mt = 0; mt < 4; ++mt)
#pragma unroll
                for (int q4 = 0; q4 < 4; ++q4) *(GAS unsigned*)(orow + 32 * mt + 8 * q4) = pk4_fp8(o[mt][4 * q4] * inv4, o[mt][4 * q4 + 1] * inv4, o[mt][4 * q4 + 2] * inv4, o[mt][4 * q4 + 3] * inv4);
        }
    }
    __syncthreads();
}
__device__ __forceinline__ void combine_groups(const bf16* og, const float* lse, bf16* ob, int tid, int G) {
    for (size_t idx = (size_t)blockIdx.x * 512 + tid; idx < (size_t)NT * 32; idx += (size_t)G * 512) {
        const int t = (int)(idx >> 5), ch = (int)(idx & 31), h = ch >> 3, d0 = (ch & 7) * 8, b = t >> 14, s = t & 16383;
        float l[3]; size_t n[3];
#pragma unroll
        for (int g = 0; g < 3; ++g) { const int sh = 2 * g; n[g] = (size_t)(b << 14) + (size_t)(s & ((1 << sh) - 1)) * (16384 >> sh) + (s >> sh); l[g] = lse[((size_t)g * NT + n[g]) * 4 + h]; }
        const float mx = fmaxf(l[0], fmaxf(l[1], l[2])); float w[3], sum = 0.f;
#pragma unroll
        for (int g = 0; g < 3; ++g) { w[g] = __expf(l[g] - mx); sum += w[g]; }
        float o[8] = {0, 0, 0, 0, 0, 0, 0, 0};
#pragma unroll
        for (int g = 0; g < 3; ++g) { const float wg = w[g] / sum; const v4u v = *(const GAS v4u*)(og + ((size_t)g * NT + n[g]) * 256 + h * 64 + d0);
            o[0] += wg * bflo(v.x); o[1] += wg * bfhi(v.x); o[2] += wg * bflo(v.y); o[3] += wg * bfhi(v.y); o[4] += wg * bflo(v.z); o[5] += wg * bfhi(v.z); o[6] += wg * bflo(v.w); o[7] += wg * bfhi(v.w); }
        v2u r; r.x = pk4_fp8(o[0] * SC_ACT, o[1] * SC_ACT, o[2] * SC_ACT, o[3] * SC_ACT); r.y = pk4_fp8(o[4] * SC_ACT, o[5] * SC_ACT, o[6] * SC_ACT, o[7] * SC_ACT);
        *(GAS v2u*)((unsigned char*)ob + (size_t)t * 256 + h * 64 + d0) = r;
    }
}

template <int C> __device__ __forceinline__ unsigned dppu(unsigned v) { return (unsigned)__builtin_amdgcn_update_dpp(0, (int)v, C, 0xF, 0xF, true); }
template <int C> __device__ __forceinline__ float dppf(float v) { return __builtin_bit_cast(float, __builtin_amdgcn_update_dpp(0, __builtin_bit_cast(int, v), C, 0xF, 0xF, true)); }
__device__ __forceinline__ unsigned umax2(unsigned a, unsigned b) { return a > b ? a : b; }
__device__ __forceinline__ unsigned row_max_u(unsigned v) { v = umax2(v, dppu<0xB1>(v)); v = umax2(v, dppu<0x4E>(v)); v = umax2(v, dppu<0x141>(v)); v = umax2(v, dppu<0x140>(v)); return v; }
__device__ __forceinline__ float row_max_f(float v) { v = fmaxf(v, dppf<0xB1>(v)); v = fmaxf(v, dppf<0x4E>(v)); v = fmaxf(v, dppf<0x141>(v)); v = fmaxf(v, dppf<0x140>(v)); return v; }
__device__ __forceinline__ float row_sum_f(float v) { v += dppf<0xB1>(v); v += dppf<0x4E>(v); v += dppf<0x141>(v); v += dppf<0x140>(v); return v; }
__device__ __forceinline__ unsigned ordf(float f) { const unsigned b = __builtin_bit_cast(unsigned, f); return b ^ ((unsigned)((int)b >> 31) | 0x80000000u); }
__device__ __forceinline__ float decf(unsigned k) { const unsigned b = (k & 0x80000000u) ? (k ^ 0x80000000u) : ~k; return __builtin_bit_cast(float, b); }
__device__ __forceinline__ unsigned bperm(unsigned v, int src_lane) { return (unsigned)__builtin_amdgcn_ds_bpermute(src_lane * 4, (int)v); }
typedef __bf16 bf16x2_t __attribute__((ext_vector_type(2)));
__device__ __forceinline__ float dot2bf(unsigned a, unsigned b, float c) { return __builtin_amdgcn_fdot2_f32_bf16(__builtin_bit_cast(bf16x2_t, a), __builtin_bit_cast(bf16x2_t, b), c, false); }

__device__ __forceinline__ float gelu_as(float v) {
    const float av = fabsf(v), t = __builtin_amdgcn_rcpf(av * 0.2316418882f + 1.0f);
    float q = t * 0.5307027145f + (-0.7265760135f); q = q * t + 0.7107068705f; q = q * t + (-0.142248368f); q = q * t + 0.127414796f; q = q * t;
    const float e = __builtin_amdgcn_exp2f((v * v) * (-0.72134752044f));
    const float m = v * (q * e);
    return v < 0.f ? m : v - m;
}
constexpr int PEER_SKB = 0, PEER_EL = 36864, PEER_PTAB = PEER_EL + 32768, PEER_EL2 = PEER_PTAB + 256;
__device__ __forceinline__ void peer_scores_top16(const bf16* qp, LAS unsigned char* lds, int tokb, int hf, int fr, int fq, unsigned& o0, unsigned& o1, unsigned& o2, unsigned& o3) {
    const bf16* arow = qp + (size_t)(tokb + (fr >> 3)) * 1024 + (fr & 7) * 128 + hf * 64 + 8 * fq;
    const bf16x8 a0 = *(const GAS bf16x8*)arow, a1 = *(const GAS bf16x8*)(arow + 32);
    unsigned e0[8], e1[8], e2[8], e3[8];
#pragma unroll
    for (int nb = 0; nb < 8; ++nb) {
        const LAS unsigned char* bp = lds + PEER_SKB + hf * 18432 + (fr + 16 * nb) * 144 + fq * 16;
        const bf16x8 b0 = *(const LAS bf16x8*)bp, b1 = *(const LAS bf16x8*)(bp + 64);
        f32x4 acc = (f32x4){0.f, 0.f, 0.f, 0.f};
        acc = __builtin_amdgcn_mfma_f32_16x16x32_bf16(a0, b0, acc, 0, 0, 0);
        acc = __builtin_amdgcn_mfma_f32_16x16x32_bf16(a1, b1, acc, 0, 0, 0);
        const unsigned ix = (unsigned)(127 - (fr + 16 * nb));
        e0[nb] = (ordf(acc[0]) & ~127u) | ix; e1[nb] = (ordf(acc[1]) & ~127u) | ix; e2[nb] = (ordf(acc[2]) & ~127u) | ix; e3[nb] = (ordf(acc[3]) & ~127u) | ix;
    }
    o0 = 0u; o1 = 0u; o2 = 0u; o3 = 0u;
#define PEER_CE(E, A, B) do { const unsigned hi_ = umax2(E[A], E[B]), lo_ = E[A] < E[B] ? E[A] : E[B]; E[A] = hi_; E[B] = lo_; } while (0)
#define PEER_SORT8(E) do { PEER_CE(E, 0, 1); PEER_CE(E, 2, 3); PEER_CE(E, 4, 5); PEER_CE(E, 6, 7); PEER_CE(E, 0, 2); PEER_CE(E, 1, 3); PEER_CE(E, 4, 6); PEER_CE(E, 5, 7); PEER_CE(E, 1, 2); PEER_CE(E, 5, 6); \
        PEER_CE(E, 0, 4); PEER_CE(E, 1, 5); PEER_CE(E, 2, 6); PEER_CE(E, 3, 7); PEER_CE(E, 2, 4); PEER_CE(E, 3, 5); PEER_CE(E, 1, 2); PEER_CE(E, 3, 4); PEER_CE(E, 5, 6); } while (0)
#define PEER_ROUND(E, O) do { const unsigned m = row_max_u(E[0]); const bool win = (E[0] == m); \
        E[0] = win ? E[1] : E[0]; E[1] = win ? E[2] : E[1]; E[2] = win ? E[3] : E[2]; E[3] = win ? E[4] : E[3]; E[4] = win ? E[5] : E[4]; E[5] = win ? E[6] : E[5]; E[6] = win ? E[7] : E[6]; E[7] = win ? 0u : E[7]; \
        O = (fr == r) ? m : O; } while (0)
    PEER_SORT8(e0); PEER_SORT8(e1); PEER_SORT8(e2); PEER_SORT8(e3);
#pragma unroll 1
    for (int r = 0; r < 16; ++r) { PEER_ROUND(e0, o0); PEER_ROUND(e1, o1); PEER_ROUND(e2, o2); PEER_ROUND(e3, o3); }
#undef PEER_ROUND
#undef PEER_SORT8
#undef PEER_CE
}
__device__ __forceinline__ void peer_cand(LAS unsigned char* lds, LAS unsigned char* el, unsigned ptab, unsigned L1, unsigned L2, int lane, int fr, int slot) {
    unsigned c0, c1, c2, c3;
#define PEER_CK(SL, C) do { const unsigned byte = (ptab >> (8 * SL)) & 255u; const int a = byte >> 4, b = byte & 15; \
        const unsigned k1 = bperm(L1, (lane & 48) + a), k2 = bperm(L2, (lane & 48) + b); const float sum = decf(k1 & ~127u) + decf(k2 & ~127u); \
        C = (byte != 255u) ? ((ordf(sum) & ~63u) | (unsigned)(fr * 4 + SL)) : 0u; } while (0)
    PEER_CK(0, c0); PEER_CK(1, c1); PEER_CK(2, c2); PEER_CK(3, c3);
#undef PEER_CK
    unsigned co = 0u;
#define PEER_CE2(A, B) do { const unsigned hi_ = umax2(A, B), lo_ = A < B ? A : B; A = hi_; B = lo_; } while (0)
    PEER_CE2(c0, c1); PEER_CE2(c2, c3); PEER_CE2(c0, c2); PEER_CE2(c1, c3); PEER_CE2(c1, c2);
#undef PEER_CE2
#pragma unroll 1
    for (int r = 0; r < 16; ++r) { const unsigned m = row_max_u(c0); const bool win = (c0 == m);
        c0 = win ? c1 : c0; c1 = win ? c2 : c1; c2 = win ? c3 : c2; c3 = win ? 0u : c3;
        co = (fr == r) ? m : co; }
    const unsigned pb = *(LAS unsigned char*)(lds + PEER_PTAB + (co & 63u));
    const unsigned k1 = bperm(L1, (lane & 48) + (int)(pb >> 4)), k2 = bperm(L2, (lane & 48) + (int)(pb & 15u));
    const unsigned expert = (127u - (k1 & 127u)) * 128u + (127u - (k2 & 127u));
    const float sc = decf(co & ~63u);
    const float ex = __expf(sc - row_max_f(sc));
    const float gate = ex / row_sum_f(ex);
    v2u rec; rec.x = expert; rec.y = __builtin_bit_cast(unsigned, gate);
    *(LAS v2u*)(el + slot * 8) = rec;
}
template <int sh>
__device__ __forceinline__ void peer_regroup16(const LAS unsigned char* src, LAS unsigned char* dst, int lane, int fr) {
    v2u rc[8]; unsigned c0 = 0u, c1 = 0u, c2 = 0u, c3 = 0u;
#pragma unroll
    for (int j = 0; j < 8; ++j) { rc[j] = *(const LAS v2u*)(src + (fr * 8 + j) * 8); const unsigned bk = (rc[j].x >> sh) & 15u, one = 1u << (8 * (bk & 3u)), w = bk >> 2;
        c0 += (w == 0u) ? one : 0u; c1 += (w == 1u) ? one : 0u; c2 += (w == 2u) ? one : 0u; c3 += (w == 3u) ? one : 0u; }
    unsigned i0 = c0, i1 = c1, i2 = c2, i3 = c3;
    i0 += dppu<0x111>(i0); i1 += dppu<0x111>(i1); i2 += dppu<0x111>(i2); i3 += dppu<0x111>(i3);
    i0 += dppu<0x112>(i0); i1 += dppu<0x112>(i1); i2 += dppu<0x112>(i2); i3 += dppu<0x112>(i3);
    i0 += dppu<0x114>(i0); i1 += dppu<0x114>(i1); i2 += dppu<0x114>(i2); i3 += dppu<0x114>(i3);
    i0 += dppu<0x118>(i0); i1 += dppu<0x118>(i1); i2 += dppu<0x118>(i2); i3 += dppu<0x118>(i3);
    const int l15 = (lane & 48) + 15;
    const unsigned t0 = bperm(i0, l15), t1 = bperm(i1, l15), t2 = bperm(i2, l15), t3 = bperm(i3, l15);
    const unsigned s0 = (t0 * 0x01010101u) >> 24, s1 = (t1 * 0x01010101u) >> 24, s2 = (t2 * 0x01010101u) >> 24;
    unsigned p0 = (i0 - c0) + (t0 * 0x01010100u), p1 = (i1 - c1) + (t1 * 0x01010100u) + s0 * 0x01010101u, p2 = (i2 - c2) + (t2 * 0x01010100u) + (s0 + s1) * 0x01010101u,
             p3 = (i3 - c3) + (t3 * 0x01010100u) + (s0 + s1 + s2) * 0x01010101u;
#pragma unroll
    for (int j = 0; j < 8; ++j) { const unsigned bk = (rc[j].x >> sh) & 15u, q8 = 8 * (bk & 3u), w = bk >> 2, one = 1u << q8;
        const unsigned pw = (w == 0u) ? p0 : ((w == 1u) ? p1 : ((w == 2u) ? p2 : p3));
        *(LAS v2u*)(dst + ((pw >> q8) & 255u) * 8) = rc[j];
        p0 += (w == 0u) ? one : 0u; p1 += (w == 1u) ? one : 0u; p2 += (w == 2u) ? one : 0u; p3 += (w == 3u) ? one : 0u; }
}
__device__ __forceinline__ void peer_v2(const Ptrs& P, LAS unsigned char* lds, int tid, int lane, int wave, int G) {
    unsigned char* ws = P.ws;
    const bf16* qp = (const bf16*)(ws + WS_QP); const bf16* utab = (const bf16*)(ws + WS_UTAB); const bf16* vtab = (const bf16*)(ws + WS_VTAB);
    const bf16* h1b = (const bf16*)(ws + WS_H1B);
    const int fr = lane & 15, fq = lane >> 4;
    for (int idx = tid; idx < 2 * 128 * 32; idx += 512) { const int hf = idx >> 12, k = (idx >> 5) & 127, c2 = idx & 31; const float* sk = (hf ? P.in[16] : P.in[15]) + k * 64 + c2 * 2;
        *(LAS unsigned*)(lds + PEER_SKB + hf * 18432 + k * 144 + c2 * 4) = pk2(sk[0], sk[1]); }
    if (tid < 64) { int q = 0, a = 0, b = 0; unsigned char val = 0xFF;
        for (a = 0; a < 16 && val == 0xFF; ++a) for (b = 0; b < 16 && (a + 1) * (b + 1) <= 16; ++b) { if (q == tid) { val = (unsigned char)((a << 4) | b); break; } ++q; }
        *(LAS unsigned char*)(lds + PEER_PTAB + tid) = val; }
    __syncthreads();
    LAS unsigned char* el = lds + PEER_EL + wave * 4096;
    const int lane_k = lane;
    for (int tile = blockIdx.x; tile < NT / 32; tile += G) {
        const int lane = (int)opq((unsigned)lane_k), fr = lane & 15, fq = lane >> 4; const unsigned ptab = *(LAS unsigned*)(lds + PEER_PTAB + fr * 4);
        const int tok0 = tile * 32 + wave * 4;
#pragma unroll 1
        for (int mt = 0; mt < 2; ++mt) {
            unsigned L00, L01, L02, L03, L10, L11, L12, L13;
            peer_scores_top16(qp, lds, tok0 + 2 * mt, 0, fr, fq, L00, L01, L02, L03);
            peer_scores_top16(qp, lds, tok0 + 2 * mt, 1, fr, fq, L10, L11, L12, L13);
            peer_cand(lds, el, ptab, L00, L10, lane, fr, (2 * mt + (fq >> 1)) * 128 + ((fq & 1) * 4 + 0) * 16 + fr);
            peer_cand(lds, el, ptab, L01, L11, lane, fr, (2 * mt + (fq >> 1)) * 128 + ((fq & 1) * 4 + 1) * 16 + fr);
            peer_cand(lds, el, ptab, L02, L12, lane, fr, (2 * mt + (fq >> 1)) * 128 + ((fq & 1) * 4 + 2) * 16 + fr);
            peer_cand(lds, el, ptab, L03, L13, lane, fr, (2 * mt + (fq >> 1)) * 128 + ((fq & 1) * 4 + 3) * 16 + fr);
        }
        asm volatile("s_waitcnt lgkmcnt(0)" ::: "memory");
#if TAB_FP6
        const int tok = tok0 + fq;
        const unsigned char* u6 = (const unsigned char*)utab; const unsigned char* v6 = (const unsigned char*)vtab;
        float xf[64], yf[64];
        { const bf16* prow = (const bf16*)(ws + WS_H0) + (size_t)tok * 1024 + fr * 16;
          const GAS f32x4* sp = (const GAS f32x4*)((const float*)(ws + WS_STATS4) + (size_t)tok * 8); const f32x4 sa = sp[0], sb = sp[1];
          f32x2 st; st.x = ((sa.x + sa.z) + sb.x) + sb.z; st.y = ((sa.y + sa.w) + sb.y) + sb.w;
          const float mean1 = st.x * (1.f / D), rstd1 = 1.f / sqrtf(fmaxf(st.y * (1.f / D) - mean1 * mean1, 0.f) + LN_EPS);
#pragma unroll
          for (int c = 0; c < 4; ++c)
#pragma unroll
            for (int q8 = 0; q8 < 2; ++q8) { const v4u pw = *(const GAS v4u*)(prow + c * 256 + q8 * 8); f32x4 pa, pb2; unpack8(pw, pa, pb2);
#pragma unroll
                for (int hq = 0; hq < 2; ++hq) { const int q4 = q8 * 2 + hq; const f32x4 pv = hq ? pb2 : pa;
                    const f32x4 gv = *(const GAS f32x4*)(P.in[12] + c * 256 + fr * 16 + q4 * 4), bv = *(const GAS f32x4*)(P.in[13] + c * 256 + fr * 16 + q4 * 4);
                    const f32x4 xv = (pv - mean1) * rstd1 * gv + bv;
                    xf[c * 16 + q4 * 4] = xv.x; xf[c * 16 + q4 * 4 + 1] = xv.y; xf[c * 16 + q4 * 4 + 2] = xv.z; xf[c * 16 + q4 * 4 + 3] = xv.w; } } }
#pragma unroll
        for (int j = 0; j < 64; ++j) yf[j] = 0.f;
        LAS unsigned char* el2 = el;
        __builtin_amdgcn_sched_barrier(0);
        peer_regroup16<6>(el + fq * 1024, lds + PEER_EL2 + wave * 4096 + fq * 1024, lane, fr);
        asm volatile("s_waitcnt lgkmcnt(0)" ::: "memory"); __builtin_amdgcn_sched_barrier(0);
        peer_regroup16<10>(lds + PEER_EL2 + wave * 4096 + fq * 1024, el + fq * 1024, lane, fr);
        asm volatile("s_waitcnt lgkmcnt(0)" ::: "memory"); __builtin_amdgcn_sched_barrier(0);
#pragma unroll 1
        for (int sidx = 0; sidx < 128; ++sidx) {
            const unsigned rec_e = *(const LAS unsigned*)(el2 + (fq * 128 + sidx) * 8);
            const float rec_g = *(const LAS float*)(el2 + (fq * 128 + sidx) * 8 + 4);
#if TABU_FP4
            const unsigned char* ur = u6 + (size_t)rec_e * 512 + fr * 16;
            const v4u ua = *(const GAS v4u*)ur, ub = *(const GAS v4u*)(ur + 256);
#else
            const unsigned char* ur = u6 + (size_t)rec_e * 768 + fr * 16;
            const v4u ua = *(const GAS v4u*)ur, ub = *(const GAS v4u*)(ur + 256), uc = *(const GAS v4u*)(ur + 512);
#endif
#if TABV_FP4
            const unsigned char* vr = v6 + (size_t)rec_e * 512 + fr * 16;
            const v4u va = *(const GAS v4u*)vr, vb = *(const GAS v4u*)(vr + 256);
#else
            const unsigned char* vr = v6 + (size_t)rec_e * 768 + fr * 16;
            const v4u va = *(const GAS v4u*)vr, vb = *(const GAS v4u*)(vr + 256), vc = *(const GAS v4u*)(vr + 512);
#endif
            float d0 = 0.f, d1 = 0.f;
#if TABU_FP4
#define PEER_U4B(DW, BASE, BB) do { const f32x2 f2 = __builtin_amdgcn_cvt_scalef32_pk_f32_fp4((DW), 1.0f, BB); d0 += f2.x * xf[(BASE) + 2 * BB]; d1 += f2.y * xf[(BASE) + 2 * BB + 1]; } while (0)
#define PEER_U4(DW, BASE) do { PEER_U4B(DW, BASE, 0); PEER_U4B(DW, BASE, 1); PEER_U4B(DW, BASE, 2); PEER_U4B(DW, BASE, 3); } while (0)
            PEER_U4(ua.x, 0); PEER_U4(ua.y, 8); PEER_U4(ua.z, 16); PEER_U4(ua.w, 24); PEER_U4(ub.x, 32); PEER_U4(ub.y, 40); PEER_U4(ub.z, 48); PEER_U4(ub.w, 56);
#undef PEER_U4
#undef PEER_U4B
            const float dot = row_sum_f(d0 + d1) * (1.f / FP4_SU);
#else
            { v6u g; g[0] = ua.x; g[1] = ua.y; g[2] = ua.z; g[3] = ua.w; g[4] = ub.x; g[5] = ub.y;
              const v32f f = __builtin_amdgcn_cvt_scalef32_pk32_f32_fp6(g, 1.0f);
#pragma unroll
              for (int i = 0; i < 32; i += 2) { d0 += f[i] * xf[i]; d1 += f[i + 1] * xf[i + 1]; } }
            { v6u g; g[0] = ub.z; g[1] = ub.w; g[2] = uc.x; g[3] = uc.y; g[4] = uc.z; g[5] = uc.w;
              const v32f f = __builtin_amdgcn_cvt_scalef32_pk32_f32_fp6(g, 1.0f);
#pragma unroll
              for (int i = 0; i < 32; i += 2) { d0 += f[i] * xf[32 + i]; d1 += f[i + 1] * xf[32 + i + 1]; } }
            const float dot = row_sum_f(d0 + d1) * (1.f / FP6_SU);
#endif
#if TABV_FP4
            const float w = rec_g * gelu_as(dot) * (1.f / FP4_SV);
#define PEER_V4B(DW, BASE, BB) do { const f32x2 f2 = __builtin_amdgcn_cvt_scalef32_pk_f32_fp4((DW), 1.0f, BB); yf[(BASE) + 2 * BB] += w * f2.x; yf[(BASE) + 2 * BB + 1] += w * f2.y; } while (0)
#define PEER_V4(DW, BASE) do { PEER_V4B(DW, BASE, 0); PEER_V4B(DW, BASE, 1); PEER_V4B(DW, BASE, 2); PEER_V4B(DW, BASE, 3); } while (0)
            PEER_V4(va.x, 0); PEER_V4(va.y, 8); PEER_V4(va.z, 16); PEER_V4(va.w, 24); PEER_V4(vb.x, 32); PEER_V4(vb.y, 40); PEER_V4(vb.z, 48); PEER_V4(vb.w, 56);
#undef PEER_V4
#undef PEER_V4B
#else
            const float w = rec_g * gelu_as(dot) * (1.f / FP6_SV);
            { v6u g; g[0] = va.x; g[1] = va.y; g[2] = va.z; g[3] = va.w; g[4] = vb.x; g[5] = vb.y;
              const v32f f = __builtin_amdgcn_cvt_scalef32_pk32_f32_fp6(g, 1.0f);
#pragma unroll
              for (int i = 0; i < 32; ++i) yf[i] += w * f[i]; }
            { v6u g; g[0] = vb.z; g[1] = vb.w; g[2] = vc.x; g[3] = vc.y; g[4] = vc.z; g[5] = vc.w;
              const v32f f = __builtin_amdgcn_cvt_scalef32_pk32_f32_fp6(g, 1.0f);
#pragma unroll
              for (int i = 0; i < 32; ++i) yf[32 + i] += w * f[i]; }
#endif
        }
        float ssum = 0.f;
#pragma unroll
        for (int j = 0; j < 64; ++j) { yf[j] += ALPHA * xf[j]; ssum += yf[j]; }
        const float mean = row_sum_f(ssum) * (1.f / D);
        float s2 = 0.f;
#pragma unroll
        for (int j = 0; j < 64; ++j) { yf[j] -= mean; s2 += yf[j] * yf[j]; }
        const float rstd = 1.f / sqrtf(row_sum_f(s2) * (1.f / D) + LN_EPS);
        float* orow = P.out + (size_t)tok * 1024 + fr * 16;
#pragma unroll
        for (int c = 0; c < 4; ++c)
#pragma unroll
            for (int q4 = 0; q4 < 4; ++q4) { const f32x4 g0 = *(const GAS f32x4*)(P.in[19] + c * 256 + fr * 16 + q4 * 4), b0 = *(const GAS f32x4*)(P.in[20] + c * 256 + fr * 16 + q4 * 4);
                f32x4 o; o.x = yf[c * 16 + q4 * 4] * rstd * g0.x + b0.x; o.y = yf[c * 16 + q4 * 4 + 1] * rstd * g0.y + b0.y; o.z = yf[c * 16 + q4 * 4 + 2] * rstd * g0.z + b0.z; o.w = yf[c * 16 + q4 * 4 + 3] * rstd * g0.w + b0.w;
                *(GAS f32x4*)(orow + c * 256 + q4 * 4) = o; }
#endif
        asm volatile("s_waitcnt lgkmcnt(0)" ::: "memory");
    }
}

struct Args { const float* in[21]; float* out; unsigned char* ws; int ph_lo, ph_hi; };
__global__ void __launch_bounds__(NWAVES * 64, 2) fwd_kernel(Args args) {
    extern __shared__ __attribute__((aligned(16))) unsigned char lds_raw[];
    LAS unsigned char* lds = (LAS unsigned char*)lds_raw;
    volatile LAS unsigned* MISC = (volatile LAS unsigned*)(lds + MISC_OFF);
    const int tid = threadIdx.x, lane = tid & 63, wave = __builtin_amdgcn_readfirstlane(tid >> 6);
    const int G = gridDim.x;
    Ptrs P;
#pragma unroll
    for (int i = 0; i < 21; ++i) P.in[i] = args.in[i];
    P.out = args.out; P.ws = args.ws;
    unsigned char* ws = args.ws;
    if (tid < 16) MISC[tid] = 0u;
    __syncthreads();
    XcdBarrier bar; bar.bar = (unsigned*)(ws + WS_CTL) + 4096; bar.x = 0; bar.st = nullptr;
    if (N_LAUNCHES == 1) bar = xcd_barrier_post((unsigned*)(ws + WS_CTL) + 4096, MISC + 8);
    const int lo = args.ph_lo, hi = args.ph_hi;
#ifndef PHMASK
#define PHMASK 0x1ff
#endif
#define IN(k) (((PHMASK >> (k)) & 1) && lo <= (k) && (k) < hi)
#define SEAM(k) do { if (IN(k) && IN((k) + 1)) xcd_barrier(bar); } while (0)

    if (IN(0)) { phase0(P, lds, tid, lane, wave, G); } SEAM(0);

    if (IN(1)) {
        if (blockIdx.x < 4) { const int n = blockIdx.x * 256 + (tid & 255); const float* part = (const float*)(ws + WS_CPART) + (tid >> 8) * 16 * 1024; float a = 0.f;
#pragma unroll
            for (int kb = 0; kb < 16; ++kb) a += part[kb * 1024 + n];
            ((float*)(ws + ((tid >> 8) ? WS_DVEC : WS_CVEC)))[n] = a; }
        for (int i = tid; i < WR_GATE; i += 512) ((LAS float*)(lds + RING_BYTES))[i] = ((const float*)(ws + WS_BIASIN))[i];
        __syncthreads();
        SchedP1 S{(const char*)ws, G, (int)blockIdx.x};
        EpiP1 E{(bf16*)P.out, ws, lds + RING_BYTES};
        pg8::gemm_phase<EpiP1, SchedP1, 2>(lds, S, E);
    } SEAM(1);

    if (IN(2)) {
        fft_step_mfma<1>((const bf16*)P.out, (bf16*)P.out + (size_t)NT * 1024, lds, tid, lane, wave, G);
        dil_attn_lds((const bf16*)(ws + WS_QK), (const bf16*)(ws + WS_VT), (const float*)(ws + WS_BIASTAB), (bf16*)(ws + WS_OG), (float*)(ws + WS_LSE), lds, tid, lane, wave, G);
        mem_attn_lds((const bf16*)(ws + WS_QC), (const bf16*)(ws + WS_MEMKV), (const bf16*)(ws + WS_MEMKV) + 512 * 512, (bf16*)(ws + WS_YCIN), lds, tid, lane, wave, G);
    } SEAM(2);

    if (IN(3)) {
        fft_step_mfma<2>((const bf16*)P.out + (size_t)NT * 1024, (bf16*)(ws + WS_FA), lds, tid, lane, wave, G);
        combine_groups((const bf16*)(ws + WS_OG), (const float*)(ws + WS_LSE), (bf16*)(ws + WS_OB), tid, G);
    } SEAM(3);

    if (IN(4)) {
        SchedP4 S{(const char*)ws, G, (int)blockIdx.x};
        for (int i = tid; i < 3072; i += 512) ((LAS float*)(lds + RING_BYTES))[i] = ((const float*)(ws + WS_BIASIN))[WR_GATE + i];
        __syncthreads();
        EpiP4 E{(bf16*)(ws + WS_MERGED), lds + RING_BYTES};
        pg8::gemm_phase<EpiP4, SchedP4, 2>(lds, S, E);
    } SEAM(4);

    if (IN(5)) {
        SchedPlain S{(const char*)(ws + WS_MERGED), (const char*)(ws + WS_WTO), G, (int)blockIdx.x, K_WO};
        EpiP5 E{(bf16*)(ws + WS_H0), (float*)(ws + WS_PRELN), (float*)(ws + WS_STATS4), lds + RING_BYTES};
        pg8::gemm_phase<EpiP5, SchedPlain>(lds, S, E);
    } SEAM(5);


    if (IN(7)) {
        SchedPlain S{(const char*)(ws + WS_H0), (const char*)(ws + WS_WTPQ), G, (int)blockIdx.x, K_PQ};
        EpiP7 E{(bf16*)(ws + WS_QP), (const float*)(ws + WS_STATS4), (const float*)(ws + WS_CVEC), (const float*)(ws + WS_DVEC)};
        pg8::gemm_phase<EpiP7, SchedPlain>(lds, S, E);
    } SEAM(7);

    if (IN(8)) {
        peer_v2(P, lds, tid, lane, wave, G);
    }
#undef IN
#undef SEAM
}

extern "C" void kernel_launch(void* const* d_in, const int* in_sizes, int n_in, void* d_out, int out_size, void* d_ws, size_t ws_size, hipStream_t stream) {
    static int grid = 0;
    if (grid == 0) {
        if (n_in != 21 || out_size != NT * D || ws_size < WS_END) { fprintf(stderr, "kernel_launch: unexpected shapes (n_in %d, out %d, ws %zu); nothing launched\n", n_in, out_size, ws_size); grid = -1; return; }
        int dev = 0, cus = 0, per_cu = 0;
        if (hipGetDevice(&dev) != hipSuccess || hipDeviceGetAttribute(&cus, hipDeviceAttributeMultiprocessorCount, dev) != hipSuccess) { grid = -1; return; }
        if (hipFuncSetAttribute((const void*)fwd_kernel, hipFuncAttributeMaxDynamicSharedMemorySize, LDS_BYTES) != hipSuccess) { fprintf(stderr, "kernel_launch: hipFuncSetAttribute failed\n"); grid = -1; return; }
        if (hipOccupancyMaxActiveBlocksPerMultiprocessor(&per_cu, (const void*)fwd_kernel, NWAVES * 64, LDS_BYTES) != hipSuccess || per_cu < 1) { fprintf(stderr, "kernel_launch: occupancy query says %d\n", per_cu); }
        (void)hipGetLastError();
        grid = cus;
    }
    if (grid < 0) return;
    (void)hipMemsetAsync((char*)d_ws + WS_CTL, 0, CTL_ZERO_BYTES, stream);
    Args a{};
    for (int i = 0; i < 21; ++i) a.in[i] = (const float*)d_in[i];
    a.out = (float*)d_out; a.ws = (unsigned char*)d_ws;
    if (N_LAUNCHES == 1) { a.ph_lo = 0; a.ph_hi = NPH; hipLaunchKernelGGL(fwd_kernel, dim3(grid), dim3(NWAVES * 64), LDS_BYTES, stream, a); }
    else for (int ph = 0; ph < NPH; ++ph) { a.ph_lo = ph; a.ph_hi = ph + 1; hipLaunchKernelGGL(fwd_kernel, dim3(grid), dim3(NWAVES * 64), LDS_BYTES, stream, a); }
}
```

```cpp
#include <hip/hip_runtime.h>
#include <cstdio>
#include <cstdint>

#ifndef TABU_FP4
#define TABU_FP4 1
#endif
#ifndef TABV_FP4
#define TABV_FP4 1
#endif
#ifndef TAB_FP6
#define TAB_FP6 1
#endif
static_assert(TAB_FP6 == 1, "the workspace map assumes 12 MiB fp6 expert tables");
#ifndef TAB_FP8
#define TAB_FP8 1
#endif
#ifndef N_LAUNCHES
#define N_LAUNCHES 1
#endif

#define GAS __attribute__((address_space(1)))
#define LAS __attribute__((address_space(3)))
typedef unsigned short bf16;
typedef unsigned v4u __attribute__((ext_vector_type(4)));
typedef unsigned v2u __attribute__((ext_vector_type(2)));
typedef float f32x4 __attribute__((ext_vector_type(4)));
typedef float f32x2 __attribute__((ext_vector_type(2)));
typedef short bf16x8 __attribute__((ext_vector_type(8)));

constexpr int NT = 32768, SEQ = 16384, D = 1024;
constexpr int NPH = 9;
constexpr float ALPHA = 1.189207115002721f;
constexpr float LN_EPS = 1e-5f;
constexpr int NWAVES = 8;

constexpr size_t MiB = 1u << 20;
constexpr size_t WS_CTL = 0, CTL_ZERO_BYTES = 1 * MiB;
constexpr size_t WS_CPART = 256 * 1024;
constexpr size_t WS_STATS = 512 * 1024;
constexpr size_t WS_CVEC = 768 * 1024, WS_DVEC = 772 * 1024;
constexpr size_t WS_BIASIN = 1 * MiB;
constexpr size_t WS_STATS4 = 4 * MiB;
constexpr size_t WS_BIASTAB = 1 * MiB + 64 * 1024;
constexpr size_t WS_WTIN = 2 * MiB;
constexpr size_t WS_WTA = 16 * MiB, WS_WTB = 17 * MiB, WS_WTC = 18 * MiB, WS_WTO = 19 * MiB, WS_WTPQ = 21 * MiB, WS_WTMKV = 23 * MiB;
constexpr size_t WS_MEMB = 25 * MiB, WS_MEMKV = 26 * MiB;
constexpr size_t WS_MEMF8 = 27 * MiB, WS_WMKVF8 = 28 * MiB;
constexpr size_t WS_UTAB = 32 * MiB, WS_VTAB = 44 * MiB;
constexpr size_t WS_H0F8 = 56 * MiB;
constexpr size_t WS_WF8IN = 88 * MiB;
constexpr size_t WS_H0 = 96 * MiB;
constexpr size_t WS_QK = 160 * MiB;
constexpr size_t WS_VT = 256 * MiB;
constexpr size_t WS_QC = 304 * MiB;
constexpr size_t WS_OG = 336 * MiB;
constexpr size_t WS_LSE = 384 * MiB;
constexpr size_t WS_YCIN = 386 * MiB;
constexpr size_t WS_FA = 418 * MiB;
constexpr size_t WS_OB = 450 * MiB;
constexpr size_t WS_GSCR = 466 * MiB;
constexpr size_t WS_MERGED = WS_QK;
constexpr size_t WS_PRELN = 224 * MiB;
constexpr size_t WS_H1B = WS_H0;
constexpr size_t WS_QP = WS_QK;
constexpr size_t WS_END = 498 * MiB;

constexpr int WR_A = 0, WR_QK = 1024, WR_V = 2560, WR_QC = 3328, WR_GATE = 3840, WR_END = 6912;

constexpr int RING_BYTES = 131072;
constexpr int LDS_BYTES = 147456;
constexpr int MISC_OFF = LDS_BYTES - 256;
static_assert(RING_BYTES + 3840 * 4 <= MISC_OFF, "bias copy fits the spare LDS above the GEMM stage buffers");

#define RLX_AGENT __ATOMIC_RELAXED, __HIP_MEMORY_SCOPE_AGENT
#define LDS_WAIT() asm volatile("s_waitcnt lgkmcnt(0)" ::: "memory")
#define VM_WAIT() asm volatile("s_waitcnt vmcnt(0)" ::: "memory")

__device__ __forceinline__ unsigned f2bf(float f) { unsigned u = __builtin_bit_cast(unsigned, f); return (u + 0x7fffu + ((u >> 16) & 1u)) >> 16; }
__device__ __forceinline__ unsigned pk2(float lo, float hi) { return f2bf(lo) | (f2bf(hi) << 16); }
__device__ __forceinline__ unsigned pk4_fp8(float a, float b, float c, float d) { int p = __builtin_amdgcn_cvt_pk_fp8_f32(a, b, 0, false); p = __builtin_amdgcn_cvt_pk_fp8_f32(c, d, p, true); return (unsigned)p; }
__device__ __forceinline__ float bf2f(unsigned b) { return __builtin_bit_cast(float, b << 16); }
__device__ __forceinline__ float bflo(unsigned w) { return __builtin_bit_cast(float, w << 16); }
__device__ __forceinline__ float bfhi(unsigned w) { return __builtin_bit_cast(float, w & 0xffff0000u); }
__device__ __forceinline__ float wave_sum(float v) {
#pragma unroll
    for (int o = 1; o < 64; o <<= 1) v += __shfl_xor(v, o);
    return v;
}
__device__ __forceinline__ float wave_max(float v) {
#pragma unroll
    for (int o = 1; o < 64; o <<= 1) v = fmaxf(v, __shfl_xor(v, o));
    return v;
}

#define XB_TMO      128
#define XB_XCNT(j)  (256  + 64 * (j))
#define XB_XSUB(j)  (1280 + 64 * (j))
#define XB_XGEN(j)  (2304 + 64 * (j))
#define XB_TOP      3328
#define XB_TOPGEN   3392
#define XCD_BAR_WORDS 3456
#define XB_SPIN_CAP (1u << 18)

__device__ __forceinline__ unsigned xb_ld(unsigned* p)              { return __hip_atomic_load(p, __ATOMIC_RELAXED, __HIP_MEMORY_SCOPE_AGENT); }
__device__ __forceinline__ unsigned xb_add(unsigned* p, unsigned v) { return __hip_atomic_fetch_add(p, v, __ATOMIC_RELAXED, __HIP_MEMORY_SCOPE_AGENT); }
__device__ __forceinline__ unsigned xb_xcc_id() { return (unsigned)__builtin_amdgcn_s_getreg((3 << 11) | 20) & 0xFu; }
#define XB_SPIN(cond, bar) do { unsigned _sp = 0; while (cond) { __builtin_amdgcn_s_sleep(1); \
    if ((++_sp & 255u) == 0u) { if (xb_ld(&(bar)[XB_TMO])) break; if (_sp > XB_SPIN_CAP) { atomicAdd(&(bar)[XB_TMO], 1u); break; } } } } while (0)

struct XcdBarrier {
    unsigned* bar; unsigned x;
    volatile LAS unsigned* st;
};
__device__ __forceinline__ XcdBarrier xcd_barrier_post(unsigned* bar, volatile LAS unsigned* st) {
    XcdBarrier b; b.bar = bar; b.x = xb_xcc_id(); b.st = st;
    if (threadIdx.x == 0) (void)xb_add(&bar[XB_XCNT(b.x)], 1u);
    return b;
}
__device__ __forceinline__ void xcd_barrier_complete(unsigned* bar, unsigned x, unsigned& nloc, unsigned& nx) {
    const unsigned G = gridDim.x * gridDim.y * gridDim.z;
    unsigned sum, cnt, mine, sp = 0u;
    for (;;) {
        sum = 0u; cnt = 0u; mine = 0u;
#pragma unroll
        for (unsigned j = 0; j < 16; ++j) { const unsigned c = xb_ld(&bar[XB_XCNT(j)]); sum += c; cnt += (c > 0u) ? 1u : 0u; mine = (j == x) ? c : mine; }
        if (sum == G) break;
        __builtin_amdgcn_s_sleep(1);
        if ((++sp & 255u) == 0u) { if (xb_ld(&bar[XB_TMO])) break; if (sp > XB_SPIN_CAP) { atomicAdd(&bar[XB_TMO], 1u); break; } }
    }
    nloc = mine > 0u ? mine : 1u; nx = cnt > 0u ? cnt : 1u;
}
__device__ __forceinline__ void xcd_barrier(const XcdBarrier& b) {
    asm volatile("s_waitcnt vmcnt(0)" ::: "memory");
    __syncthreads();
    if (threadIdx.x == 0) {
        unsigned* bar = b.bar;
        __builtin_amdgcn_s_waitcnt(0);
        unsigned nloc = b.st[0], nx = b.st[1];
        if (nloc == 0u) { xcd_barrier_complete(bar, b.x, nloc, nx); b.st[0] = nloc; b.st[1] = nx; }
        const unsigned old = xb_add(&bar[XB_XSUB(b.x)], 1u);
        const unsigned gen = old / nloc;
        if (old + 1u == (gen + 1u) * nloc) {
            __builtin_amdgcn_fence(__ATOMIC_RELEASE, "agent");
            asm volatile("s_waitcnt vmcnt(0)" ::: "memory");
            const unsigned og = xb_add(&bar[XB_TOP], 1u);
            const unsigned tg = og / nx;
            if (og + 1u == (tg + 1u) * nx) xb_add(&bar[XB_TOPGEN], 1u);
            else XB_SPIN(xb_ld(&bar[XB_TOPGEN]) == tg, bar);
            __builtin_amdgcn_fence(__ATOMIC_ACQUIRE, "agent");
            xb_add(&bar[XB_XGEN(b.x)], 1u);
            asm volatile("s_waitcnt vmcnt(0)" ::: "memory");
        } else {
            XB_SPIN(xb_ld(&bar[XB_XGEN(b.x)]) == gen, bar);
            __builtin_amdgcn_fence(__ATOMIC_ACQUIRE, "agent");
            asm volatile("s_waitcnt vmcnt(0)" ::: "memory");
        }
    }
    __syncthreads();
}

namespace pg8 {
constexpr int BM = 256, BK = 64, HALF = 128, HTB = HALF * BK * 2, STAGE_BYTES = 8 * HTB;
__host__ __device__ __forceinline__ int lds_byte(int r, int c) { const int st = (r >> 4) * 2 + (c >> 5), rr = r & 15, cc = c & 31, ob = rr * 64 + cc * 2; return st * 1024 + (ob ^ (((ob >> 9) & 1) << 5)); }
__host__ __device__ __forceinline__ void stage_rc(int b, int& R, int& C) { const int st = b / 1024, sb = b % 1024, swz = sb ^ (((sb >> 9) & 1) << 5); R = (st >> 1) * 16 + swz / 64; C = (st & 1) * 32 + (swz % 64) / 2; }
__host__ __device__ __forceinline__ int perm32(int rho) { const int n = rho >> 4, i = rho & 15; return 8 * (i >> 2) + 4 * n + (i & 3); }

struct GUnit { const char* a; const char* b; unsigned sa, sb; int nt; int pm, pn, kind; };

typedef int v8i __attribute__((ext_vector_type(8)));
constexpr int K_FP8 = 1 << 16;
__device__ __forceinline__ unsigned pg8_rb(unsigned ra) { asm volatile("" : "+v"(ra)); const unsigned rho = ra & 31u, n = rho >> 4, i = rho & 15u; return (ra & ~31u) + 8u * (i >> 2) + 4u * n + (i & 3u); }
template <class Epi, class Sched, int MODE = 0>
__device__ __forceinline__ void gemm_phase(LAS unsigned char* lds, const Sched& S, const Epi& E) {
    const int tid = threadIdx.x, wid = __builtin_amdgcn_readfirstlane(tid >> 6), lane = tid & 63, wr = wid >> 2, wc = wid & 3, fr = lane & 15, fq = lane >> 4;
    int R0, C0; stage_rc(tid * 16, R0, C0);
    const unsigned RA = (unsigned)R0, C2 = (unsigned)C0 * 2u;
#define RB pg8_rb(RA)
    const size_t kstep = (size_t)(BK * 2);
    const unsigned ldsw = (unsigned)wid * 1024u;
    const int aoff = lds_byte(wr * 64 + fr, fq * 8), boff = lds_byte(wc * 32 + fr, fq * 8);
#define PG8_SA(b, h) (((b) * 2 + (h)) * HTB)
#define PG8_SB(b, h) ((4 + (b) * 2 + (h)) * HTB)
#define PG8_STAGE(bufoff, gbase, RR, stride) do { const unsigned _vo = (RR) * (unsigned)(stride) + C2; const char* _g = (const char*)(gbase); \
        __builtin_amdgcn_global_load_lds((const unsigned*)(_g + _vo), (LAS unsigned*)(lds + (bufoff) + ldsw), 16, 0, 0); \
        __builtin_amdgcn_global_load_lds((const unsigned*)(_g + (size_t)64 * (stride) + _vo), (LAS unsigned*)(lds + (bufoff) + ldsw + 8192), 16, 0, 0); } while (0)
#define PG8_LDA(dst, b, h) do { _Pragma("unroll") for (int m = 0; m < 4; ++m) _Pragma("unroll") for (int k = 0; k < 2; ++k) dst[m][k] = *(const LAS bf16x8*)(lds + PG8_SA(b, h) + aoff + m * 2048 + k * 1024); } while (0)
#define PG8_LDB(dst, b, h) do { _Pragma("unroll") for (int n = 0; n < 2; ++n) _Pragma("unroll") for (int k = 0; k < 2; ++k) dst[n][k] = *(const LAS bf16x8*)(lds + PG8_SB(b, h) + boff + n * 2048 + k * 1024); } while (0)
#define PG8_CAT(lo, hi) __builtin_bit_cast(v8i, __builtin_shufflevector(lo, hi, 0, 1, 2, 3, 4, 5, 6, 7, 8, 9, 10, 11, 12, 13, 14, 15))
#define PG8_MMA_BF(ai, bj, At, Bt) do { __builtin_amdgcn_s_setprio(1); _Pragma("unroll") for (int m = 0; m < 4; ++m) _Pragma("unroll") for (int n = 0; n < 2; ++n) _Pragma("unroll") for (int k = 0; k < 2; ++k) \
        acc[ai][bj][m][n] = __builtin_amdgcn_mfma_f32_16x16x32_bf16(Bt[n][k], At[m][k], acc[ai][bj][m][n], 0, 0, 0); __builtin_amdgcn_s_setprio(0); } while (0)
#define PG8_MMA_F8(ai, bj, At, Bt) do { __builtin_amdgcn_s_setprio(1); _Pragma("unroll") for (int m = 0; m < 4; ++m) _Pragma("unroll") for (int n = 0; n < 2; ++n) \
        acc[ai][bj][m][n] = __builtin_amdgcn_mfma_scale_f32_16x16x128_f8f6f4(PG8_CAT(Bt[n][0], Bt[n][1]), PG8_CAT(At[m][0], At[m][1]), acc[ai][bj][m][n], 0, 0, 0, 0x7F7F7F7F, 0, 0x7F7F7F7F); __builtin_amdgcn_s_setprio(0); } while (0)
#define PG8_WAIT_V(n) asm volatile("s_waitcnt vmcnt(" #n ")" ::: "memory")
#define PG8_WAIT_L(n) asm volatile("s_waitcnt lgkmcnt(" #n ")" ::: "memory")
#define PG8_BAR __builtin_amdgcn_s_barrier()
#define PG8_SCHED __builtin_amdgcn_sched_barrier(0)
#define PG8_KLOOP(MMA) \
        for (int t = 0; t < nt; t += 2) { \
            const bool last = (t == nt - 2); \
            const char* a1 = cA + (size_t)(t + 1) * kstep; \
            const char* a2 = last ? nxt.a : cA + (size_t)(t + 2) * kstep; const char* b2 = last ? nxt.b : cB + (size_t)(t + 2) * kstep; \
            const unsigned sa2 = last ? nxt.sa : csa, sb2 = last ? nxt.sb : csb; const size_t hA2 = (size_t)HALF * sa2, hB2 = (size_t)HALF * sb2; \
            const char* a3 = a2 + kstep; const char* b3 = b2 + kstep; \
            PG8_LDB(B0, 0, 0); PG8_LDB(B1, 0, 1); PG8_SCHED; PG8_LDA(At, 0, 0); PG8_STAGE(PG8_SA(1, 1), a1 + hA, RA, csa); \
            PG8_WAIT_V(8); PG8_WAIT_L(0); PG8_BAR; MMA(0, 0, At, B0); MMA(0, 1, At, B1); PG8_BAR; PG8_SCHED; \
            PG8_LDA(At, 0, 1); PG8_STAGE(PG8_SB(0, 0), b2, RB, sb2); PG8_STAGE(PG8_SB(0, 1), b2 + hB2, RB, sb2); PG8_STAGE(PG8_SA(0, 0), a2, RA, sa2); \
            PG8_WAIT_V(8); PG8_WAIT_L(0); PG8_BAR; MMA(1, 0, At, B0); MMA(1, 1, At, B1); PG8_BAR; PG8_SCHED; \
            PG8_LDB(B0, 1, 0); PG8_LDB(B1, 1, 1); PG8_SCHED; PG8_LDA(At, 1, 0); PG8_STAGE(PG8_SA(0, 1), a2 + hA2, RA, sa2); \
            PG8_WAIT_V(8); PG8_WAIT_L(0); PG8_BAR; MMA(0, 0, At, B0); MMA(0, 1, At, B1); PG8_BAR; PG8_SCHED; \
            PG8_LDA(At, 1, 1); PG8_STAGE(PG8_SB(1, 0), b3, RB, sb2); PG8_STAGE(PG8_SB(1, 1), b3 + hB2, RB, sb2); PG8_STAGE(PG8_SA(1, 0), a3, RA, sa2); \
            PG8_WAIT_V(8); PG8_WAIT_L(0); PG8_BAR; MMA(1, 0, At, B0); MMA(1, 1, At, B1); PG8_BAR; PG8_SCHED; \
        }
    GUnit cur, nxt; int ui = 0;
    if (!S.next(0, cur)) return;
    f32x4 acc[2][2][4][2];
#pragma unroll
    for (int a = 0; a < 2; ++a)
#pragma unroll
        for (int b = 0; b < 2; ++b)
#pragma unroll
            for (int m = 0; m < 4; ++m)
#pragma unroll
                for (int n = 0; n < 2; ++n) acc[a][b][m][n] = (f32x4){0.f, 0.f, 0.f, 0.f};
    bf16x8 At[4][2], B0[2][2], B1[2][2];
    unsigned keep[2][2][4][2];
    {
        const char* cA = cur.a; const char* cB = cur.b; const size_t hA = (size_t)HALF * cur.sa, hB = (size_t)HALF * cur.sb;
        PG8_STAGE(PG8_SB(0, 0), cB, RB, cur.sb); PG8_STAGE(PG8_SB(0, 1), cB + hB, RB, cur.sb); PG8_STAGE(PG8_SA(0, 0), cA, RA, cur.sa); PG8_STAGE(PG8_SA(0, 1), cA + hA, RA, cur.sa);
        if (wr == 1) PG8_BAR;
        PG8_WAIT_V(2); PG8_BAR;
        PG8_STAGE(PG8_SB(1, 0), cB + kstep, RB, cur.sb); PG8_STAGE(PG8_SA(1, 0), cA + kstep, RA, cur.sa); PG8_STAGE(PG8_SB(1, 1), cB + hB + kstep, RB, cur.sb);
        PG8_WAIT_V(6); PG8_BAR;
    }
    for (;;) {
        const bool has_next = S.next(ui + 1, nxt);
        if (!has_next) { nxt = cur; }
        const char* cA = cur.a; const char* cB = cur.b; const unsigned csa = cur.sa, csb = cur.sb; const size_t hA = (size_t)HALF * csa, hB = (size_t)HALF * csb;
        const int nt = cur.nt; const bool cur_fp8 = (cur.kind & K_FP8) != 0; (void)cur_fp8;
        if (MODE == 1 || (MODE == 2 && cur_fp8)) { PG8_KLOOP(PG8_MMA_F8) } else { PG8_KLOOP(PG8_MMA_BF) }
        if (wr == 0) PG8_BAR;
        E(acc, keep, cur, wr, wc, fr, fq);
        if (!has_next) break;
#pragma unroll
        for (int a = 0; a < 2; ++a)
#pragma unroll
            for (int b = 0; b < 2; ++b)
#pragma unroll
                for (int m = 0; m < 4; ++m)
#pragma unroll
                    for (int n = 0; n < 2; ++n) acc[a][b][m][n] = (f32x4){0.f, 0.f, 0.f, 0.f};
        cur = nxt; ++ui;
        if (wr == 1) PG8_BAR;
    }
    PG8_WAIT_V(0);
    PG8_BAR;
#undef PG8_SA
#undef PG8_SB
#undef PG8_STAGE
#undef PG8_LDA
#undef PG8_LDB
#undef PG8_MMA_BF
#undef PG8_MMA_F8
#undef PG8_KLOOP
#undef RB
#undef PG8_CAT
#undef PG8_WAIT_V
#undef PG8_WAIT_L
#undef PG8_BAR
#undef PG8_SCHED
}
}
using pg8::GUnit; using pg8::K_FP8;

__device__ __forceinline__ int tok0_of(int p, int g) {
    const int n = p << 8, b = n >> 14, rem = n & 16383, sh = 2 * g;
    const int r = rem >> (14 - sh), l0 = rem & ((16384 >> sh) - 1);
    return (b << 14) + (l0 << sh) + r;
}
__device__ __forceinline__ void tile_of(int t, int nN, int& pm, int& pn) { const int nig = 8 * nN, gid = t / nig, w = t % nig; pm = gid * 8 + (w & 7); pn = w >> 3; }

struct Ptrs {
    const float* in[21]; float* out; unsigned char* ws;
};

enum { K_ZA = 0, K_QK = 1, K_VT = 2, K_QC = 3, K_MKV = 4, K_GATE = 5, K_YA = 6, K_YB = 7, K_YC = 8, K_WO = 9, K_PQ = 10 };
struct SchedP1 {
    const char* wsb; int G, c;
    static constexpr int NLONG = 512, NSHORT = 768 + 384 + 256 + 8;
    __device__ __forceinline__ bool next(int i, GUnit& u) const {
        const char* const h0b = wsb + WS_H0; const char* const wtb = wsb + WS_WTIN; const char* const h0 = wsb + WS_H0F8; const char* const wtin = wsb + WS_WF8IN; const char* const memb = wsb + WS_MEMF8; const char* const wtmkv = wsb + WS_WMKVF8;
        const int nshort = (NSHORT - c + G - 1) / G, nslots = 2 + nshort; if (i >= nslots) return false;
        const int k = (c >> 3) & 3; int pa = k % nslots, pb = (k + 4) % nslots; if (pa > pb) { const int t_ = pa; pa = pb; pb = t_; }
        int j; if (i == pa) j = 0; else if (i == pb) j = 1; else j = 2 + i - (i > pa ? 1 : 0) - (i > pb ? 1 : 0);
        const int L = j * G + c; if (L >= NLONG + NSHORT) return false;
        if (L < NLONG) { const int T = (G % 8 == 0) ? (L % 8) * (NLONG / 8) + L / 8 : L; int pm, pn; tile_of(T, 4, pm, pn);
            u.a = h0b + (size_t)pm * 256 * 2048; u.b = wtb + (size_t)(WR_A + pn * 256) * 2048; u.sa = 2048; u.sb = 2048; u.nt = 16; u.pm = pm; u.pn = pn; u.kind = K_ZA; return true; }
        const int Ls = L - NLONG; int T = (NSHORT % 8 == 0 && G % 8 == 0) ? (Ls % 8) * (NSHORT / 8) + Ls / 8 : Ls;
        u.nt = 8; u.sa = 1024; u.sb = 1024;
        if (T < 768) { const int g = T >> 8; int pm, pn; tile_of(T & 255, 2, pm, pn); u.a = h0 + (size_t)tok0_of(pm, g) * 1024; u.sa = 1024u << (2 * g);
            u.b = wtin + (size_t)(WR_QK + g * 512 + pn * 256) * 1024; u.pm = pm; u.pn = pn; u.kind = K_QK | (g << 8) | K_FP8; return true; }
        T -= 768;
        if (T < 384) { const int g = T >> 7, pn = T & 127; u.a = wtin + (size_t)(WR_V + g * 256) * 1024; u.b = h0 + (size_t)tok0_of(pn, g) * 1024; u.sb = 1024u << (2 * g);
            u.pm = 0; u.pn = pn; u.kind = K_VT | (g << 8) | K_FP8; return true; }
        T -= 384;
        if (T < 256) { int pm, pn; tile_of(T, 2, pm, pn); u.a = h0 + (size_t)pm * 256 * 1024; u.b = wtin + (size_t)(WR_QC + pn * 256) * 1024; u.pm = pm; u.pn = pn; u.kind = K_QC | K_FP8; return true; }
        T -= 256;
        if (T < 4) { const int pm = T >> 1, pn = T & 1; u.a = memb + (size_t)pm * 256 * 1024; u.b = wtmkv + (size_t)pn * 256 * 1024; u.pm = pm; u.pn = pn; u.kind = K_MKV | K_FP8; return true; }
        T -= 4;
        { const int pm = T >> 1, pn = T & 1; u.a = wtmkv + (size_t)(512 + pm * 256) * 1024; u.b = memb + (size_t)pn * 256 * 1024; u.pm = pm; u.pn = pn; u.kind = K_MKV | (1 << 8) | K_FP8; return true; }
    }
};
__device__ __forceinline__ void out_tile_of(int L, int G, int& pm, int& pn) {
    const int T = (G % 8 == 0) ? (L % 8) * 64 + L / 8 : L; tile_of(T, 4, pm, pn);
}
struct SchedP4 {
    const char* wsb; int G, c;
    __device__ __forceinline__ bool next(int i, GUnit& u) const {
        const int io = i / 6, s = i - io * 6; const int L = io * G + c; if (L >= 512) return false;
        int pm, pn; out_tile_of(L, G, pm, pn); u.pm = pm; u.pn = pn;
        if ((s & 1) == 0) { const int gi = s >> 1; u.a = wsb + WS_H0F8 + (size_t)pm * 256 * 1024; u.sa = 1024; u.b = wsb + WS_WF8IN + (size_t)(WR_GATE + gi * 1024 + pn * 256) * 1024; u.sb = 1024; u.nt = 8; u.kind = K_GATE | (gi << 8) | K_FP8; return true; }
        if (s == 1) { u.a = wsb + WS_FA + (size_t)pm * 256 * 1024; u.sa = 1024; u.b = wsb + WS_WTA + (size_t)pn * 256 * 1024; u.sb = 1024; u.nt = 8; u.kind = K_YA; return true; }
        if (s == 3) { u.a = wsb + WS_OB + (size_t)pm * 256 * 256; u.sa = 256; u.b = wsb + WS_WTB + (size_t)pn * 256 * 256; u.sb = 256; u.nt = 2; u.kind = K_YB | K_FP8; return true; }
        u.a = wsb + WS_YCIN + (size_t)pm * 256 * 512; u.sa = 512; u.b = wsb + WS_WTC + (size_t)pn * 256 * 512; u.sb = 512; u.nt = 4; u.kind = K_YC | K_FP8; return true;
    }
};
struct SchedPlain {
    const char* a; const char* b; int G, c, kind;
    __device__ __forceinline__ bool next(int i, GUnit& u) const {
        const int L = i * G + c; if (L >= 512) return false;
        int pm, pn; out_tile_of(L, G, pm, pn); u.pm = pm; u.pn = pn; u.a = a + (size_t)pm * 256 * 2048; u.b = b + (size_t)pn * 256 * 2048; u.sa = 2048; u.sb = 2048; u.nt = 16; u.kind = kind; return true;
    }
};

__device__ __forceinline__ unsigned opq(unsigned x) { asm volatile("" : "+v"(x)); return x; }
__device__ __forceinline__ v4u pack8(f32x4 v0, f32x4 v1) { v4u o; o.x = pk2(v0[0], v0[1]); o.y = pk2(v0[2], v0[3]); o.z = pk2(v1[0], v1[1]); o.w = pk2(v1[2], v1[3]); return o; }
__device__ __forceinline__ void unpack8(v4u w, f32x4& a, f32x4& b) { a[0] = bflo(w.x); a[1] = bfhi(w.x); a[2] = bflo(w.y); a[3] = bfhi(w.y); b[0] = bflo(w.z); b[1] = bfhi(w.z); b[2] = bflo(w.w); b[3] = bfhi(w.w); }
#define EPI_LOOP(ai, m, bj) _Pragma("unroll") for (int ai = 0; ai < 2; ++ai) _Pragma("unroll") for (int m = 0; m < 4; ++m) _Pragma("unroll") for (int bj = 0; bj < 2; ++bj)

constexpr float W8SC = 32.f, W8INV = 1.f / 32.f;
constexpr float SC_WBC = 16.f, SC_ACT = 4.f;
struct EpiP1 {
    bf16* za; unsigned char* wsb; const LAS unsigned char* bias;
    __device__ __forceinline__ void operator()(f32x4 (&acc)[2][2][4][2], unsigned (&keep)[2][2][4][2], const GUnit& u, int wr, int wc, int fr, int fq) const {
        bf16* const qk = (bf16*)(wsb + WS_QK); bf16* const vt = (bf16*)(wsb + WS_VT); bf16* const qc = (bf16*)(wsb + WS_QC); bf16* const memkv = (bf16*)(wsb + WS_MEMKV);
        const int kind = u.kind & 255, g = (u.kind >> 8) & 255; const float asc = (u.kind & K_FP8) ? W8INV : 1.f;
        const unsigned rl0 = opq((unsigned)(wr * 64 + fr)), cl0 = opq((unsigned)(wc * 32 + 8 * fq));
        if (kind == K_VT) {
            char* base = (char*)(vt + (size_t)g * 256 * NT + (size_t)u.pn * 256); const LAS unsigned char* bb = bias + (WR_V + g * 256) * 4;
            const unsigned lo = rl0 * (unsigned)(NT * 2) + cl0 * 2u;
#pragma unroll
            for (int ai = 0; ai < 2; ++ai)
#pragma unroll
                for (int m = 0; m < 4; ++m) { const float br = *(const LAS float*)(bb + (rl0 + ai * 128 + m * 16) * 4u);
#pragma unroll
                    for (int bj = 0; bj < 2; ++bj) *(GAS v4u*)(base + (lo + (unsigned)((ai * 128 + m * 16) * NT * 2 + bj * 256))) = pack8(acc[ai][bj][m][0] * asc + br, acc[ai][bj][m][1] * asc + br);
                    __builtin_amdgcn_sched_barrier(0); }
            return;
        }
        char* base; unsigned ldb; const LAS unsigned char* bb; bool hasb = true;
        if (kind == K_ZA) { base = (char*)(za + (size_t)u.pm * 256 * 1024 + u.pn * 256); ldb = 2048; bb = bias + (WR_A + u.pn * 256) * 4; }
        else if (kind == K_QK) { base = (char*)(qk + (size_t)g * NT * 512 + (size_t)u.pm * 256 * 512 + u.pn * 256); ldb = 1024; bb = bias + (WR_QK + g * 512 + u.pn * 256) * 4; }
        else if (kind == K_QC) { base = (char*)(qc + (size_t)u.pm * 256 * 512 + u.pn * 256); ldb = 1024; bb = bias + (WR_QC + u.pn * 256) * 4; }
        else { base = (char*)(memkv + (size_t)g * 512 * 512 + (size_t)u.pm * 256 * 512 + u.pn * 256); ldb = 1024; bb = bias; hasb = false; }
        f32x4 bv[2][2];
#pragma unroll
        for (int bj = 0; bj < 2; ++bj)
#pragma unroll
            for (int n = 0; n < 2; ++n) bv[bj][n] = hasb ? *(const LAS f32x4*)(bb + (cl0 + bj * 128 + 4 * n) * 4u) : (f32x4){0.f, 0.f, 0.f, 0.f};
        const unsigned lo = rl0 * ldb + cl0 * 2u;
#pragma unroll
        for (int ai = 0; ai < 2; ++ai)
#pragma unroll
            for (int m = 0; m < 4; ++m) {
#pragma unroll
                for (int bj = 0; bj < 2; ++bj) *(GAS v4u*)(base + (lo + (unsigned)(ai * 128 + m * 16) * ldb + (unsigned)(bj * 256))) = pack8(acc[ai][bj][m][0] * asc + bv[bj][0], acc[ai][bj][m][1] * asc + bv[bj][1]);
                __builtin_amdgcn_sched_barrier(0); }
    }
};
struct EpiP4 {
    bf16* merged; const LAS unsigned char* bias;
    __device__ __forceinline__ void operator()(f32x4 (&acc)[2][2][4][2], unsigned (&keep)[2][2][4][2], const GUnit& u, int wr, int wc, int fr, int fq) const {
        const int kind = u.kind & 255, gi = (u.kind >> 8) & 255;
        const unsigned rl0 = opq((unsigned)(wr * 64 + fr)), cl0 = opq((unsigned)(wc * 32 + 8 * fq));
        if (kind == K_GATE) {
            const LAS unsigned char* bb = bias + (gi * 1024 + u.pn * 256) * 4;
#pragma unroll
            for (int bj = 0; bj < 2; ++bj) { const f32x4 b0 = *(const LAS f32x4*)(bb + (cl0 + bj * 128) * 4u), b1 = *(const LAS f32x4*)(bb + (cl0 + bj * 128 + 4) * 4u);
#pragma unroll
                for (int ai = 0; ai < 2; ++ai)
#pragma unroll
                    for (int m = 0; m < 4; ++m)
#pragma unroll
                        for (int n = 0; n < 2; ++n) { const f32x4 v = acc[ai][bj][m][n] * W8INV + (n ? b1 : b0); unsigned pk = 0u;
#pragma unroll
                            for (int e = 0; e < 4; ++e) { const float sg = __builtin_amdgcn_rcpf(1.f + __expf(-v[e])); pk |= (unsigned)(sg * 255.f + 0.5f) << (8 * e); }
                            keep[ai][bj][m][n] = pk; } }
            return;
        }
        char* mb = (char*)(merged + (size_t)u.pm * 256 * 1024 + u.pn * 256); const unsigned mlo = rl0 * 2048u + cl0 * 2u;
        const float ysc = ((kind == K_YA) ? 1.f : 1.f / (SC_WBC * SC_ACT)) * (1.f / 255.f);
#pragma unroll
        for (int ai = 0; ai < 2; ++ai) {
            v4u pw[4][2];
            if (kind != K_YA) {
#pragma unroll
                for (int m = 0; m < 4; ++m)
#pragma unroll
                    for (int bj = 0; bj < 2; ++bj) pw[m][bj] = *(const GAS v4u*)(mb + (mlo + (unsigned)((ai * 128 + m * 16) * 2048 + bj * 256))); }
#pragma unroll
            for (int m = 0; m < 4; ++m)
#pragma unroll
                for (int bj = 0; bj < 2; ++bj) { f32x4 v[2];
#pragma unroll
                    for (int n = 0; n < 2; ++n) { const unsigned pk = keep[ai][bj][m][n];
                        v[n][0] = acc[ai][bj][m][n][0] * ((float)(pk & 255u) * ysc); v[n][1] = acc[ai][bj][m][n][1] * ((float)((pk >> 8) & 255u) * ysc);
                        v[n][2] = acc[ai][bj][m][n][2] * ((float)((pk >> 16) & 255u) * ysc); v[n][3] = acc[ai][bj][m][n][3] * ((float)(pk >> 24) * ysc); }
                    if (kind != K_YA) { f32x4 p0, p1; unpack8(pw[m][bj], p0, p1); v[0] += p0; v[1] += p1; }
                    *(GAS v4u*)(mb + (mlo + (unsigned)((ai * 128 + m * 16) * 2048 + bj * 256))) = pack8(v[0], v[1]); }
            __builtin_amdgcn_sched_barrier(0); }
    }
};
struct EpiP5 {
    bf16* h0; float* preln; float* stats; LAS unsigned char* lds_spare;
    __device__ __forceinline__ void operator()(f32x4 (&acc)[2][2][4][2], unsigned (&keep)[2][2][4][2], const GUnit& u, int wr, int wc, int fr, int fq) const {
        const unsigned rl0 = opq((unsigned)(wr * 64 + fr)), cl0 = opq((unsigned)(wc * 32 + 8 * fq));
        const size_t t0 = (size_t)u.pm * 256 * 1024 + u.pn * 256;
        char* hb = (char*)(h0 + t0);
        const unsigned hlo = rl0 * 2048u + cl0 * 2u;
#pragma unroll
        for (int ai = 0; ai < 2; ++ai) {
            v4u hw[4][2];
#pragma unroll
            for (int m = 0; m < 4; ++m)
#pragma unroll
                for (int bj = 0; bj < 2; ++bj) hw[m][bj] = *(const GAS v4u*)(hb + (hlo + (unsigned)((ai * 128 + m * 16) * 2048 + bj * 256)));
#pragma unroll
            for (int m = 0; m < 4; ++m) { float s1 = 0.f, s2 = 0.f;
#pragma unroll
                for (int bj = 0; bj < 2; ++bj) { f32x4 h0v, h1v; unpack8(hw[m][bj], h0v, h1v);
                    const f32x4 v0 = acc[ai][bj][m][0] + ALPHA * h0v, v1 = acc[ai][bj][m][1] + ALPHA * h1v;
                    *(GAS v4u*)(hb + (hlo + (unsigned)((ai * 128 + m * 16) * 2048 + bj * 256))) = pack8(v0, v1);
                    s1 += (v0[0] + v0[1]) + (v0[2] + v0[3]) + (v1[0] + v1[1]) + (v1[2] + v1[3]);
                    s2 += (v0[0] * v0[0] + v0[1] * v0[1]) + (v0[2] * v0[2] + v0[3] * v0[3]) + (v1[0] * v1[0] + v1[1] * v1[1]) + (v1[2] * v1[2] + v1[3] * v1[3]); }
                s1 += __shfl_xor(s1, 16); s1 += __shfl_xor(s1, 32); s2 += __shfl_xor(s2, 16); s2 += __shfl_xor(s2, 32);
                if (fq == 0) { f32x2 pr; pr.x = s1; pr.y = s2; *(LAS f32x2*)(lds_spare + ((ai * 128 + m * 16 + rl0) * 4 + wc) * 8) = pr; } }
            __builtin_amdgcn_sched_barrier(0); }
        asm volatile("s_waitcnt lgkmcnt(0)" ::: "memory"); __builtin_amdgcn_s_barrier(); asm volatile("" ::: "memory");
        { const int t = threadIdx.x;
          if (t < 256) { const LAS f32x2* pp = (const LAS f32x2*)(lds_spare + t * 32); f32x2 a = pp[0]; a += pp[1]; a += pp[2]; a += pp[3];
              *(GAS f32x2*)(stats + ((size_t)(u.pm * 256 + t) * 4 + u.pn) * 2) = a; } }
    }
};
struct EpiP7 {
    bf16* qp; const float* stats; const float* cvec; const float* dvec;
    __device__ __forceinline__ void operator()(f32x4 (&acc)[2][2][4][2], unsigned (&keep)[2][2][4][2], const GUnit& u, int wr, int wc, int fr, int fq) const {
        const unsigned rl0 = opq((unsigned)(wr * 64 + fr)), cl0 = opq((unsigned)(wc * 32 + 8 * fq));
        char* qb = (char*)(qp + (size_t)u.pm * 256 * 1024 + u.pn * 256); const unsigned lo = rl0 * 2048u + cl0 * 2u;
        f32x4 cv[2][2], dv[2][2];
#pragma unroll
        for (int bj = 0; bj < 2; ++bj)
#pragma unroll
            for (int n = 0; n < 2; ++n) { cv[bj][n] = *(const GAS f32x4*)(cvec + u.pn * 256 + cl0 + bj * 128 + 4 * n); dv[bj][n] = *(const GAS f32x4*)(dvec + u.pn * 256 + cl0 + bj * 128 + 4 * n); }
#pragma unroll
        for (int ai = 0; ai < 2; ++ai)
#pragma unroll
            for (int m = 0; m < 4; ++m) { const GAS f32x4* sp = (const GAS f32x4*)(stats + (size_t)(u.pm * 256 + ai * 128 + m * 16 + rl0) * 8); const f32x4 sa = sp[0], sb = sp[1];
                f32x2 st; st.x = ((sa.x + sa.z) + sb.x) + sb.z; st.y = ((sa.y + sa.w) + sb.y) + sb.w;
                const float mean = st.x * (1.f / D), rstd = 1.f / sqrtf(fmaxf(st.y * (1.f / D) - mean * mean, 0.f) + LN_EPS), mr = mean * rstd;
#pragma unroll
                for (int bj = 0; bj < 2; ++bj) *(GAS v4u*)(qb + (lo + (unsigned)((ai * 128 + m * 16) * 2048 + bj * 256))) = pack8(acc[ai][bj][m][0] * rstd - mr * cv[bj][0] + dv[bj][0], acc[ai][bj][m][1] * rstd - mr * cv[bj][1] + dv[bj][1]); }
    }
};

constexpr float FP6_SU = 60.f, FP6_SV = 3.15f;
__device__ __forceinline__ unsigned fp6_code(float v) {
    const float a = fminf(fabsf(v), 7.5f);
    const float c = a < 2.f ? rintf(a * 8.f) : (a < 4.f ? 16.f + rintf((a - 2.f) * 4.f) : 24.f + rintf((a - 4.f) * 2.f));
    return (unsigned)c | (v < 0.f ? 32u : 0u);
}
constexpr float FP4_SV = 3.36f, FP4_SU = 64.f;
__device__ __forceinline__ unsigned fp4_code(float v) {
    const float a = fminf(fabsf(v), 6.f);
    const float c = a < 2.f ? rintf(a * 2.f) : (a < 4.f ? 4.f + rintf(a - 2.f) : 6.f + rintf((a - 4.f) * 0.5f));
    return (unsigned)c | (v < 0.f ? 8u : 0u);
}
typedef unsigned v6u __attribute__((ext_vector_type(6)));
typedef float v32f __attribute__((ext_vector_type(32)));
__device__ __forceinline__ void p0_transpose_item(const float* W, int K, int ld, int col0, bf16* WT, unsigned char* WT8, float sc8, int row0, LAS float* scr, int item, int lane, int ncols,
                                                  const float* kg = nullptr, const float* kb = nullptr, float* cvec = nullptr, float* dvec = nullptr) {
    const int nblk = ncols / 32, kb_ = item / nblk, nb = item % nblk, k0 = 64 * kb_, n0 = 32 * nb;
    { float wv[32];
#pragma unroll
      for (int i = 0; i < 32; ++i) wv[i] = W[(size_t)(k0 + 2 * i + (lane >> 5)) * ld + col0 + n0 + (lane & 31)];
#pragma unroll
      for (int i = 0; i < 32; ++i) scr[(2 * i + (lane >> 5)) * 33 + (lane & 31)] = wv[i]; }
    LDS_WAIT(); asm volatile("" ::: "memory");
    const int c = lane & 7;
#pragma unroll
    for (int j = 0; j < 4; ++j) { const int n = (lane >> 3) + 8 * j; const LAS float* s = scr + (8 * c) * 33 + n;
        float e[8];
#pragma unroll
        for (int i = 0; i < 8; ++i) e[i] = s[i * 33];
        if (kg) { float pc = 0.f, pd = 0.f;
#pragma unroll
            for (int i = 0; i < 8; ++i) { const float g = kg[k0 + 8 * c + i]; pd += e[i] * kb[k0 + 8 * c + i]; e[i] *= g; pc += e[i]; }
            pc += __shfl_xor(pc, 1); pc += __shfl_xor(pc, 2); pc += __shfl_xor(pc, 4); pd += __shfl_xor(pd, 1); pd += __shfl_xor(pd, 2); pd += __shfl_xor(pd, 4);
            if (c == 0) { cvec[kb_ * 1024 + col0 + n0 + n] = pc; dvec[kb_ * 1024 + col0 + n0 + n] = pd; } }
        if (WT) { v4u o; o.x = pk2(e[0], e[1]); o.y = pk2(e[2], e[3]); o.z = pk2(e[4], e[5]); o.w = pk2(e[6], e[7]); *(GAS v4u*)(WT + (size_t)(row0 + n0 + n) * K + k0 + 8 * c) = o; }
        if (WT8) { v2u o; o.x = pk4_fp8(e[0] * sc8, e[1] * sc8, e[2] * sc8, e[3] * sc8); o.y = pk4_fp8(e[4] * sc8, e[5] * sc8, e[6] * sc8, e[7] * sc8); *(GAS v2u*)(WT8 + (size_t)(row0 + n0 + n) * K + k0 + 8 * c) = o; } }
    LDS_WAIT(); asm volatile("" ::: "memory");
}
__device__ __forceinline__ void ln_row(const float* xrow, const float* g, const float* b, bf16* obf, float* of32, int lane) {
    const GAS f32x4* xr = (const GAS f32x4*)xrow + lane;
    f32x4 v[4]; float s = 0.f;
#pragma unroll
    for (int j = 0; j < 4; ++j) { v[j] = xr[64 * j]; s += (v[j].x + v[j].y) + (v[j].z + v[j].w); }
    const float mean = wave_sum(s) * (1.f / D); float s2 = 0.f;
#pragma unroll
    for (int j = 0; j < 4; ++j) { v[j] = v[j] - mean; s2 += (v[j].x * v[j].x + v[j].y * v[j].y) + (v[j].z * v[j].z + v[j].w * v[j].w); }
    const float rstd = 1.f / sqrtf(wave_sum(s2) * (1.f / D) + LN_EPS);
#pragma unroll
    for (int j = 0; j < 4; ++j) { const f32x4 gg = ((const GAS f32x4*)g)[lane + 64 * j], bb = ((const GAS f32x4*)b)[lane + 64 * j];
        const f32x4 y = v[j] * rstd * gg + bb;
        if (obf) ((GAS unsigned long long*)obf)[lane + 64 * j] = (unsigned long long)pk2(y.x, y.y) | ((unsigned long long)pk2(y.z, y.w) << 32);
        if (of32) ((GAS f32x4*)of32)[lane + 64 * j] = y; }
}
__device__ __forceinline__ void ln_row2(const float* xa, const float* xb, const float* g, const float* b, bf16* oa, bf16* ob, unsigned char* oa8, unsigned char* ob8, int lane) {
    const GAS f32x4* pa = (const GAS f32x4*)xa + lane; const GAS f32x4* pb = (const GAS f32x4*)xb + lane;
    f32x4 va[4], vb[4]; float sa = 0.f, sb = 0.f;
#pragma unroll
    for (int j = 0; j < 4; ++j) { va[j] = pa[64 * j]; vb[j] = pb[64 * j]; }
#pragma unroll
    for (int j = 0; j < 4; ++j) { sa += (va[j].x + va[j].y) + (va[j].z + va[j].w); sb += (vb[j].x + vb[j].y) + (vb[j].z + vb[j].w); }
    const float ma = wave_sum(sa) * (1.f / D), mb = wave_sum(sb) * (1.f / D); float qa = 0.f, qb = 0.f;
#pragma unroll
    for (int j = 0; j < 4; ++j) { va[j] = va[j] - ma; vb[j] = vb[j] - mb; qa += (va[j].x * va[j].x + va[j].y * va[j].y) + (va[j].z * va[j].z + va[j].w * va[j].w); qb += (vb[j].x * vb[j].x + vb[j].y * vb[j].y) + (vb[j].z * vb[j].z + vb[j].w * vb[j].w); }
    const float ra = 1.f / sqrtf(wave_sum(qa) * (1.f / D) + LN_EPS), rb = 1.f / sqrtf(wave_sum(qb) * (1.f / D) + LN_EPS);
#pragma unroll
    for (int j = 0; j < 4; ++j) { const f32x4 gg = ((const GAS f32x4*)g)[lane + 64 * j], bb = ((const GAS f32x4*)b)[lane + 64 * j];
        const f32x4 ya = va[j] * ra * gg + bb, yb = vb[j] * rb * gg + bb;
        ((GAS unsigned long long*)oa)[lane + 64 * j] = (unsigned long long)pk2(ya.x, ya.y) | ((unsigned long long)pk2(ya.z, ya.w) << 32);
        ((GAS unsigned long long*)ob)[lane + 64 * j] = (unsigned long long)pk2(yb.x, yb.y) | ((unsigned long long)pk2(yb.z, yb.w) << 32);
        ((GAS unsigned*)oa8)[lane + 64 * j] = pk4_fp8(ya.x, ya.y, ya.z, ya.w); ((GAS unsigned*)ob8)[lane + 64 * j] = pk4_fp8(yb.x, yb.y, yb.z, yb.w); }
}
__device__ __forceinline__ int t5_bucket(int rel) {
    const int ret = rel > 0 ? 16 : 0; const int n = rel < 0 ? -rel : rel; const float nf = (float)(n > 1 ? n : 1);
    int large = 8 + (int)(logf(nf / 8.f) / 4.852030263919617f * 8.f); large = large < 15 ? large : 15;
    return ret + (n < 8 ? n : large);
}

__device__ __forceinline__ void phase0(const Ptrs& P, LAS unsigned char* lds, int tid, int lane, int wave, int G) {
    unsigned char* ws = P.ws;
    const int gw = blockIdx.x * NWAVES + wave, NGW = G * NWAVES;
    { bf16* h0 = (bf16*)(ws + WS_H0);
      unsigned char* h08 = ws + WS_H0F8;
      for (int m = gw; m < NT; m += 2 * NGW) ln_row2(P.in[0] + (size_t)m * D, P.in[0] + (size_t)(m + NGW) * D, P.in[3], P.in[4], h0 + (size_t)m * D, h0 + (size_t)(m + NGW) * D, h08 + (size_t)m * D, h08 + (size_t)(m + NGW) * D, lane); }
    { LAS float* scr = (LAS float*)(lds + wave * 16384);
      bf16* wtin = (bf16*)(ws + WS_WTIN);
      constexpr int I_IN = 23 * 16 * 8, I_A = 8 * 32, I_B = 4 * 32, I_C = 8 * 32, I_SQ = 16 * 32;
      constexpr int NIT = I_IN + I_A + I_B + I_C + 3 * I_SQ;
      unsigned char* wf8 = ws + WS_WF8IN;
      for (int it = gw; it < NIT; it += NGW) {
          int r = it;
          if (r < I_IN) { const int j = r / 128, q = r % 128; int src;
              if (j < 6) src = ((j & 1) ? 1280 : 512) + (j >> 1) * 256; else if (j < 9) src = 2048 + (j - 6) * 256; else if (j < 11) src = 2816 + (j - 9) * 256; else src = 3328 + (j - 11) * 256;
              p0_transpose_item(P.in[5], 1024, 6400, src, nullptr, wf8, W8SC, 1024 + 256 * j, scr, q, lane, 256); continue; }
          r -= I_IN;
          if (r < I_A) { p0_transpose_item(P.in[7], 512, 1024, 0, (bf16*)(ws + WS_WTA), nullptr, 0.f, 0, scr, r, lane, 1024); continue; } r -= I_A;
          if (r < I_B) { p0_transpose_item(P.in[8], 256, 1024, 0, nullptr, ws + WS_WTB, SC_WBC, 0, scr, r, lane, 1024); continue; } r -= I_B;
          if (r < I_C) { p0_transpose_item(P.in[9], 512, 1024, 0, nullptr, ws + WS_WTC, SC_WBC, 0, scr, r, lane, 1024); continue; } r -= I_C;
          if (r < I_SQ) { p0_transpose_item(P.in[10], 1024, 1024, 0, nullptr, ws + WS_WMKVF8, W8SC, 0, scr, r, lane, 1024); continue; } r -= I_SQ;
          if (r < I_SQ) { p0_transpose_item(P.in[11], 1024, 1024, 0, (bf16*)(ws + WS_WTO), nullptr, 0.f, 0, scr, r, lane, 1024); continue; } r -= I_SQ;
          p0_transpose_item(P.in[14], 1024, 1024, 0, (bf16*)(ws + WS_WTPQ), nullptr, 0.f, 0, scr, r, lane, 1024, P.in[12], P.in[13], (float*)(ws + WS_CPART), (float*)(ws + WS_CPART) + 16 * 1024);
      } }
    __syncthreads();
    { LAS float* wt = (LAS float*)lds;
      LAS float* cs = wt + 64 * 129; LAS float* sn = cs + 128;
      if (tid < 128) { float s, c; sincospif((float)tid / 64.f, &s, &c); cs[tid] = c; sn[tid] = s; }
      bf16* wtin = (bf16*)(ws + WS_WTIN);
      unsigned char* wf8 = ws + WS_WF8IN;
      for (int it = blockIdx.x; it < 256; it += G) {
          const int g = it >> 6, k0 = (it & 63) * 16;
          __syncthreads();
          for (int idx = tid; idx < 16 * 128; idx += 512) { const int kk = idx >> 7, c = idx & 127; wt[kk * 129 + c] = P.in[5][(size_t)(k0 + kk) * 6400 + g * 128 + c]; }
          __syncthreads();
          const int cp = tid & 127, kq = tid >> 7;
          float ac[4] = {0.f, 0.f, 0.f, 0.f}, as[4] = {0.f, 0.f, 0.f, 0.f};
#pragma unroll 4
          for (int c = 0; c < 128; ++c) { const int ix = (c * cp) & 127; const float cv = cs[ix], sv = sn[ix];
#pragma unroll
              for (int i = 0; i < 4; ++i) { const float w = wt[(4 * kq + i) * 129 + c]; ac[i] += w * cv; as[i] += w * sv; } }
          { v2u o; o.x = pk2(ac[0], ac[1]); o.y = pk2(ac[2], ac[3]); *(GAS v2u*)(wtin + (size_t)(g * 256 + cp) * 1024 + k0 + 4 * kq) = o;
            v2u q; q.x = pk2(as[0], as[1]); q.y = pk2(as[2], as[3]); *(GAS v2u*)(wtin + (size_t)(g * 256 + 128 + cp) * 1024 + k0 + 4 * kq) = q; }
      }
      __syncthreads();
      { float* bi = (float*)(ws + WS_BIASIN); const float* b_in = P.in[6];
        for (int r = gw; r < 1024; r += NGW) { const int g = r >> 8, w = r & 255, cp = w & 127; const bool isin = w >= 128;
            const int i0 = (lane * cp) & 127, i1 = ((lane + 64) * cp) & 127;
            float a = b_in[g * 128 + lane] * (isin ? sn[i0] : cs[i0]) + b_in[g * 128 + 64 + lane] * (isin ? sn[i1] : cs[i1]);
            a = wave_sum(a); if (lane == 0) bi[r] = a; }
        const int gtid = blockIdx.x * 512 + tid, nth = G * 512;
        for (int r = 1024 + gtid; r < WR_END; r += nth) { const int j = (r - 1024) >> 8, w = (r - 1024) & 255; int src;
            if (j < 6) src = ((j & 1) ? 1280 : 512) + (j >> 1) * 256; else if (j < 9) src = 2048 + (j - 6) * 256; else if (j < 11) src = 2816 + (j - 9) * 256; else src = 3328 + (j - 11) * 256;
            bi[r] = b_in[src + w]; }
        float* bt = (float*)(ws + WS_BIASTAB);
        for (int r = gtid; r < 3 * 4 * 129; r += nth) { const int g = r / (4 * 129), h = (r / 129) & 3, j = r % 129; const int rel = (j - 64) << (2 * g);
            bt[(g * 4 + h) * 132 + j] = P.in[2][t5_bucket(rel) * 12 + g * 4 + h]; }
      }
    }
    { const size_t gt = (size_t)blockIdx.x * 512 + tid, NTH = (size_t)G * 512;
      const GAS f32x4* us = (const GAS f32x4*)P.in[17]; const GAS f32x4* vs = (const GAS f32x4*)P.in[18];
      GAS v2u* ud = (GAS v2u*)(ws + WS_UTAB); GAS v2u* vd = (GAS v2u*)(ws + WS_VTAB);
#if TAB_FP6
      {
        const int njobs = 2 * 16384 * 16;
        for (int job = (int)gt; job < njobs; job += (int)NTH) { const int tb = job >> 18, e = (job >> 4) & 16383, fr = job & 15;
            const float sc = tb ? FP4_SV : (TABU_FP4 ? FP4_SU : FP6_SU);
            const GAS f32x4* src = (const GAS f32x4*)((tb ? P.in[18] : P.in[17]) + (size_t)e * 1024);
            const int kq = fr & 3, sp = fr >> 2;
            f32x4 v[16];
#pragma unroll
            for (int idx = 0; idx < 16; ++idx) v[idx] = src[tb ? (16 * fr + idx) : (32 * (2 * sp + (idx >> 3)) + 8 * kq + (idx & 7))];
            if (tb || TABU_FP4) {
                unsigned wd4[8];
#pragma unroll
                for (int w = 0; w < 8; ++w) { unsigned acc4 = 0u;
#pragma unroll
                    for (int t = 0; t < 8; ++t) acc4 |= fp4_code(v[w * 2 + (t >> 2)][t & 3] * sc) << (4 * t);
                    wd4[w] = acc4; }
                unsigned char* dst4 = tb ? ws + WS_VTAB + (size_t)e * 512 + fr * 32 : ws + WS_UTAB + (size_t)e * 512 + (2 * sp) * 64 + kq * 16;
#pragma unroll
                for (int p = 0; p < 2; ++p) { v4u o; o.x = wd4[4 * p]; o.y = wd4[4 * p + 1]; o.z = wd4[4 * p + 2]; o.w = wd4[4 * p + 3]; *(GAS v4u*)(dst4 + p * (tb ? 16 : 64)) = o; }
                continue; }
            unsigned wd[12];
#pragma unroll
            for (int h = 0; h < 4; ++h) {
                unsigned cd[16];
#pragma unroll
                for (int q4 = 0; q4 < 4; ++q4)
#pragma unroll
                    for (int t = 0; t < 4; ++t) cd[q4 * 4 + t] = fp6_code(v[h * 4 + q4][t] * sc);
                wd[h * 3 + 0] = cd[0] | (cd[1] << 6) | (cd[2] << 12) | (cd[3] << 18) | (cd[4] << 24) | ((cd[5] & 3u) << 30);
                wd[h * 3 + 1] = (cd[5] >> 2) | (cd[6] << 4) | (cd[7] << 10) | (cd[8] << 16) | (cd[9] << 22) | ((cd[10] & 15u) << 28);
                wd[h * 3 + 2] = (cd[10] >> 4) | (cd[11] << 2) | (cd[12] << 8) | (cd[13] << 14) | (cd[14] << 20) | (cd[15] << 26); }
            unsigned char* dst = ws + WS_UTAB + (size_t)e * 768 + kq * 16;
#pragma unroll
            for (int p = 0; p < 3; ++p) { v4u o; o.x = wd[4 * p]; o.y = wd[4 * p + 1]; o.z = wd[4 * p + 2]; o.w = wd[4 * p + 3]; *(GAS v4u*)(dst + (3 * sp + p) * 64) = o; } } }
#endif
      const GAS f32x4* ms = (const GAS f32x4*)P.in[1]; GAS unsigned* md = (GAS unsigned*)(ws + WS_MEMF8);
      for (size_t i = gt; i < (size_t)512 * 1024 / 4; i += NTH) { const f32x4 a = ms[i]; md[i] = pk4_fp8(a.x, a.y, a.z, a.w); }
    }
}

constexpr int FFT_PITCH = 544, FFT_BUF = 128 * FFT_PITCH;
static_assert(2 * FFT_BUF <= MISC_OFF, "FFT LDS map");
typedef short s16x4 __attribute__((ext_vector_type(4)));
__device__ __forceinline__ s16x4 tr_read(LAS unsigned char* p) { return __builtin_amdgcn_ds_read_tr16_b64_v4i16((LAS s16x4*)p); }
template <int STEP>
__device__ __forceinline__ void fft_step_mfma(const bf16* src, bf16* dst, LAS unsigned char* lds, int tid, int lane, int wave, int G) {
    const int fr = lane & 15, kq = lane >> 4, kout = 16 * wave + fr;
    bf16x8 cf[4], sf[4];
    { LAS float* tab = (LAS float*)(lds + FFT_BUF);
      __syncthreads();
      if (tid < 128) { float sn, cs; sincospif((float)tid / 64.f, &sn, &cs); tab[tid] = cs; tab[128 + tid] = sn; }
      __syncthreads();
#pragma unroll
      for (int kk = 0; kk < 4; ++kk) { v4u cw, sw; unsigned cl[8], sl[8];
#pragma unroll
          for (int j = 0; j < 8; ++j) { const int sv = 32 * kk + (j < 4 ? 4 * kq + j : 16 + 4 * kq + j - 4); const int ix = (kout * sv) & 127; cl[j] = f2bf(tab[ix]); sl[j] = f2bf(tab[128 + ix]); }
          cw.x = cl[0] | (cl[1] << 16); cw.y = cl[2] | (cl[3] << 16); cw.z = cl[4] | (cl[5] << 16); cw.w = cl[6] | (cl[7] << 16);
          sw.x = sl[0] | (sl[1] << 16); sw.y = sl[2] | (sl[3] << 16); sw.z = sl[4] | (sl[5] << 16); sw.w = sl[6] | (sl[7] << 16);
          cf[kk] = __builtin_bit_cast(bf16x8, cw); sf[kk] = __builtin_bit_cast(bf16x8, sw); } }
    v4u iw[8];
#define FFT_LOAD(UN) do { const int b_ = (UN) >> 9, f_ = ((UN) >> 2) & 127, g_ = (UN) & 3; _Pragma("unroll") for (int j = 0; j < 8; ++j) { const int c = tid + 512 * j; const int sr = c >> 5, piece = c & 31; \
            const size_t row = (STEP == 1) ? (size_t)(b_ << 14) + 128 * sr + f_ : (size_t)(b_ << 14) + 128 * f_ + sr; iw[j] = *(const GAS v4u*)(src + row * 1024 + g_ * 256 + piece * 8); } } while (0)
#define FFT_PUT(BUF) do { _Pragma("unroll") for (int j = 0; j < 8; ++j) { const int c = tid + 512 * j; *(LAS v4u*)(lds + (BUF) * FFT_BUF + (c >> 5) * FFT_PITCH + (c & 31) * 16) = iw[j]; } } while (0)
    __syncthreads();
    if (blockIdx.x < 1024) { FFT_LOAD(blockIdx.x); FFT_PUT(0); }
    __syncthreads();
    int cur = 0;
    for (int unit = blockIdx.x; unit < 1024; unit += G) {
        const int b = unit >> 9, f = (unit >> 2) & 127, g = unit & 3;
        const bool more = unit + G < 1024;
        if (more) FFT_LOAD(unit + G);
        LAS unsigned char* img = lds + cur * FFT_BUF;
        f32x4 accR[8], accI[8];
#pragma unroll
        for (int mt = 0; mt < 8; ++mt) { accR[mt] = (f32x4){0.f, 0.f, 0.f, 0.f}; accI[mt] = (f32x4){0.f, 0.f, 0.f, 0.f}; }
#pragma unroll
        for (int mt = 0; mt < 8; ++mt)
#pragma unroll
            for (int kk = 0; kk < 4; ++kk) {
                LAS unsigned char* a1 = img + (32 * kk + 4 * kq + (fr >> 2)) * FFT_PITCH + (16 * mt + 4 * (fr & 3)) * 2;
                LAS unsigned char* a2 = a1 + 16 * FFT_PITCH;
                const s16x4 r0 = tr_read(a1), r1 = tr_read(a2), i0 = tr_read(a1 + 256), i1 = tr_read(a2 + 256);
                const bf16x8 xr = __builtin_shufflevector(r0, r1, 0, 1, 2, 3, 4, 5, 6, 7), xi = __builtin_shufflevector(i0, i1, 0, 1, 2, 3, 4, 5, 6, 7);
                if (STEP == 1) {
                    v4u t = __builtin_bit_cast(v4u, xi); t.x ^= 0x80008000u; t.y ^= 0x80008000u; t.z ^= 0x80008000u; t.w ^= 0x80008000u; const bf16x8 nxi = __builtin_bit_cast(bf16x8, t);
                    accR[mt] = __builtin_amdgcn_mfma_f32_16x16x32_bf16(xr, cf[kk], accR[mt], 0, 0, 0); accR[mt] = __builtin_amdgcn_mfma_f32_16x16x32_bf16(nxi, sf[kk], accR[mt], 0, 0, 0);
                    accI[mt] = __builtin_amdgcn_mfma_f32_16x16x32_bf16(xi, cf[kk], accI[mt], 0, 0, 0); accI[mt] = __builtin_amdgcn_mfma_f32_16x16x32_bf16(xr, sf[kk], accI[mt], 0, 0, 0);
                } else {
                    accR[mt] = __builtin_amdgcn_mfma_f32_16x16x32_bf16(xr, cf[kk], accR[mt], 0, 0, 0); accR[mt] = __builtin_amdgcn_mfma_f32_16x16x32_bf16(xi, sf[kk], accR[mt], 0, 0, 0);
                }
                if (kk == 3) __builtin_amdgcn_sched_barrier(0);
            }
        if (STEP == 1) { float ws_, wc_; sincospif(-(float)(f * kout) / 8192.f, &ws_, &wc_);
            bf16* orow = dst + ((size_t)(b << 14) + kout * 128 + f) * 1024 + g * 256 + 4 * kq;
#pragma unroll
            for (int mt = 0; mt < 8; ++mt) { v2u re, im; re.x = pk2(accR[mt][0] * wc_ + accI[mt][0] * ws_, accR[mt][1] * wc_ + accI[mt][1] * ws_); re.y = pk2(accR[mt][2] * wc_ + accI[mt][2] * ws_, accR[mt][3] * wc_ + accI[mt][3] * ws_);
                im.x = pk2(accR[mt][0] * ws_ - accI[mt][0] * wc_, accR[mt][1] * ws_ - accI[mt][1] * wc_); im.y = pk2(accR[mt][2] * ws_ - accI[mt][2] * wc_, accR[mt][3] * ws_ - accI[mt][3] * wc_);
                *(GAS v2u*)(orow + 16 * mt) = re; *(GAS v2u*)(orow + 128 + 16 * mt) = im; }
        } else { const float scale = 6.905339660024878e-4f;
            bf16* orow = dst + ((size_t)(b << 14) + f + 128 * kout) * 512 + g * 128 + 4 * kq;
#pragma unroll
            for (int mt = 0; mt < 8; ++mt) { v2u re; re.x = pk2(accR[mt][0] * scale, accR[mt][1] * scale); re.y = pk2(accR[mt][2] * scale, accR[mt][3] * scale); *(GAS v2u*)(orow + 16 * mt) = re; }
        }
        if (more) FFT_PUT(cur ^ 1);
        __syncthreads();
        cur ^= 1;
    }
#undef FFT_LOAD
#undef FFT_PUT
}

typedef float f32x16 __attribute__((ext_vector_type(16)));
constexpr int DA_BT = 0, DA_K = 9216, DA_KP = 144, DA_V = DA_K + 384 * DA_KP, DA_VP = 776;
static_assert(DA_V + 64 * DA_VP <= MISC_OFF, "dil-attn LDS map");
template <int T>
__device__ __forceinline__ void dil_tile(LAS unsigned char* lds, int kr0, int r31, int hh, const LAS float* btl, const bf16x8 (&qf)[4], f32x16& o0, f32x16& o1, float& mx, float& den) {
    const LAS unsigned char* kp = lds + DA_K + (kr0 + r31) * DA_KP + 16 * hh;
    f32x16 sacc;
#pragma unroll
    for (int i = 0; i < 16; ++i) sacc[i] = 0.f;
#pragma unroll
    for (int kk = 0; kk < 4; ++kk) { const bf16x8 kf = *(const LAS bf16x8*)(kp + 32 * kk); sacc = __builtin_amdgcn_mfma_f32_32x32x16_bf16(kf, qf[kk], sacc, 0, 0, 0); }
    const LAS float* bl = btl + (32 + 32 * T + 4 * hh - r31);
    float tmax = -INFINITY;
#pragma unroll
    for (int i = 0; i < 16; ++i) { const int krow = (i & 3) + 8 * (i >> 2);
        float sv = sacc[i] * 0.18033688011112042f + bl[krow];
        if (T == 0) sv = (krow + 4 * hh >= r31) ? sv : -INFINITY;
        if (T == 4) sv = (krow + 4 * hh <= r31) ? sv : -INFINITY;
        sacc[i] = sv; tmax = fmaxf(tmax, sv); }
    tmax = fmaxf(tmax, __shfl_xor(tmax, 32));
    const float mn = fmaxf(mx, tmax), corr = __builtin_amdgcn_exp2f(mx - mn); mx = mn;
    float psum = 0.f;
#pragma unroll
    for (int i = 0; i < 16; ++i) { const float p = __builtin_amdgcn_exp2f(sacc[i] - mn); sacc[i] = p; psum += p; }
    den = den * corr + psum;
#pragma unroll
    for (int i = 0; i < 16; ++i) { o0[i] *= corr; o1[i] *= corr; }
#pragma unroll
    for (int s2 = 0; s2 < 2; ++s2) { v4u pw; pw.x = pk2(sacc[8 * s2], sacc[8 * s2 + 1]); pw.y = pk2(sacc[8 * s2 + 2], sacc[8 * s2 + 3]); pw.z = pk2(sacc[8 * s2 + 4], sacc[8 * s2 + 5]); pw.w = pk2(sacc[8 * s2 + 6], sacc[8 * s2 + 7]);
        const bf16x8 pf = __builtin_bit_cast(bf16x8, pw);
        const LAS unsigned char* vp = lds + DA_V + r31 * DA_VP + (kr0 + 16 * s2 + 4 * hh) * 2;
        const v2u lo0 = *(const LAS v2u*)vp, hi0 = *(const LAS v2u*)(vp + 16), lo1 = *(const LAS v2u*)(vp + 32 * DA_VP), hi1 = *(const LAS v2u*)(vp + 32 * DA_VP + 16);
        v4u w0, w1; w0.x = lo0.x; w0.y = lo0.y; w0.z = hi0.x; w0.w = hi0.y; w1.x = lo1.x; w1.y = lo1.y; w1.z = hi1.x; w1.w = hi1.y;
        o0 = __builtin_amdgcn_mfma_f32_32x32x16_bf16(__builtin_bit_cast(bf16x8, w0), pf, o0, 0, 0, 0);
        o1 = __builtin_amdgcn_mfma_f32_32x32x16_bf16(__builtin_bit_cast(bf16x8, w1), pf, o1, 0, 0, 0); }
}
__device__ __forceinline__ void dil_attn_lds(const bf16* qk, const bf16* vt, const float* btab_g, bf16* og, float* lse, LAS unsigned char* lds, int tid, int lane, int wave, int G) {
    LAS float* bt = (LAS float*)(lds + DA_BT);
    __syncthreads();
    for (int i = tid; i < 12 * 192; i += 512) { const int tb = i / 192, j = i - tb * 192 - 32; bt[i] = (j >= 0 && j <= 128) ? btab_g[tb * 132 + j] * 1.4426950408889634f : 0.f; }
    const int r31 = lane & 31, hh = lane >> 5;
    v4u kw[6], vw[6]; bf16x8 qn[4];
#define DIL_UNIT(U) const int blk = (U) & 63, hd = ((U) >> 6) & 3, g = ((U) >> 8) % 3, b = (U) / 768; const int sh = 2 * g, sub = 16384 >> sh; \
        const int nl0 = blk * 256, rr = nl0 >> (14 - sh), l0 = nl0 & (sub - 1); const size_t seq0 = ((size_t)g * NT + (size_t)(b << 14) + (size_t)rr * sub); \
        const bf16* qkg = qk + seq0 * 512; const bf16* vtg = vt + ((size_t)g * 256 + hd * 64) * NT + (size_t)(b << 14) + (size_t)rr * sub;
#define DIL_LOAD() do { _Pragma("unroll") for (int j = 0; j < 6; ++j) { const int c = tid + 512 * j; const int kr = c >> 3, pc = c & 7; const int lk = l0 - 64 + kr; const int lkc = lk < 0 ? 0 : (lk >= sub ? sub - 1 : lk); \
              kw[j] = *(const GAS v4u*)(qkg + (size_t)lkc * 512 + 256 + hd * 64 + pc * 8); \
              const int d = c / 48, pv = c - d * 48; const int lv = l0 - 64 + pv * 8; const int lvc = lv < 0 ? 0 : (lv >= sub ? sub - 8 : lv); \
              vw[j] = *(const GAS v4u*)(vtg + (size_t)d * NT + lvc); } \
          _Pragma("unroll") for (int kk = 0; kk < 4; ++kk) qn[kk] = *(const GAS bf16x8*)(qkg + (size_t)(l0 + 32 * wave + (lane & 31)) * 512 + hd * 64 + 16 * kk + 8 * (lane >> 5)); } while (0)
    if (blockIdx.x < 1536) { DIL_UNIT(blockIdx.x) DIL_LOAD(); }
    for (int u = blockIdx.x; u < 1536; u += G) {
        DIL_UNIT(u)
        __syncthreads();
#pragma unroll
        for (int j = 0; j < 6; ++j) { const int c = tid + 512 * j; const int kr = c >> 3, pc = c & 7;
            *(LAS v4u*)(lds + DA_K + kr * DA_KP + pc * 16) = kw[j];
            const int d = c / 48, pv = c - d * 48;
            v2u lo, hi; lo.x = vw[j].x; lo.y = vw[j].y; hi.x = vw[j].z; hi.y = vw[j].w;
            *(LAS v2u*)(lds + DA_V + d * DA_VP + pv * 16) = lo; *(LAS v2u*)(lds + DA_V + d * DA_VP + pv * 16 + 8) = hi; }
        __syncthreads();
        bf16x8 qf[4];
#pragma unroll
        for (int kk = 0; kk < 4; ++kk) qf[kk] = qn[kk];
        if (u + G < 1536) { const int un = u + G; const int blkn = un & 63, hdn = (un >> 6) & 3, gn = (un >> 8) % 3, bn = un / 768; const int shn = 2 * gn, subn = 16384 >> shn;
            const int nl0n = blkn * 256, rrn = nl0n >> (14 - shn), l0n = nl0n & (subn - 1); const size_t seq0n = ((size_t)gn * NT + (size_t)(bn << 14) + (size_t)rrn * subn);
            const bf16* qkgn = qk + seq0n * 512; const bf16* vtgn = vt + ((size_t)gn * 256 + hdn * 64) * NT + (size_t)(bn << 14) + (size_t)rrn * subn;
#pragma unroll
            for (int j = 0; j < 6; ++j) { const int c = tid + 512 * j; const int kr = c >> 3, pc = c & 7; const int lk = l0n - 64 + kr; const int lkc = lk < 0 ? 0 : (lk >= subn ? subn - 1 : lk);
                kw[j] = *(const GAS v4u*)(qkgn + (size_t)lkc * 512 + 256 + hdn * 64 + pc * 8);
                const int d = c / 48, pv = c - d * 48; const int lv = l0n - 64 + pv * 8; const int lvc = lv < 0 ? 0 : (lv >= subn ? subn - 8 : lv);
                vw[j] = *(const GAS v4u*)(vtgn + (size_t)d * NT + lvc); }
#pragma unroll
            for (int kk = 0; kk < 4; ++kk) qn[kk] = *(const GAS bf16x8*)(qkgn + (size_t)(l0n + 32 * wave + (lane & 31)) * 512 + hdn * 64 + 16 * kk + 8 * (lane >> 5)); }
        const int lq0 = l0 + 32 * wave;
        const LAS float* btl = bt + (g * 4 + hd) * 192;
        f32x16 o0, o1;
#pragma unroll
        for (int i = 0; i < 16; ++i) { o0[i] = 0.f; o1[i] = 0.f; }
        float mx = -1e30f, den = 0.f;
        if (lq0 - 64 >= 0) dil_tile<0>(lds, 32 * wave, r31, hh, btl, qf, o0, o1, mx, den);
        if (lq0 - 32 >= 0) dil_tile<1>(lds, 32 * wave + 32, r31, hh, btl, qf, o0, o1, mx, den);
        dil_tile<2>(lds, 32 * wave + 64, r31, hh, btl, qf, o0, o1, mx, den);
        if (lq0 + 32 < sub) dil_tile<3>(lds, 32 * wave + 96, r31, hh, btl, qf, o0, o1, mx, den);
        if (lq0 + 64 < sub) dil_tile<4>(lds, 32 * wave + 128, r31, hh, btl, qf, o0, o1, mx, den);
        den += __shfl_xor(den, 32);
        const float inv = 1.f / den;
        const size_t n = seq0 + lq0 + r31;
        bf16* orow = og + n * 256 + hd * 64 + 4 * hh;
#pragma unroll
        for (int q4 = 0; q4 < 4; ++q4) { v2u w0, w1; w0.x = pk2(o0[4 * q4] * inv, o0[4 * q4 + 1] * inv); w0.y = pk2(o0[4 * q4 + 2] * inv, o0[4 * q4 + 3] * inv);
            w1.x = pk2(o1[4 * q4] * inv, o1[4 * q4 + 1] * inv); w1.y = pk2(o1[4 * q4 + 2] * inv, o1[4 * q4 + 3] * inv);
            *(GAS v2u*)(orow + 8 * q4) = w0; *(GAS v2u*)(orow + 32 + 8 * q4) = w1; }
        if (hh == 0) lse[n * 4 + hd] = (mx + __builtin_amdgcn_logf(den)) * 0.6931471805599453f;
    }
    __syncthreads();
#undef DIL_UNIT
#undef DIL_LOAD
}
constexpr int MA_KP = 272, MA_VP = 520, MA_V = 256 * MA_KP;
static_assert(MA_V + 128 * MA_VP <= MISC_OFF, "mem-attn LDS map");
__device__ __forceinline__ void mem_attn_lds(const bf16* qc, const bf16* memk, const bf16* vtm, bf16* ycin, LAS unsigned char* lds, int tid, int lane, int wave, int G) {
    const int r31 = lane & 31, hh = lane >> 5;
    for (int wu = blockIdx.x; wu < 256; wu += G) {
        const int combo = wu & 7, b = combo >> 2, hd = combo & 3, chunk = wu >> 3;
        __syncthreads();
        { v4u kw[8], vw[8];
#pragma unroll
          for (int j = 0; j < 8; ++j) { const int c = tid + 512 * j; kw[j] = *(const GAS v4u*)(memk + (size_t)(b * 256 + (c >> 4)) * 512 + hd * 128 + (c & 15) * 8);
              vw[j] = *(const GAS v4u*)(vtm + (size_t)(hd * 128 + (c >> 5)) * 512 + b * 256 + (c & 31) * 8); }
#pragma unroll
          for (int j = 0; j < 8; ++j) { const int c = tid + 512 * j; *(LAS v4u*)(lds + (c >> 4) * MA_KP + (c & 15) * 16) = kw[j];
              v2u lo, hi; lo.x = vw[j].x; lo.y = vw[j].y; hi.x = vw[j].z; hi.y = vw[j].w;
              *(LAS v2u*)(lds + MA_V + (c >> 5) * MA_VP + (c & 31) * 16) = lo; *(LAS v2u*)(lds + MA_V + (c >> 5) * MA_VP + (c & 31) * 16 + 8) = hi; } }
        __syncthreads();
#pragma unroll 1
        for (int qi = 0; qi < 2; ++qi) {
            const int blk = chunk * 16 + wave * 2 + qi;
            const size_t tok = (size_t)(b << 14) + blk * 32 + r31;
            const bf16* qrow = qc + tok * 512 + hd * 128 + 8 * hh;
            bf16x8 qf[8];
#pragma unroll
            for (int kk = 0; kk < 8; ++kk) qf[kk] = *(const GAS bf16x8*)(qrow + 16 * kk);
            f32x16 o[4];
#pragma unroll
            for (int mt = 0; mt < 4; ++mt)
#pragma unroll
                for (int i = 0; i < 16; ++i) o[mt][i] = 0.f;
            float mx = -1e30f, den = 0.f;
            const LAS unsigned char* kb = lds + r31 * MA_KP + 16 * hh;
            const LAS unsigned char* vb = lds + MA_V + r31 * MA_VP + 8 * hh;
#pragma unroll 1
            for (int t = 0; t < 8; ++t) {
                f32x16 sacc;
#pragma unroll
                for (int i = 0; i < 16; ++i) sacc[i] = 0.f;
#pragma unroll
                for (int kk = 0; kk < 8; ++kk) { const bf16x8 kf = *(const LAS bf16x8*)(kb + (32 * t) * MA_KP + 32 * kk); sacc = __builtin_amdgcn_mfma_f32_32x32x16_bf16(kf, qf[kk], sacc, 0, 0, 0); }
                float tmax = -INFINITY;
#pragma unroll
                for (int i = 0; i < 16; ++i) { sacc[i] *= 0.08838834764831845f; tmax = fmaxf(tmax, sacc[i]); }
                tmax = fmaxf(tmax, __shfl_xor(tmax, 32));
                const float mn = fmaxf(mx, tmax), corr = __expf(mx - mn); mx = mn;
                float psum = 0.f;
#pragma unroll
                for (int i = 0; i < 16; ++i) { const float p = __expf(sacc[i] - mn); sacc[i] = p; psum += p; }
                den = den * corr + psum;
#pragma unroll
                for (int mt = 0; mt < 4; ++mt)
#pragma unroll
                    for (int i = 0; i < 16; ++i) o[mt][i] *= corr;
#pragma unroll
                for (int s2 = 0; s2 < 2; ++s2) { v4u pw; pw.x = pk2(sacc[8 * s2], sacc[8 * s2 + 1]); pw.y = pk2(sacc[8 * s2 + 2], sacc[8 * s2 + 3]); pw.z = pk2(sacc[8 * s2 + 4], sacc[8 * s2 + 5]); pw.w = pk2(sacc[8 * s2 + 6], sacc[8 * s2 + 7]);
                    const bf16x8 pf = __builtin_bit_cast(bf16x8, pw);
#pragma unroll
                    for (int mt = 0; mt < 4; ++mt) { const LAS unsigned char* vp = vb + (32 * mt) * MA_VP + (32 * t + 16 * s2) * 2;
                        const v2u lo = *(const LAS v2u*)vp, hi = *(const LAS v2u*)(vp + 16);
                        v4u w; w.x = lo.x; w.y = lo.y; w.z = hi.x; w.w = hi.y;
                        o[mt] = __builtin_amdgcn_mfma_f32_32x32x16_bf16(__builtin_bit_cast(bf16x8, w), pf, o[mt], 0, 0, 0); } }
            }
            den += __shfl_xor(den, 32);
            const float inv = 1.f / den;
            unsigned char* orow = (unsigned char*)ycin + tok * 512 + hd * 128 + 4 * hh; const float inv4 = inv * SC_ACT;
#pragma unroll
            for (int mt = 0; mt < 4; ++mt)
#pragma unroll
                for (int q4 = 0; q4 < 4; ++q4) *(GAS unsigned*)(orow + 32 * mt + 8 * q4) = pk4_fp8(o[mt][4 * q4] * inv4, o[mt][4 * q4 + 1] * inv4, o[mt][4 * q4 + 2] * inv4, o[mt][4 * q4 + 3] * inv4);
        }
    }
    __syncthreads();
}
__device__ __forceinline__ void combine_groups(const bf16* og, const float* lse, bf16* ob, int tid, int G) {
    for (size_t idx = (size_t)blockIdx.x * 512 + tid; idx < (size_t)NT * 32; idx += (size_t)G * 512) {
        const int t = (int)(idx >> 5), ch = (int)(idx & 31), h = ch >> 3, d0 = (ch & 7) * 8, b = t >> 14, s = t & 16383;
        float l[3]; size_t n[3];
#pragma unroll
        for (int g = 0; g < 3; ++g) { const int sh = 2 * g; n[g] = (size_t)(b << 14) + (size_t)(s & ((1 << sh) - 1)) * (16384 >> sh) + (s >> sh); l[g] = lse[((size_t)g * NT + n[g]) * 4 + h]; }
        const float mx = fmaxf(l[0], fmaxf(l[1], l[2])); float w[3], sum = 0.f;
#pragma unroll
        for (int g = 0; g < 3; ++g) { w[g] = __expf(l[g] - mx); sum += w[g]; }
        float o[8] = {0, 0, 0, 0, 0, 0, 0, 0};
#pragma unroll
        for (int g = 0; g < 3; ++g) { const float wg = w[g] / sum; const v4u v = *(const GAS v4u*)(og + ((size_t)g * NT + n[g]) * 256 + h * 64 + d0);
            o[0] += wg * bflo(v.x); o[1] += wg * bfhi(v.x); o[2] += wg * bflo(v.y); o[3] += wg * bfhi(v.y); o[4] += wg * bflo(v.z); o[5] += wg * bfhi(v.z); o[6] += wg * bflo(v.w); o[7] += wg * bfhi(v.w); }
        v2u r; r.x = pk4_fp8(o[0] * SC_ACT, o[1] * SC_ACT, o[2] * SC_ACT, o[3] * SC_ACT); r.y = pk4_fp8(o[4] * SC_ACT, o[5] * SC_ACT, o[6] * SC_ACT, o[7] * SC_ACT);
        *(GAS v2u*)((unsigned char*)ob + (size_t)t * 256 + h * 64 + d0) = r;
    }
}

template <int C> __device__ __forceinline__ unsigned dppu(unsigned v) { return (unsigned)__builtin_amdgcn_update_dpp(0, (int)v, C, 0xF, 0xF, true); }
template <int C> __device__ __forceinline__ float dppf(float v) { return __builtin_bit_cast(float, __builtin_amdgcn_update_dpp(0, __builtin_bit_cast(int, v), C, 0xF, 0xF, true)); }
__device__ __forceinline__ unsigned umax2(unsigned a, unsigned b) { return a > b ? a : b; }
__device__ __forceinline__ unsigned row_max_u(unsigned v) { v = umax2(v, dppu<0xB1>(v)); v = umax2(v, dppu<0x4E>(v)); v = umax2(v, dppu<0x141>(v)); v = umax2(v, dppu<0x140>(v)); return v; }
__device__ __forceinline__ float row_max_f(float v) { v = fmaxf(v, dppf<0xB1>(v)); v = fmaxf(v, dppf<0x4E>(v)); v = fmaxf(v, dppf<0x141>(v)); v = fmaxf(v, dppf<0x140>(v)); return v; }
__device__ __forceinline__ float row_sum_f(float v) { v += dppf<0xB1>(v); v += dppf<0x4E>(v); v += dppf<0x141>(v); v += dppf<0x140>(v); return v; }
__device__ __forceinline__ unsigned ordf(float f) { const unsigned b = __builtin_bit_cast(unsigned, f); return b ^ ((unsigned)((int)b >> 31) | 0x80000000u); }
__device__ __forceinline__ float decf(unsigned k) { const unsigned b = (k & 0x80000000u) ? (k ^ 0x80000000u) : ~k; return __builtin_bit_cast(float, b); }
__device__ __forceinline__ unsigned bperm(unsigned v, int src_lane) { return (unsigned)__builtin_amdgcn_ds_bpermute(src_lane * 4, (int)v); }
typedef __bf16 bf16x2_t __attribute__((ext_vector_type(2)));
__device__ __forceinline__ float dot2bf(unsigned a, unsigned b, float c) { return __builtin_amdgcn_fdot2_f32_bf16(__builtin_bit_cast(bf16x2_t, a), __builtin_bit_cast(bf16x2_t, b), c, false); }

__device__ __forceinline__ float gelu_as(float v) {
    const float av = fabsf(v), t = __builtin_amdgcn_rcpf(av * 0.2316418882f + 1.0f);
    float q = t * 0.5307027145f + (-0.7265760135f); q = q * t + 0.7107068705f; q = q * t + (-0.142248368f); q = q * t + 0.127414796f; q = q * t;
    const float e = __builtin_amdgcn_exp2f((v * v) * (-0.72134752044f));
    const float m = v * (q * e);
    return v < 0.f ? m : v - m;
}
constexpr int PEER_SKB = 0, PEER_EL = 36864, PEER_PTAB = PEER_EL + 32768, PEER_VB = PEER_PTAB + 256, PEER_XA = PEER_VB + 8 * 8192, PEER_WB = PEER_XA + 8 * 1024;
static_assert(PEER_WB + 8 * 64 <= MISC_OFF, "PEER LDS map");
constexpr float PEER_XS = 32.f, PEER_WS = 32.f;
typedef int v8i_p __attribute__((ext_vector_type(8)));
typedef int v2i __attribute__((ext_vector_type(2)));
__device__ __forceinline__ void peer_scores_top16(const bf16* qp, LAS unsigned char* lds, int tokb, int hf, int fr, int fq, unsigned& o0, unsigned& o1, unsigned& o2, unsigned& o3) {
    const bf16* arow = qp + (size_t)(tokb + (fr >> 3)) * 1024 + (fr & 7) * 128 + hf * 64 + 8 * fq;
    const bf16x8 a0 = *(const GAS bf16x8*)arow, a1 = *(const GAS bf16x8*)(arow + 32);
    unsigned e0[8], e1[8], e2[8], e3[8];
#pragma unroll
    for (int nb = 0; nb < 8; ++nb) {
        const LAS unsigned char* bp = lds + PEER_SKB + hf * 18432 + (fr + 16 * nb) * 144 + fq * 16;
        const bf16x8 b0 = *(const LAS bf16x8*)bp, b1 = *(const LAS bf16x8*)(bp + 64);
        f32x4 acc = (f32x4){0.f, 0.f, 0.f, 0.f};
        acc = __builtin_amdgcn_mfma_f32_16x16x32_bf16(a0, b0, acc, 0, 0, 0);
        acc = __builtin_amdgcn_mfma_f32_16x16x32_bf16(a1, b1, acc, 0, 0, 0);
        const unsigned ix = (unsigned)(127 - (fr + 16 * nb));
        e0[nb] = (ordf(acc[0]) & ~127u) | ix; e1[nb] = (ordf(acc[1]) & ~127u) | ix; e2[nb] = (ordf(acc[2]) & ~127u) | ix; e3[nb] = (ordf(acc[3]) & ~127u) | ix;
    }
    o0 = 0u; o1 = 0u; o2 = 0u; o3 = 0u;
#define PEER_CE(E, A, B) do { const unsigned hi_ = umax2(E[A], E[B]), lo_ = E[A] < E[B] ? E[A] : E[B]; E[A] = hi_; E[B] = lo_; } while (0)
#define PEER_SORT8(E) do { PEER_CE(E, 0, 1); PEER_CE(E, 2, 3); PEER_CE(E, 4, 5); PEER_CE(E, 6, 7); PEER_CE(E, 0, 2); PEER_CE(E, 1, 3); PEER_CE(E, 4, 6); PEER_CE(E, 5, 7); PEER_CE(E, 1, 2); PEER_CE(E, 5, 6); \
        PEER_CE(E, 0, 4); PEER_CE(E, 1, 5); PEER_CE(E, 2, 6); PEER_CE(E, 3, 7); PEER_CE(E, 2, 4); PEER_CE(E, 3, 5); PEER_CE(E, 1, 2); PEER_CE(E, 3, 4); PEER_CE(E, 5, 6); } while (0)
#define PEER_ROUND(E, O) do { const unsigned m = row_max_u(E[0]); const bool win = (E[0] == m); \
        E[0] = win ? E[1] : E[0]; E[1] = win ? E[2] : E[1]; E[2] = win ? E[3] : E[2]; E[3] = win ? E[4] : E[3]; E[4] = win ? E[5] : E[4]; E[5] = win ? E[6] : E[5]; E[6] = win ? E[7] : E[6]; E[7] = win ? 0u : E[7]; \
        O = (fr == r) ? m : O; } while (0)
    PEER_SORT8(e0); PEER_SORT8(e1); PEER_SORT8(e2); PEER_SORT8(e3);
#pragma unroll 1
    for (int r = 0; r < 16; ++r) { PEER_ROUND(e0, o0); PEER_ROUND(e1, o1); PEER_ROUND(e2, o2); PEER_ROUND(e3, o3); }
#undef PEER_ROUND
#undef PEER_SORT8
#undef PEER_CE
}
__device__ __forceinline__ void peer_cand(LAS unsigned char* lds, LAS unsigned char* el, unsigned ptab, unsigned L1, unsigned L2, int lane, int fr, int slot) {
    unsigned c0, c1, c2, c3;
#define PEER_CK(SL, C) do { const unsigned byte = (ptab >> (8 * SL)) & 255u; const int a = byte >> 4, b = byte & 15; \
        const unsigned k1 = bperm(L1, (lane & 48) + a), k2 = bperm(L2, (lane & 48) + b); const float sum = decf(k1 & ~127u) + decf(k2 & ~127u); \
        C = (byte != 255u) ? ((ordf(sum) & ~63u) | (unsigned)(fr * 4 + SL)) : 0u; } while (0)
    PEER_CK(0, c0); PEER_CK(1, c1); PEER_CK(2, c2); PEER_CK(3, c3);
#undef PEER_CK
    unsigned co = 0u;
#define PEER_CE2(A, B) do { const unsigned hi_ = umax2(A, B), lo_ = A < B ? A : B; A = hi_; B = lo_; } while (0)
    PEER_CE2(c0, c1); PEER_CE2(c2, c3); PEER_CE2(c0, c2); PEER_CE2(c1, c3); PEER_CE2(c1, c2);
#undef PEER_CE2
#pragma unroll 1
    for (int r = 0; r < 16; ++r) { const unsigned m = row_max_u(c0); const bool win = (c0 == m);
        c0 = win ? c1 : c0; c1 = win ? c2 : c1; c2 = win ? c3 : c2; c3 = win ? 0u : c3;
        co = (fr == r) ? m : co; }
    const unsigned pb = *(LAS unsigned char*)(lds + PEER_PTAB + (co & 63u));
    const unsigned k1 = bperm(L1, (lane & 48) + (int)(pb >> 4)), k2 = bperm(L2, (lane & 48) + (int)(pb & 15u));
    const unsigned expert = (127u - (k1 & 127u)) * 128u + (127u - (k2 & 127u));
    const float sc = decf(co & ~63u);
    const float ex = __expf(sc - row_max_f(sc));
    const float gate = ex / row_sum_f(ex);
    v2u rec; rec.x = expert; rec.y = __builtin_bit_cast(unsigned, gate);
    *(LAS v2u*)(el + slot * 8) = rec;
}
template <int sh>
__device__ __forceinline__ void peer_regroup16(const LAS unsigned char* src, LAS unsigned char* dst, int lane, int fr) {
    v2u rc[8]; unsigned c0 = 0u, c1 = 0u, c2 = 0u, c3 = 0u;
#pragma unroll
    for (int j = 0; j < 8; ++j) { rc[j] = *(const LAS v2u*)(src + (fr * 8 + j) * 8); const unsigned bk = (rc[j].x >> sh) & 15u, one = 1u << (8 * (bk & 3u)), w = bk >> 2;
        c0 += (w == 0u) ? one : 0u; c1 += (w == 1u) ? one : 0u; c2 += (w == 2u) ? one : 0u; c3 += (w == 3u) ? one : 0u; }
    unsigned i0 = c0, i1 = c1, i2 = c2, i3 = c3;
    i0 += dppu<0x111>(i0); i1 += dppu<0x111>(i1); i2 += dppu<0x111>(i2); i3 += dppu<0x111>(i3);
    i0 += dppu<0x112>(i0); i1 += dppu<0x112>(i1); i2 += dppu<0x112>(i2); i3 += dppu<0x112>(i3);
    i0 += dppu<0x114>(i0); i1 += dppu<0x114>(i1); i2 += dppu<0x114>(i2); i3 += dppu<0x114>(i3);
    i0 += dppu<0x118>(i0); i1 += dppu<0x118>(i1); i2 += dppu<0x118>(i2); i3 += dppu<0x118>(i3);
    const int l15 = (lane & 48) + 15;
    const unsigned t0 = bperm(i0, l15), t1 = bperm(i1, l15), t2 = bperm(i2, l15), t3 = bperm(i3, l15);
    const unsigned s0 = (t0 * 0x01010101u) >> 24, s1 = (t1 * 0x01010101u) >> 24, s2 = (t2 * 0x01010101u) >> 24;
    unsigned p0 = (i0 - c0) + (t0 * 0x01010100u), p1 = (i1 - c1) + (t1 * 0x01010100u) + s0 * 0x01010101u, p2 = (i2 - c2) + (t2 * 0x01010100u) + (s0 + s1) * 0x01010101u,
             p3 = (i3 - c3) + (t3 * 0x01010100u) + (s0 + s1 + s2) * 0x01010101u;
#pragma unroll
    for (int j = 0; j < 8; ++j) { const unsigned bk = (rc[j].x >> sh) & 15u, q8 = 8 * (bk & 3u), w = bk >> 2, one = 1u << q8;
        const unsigned pw = (w == 0u) ? p0 : ((w == 1u) ? p1 : ((w == 2u) ? p2 : p3));
        *(LAS v2u*)(dst + ((pw >> q8) & 255u) * 8) = rc[j];
        p0 += (w == 0u) ? one : 0u; p1 += (w == 1u) ? one : 0u; p2 += (w == 2u) ? one : 0u; p3 += (w == 3u) ? one : 0u; }
}
__device__ __forceinline__ void peer_v2(const Ptrs& P, LAS unsigned char* lds, int tid, int lane, int wave, int G) {
    unsigned char* ws = P.ws;
    const bf16* qp = (const bf16*)(ws + WS_QP); const bf16* utab = (const bf16*)(ws + WS_UTAB); const bf16* vtab = (const bf16*)(ws + WS_VTAB);
    const bf16* h1b = (const bf16*)(ws + WS_H1B);
    const int fr = lane & 15, fq = lane >> 4;
    for (int idx = tid; idx < 2 * 128 * 32; idx += 512) { const int hf = idx >> 12, k = (idx >> 5) & 127, c2 = idx & 31; const float* sk = (hf ? P.in[16] : P.in[15]) + k * 64 + c2 * 2;
        *(LAS unsigned*)(lds + PEER_SKB + hf * 18432 + k * 144 + c2 * 4) = pk2(sk[0], sk[1]); }
    if (tid < 64) { int q = 0, a = 0, b = 0; unsigned char val = 0xFF;
        for (a = 0; a < 16 && val == 0xFF; ++a) for (b = 0; b < 16 && (a + 1) * (b + 1) <= 16; ++b) { if (q == tid) { val = (unsigned char)((a << 4) | b); break; } ++q; }
        *(LAS unsigned char*)(lds + PEER_PTAB + tid) = val; }
    __syncthreads();
    LAS unsigned char* el = lds + PEER_EL + wave * 4096;
    const int lane_k = lane;
    for (int tile = blockIdx.x; tile < NT / 32; tile += G) {
        const int lane = (int)opq((unsigned)lane_k), fr = lane & 15, fq = lane >> 4; const unsigned ptab = *(LAS unsigned*)(lds + PEER_PTAB + fr * 4);
        const int tok0 = tile * 32 + wave * 4;
#pragma unroll 1
        for (int mt = 0; mt < 2; ++mt) {
            unsigned L00, L01, L02, L03, L10, L11, L12, L13;
            peer_scores_top16(qp, lds, tok0 + 2 * mt, 0, fr, fq, L00, L01, L02, L03);
            peer_scores_top16(qp, lds, tok0 + 2 * mt, 1, fr, fq, L10, L11, L12, L13);
            peer_cand(lds, el, ptab, L00, L10, lane, fr, (2 * mt + (fq >> 1)) * 128 + ((fq & 1) * 4 + 0) * 16 + fr);
            peer_cand(lds, el, ptab, L01, L11, lane, fr, (2 * mt + (fq >> 1)) * 128 + ((fq & 1) * 4 + 1) * 16 + fr);
            peer_cand(lds, el, ptab, L02, L12, lane, fr, (2 * mt + (fq >> 1)) * 128 + ((fq & 1) * 4 + 2) * 16 + fr);
            peer_cand(lds, el, ptab, L03, L13, lane, fr, (2 * mt + (fq >> 1)) * 128 + ((fq & 1) * 4 + 3) * 16 + fr);
        }
        asm volatile("s_waitcnt lgkmcnt(0)" ::: "memory");
        LAS unsigned char* vb = lds + PEER_VB + wave * 8192;
        __builtin_amdgcn_sched_barrier(0);
        peer_regroup16<6>(el + fq * 1024, vb + fq * 1024, lane, fr);
        asm volatile("s_waitcnt lgkmcnt(0)" ::: "memory"); __builtin_amdgcn_sched_barrier(0);
        peer_regroup16<10>(vb + fq * 1024, el + fq * 1024, lane, fr);
        asm volatile("s_waitcnt lgkmcnt(0)" ::: "memory"); __builtin_amdgcn_sched_barrier(0);
        const unsigned char* u6 = (const unsigned char*)utab; const unsigned char* v6 = (const unsigned char*)vtab;
        LAS unsigned char* xal = lds + PEER_XA + wave * 1024; LAS unsigned char* wbl = lds + PEER_WB + wave * 64;
        const unsigned trofs = (unsigned)((fq >> 1) * 256 + fr * 16 + (fq & 1) * 8);
        const int awg = 2 * (fr >> 2) + (fr & 3);
        const bool aw0 = ((fr & 3) < 2) && (awg == fq), aw1 = ((fr & 3) < 2) && (awg == fq + 4);
#define PEER_ULOAD(U, E) do { const unsigned char* up_ = u6 + (size_t)(E) * 512 + fq * 16; \
            _Pragma("unroll") for (int m = 0; m < 8; ++m) U[m] = *(const GAS v4u*)(up_ + m * 64); } while (0)
#define PEER_VDMA(E) do { const unsigned char* vp_ = v6 + (size_t)(E) * 512 + fq * 16; \
            _Pragma("unroll") for (int c = 0; c < 8; ++c) asm volatile("s_mov_b32 m0, %1\n\ts_nop 0\n\tglobal_load_lds_dwordx4 %0, off" :: "v"(vp_ + c * 64), "s"(vbaddr + (unsigned)c * 1024u) : "memory"); } while (0)
        const unsigned vbaddr = (unsigned)__builtin_amdgcn_readfirstlane((int)(unsigned)(size_t)vb);
#pragma unroll 1
        for (int tq = 0; tq < 4; ++tq) {
            const int tok = tok0 + tq; const int lane_t = (int)opq((unsigned)lane);
            const LAS unsigned char* recp = el + (tq * 128 + fr) * 8;
            unsigned e_cur = *(const LAS unsigned*)recp; float g_cur = *(const LAS float*)(recp + 4);
            v4u ub[8], ub2[8];
            asm volatile("s_waitcnt lgkmcnt(0)" ::: "memory");
            PEER_ULOAD(ub, e_cur);
            PEER_VDMA(e_cur);
            float xn[16];
            { const bf16* prow = (const bf16*)(ws + WS_H0) + (size_t)tok * 1024 + lane_t * 16;
              const GAS f32x4* sp = (const GAS f32x4*)((const float*)(ws + WS_STATS4) + (size_t)tok * 8); const f32x4 sa = sp[0], sb = sp[1];
              f32x2 st; st.x = ((sa.x + sa.z) + sb.x) + sb.z; st.y = ((sa.y + sa.w) + sb.y) + sb.w;
              const float mean1 = st.x * (1.f / D), rstd1 = 1.f / sqrtf(fmaxf(st.y * (1.f / D) - mean1 * mean1, 0.f) + LN_EPS);
#pragma unroll
              for (int q8 = 0; q8 < 2; ++q8) { const v4u pw = *(const GAS v4u*)(prow + q8 * 8); f32x4 pa, pb2; unpack8(pw, pa, pb2);
#pragma unroll
                for (int hq = 0; hq < 2; ++hq) { const int q4 = q8 * 2 + hq; const f32x4 pv = hq ? pb2 : pa;
                    const f32x4 gv = *(const GAS f32x4*)(P.in[12] + lane_t * 16 + q4 * 4), bv = *(const GAS f32x4*)(P.in[13] + lane_t * 16 + q4 * 4);
                    const f32x4 xv = (pv - mean1) * rstd1 * gv + bv;
                    xn[q4 * 4] = xv.x; xn[q4 * 4 + 1] = xv.y; xn[q4 * 4 + 2] = xv.z; xn[q4 * 4 + 3] = xv.w; } } }
            { v4u xq;
#pragma unroll
              for (int c = 0; c < 4; ++c) xq[c] = pk4_fp8(__builtin_amdgcn_fmed3f(xn[4 * c] * PEER_XS, -448.f, 448.f), __builtin_amdgcn_fmed3f(xn[4 * c + 1] * PEER_XS, -448.f, 448.f),
                                                          __builtin_amdgcn_fmed3f(xn[4 * c + 2] * PEER_XS, -448.f, 448.f), __builtin_amdgcn_fmed3f(xn[4 * c + 3] * PEER_XS, -448.f, 448.f));
              *(LAS v4u*)(xal + lane * 16) = xq; }
            unsigned xnb[8];
#pragma unroll
            for (int i = 0; i < 8; ++i) xnb[i] = pk2(xn[2 * i], xn[2 * i + 1]);
            asm volatile("s_waitcnt lgkmcnt(0)" ::: "memory");
            f32x4 yacc[8];
#pragma unroll
            for (int m = 0; m < 8; ++m) yacc[m] = (f32x4){0.f, 0.f, 0.f, 0.f};
#define PEER_BATCH(BI, UC, UN, HASNEXT) do { \
                unsigned e_nx = e_cur; float g_nx = g_cur; \
                if (HASNEXT) { e_nx = *(const LAS unsigned*)(recp + ((BI) + 1) * 128); g_nx = *(const LAS float*)(recp + ((BI) + 1) * 128 + 4); PEER_ULOAD(UN, e_nx); } \
                f32x4 acc = (f32x4){0.f, 0.f, 0.f, 0.f}; \
                const unsigned xo = opq((unsigned)fq * 16u);              \
                _Pragma("unroll") for (int s = 0; s < 8; ++s) { v8i_p bu, xs; \
                    bu[0] = (int)UC[s].x; bu[1] = (int)UC[s].y; bu[2] = (int)UC[s].z; bu[3] = (int)UC[s].w; bu[4] = 0; bu[5] = 0; bu[6] = 0; bu[7] = 0; \
                    const v4u lo = *(const LAS v4u*)(xal + xo + s * 128), hi = *(const LAS v4u*)(xal + xo + s * 128 + 64);         \
                    xs[0] = (int)lo.x; xs[1] = (int)lo.y; xs[2] = (int)lo.z; xs[3] = (int)lo.w; xs[4] = (int)hi.x; xs[5] = (int)hi.y; xs[6] = (int)hi.z; xs[7] = (int)hi.w; \
                    acc = __builtin_amdgcn_mfma_scale_f32_16x16x128_f8f6f4(xs, bu, acc, 0, 4, 0, 0x7F7F7F7F, 0, 0x7F7F7F7F); } \
                const float h = acc[0] * (1.f / (PEER_XS * FP4_SU)); \
                const float wq = __builtin_amdgcn_fmed3f(g_cur * gelu_as(h) * PEER_WS, -448.f, 448.f); \
                *(LAS unsigned char*)(wbl + fr) = (unsigned char)(pk4_fp8(wq, 0.f, 0.f, 0.f) & 255u); \
                asm volatile("s_waitcnt lgkmcnt(0)" ::: "memory"); \
                const v4u W = *(const LAS v4u*)wbl; \
                v8i_p aw; aw[0] = aw0 ? (int)W.x : 0; aw[1] = aw0 ? (int)W.y : 0; aw[2] = aw0 ? (int)W.z : 0; aw[3] = aw0 ? (int)W.w : 0; \
                aw[4] = aw1 ? (int)W.x : 0; aw[5] = aw1 ? (int)W.y : 0; aw[6] = aw1 ? (int)W.z : 0; aw[7] = aw1 ? (int)W.w : 0; \
                if (HASNEXT) asm volatile("s_waitcnt vmcnt(8)" ::: "memory"); else asm volatile("s_waitcnt vmcnt(0)" ::: "memory");        \
                _Pragma("unroll") for (int m = 0; m < 8; ++m) { const v2i t0 = __builtin_amdgcn_ds_read_tr4_b64_v2i32((LAS v2i*)(vb + m * 1024 + trofs)), t1 = __builtin_amdgcn_ds_read_tr4_b64_v2i32((LAS v2i*)(vb + m * 1024 + 512 + trofs)); \
                    v8i_p bv; bv[0] = t0[0]; bv[1] = t0[1]; bv[2] = t1[0]; bv[3] = t1[1]; bv[4] = 0; bv[5] = 0; bv[6] = 0; bv[7] = 0; \
                    yacc[m] = __builtin_amdgcn_mfma_scale_f32_16x16x128_f8f6f4(aw, bv, yacc[m], 0, 4, 0, 0x7F7F7F7F, 0, 0x7F7F7F7F); } \
                asm volatile("s_waitcnt lgkmcnt(0)" ::: "memory"); \
                if (HASNEXT) PEER_VDMA(e_nx); \
                e_cur = e_nx; g_cur = g_nx; } while (0)
#pragma unroll 1
            for (int bp = 0; bp < 3; ++bp) { PEER_BATCH(2 * bp, ub, ub2, 1); PEER_BATCH(2 * bp + 1, ub2, ub, 1); }
            PEER_BATCH(6, ub, ub2, 1); PEER_BATCH(7, ub2, ub, 0);
#undef PEER_BATCH
#pragma unroll
            for (int m = 0; m < 8; ++m) { *(LAS float*)(vb + m * 512 + lane * 4) = yacc[m][0]; *(LAS float*)(vb + m * 512 + 256 + lane * 4) = yacc[m][1]; }
            asm volatile("s_waitcnt lgkmcnt(0)" ::: "memory");
            float yv[16];
#pragma unroll
            for (int q4 = 0; q4 < 4; ++q4) { const f32x4 t = *(const LAS f32x4*)(vb + lane * 64 + q4 * 16); yv[q4 * 4] = t.x; yv[q4 * 4 + 1] = t.y; yv[q4 * 4 + 2] = t.z; yv[q4 * 4 + 3] = t.w; }
            asm volatile("s_waitcnt lgkmcnt(0)" ::: "memory");
            float ssum = 0.f;
#pragma unroll
            for (int i = 0; i < 16; ++i) { yv[i] = yv[i] * (1.f / (PEER_WS * FP4_SV)) + ALPHA * ((i & 1) ? bfhi(xnb[i >> 1]) : bflo(xnb[i >> 1])); ssum += yv[i]; }
            const float mean = wave_sum(ssum) * (1.f / D);
            float s2 = 0.f;
#pragma unroll
            for (int i = 0; i < 16; ++i) { yv[i] -= mean; s2 += yv[i] * yv[i]; }
            const float rstd = 1.f / sqrtf(wave_sum(s2) * (1.f / D) + LN_EPS);
            float* orow = P.out + (size_t)tok * 1024 + lane_t * 16;
#pragma unroll
            for (int q4 = 0; q4 < 4; ++q4) { const f32x4 g0 = *(const GAS f32x4*)(P.in[19] + lane_t * 16 + q4 * 4), b0 = *(const GAS f32x4*)(P.in[20] + lane_t * 16 + q4 * 4);
                f32x4 o; o.x = yv[q4 * 4] * rstd * g0.x + b0.x; o.y = yv[q4 * 4 + 1] * rstd * g0.y + b0.y; o.z = yv[q4 * 4 + 2] * rstd * g0.z + b0.z; o.w = yv[q4 * 4 + 3] * rstd * g0.w + b0.w;
                *(GAS f32x4*)(orow + q4 * 4) = o; }
        }
        asm volatile("s_waitcnt lgkmcnt(0)" ::: "memory");
    }
}

struct Args { const float* in[21]; float* out; unsigned char* ws; int ph_lo, ph_hi; };
__global__ void __launch_bounds__(NWAVES * 64, 2) fwd_kernel(Args args) {
    extern __shared__ __attribute__((aligned(16))) unsigned char lds_raw[];
    LAS unsigned char* lds = (LAS unsigned char*)lds_raw;
    volatile LAS unsigned* MISC = (volatile LAS unsigned*)(lds + MISC_OFF);
    const int tid = threadIdx.x, lane = tid & 63, wave = __builtin_amdgcn_readfirstlane(tid >> 6);
    const int G = gridDim.x;
    Ptrs P;
#pragma unroll
    for (int i = 0; i < 21; ++i) P.in[i] = args.in[i];
    P.out = args.out; P.ws = args.ws;
    unsigned char* ws = args.ws;
    if (tid < 16) MISC[tid] = 0u;
    __syncthreads();
    XcdBarrier bar; bar.bar = (unsigned*)(ws + WS_CTL) + 4096; bar.x = 0; bar.st = nullptr;
    if (N_LAUNCHES == 1) bar = xcd_barrier_post((unsigned*)(ws + WS_CTL) + 4096, MISC + 8);
    const int lo = args.ph_lo, hi = args.ph_hi;
#ifndef PHMASK
#define PHMASK 0x1ff
#endif
#define IN(k) (((PHMASK >> (k)) & 1) && lo <= (k) && (k) < hi)
#define SEAM(k) do { if (IN(k) && IN((k) + 1)) xcd_barrier(bar); } while (0)

    if (IN(0)) { phase0(P, lds, tid, lane, wave, G); } SEAM(0);

    if (IN(1)) {
        if (blockIdx.x < 4) { const int n = blockIdx.x * 256 + (tid & 255); const float* part = (const float*)(ws + WS_CPART) + (tid >> 8) * 16 * 1024; float a = 0.f;
#pragma unroll
            for (int kb = 0; kb < 16; ++kb) a += part[kb * 1024 + n];
            ((float*)(ws + ((tid >> 8) ? WS_DVEC : WS_CVEC)))[n] = a; }
        for (int i = tid; i < WR_GATE; i += 512) ((LAS float*)(lds + RING_BYTES))[i] = ((const float*)(ws + WS_BIASIN))[i];
        __syncthreads();
        SchedP1 S{(const char*)ws, G, (int)blockIdx.x};
        EpiP1 E{(bf16*)P.out, ws, lds + RING_BYTES};
        pg8::gemm_phase<EpiP1, SchedP1, 2>(lds, S, E);
    } SEAM(1);

    if (IN(2)) {
        fft_step_mfma<1>((const bf16*)P.out, (bf16*)P.out + (size_t)NT * 1024, lds, tid, lane, wave, G);
        dil_attn_lds((const bf16*)(ws + WS_QK), (const bf16*)(ws + WS_VT), (const float*)(ws + WS_BIASTAB), (bf16*)(ws + WS_OG), (float*)(ws + WS_LSE), lds, tid, lane, wave, G);
        mem_attn_lds((const bf16*)(ws + WS_QC), (const bf16*)(ws + WS_MEMKV), (const bf16*)(ws + WS_MEMKV) + 512 * 512, (bf16*)(ws + WS_YCIN), lds, tid, lane, wave, G);
    } SEAM(2);

    if (IN(3)) {
        fft_step_mfma<2>((const bf16*)P.out + (size_t)NT * 1024, (bf16*)(ws + WS_FA), lds, tid, lane, wave, G);
        combine_groups((const bf16*)(ws + WS_OG), (const float*)(ws + WS_LSE), (bf16*)(ws + WS_OB), tid, G);
    } SEAM(3);

    if (IN(4)) {
        SchedP4 S{(const char*)ws, G, (int)blockIdx.x};
        for (int i = tid; i < 3072; i += 512) ((LAS float*)(lds + RING_BYTES))[i] = ((const float*)(ws + WS_BIASIN))[WR_GATE + i];
        __syncthreads();
        EpiP4 E{(bf16*)(ws + WS_MERGED), lds + RING_BYTES};
        pg8::gemm_phase<EpiP4, SchedP4, 2>(lds, S, E);
    } SEAM(4);

    if (IN(5)) {
        SchedPlain S{(const char*)(ws + WS_MERGED), (const char*)(ws + WS_WTO), G, (int)blockIdx.x, K_WO};
        EpiP5 E{(bf16*)(ws + WS_H0), (float*)(ws + WS_PRELN), (float*)(ws + WS_STATS4), lds + RING_BYTES};
        pg8::gemm_phase<EpiP5, SchedPlain>(lds, S, E);
    } SEAM(5);


    if (IN(7)) {
        SchedPlain S{(const char*)(ws + WS_H0), (const char*)(ws + WS_WTPQ), G, (int)blockIdx.x, K_PQ};
        EpiP7 E{(bf16*)(ws + WS_QP), (const float*)(ws + WS_STATS4), (const float*)(ws + WS_CVEC), (const float*)(ws + WS_DVEC)};
        pg8::gemm_phase<EpiP7, SchedPlain>(lds, S, E);
    } SEAM(7);

    if (IN(8)) {
        peer_v2(P, lds, tid, lane, wave, G);
    }
#undef IN
#undef SEAM
}

extern "C" void kernel_launch(void* const* d_in, const int* in_sizes, int n_in, void* d_out, int out_size, void* d_ws, size_t ws_size, hipStream_t stream) {
    static int grid = 0;
    if (grid == 0) {
        if (n_in != 21 || out_size != NT * D || ws_size < WS_END) { fprintf(stderr, "kernel_launch: unexpected shapes (n_in %d, out %d, ws %zu); nothing launched\n", n_in, out_size, ws_size); grid = -1; return; }
        int dev = 0, cus = 0, per_cu = 0;
        if (hipGetDevice(&dev) != hipSuccess || hipDeviceGetAttribute(&cus, hipDeviceAttributeMultiprocessorCount, dev) != hipSuccess) { grid = -1; return; }
        if (hipFuncSetAttribute((const void*)fwd_kernel, hipFuncAttributeMaxDynamicSharedMemorySize, LDS_BYTES) != hipSuccess) { fprintf(stderr, "kernel_launch: hipFuncSetAttribute failed\n"); grid = -1; return; }
        if (hipOccupancyMaxActiveBlocksPerMultiprocessor(&per_cu, (const void*)fwd_kernel, NWAVES * 64, LDS_BYTES) != hipSuccess || per_cu < 1) { fprintf(stderr, "kernel_launch: occupancy query says %d\n", per_cu); }
        (void)hipGetLastError();
        grid = cus;
    }
    if (grid < 0) return;
    (void)hipMemsetAsync((char*)d_ws + WS_CTL, 0, CTL_ZERO_BYTES, stream);
    Args a{};
    for (int i = 0; i < 21; ++i) a.in[i] = (const float*)d_in[i];
    a.out = (float*)d_out; a.ws = (unsigned char*)d_ws;
    if (N_LAUNCHES == 1) { a.ph_lo = 0; a.ph_hi = NPH; hipLaunchKernelGGL(fwd_kernel, dim3(grid), dim3(NWAVES * 64), LDS_BYTES, stream, a); }
    else for (int ph = 0; ph < NPH; ++ph) { a.ph_lo = ph; a.ph_hi = ph + 1; hipLaunchKernelGGL(fwd_kernel, dim3(grid), dim3(NWAVES * 64), LDS_BYTES, stream, a); }
}
```

```cpp
#include <hip/hip_runtime.h>
#include <cstdio>
#include <cstdint>

#ifndef TABU_FP4
#define TABU_FP4 1
#endif
#ifndef TABV_FP4
#define TABV_FP4 1
#endif
#ifndef TAB_FP6
#define TAB_FP6 1
#endif
static_assert(TAB_FP6 == 1, "the workspace map assumes 12 MiB fp6 expert tables");
#ifndef TAB_FP8
#define TAB_FP8 1
#endif
#ifndef N_LAUNCHES
#define N_LAUNCHES 1
#endif

#define GAS __attribute__((address_space(1)))
#define LAS __attribute__((address_space(3)))
typedef unsigned short bf16;
typedef unsigned v4u __attribute__((ext_vector_type(4)));
typedef unsigned v2u __attribute__((ext_vector_type(2)));
typedef float f32x4 __attribute__((ext_vector_type(4)));
typedef float f32x2 __attribute__((ext_vector_type(2)));
typedef short bf16x8 __attribute__((ext_vector_type(8)));

constexpr int NT = 32768, SEQ = 16384, D = 1024;
constexpr int NPH = 9;
constexpr float ALPHA = 1.189207115002721f;
constexpr float LN_EPS = 1e-5f;
constexpr int NWAVES = 8;

constexpr size_t MiB = 1u << 20;
constexpr size_t WS_CTL = 0, CTL_ZERO_BYTES = 1 * MiB;
constexpr size_t WS_CPART = 256 * 1024;
constexpr size_t WS_STATS = 512 * 1024;
constexpr size_t WS_CVEC = 768 * 1024, WS_DVEC = 772 * 1024;
constexpr size_t WS_BIASIN = 1 * MiB;
constexpr size_t WS_STATS4 = 4 * MiB;
constexpr size_t WS_BIASTAB = 1 * MiB + 64 * 1024;
constexpr size_t WS_WTIN = 2 * MiB;
constexpr size_t WS_WTA = 16 * MiB, WS_WTB = 17 * MiB, WS_WTC = 18 * MiB, WS_WTO = 19 * MiB, WS_WTPQ = 21 * MiB, WS_WTMKV = 23 * MiB;
constexpr size_t WS_MEMB = 25 * MiB, WS_MEMKV = 26 * MiB;
constexpr size_t WS_MEMF8 = 27 * MiB, WS_WMKVF8 = 28 * MiB;
constexpr size_t WS_UTAB = 32 * MiB, WS_VTAB = 44 * MiB;
constexpr size_t WS_H0F8 = 56 * MiB;
constexpr size_t WS_WF8IN = 88 * MiB;
constexpr size_t WS_H0 = 96 * MiB;
constexpr size_t WS_QK = 160 * MiB;
constexpr size_t WS_VT = 256 * MiB;
constexpr size_t WS_QC = 304 * MiB;
constexpr size_t WS_OG = 336 * MiB;
constexpr size_t WS_LSE = 384 * MiB;
constexpr size_t WS_YCIN = 386 * MiB;
constexpr size_t WS_FA = 418 * MiB;
constexpr size_t WS_OB = 450 * MiB;
constexpr size_t WS_GSCR = 466 * MiB;
constexpr size_t WS_MERGED = WS_QK;
constexpr size_t WS_PRELN = 224 * MiB;
constexpr size_t WS_H1B = WS_H0;
constexpr size_t WS_QP = WS_QK;
constexpr size_t WS_END = 498 * MiB;

constexpr int WR_A = 0, WR_QK = 1024, WR_V = 2560, WR_QC = 3328, WR_GATE = 3840, WR_END = 6912;

constexpr int RING_BYTES = 131072;
constexpr int LDS_BYTES = 147456;
constexpr int MISC_OFF = LDS_BYTES - 256;
static_assert(RING_BYTES + 3840 * 4 <= MISC_OFF, "bias copy fits the spare LDS above the GEMM stage buffers");

#define RLX_AGENT __ATOMIC_RELAXED, __HIP_MEMORY_SCOPE_AGENT
#define LDS_WAIT() asm volatile("s_waitcnt lgkmcnt(0)" ::: "memory")
#define VM_WAIT() asm volatile("s_waitcnt vmcnt(0)" ::: "memory")

__device__ __forceinline__ unsigned f2bf(float f) { unsigned u = __builtin_bit_cast(unsigned, f); return (u + 0x7fffu + ((u >> 16) & 1u)) >> 16; }
__device__ __forceinline__ unsigned pk2(float lo, float hi) { return f2bf(lo) | (f2bf(hi) << 16); }
__device__ __forceinline__ unsigned pk4_fp8(float a, float b, float c, float d) { int p = __builtin_amdgcn_cvt_pk_fp8_f32(a, b, 0, false); p = __builtin_amdgcn_cvt_pk_fp8_f32(c, d, p, true); return (unsigned)p; }
__device__ __forceinline__ float bf2f(unsigned b) { return __builtin_bit_cast(float, b << 16); }
__device__ __forceinline__ float bflo(unsigned w) { return __builtin_bit_cast(float, w << 16); }
__device__ __forceinline__ float bfhi(unsigned w) { return __builtin_bit_cast(float, w & 0xffff0000u); }
__device__ __forceinline__ float wave_sum(float v) {
#pragma unroll
    for (int o = 1; o < 64; o <<= 1) v += __shfl_xor(v, o);
    return v;
}
__device__ __forceinline__ float wave_max(float v) {
#pragma unroll
    for (int o = 1; o < 64; o <<= 1) v = fmaxf(v, __shfl_xor(v, o));
    return v;
}

#define XB_TMO      128
#define XB_XCNT(j)  (256  + 64 * (j))
#define XB_XSUB(j)  (1280 + 64 * (j))
#define XB_XGEN(j)  (2304 + 64 * (j))
#define XB_TOP      3328
#define XB_TOPGEN   3392
#define XCD_BAR_WORDS 3456
#define XB_SPIN_CAP (1u << 18)

__device__ __forceinline__ unsigned xb_ld(unsigned* p)              { return __hip_atomic_load(p, __ATOMIC_RELAXED, __HIP_MEMORY_SCOPE_AGENT); }
__device__ __forceinline__ unsigned xb_add(unsigned* p, unsigned v) { return __hip_atomic_fetch_add(p, v, __ATOMIC_RELAXED, __HIP_MEMORY_SCOPE_AGENT); }
__device__ __forceinline__ unsigned xb_xcc_id() { return (unsigned)__builtin_amdgcn_s_getreg((3 << 11) | 20) & 0xFu; }
#define XB_SPIN(cond, bar) do { unsigned _sp = 0; while (cond) { __builtin_amdgcn_s_sleep(1); \
    if ((++_sp & 255u) == 0u) { if (xb_ld(&(bar)[XB_TMO])) break; if (_sp > XB_SPIN_CAP) { atomicAdd(&(bar)[XB_TMO], 1u); break; } } } } while (0)

struct XcdBarrier {
    unsigned* bar; unsigned x;
    volatile LAS unsigned* st;
};
__device__ __forceinline__ XcdBarrier xcd_barrier_post(unsigned* bar, volatile LAS unsigned* st) {
    XcdBarrier b; b.bar = bar; b.x = xb_xcc_id(); b.st = st;
    if (threadIdx.x == 0) (void)xb_add(&bar[XB_XCNT(b.x)], 1u);
    return b;
}
__device__ __forceinline__ void xcd_barrier_complete(unsigned* bar, unsigned x, unsigned& nloc, unsigned& nx) {
    const unsigned G = gridDim.x * gridDim.y * gridDim.z;
    unsigned sum, cnt, mine, sp = 0u;
    for (;;) {
        sum = 0u; cnt = 0u; mine = 0u;
#pragma unroll
        for (unsigned j = 0; j < 16; ++j) { const unsigned c = xb_ld(&bar[XB_XCNT(j)]); sum += c; cnt += (c > 0u) ? 1u : 0u; mine = (j == x) ? c : mine; }
        if (sum == G) break;
        __builtin_amdgcn_s_sleep(1);
        if ((++sp & 255u) == 0u) { if (xb_ld(&bar[XB_TMO])) break; if (sp > XB_SPIN_CAP) { atomicAdd(&bar[XB_TMO], 1u); break; } }
    }
    nloc = mine > 0u ? mine : 1u; nx = cnt > 0u ? cnt : 1u;
}
__device__ __forceinline__ void xcd_barrier(const XcdBarrier& b) {
    asm volatile("s_waitcnt vmcnt(0)" ::: "memory");
    __syncthreads();
    if (threadIdx.x == 0) {
        unsigned* bar = b.bar;
        __builtin_amdgcn_s_waitcnt(0);
        unsigned nloc = b.st[0], nx = b.st[1];
        if (nloc == 0u) { xcd_barrier_complete(bar, b.x, nloc, nx); b.st[0] = nloc; b.st[1] = nx; }
        const unsigned old = xb_add(&bar[XB_XSUB(b.x)], 1u);
        const unsigned gen = old / nloc;
        if (old + 1u == (gen + 1u) * nloc) {
            __builtin_amdgcn_fence(__ATOMIC_RELEASE, "agent");
            asm volatile("s_waitcnt vmcnt(0)" ::: "memory");
            const unsigned og = xb_add(&bar[XB_TOP], 1u);
            const unsigned tg = og / nx;
            if (og + 1u == (tg + 1u) * nx) xb_add(&bar[XB_TOPGEN], 1u);
            else XB_SPIN(xb_ld(&bar[XB_TOPGEN]) == tg, bar);
            __builtin_amdgcn_fence(__ATOMIC_ACQUIRE, "agent");
            xb_add(&bar[XB_XGEN(b.x)], 1u);
            asm volatile("s_waitcnt vmcnt(0)" ::: "memory");
        } else {
            XB_SPIN(xb_ld(&bar[XB_XGEN(b.x)]) == gen, bar);
            __builtin_amdgcn_fence(__ATOMIC_ACQUIRE, "agent");
            asm volatile("s_waitcnt vmcnt(0)" ::: "memory");
        }
    }
    __syncthreads();
}

namespace pg8 {
constexpr int BM = 256, BK = 64, HALF = 128, HTB = HALF * BK * 2, STAGE_BYTES = 8 * HTB;
__host__ __device__ __forceinline__ int lds_byte(int r, int c) { const int st = (r >> 4) * 2 + (c >> 5), rr = r & 15, cc = c & 31, ob = rr * 64 + cc * 2; return st * 1024 + (ob ^ (((ob >> 9) & 1) << 5)); }
__host__ __device__ __forceinline__ void stage_rc(int b, int& R, int& C) { const int st = b / 1024, sb = b % 1024, swz = sb ^ (((sb >> 9) & 1) << 5); R = (st >> 1) * 16 + swz / 64; C = (st & 1) * 32 + (swz % 64) / 2; }
__host__ __device__ __forceinline__ int perm32(int rho) { const int n = rho >> 4, i = rho & 15; return 8 * (i >> 2) + 4 * n + (i & 3); }

struct GUnit { const char* a; const char* b; unsigned sa, sb; int nt; int pm, pn, kind; };

typedef int v8i __attribute__((ext_vector_type(8)));
constexpr int K_FP8 = 1 << 16;
__device__ __forceinline__ unsigned pg8_rb(unsigned ra) { asm volatile("" : "+v"(ra)); const unsigned rho = ra & 31u, n = rho >> 4, i = rho & 15u; return (ra & ~31u) + 8u * (i >> 2) + 4u * n + (i & 3u); }
template <class Epi, class Sched, int MODE = 0>
__device__ __forceinline__ void gemm_phase(LAS unsigned char* lds, const Sched& S, const Epi& E) {
    const int tid = threadIdx.x, wid = __builtin_amdgcn_readfirstlane(tid >> 6), lane = tid & 63, wr = wid >> 2, wc = wid & 3, fr = lane & 15, fq = lane >> 4;
    int R0, C0; stage_rc(tid * 16, R0, C0);
    const unsigned RA = (unsigned)R0, C2 = (unsigned)C0 * 2u;
#define RB pg8_rb(RA)
    const size_t kstep = (size_t)(BK * 2);
    const unsigned ldsw = (unsigned)wid * 1024u;
    const int aoff = lds_byte(wr * 64 + fr, fq * 8), boff = lds_byte(wc * 32 + fr, fq * 8);
#define PG8_SA(b, h) (((b) * 2 + (h)) * HTB)
#define PG8_SB(b, h) ((4 + (b) * 2 + (h)) * HTB)
#define PG8_STAGE(bufoff, gbase, RR, stride) do { const unsigned _vo = (RR) * (unsigned)(stride) + C2; const char* _g = (const char*)(gbase); \
        __builtin_amdgcn_global_load_lds((const unsigned*)(_g + _vo), (LAS unsigned*)(lds + (bufoff) + ldsw), 16, 0, 0); \
        __builtin_amdgcn_global_load_lds((const unsigned*)(_g + (size_t)64 * (stride) + _vo), (LAS unsigned*)(lds + (bufoff) + ldsw + 8192), 16, 0, 0); } while (0)
#define PG8_LDA(dst, b, h) do { _Pragma("unroll") for (int m = 0; m < 4; ++m) _Pragma("unroll") for (int k = 0; k < 2; ++k) dst[m][k] = *(const LAS bf16x8*)(lds + PG8_SA(b, h) + aoff + m * 2048 + k * 1024); } while (0)
#define PG8_LDB(dst, b, h) do { _Pragma("unroll") for (int n = 0; n < 2; ++n) _Pragma("unroll") for (int k = 0; k < 2; ++k) dst[n][k] = *(const LAS bf16x8*)(lds + PG8_SB(b, h) + boff + n * 2048 + k * 1024); } while (0)
#define PG8_CAT(lo, hi) __builtin_bit_cast(v8i, __builtin_shufflevector(lo, hi, 0, 1, 2, 3, 4, 5, 6, 7, 8, 9, 10, 11, 12, 13, 14, 15))
#define PG8_MMA_BF(ai, bj, At, Bt) do { __builtin_amdgcn_s_setprio(1); _Pragma("unroll") for (int m = 0; m < 4; ++m) _Pragma("unroll") for (int n = 0; n < 2; ++n) _Pragma("unroll") for (int k = 0; k < 2; ++k) \
        acc[ai][bj][m][n] = __builtin_amdgcn_mfma_f32_16x16x32_bf16(Bt[n][k], At[m][k], acc[ai][bj][m][n], 0, 0, 0); __builtin_amdgcn_s_setprio(0); } while (0)
#define PG8_MMA_F8(ai, bj, At, Bt) do { __builtin_amdgcn_s_setprio(1); _Pragma("unroll") for (int m = 0; m < 4; ++m) _Pragma("unroll") for (int n = 0; n < 2; ++n) \
        acc[ai][bj][m][n] = __builtin_amdgcn_mfma_scale_f32_16x16x128_f8f6f4(PG8_CAT(Bt[n][0], Bt[n][1]), PG8_CAT(At[m][0], At[m][1]), acc[ai][bj][m][n], 0, 0, 0, 0x7F7F7F7F, 0, 0x7F7F7F7F); __builtin_amdgcn_s_setprio(0); } while (0)
#define PG8_WAIT_V(n) asm volatile("s_waitcnt vmcnt(" #n ")" ::: "memory")
#define PG8_WAIT_L(n) asm volatile("s_waitcnt lgkmcnt(" #n ")" ::: "memory")
#define PG8_BAR __builtin_amdgcn_s_barrier()
#define PG8_SCHED __builtin_amdgcn_sched_barrier(0)
#define PG8_KLOOP(MMA) \
        for (int t = 0; t < nt; t += 2) { \
            const bool last = (t == nt - 2); \
            const char* a1 = cA + (size_t)(t + 1) * kstep; \
            const char* a2 = last ? nxt.a : cA + (size_t)(t + 2) * kstep; const char* b2 = last ? nxt.b : cB + (size_t)(t + 2) * kstep; \
            const unsigned sa2 = last ? nxt.sa : csa, sb2 = last ? nxt.sb : csb; const size_t hA2 = (size_t)HALF * sa2, hB2 = (size_t)HALF * sb2; \
            const char* a3 = a2 + kstep; const char* b3 = b2 + kstep; \
            PG8_LDB(B0, 0, 0); PG8_LDB(B1, 0, 1); PG8_SCHED; PG8_LDA(At, 0, 0); PG8_STAGE(PG8_SA(1, 1), a1 + hA, RA, csa); \
            PG8_WAIT_V(8); PG8_WAIT_L(0); PG8_BAR; MMA(0, 0, At, B0); MMA(0, 1, At, B1); PG8_BAR; PG8_SCHED; \
            PG8_LDA(At, 0, 1); PG8_STAGE(PG8_SB(0, 0), b2, RB, sb2); PG8_STAGE(PG8_SB(0, 1), b2 + hB2, RB, sb2); PG8_STAGE(PG8_SA(0, 0), a2, RA, sa2); \
            PG8_WAIT_V(8); PG8_WAIT_L(0); PG8_BAR; MMA(1, 0, At, B0); MMA(1, 1, At, B1); PG8_BAR; PG8_SCHED; \
            PG8_LDB(B0, 1, 0); PG8_LDB(B1, 1, 1); PG8_SCHED; PG8_LDA(At, 1, 0); PG8_STAGE(PG8_SA(0, 1), a2 + hA2, RA, sa2); \
            PG8_WAIT_V(8); PG8_WAIT_L(0); PG8_BAR; MMA(0, 0, At, B0); MMA(0, 1, At, B1); PG8_BAR; PG8_SCHED; \
            PG8_LDA(At, 1, 1); PG8_STAGE(PG8_SB(1, 0), b3, RB, sb2); PG8_STAGE(PG8_SB(1, 1), b3 + hB2, RB, sb2); PG8_STAGE(PG8_SA(1, 0), a3, RA, sa2); \
            PG8_WAIT_V(8); PG8_WAIT_L(0); PG8_BAR; MMA(1, 0, At, B0); MMA(1, 1, At, B1); PG8_BAR; PG8_SCHED; \
        }
    GUnit cur, nxt; int ui = 0;
    if (!S.next(0, cur)) return;
    f32x4 acc[2][2][4][2];
#pragma unroll
    for (int a = 0; a < 2; ++a)
#pragma unroll
        for (int b = 0; b < 2; ++b)
#pragma unroll
            for (int m = 0; m < 4; ++m)
#pragma unroll
                for (int n = 0; n < 2; ++n) acc[a][b][m][n] = (f32x4){0.f, 0.f, 0.f, 0.f};
    bf16x8 At[4][2], B0[2][2], B1[2][2];
    unsigned keep[2][2][4][2];
    {
        const char* cA = cur.a; const char* cB = cur.b; const size_t hA = (size_t)HALF * cur.sa, hB = (size_t)HALF * cur.sb;
        PG8_STAGE(PG8_SB(0, 0), cB, RB, cur.sb); PG8_STAGE(PG8_SB(0, 1), cB + hB, RB, cur.sb); PG8_STAGE(PG8_SA(0, 0), cA, RA, cur.sa); PG8_STAGE(PG8_SA(0, 1), cA + hA, RA, cur.sa);
        if (wr == 1) PG8_BAR;
        PG8_WAIT_V(2); PG8_BAR;
        PG8_STAGE(PG8_SB(1, 0), cB + kstep, RB, cur.sb); PG8_STAGE(PG8_SA(1, 0), cA + kstep, RA, cur.sa); PG8_STAGE(PG8_SB(1, 1), cB + hB + kstep, RB, cur.sb);
        PG8_WAIT_V(6); PG8_BAR;
    }
    for (;;) {
        const bool has_next = S.next(ui + 1, nxt);
        if (!has_next) { nxt = cur; }
        const char* cA = cur.a; const char* cB = cur.b; const unsigned csa = cur.sa, csb = cur.sb; const size_t hA = (size_t)HALF * csa, hB = (size_t)HALF * csb;
        const int nt = cur.nt; const bool cur_fp8 = (cur.kind & K_FP8) != 0; (void)cur_fp8;
        if (MODE == 1 || (MODE == 2 && cur_fp8)) { PG8_KLOOP(PG8_MMA_F8) } else { PG8_KLOOP(PG8_MMA_BF) }
        if (wr == 0) PG8_BAR;
        E(acc, keep, cur, wr, wc, fr, fq);
        if (!has_next) break;
#pragma unroll
        for (int a = 0; a < 2; ++a)
#pragma unroll
            for (int b = 0; b < 2; ++b)
#pragma unroll
                for (int m = 0; m < 4; ++m)
#pragma unroll
                    for (int n = 0; n < 2; ++n) acc[a][b][m][n] = (f32x4){0.f, 0.f, 0.f, 0.f};
        cur = nxt; ++ui;
        if (wr == 1) PG8_BAR;
    }
    PG8_WAIT_V(0);
    PG8_BAR;
#undef PG8_SA
#undef PG8_SB
#undef PG8_STAGE
#undef PG8_LDA
#undef PG8_LDB
#undef PG8_MMA_BF
#undef PG8_MMA_F8
#undef PG8_KLOOP
#undef RB
#undef PG8_CAT
#undef PG8_WAIT_V
#undef PG8_WAIT_L
#undef PG8_BAR
#undef PG8_SCHED
}
}
using pg8::GUnit; using pg8::K_FP8;

__device__ __forceinline__ int tok0_of(int p, int g) {
    const int n = p << 8, b = n >> 14, rem = n & 16383, sh = 2 * g;
    const int r = rem >> (14 - sh), l0 = rem & ((16384 >> sh) - 1);
    return (b << 14) + (l0 << sh) + r;
}
__device__ __forceinline__ void tile_of(int t, int nN, int& pm, int& pn) { const int nig = 8 * nN, gid = t / nig, w = t % nig; pm = gid * 8 + (w & 7); pn = w >> 3; }

struct Ptrs {
    const float* in[21]; float* out; unsigned char* ws;
};

enum { K_ZA = 0, K_QK = 1, K_VT = 2, K_QC = 3, K_MKV = 4, K_GATE = 5, K_YA = 6, K_YB = 7, K_YC = 8, K_WO = 9, K_PQ = 10 };
struct SchedP1 {
    const char* wsb; int G, c;
    static constexpr int NLONG = 512, NSHORT = 768 + 384 + 256 + 8;
    __device__ __forceinline__ bool next(int i, GUnit& u) const {
        const char* const h0b = wsb + WS_H0; const char* const wtb = wsb + WS_WTIN; const char* const h0 = wsb + WS_H0F8; const char* const wtin = wsb + WS_WF8IN; const char* const memb = wsb + WS_MEMF8; const char* const wtmkv = wsb + WS_WMKVF8;
        const int nshort = (NSHORT - c + G - 1) / G, nslots = 2 + nshort; if (i >= nslots) return false;
        const int k = (c >> 3) & 3; int pa = k % nslots, pb = (k + 4) % nslots; if (pa > pb) { const int t_ = pa; pa = pb; pb = t_; }
        int j; if (i == pa) j = 0; else if (i == pb) j = 1; else j = 2 + i - (i > pa ? 1 : 0) - (i > pb ? 1 : 0);
        const int L = j * G + c; if (L >= NLONG + NSHORT) return false;
        if (L < NLONG) { const int T = (G % 8 == 0) ? (L % 8) * (NLONG / 8) + L / 8 : L; int pm, pn; tile_of(T, 4, pm, pn);
            u.a = h0b + (size_t)pm * 256 * 2048; u.b = wtb + (size_t)(WR_A + pn * 256) * 2048; u.sa = 2048; u.sb = 2048; u.nt = 16; u.pm = pm; u.pn = pn; u.kind = K_ZA; return true; }
        const int Ls = L - NLONG; int T = (NSHORT % 8 == 0 && G % 8 == 0) ? (Ls % 8) * (NSHORT / 8) + Ls / 8 : Ls;
        u.nt = 8; u.sa = 1024; u.sb = 1024;
        if (T < 768) { const int g = T >> 8; int pm, pn; tile_of(T & 255, 2, pm, pn); u.a = h0 + (size_t)tok0_of(pm, g) * 1024; u.sa = 1024u << (2 * g);
            u.b = wtin + (size_t)(WR_QK + g * 512 + pn * 256) * 1024; u.pm = pm; u.pn = pn; u.kind = K_QK | (g << 8) | K_FP8; return true; }
        T -= 768;
        if (T < 384) { const int g = T >> 7, pn = T & 127; u.a = wtin + (size_t)(WR_V + g * 256) * 1024; u.b = h0 + (size_t)tok0_of(pn, g) * 1024; u.sb = 1024u << (2 * g);
            u.pm = 0; u.pn = pn; u.kind = K_VT | (g << 8) | K_FP8; return true; }
        T -= 384;
        if (T < 256) { int pm, pn; tile_of(T, 2, pm, pn); u.a = h0 + (size_t)pm * 256 * 1024; u.b = wtin + (size_t)(WR_QC + pn * 256) * 1024; u.pm = pm; u.pn = pn; u.kind = K_QC | K_FP8; return true; }
        T -= 256;
        if (T < 4) { const int pm = T >> 1, pn = T & 1; u.a = memb + (size_t)pm * 256 * 1024; u.b = wtmkv + (size_t)pn * 256 * 1024; u.pm = pm; u.pn = pn; u.kind = K_MKV | K_FP8; return true; }
        T -= 4;
        { const int pm = T >> 1, pn = T & 1; u.a = wtmkv + (size_t)(512 + pm * 256) * 1024; u.b = memb + (size_t)pn * 256 * 1024; u.pm = pm; u.pn = pn; u.kind = K_MKV | (1 << 8) | K_FP8; return true; }
    }
};
__device__ __forceinline__ void out_tile_of(int L, int G, int& pm, int& pn) {
    const int T = (G % 8 == 0) ? (L % 8) * 64 + L / 8 : L; tile_of(T, 4, pm, pn);
}
struct SchedP4 {
    const char* wsb; int G, c;
    __device__ __forceinline__ bool next(int i, GUnit& u) const {
        const int io = i / 6, s = i - io * 6; const int L = io * G + c; if (L >= 512) return false;
        int pm, pn; out_tile_of(L, G, pm, pn); u.pm = pm; u.pn = pn;
        if ((s & 1) == 0) { const int gi = s >> 1; u.a = wsb + WS_H0F8 + (size_t)pm * 256 * 1024; u.sa = 1024; u.b = wsb + WS_WF8IN + (size_t)(WR_GATE + gi * 1024 + pn * 256) * 1024; u.sb = 1024; u.nt = 8; u.kind = K_GATE | (gi << 8) | K_FP8; return true; }
        if (s == 1) { u.a = wsb + WS_FA + (size_t)pm * 256 * 1024; u.sa = 1024; u.b = wsb + WS_WTA + (size_t)pn * 256 * 1024; u.sb = 1024; u.nt = 8; u.kind = K_YA; return true; }
        if (s == 3) { u.a = wsb + WS_OB + (size_t)pm * 256 * 256; u.sa = 256; u.b = wsb + WS_WTB + (size_t)pn * 256 * 256; u.sb = 256; u.nt = 2; u.kind = K_YB | K_FP8; return true; }
        u.a = wsb + WS_YCIN + (size_t)pm * 256 * 512; u.sa = 512; u.b = wsb + WS_WTC + (size_t)pn * 256 * 512; u.sb = 512; u.nt = 4; u.kind = K_YC | K_FP8; return true;
    }
};
struct SchedPlain {
    const char* a; const char* b; int G, c, kind;
    __device__ __forceinline__ bool next(int i, GUnit& u) const {
        const int L = i * G + c; if (L >= 512) return false;
        int pm, pn; out_tile_of(L, G, pm, pn); u.pm = pm; u.pn = pn; u.a = a + (size_t)pm * 256 * 2048; u.b = b + (size_t)pn * 256 * 2048; u.sa = 2048; u.sb = 2048; u.nt = 16; u.kind = kind; return true;
    }
};

__device__ __forceinline__ unsigned opq(unsigned x) { asm volatile("" : "+v"(x)); return x; }
__device__ __forceinline__ v4u pack8(f32x4 v0, f32x4 v1) { v4u o; o.x = pk2(v0[0], v0[1]); o.y = pk2(v0[2], v0[3]); o.z = pk2(v1[0], v1[1]); o.w = pk2(v1[2], v1[3]); return o; }
__device__ __forceinline__ void unpack8(v4u w, f32x4& a, f32x4& b) { a[0] = bflo(w.x); a[1] = bfhi(w.x); a[2] = bflo(w.y); a[3] = bfhi(w.y); b[0] = bflo(w.z); b[1] = bfhi(w.z); b[2] = bflo(w.w); b[3] = bfhi(w.w); }
#define EPI_LOOP(ai, m, bj) _Pragma("unroll") for (int ai = 0; ai < 2; ++ai) _Pragma("unroll") for (int m = 0; m < 4; ++m) _Pragma("unroll") for (int bj = 0; bj < 2; ++bj)

constexpr float W8SC = 32.f, W8INV = 1.f / 32.f;
constexpr float SC_WBC = 16.f, SC_ACT = 4.f;
struct EpiP1 {
    bf16* za; unsigned char* wsb; const LAS unsigned char* bias;
    __device__ __forceinline__ void operator()(f32x4 (&acc)[2][2][4][2], unsigned (&keep)[2][2][4][2], const GUnit& u, int wr, int wc, int fr, int fq) const {
        bf16* const qk = (bf16*)(wsb + WS_QK); bf16* const vt = (bf16*)(wsb + WS_VT); bf16* const qc = (bf16*)(wsb + WS_QC); bf16* const memkv = (bf16*)(wsb + WS_MEMKV);
        const int kind = u.kind & 255, g = (u.kind >> 8) & 255; const float asc = (u.kind & K_FP8) ? W8INV : 1.f;
        const unsigned rl0 = opq((unsigned)(wr * 64 + fr)), cl0 = opq((unsigned)(wc * 32 + 8 * fq));
        if (kind == K_VT) {
            char* base = (char*)(vt + (size_t)g * 256 * NT + (size_t)u.pn * 256); const LAS unsigned char* bb = bias + (WR_V + g * 256) * 4;
            const unsigned lo = rl0 * (unsigned)(NT * 2) + cl0 * 2u;
#pragma unroll
            for (int ai = 0; ai < 2; ++ai)
#pragma unroll
                for (int m = 0; m < 4; ++m) { const float br = *(const LAS float*)(bb + (rl0 + ai * 128 + m * 16) * 4u);
#pragma unroll
                    for (int bj = 0; bj < 2; ++bj) *(GAS v4u*)(base + (lo + (unsigned)((ai * 128 + m * 16) * NT * 2 + bj * 256))) = pack8(acc[ai][bj][m][0] * asc + br, acc[ai][bj][m][1] * asc + br);
                    __builtin_amdgcn_sched_barrier(0); }
            return;
        }
        char* base; unsigned ldb; const LAS unsigned char* bb; bool hasb = true;
        if (kind == K_ZA) { base = (char*)(za + (size_t)u.pm * 256 * 1024 + u.pn * 256); ldb = 2048; bb = bias + (WR_A + u.pn * 256) * 4; }
        else if (kind == K_QK) { base = (char*)(qk + (size_t)g * NT * 512 + (size_t)u.pm * 256 * 512 + u.pn * 256); ldb = 1024; bb = bias + (WR_QK + g * 512 + u.pn * 256) * 4; }
        else if (kind == K_QC) { base = (char*)(qc + (size_t)u.pm * 256 * 512 + u.pn * 256); ldb = 1024; bb = bias + (WR_QC + u.pn * 256) * 4; }
        else { base = (char*)(memkv + (size_t)g * 512 * 512 + (size_t)u.pm * 256 * 512 + u.pn * 256); ldb = 1024; bb = bias; hasb = false; }
        f32x4 bv[2][2];
#pragma unroll
        for (int bj = 0; bj < 2; ++bj)
#pragma unroll
            for (int n = 0; n < 2; ++n) bv[bj][n] = hasb ? *(const LAS f32x4*)(bb + (cl0 + bj * 128 + 4 * n) * 4u) : (f32x4){0.f, 0.f, 0.f, 0.f};
        const unsigned lo = rl0 * ldb + cl0 * 2u;
#pragma unroll
        for (int ai = 0; ai < 2; ++ai)
#pragma unroll
            for (int m = 0; m < 4; ++m) {
#pragma unroll
                for (int bj = 0; bj < 2; ++bj) *(GAS v4u*)(base + (lo + (unsigned)(ai * 128 + m * 16) * ldb + (unsigned)(bj * 256))) = pack8(acc[ai][bj][m][0] * asc + bv[bj][0], acc[ai][bj][m][1] * asc + bv[bj][1]);
                __builtin_amdgcn_sched_barrier(0); }
    }
};
struct EpiP4 {
    bf16* merged; const LAS unsigned char* bias;
    __device__ __forceinline__ void operator()(f32x4 (&acc)[2][2][4][2], unsigned (&keep)[2][2][4][2], const GUnit& u, int wr, int wc, int fr, int fq) const {
        const int kind = u.kind & 255, gi = (u.kind >> 8) & 255;
        const unsigned rl0 = opq((unsigned)(wr * 64 + fr)), cl0 = opq((unsigned)(wc * 32 + 8 * fq));
        if (kind == K_GATE) {
            const LAS unsigned char* bb = bias + (gi * 1024 + u.pn * 256) * 4;
#pragma unroll
            for (int bj = 0; bj < 2; ++bj) { const f32x4 b0 = *(const LAS f32x4*)(bb + (cl0 + bj * 128) * 4u), b1 = *(const LAS f32x4*)(bb + (cl0 + bj * 128 + 4) * 4u);
#pragma unroll
                for (int ai = 0; ai < 2; ++ai)
#pragma unroll
                    for (int m = 0; m < 4; ++m)
#pragma unroll
                        for (int n = 0; n < 2; ++n) { const f32x4 v = acc[ai][bj][m][n] * W8INV + (n ? b1 : b0); unsigned pk = 0u;
#pragma unroll
                            for (int e = 0; e < 4; ++e) { const float sg = __builtin_amdgcn_rcpf(1.f + __expf(-v[e])); pk |= (unsigned)(sg * 255.f + 0.5f) << (8 * e); }
                            keep[ai][bj][m][n] = pk; } }
            return;
        }
        char* mb = (char*)(merged + (size_t)u.pm * 256 * 1024 + u.pn * 256); const unsigned mlo = rl0 * 2048u + cl0 * 2u;
        const float ysc = ((kind == K_YA) ? 1.f : 1.f / (SC_WBC * SC_ACT)) * (1.f / 255.f);
#pragma unroll
        for (int ai = 0; ai < 2; ++ai) {
            v4u pw[4][2];
            if (kind != K_YA) {
#pragma unroll
                for (int m = 0; m < 4; ++m)
#pragma unroll
                    for (int bj = 0; bj < 2; ++bj) pw[m][bj] = *(const GAS v4u*)(mb + (mlo + (unsigned)((ai * 128 + m * 16) * 2048 + bj * 256))); }
#pragma unroll
            for (int m = 0; m < 4; ++m)
#pragma unroll
                for (int bj = 0; bj < 2; ++bj) { f32x4 v[2];
#pragma unroll
                    for (int n = 0; n < 2; ++n) { const unsigned pk = keep[ai][bj][m][n];
                        v[n][0] = acc[ai][bj][m][n][0] * ((float)(pk & 255u) * ysc); v[n][1] = acc[ai][bj][m][n][1] * ((float)((pk >> 8) & 255u) * ysc);
                        v[n][2] = acc[ai][bj][m][n][2] * ((float)((pk >> 16) & 255u) * ysc); v[n][3] = acc[ai][bj][m][n][3] * ((float)(pk >> 24) * ysc); }
                    if (kind != K_YA) { f32x4 p0, p1; unpack8(pw[m][bj], p0, p1); v[0] += p0; v[1] += p1; }
                    *(GAS v4u*)(mb + (mlo + (unsigned)((ai * 128 + m * 16) * 2048 + bj * 256))) = pack8(v[0], v[1]); }
            __builtin_amdgcn_sched_barrier(0); }
    }
};
struct EpiP5 {
    bf16* h0; float* preln; float* stats; LAS unsigned char* lds_spare;
    __device__ __forceinline__ void operator()(f32x4 (&acc)[2][2][4][2], unsigned (&keep)[2][2][4][2], const GUnit& u, int wr, int wc, int fr, int fq) const {
        const unsigned rl0 = opq((unsigned)(wr * 64 + fr)), cl0 = opq((unsigned)(wc * 32 + 8 * fq));
        const size_t t0 = (size_t)u.pm * 256 * 1024 + u.pn * 256;
        char* hb = (char*)(h0 + t0);
        const unsigned hlo = rl0 * 2048u + cl0 * 2u;
#pragma unroll
        for (int ai = 0; ai < 2; ++ai) {
            v4u hw[4][2];
#pragma unroll
            for (int m = 0; m < 4; ++m)
#pragma unroll
                for (int bj = 0; bj < 2; ++bj) hw[m][bj] = *(const GAS v4u*)(hb + (hlo + (unsigned)((ai * 128 + m * 16) * 2048 + bj * 256)));
#pragma unroll
            for (int m = 0; m < 4; ++m) { float s1 = 0.f, s2 = 0.f;
#pragma unroll
                for (int bj = 0; bj < 2; ++bj) { f32x4 h0v, h1v; unpack8(hw[m][bj], h0v, h1v);
                    const f32x4 v0 = acc[ai][bj][m][0] + ALPHA * h0v, v1 = acc[ai][bj][m][1] + ALPHA * h1v;
                    *(GAS v4u*)(hb + (hlo + (unsigned)((ai * 128 + m * 16) * 2048 + bj * 256))) = pack8(v0, v1);
                    s1 += (v0[0] + v0[1]) + (v0[2] + v0[3]) + (v1[0] + v1[1]) + (v1[2] + v1[3]);
                    s2 += (v0[0] * v0[0] + v0[1] * v0[1]) + (v0[2] * v0[2] + v0[3] * v0[3]) + (v1[0] * v1[0] + v1[1] * v1[1]) + (v1[2] * v1[2] + v1[3] * v1[3]); }
                s1 += __shfl_xor(s1, 16); s1 += __shfl_xor(s1, 32); s2 += __shfl_xor(s2, 16); s2 += __shfl_xor(s2, 32);
                if (fq == 0) { f32x2 pr; pr.x = s1; pr.y = s2; *(LAS f32x2*)(lds_spare + ((ai * 128 + m * 16 + rl0) * 4 + wc) * 8) = pr; } }
            __builtin_amdgcn_sched_barrier(0); }
        asm volatile("s_waitcnt lgkmcnt(0)" ::: "memory"); __builtin_amdgcn_s_barrier(); asm volatile("" ::: "memory");
        { const int t = threadIdx.x;
          if (t < 256) { const LAS f32x2* pp = (const LAS f32x2*)(lds_spare + t * 32); f32x2 a = pp[0]; a += pp[1]; a += pp[2]; a += pp[3];
              *(GAS f32x2*)(stats + ((size_t)(u.pm * 256 + t) * 4 + u.pn) * 2) = a; } }
    }
};
struct EpiP7 {
    bf16* qp; const float* stats; const float* cvec; const float* dvec;
    __device__ __forceinline__ void operator()(f32x4 (&acc)[2][2][4][2], unsigned (&keep)[2][2][4][2], const GUnit& u, int wr, int wc, int fr, int fq) const {
        const unsigned rl0 = opq((unsigned)(wr * 64 + fr)), cl0 = opq((unsigned)(wc * 32 + 8 * fq));
        char* qb = (char*)(qp + (size_t)u.pm * 256 * 1024 + u.pn * 256); const unsigned lo = rl0 * 2048u + cl0 * 2u;
        f32x4 cv[2][2], dv[2][2];
#pragma unroll
        for (int bj = 0; bj < 2; ++bj)
#pragma unroll
            for (int n = 0; n < 2; ++n) { cv[bj][n] = *(const GAS f32x4*)(cvec + u.pn * 256 + cl0 + bj * 128 + 4 * n); dv[bj][n] = *(const GAS f32x4*)(dvec + u.pn * 256 + cl0 + bj * 128 + 4 * n); }
#pragma unroll
        for (int ai = 0; ai < 2; ++ai)
#pragma unroll
            for (int m = 0; m < 4; ++m) { const GAS f32x4* sp = (const GAS f32x4*)(stats + (size_t)(u.pm * 256 + ai * 128 + m * 16 + rl0) * 8); const f32x4 sa = sp[0], sb = sp[1];
                f32x2 st; st.x = ((sa.x + sa.z) + sb.x) + sb.z; st.y = ((sa.y + sa.w) + sb.y) + sb.w;
                const float mean = st.x * (1.f / D), rstd = 1.f / sqrtf(fmaxf(st.y * (1.f / D) - mean * mean, 0.f) + LN_EPS), mr = mean * rstd;
#pragma unroll
                for (int bj = 0; bj < 2; ++bj) *(GAS v4u*)(qb + (lo + (unsigned)((ai * 128 + m * 16) * 2048 + bj * 256))) = pack8(acc[ai][bj][m][0] * rstd - mr * cv[bj][0] + dv[bj][0], acc[ai][bj][m][1] * rstd - mr * cv[bj][1] + dv[bj][1]); }
    }
};

constexpr float FP6_SU = 60.f, FP6_SV = 3.15f;
__device__ __forceinline__ unsigned fp6_code(float v) {
    const float a = fminf(fabsf(v), 7.5f);
    const float c = a < 2.f ? rintf(a * 8.f) : (a < 4.f ? 16.f + rintf((a - 2.f) * 4.f) : 24.f + rintf((a - 4.f) * 2.f));
    return (unsigned)c | (v < 0.f ? 32u : 0u);
}
constexpr float FP4_SV = 3.36f, FP4_SU = 64.f;
__device__ __forceinline__ unsigned fp4_code(float v) {
    const float a = fminf(fabsf(v), 6.f);
    const float c = a < 2.f ? rintf(a * 2.f) : (a < 4.f ? 4.f + rintf(a - 2.f) : 6.f + rintf((a - 4.f) * 0.5f));
    return (unsigned)c | (v < 0.f ? 8u : 0u);
}
typedef unsigned v6u __attribute__((ext_vector_type(6)));
typedef float v32f __attribute__((ext_vector_type(32)));
__device__ __forceinline__ void p0_transpose_item(const float* W, int K, int ld, int col0, bf16* WT, unsigned char* WT8, float sc8, int row0, LAS float* scr, int item, int lane, int ncols,
                                                  const float* kg = nullptr, const float* kb = nullptr, float* cvec = nullptr, float* dvec = nullptr) {
    const int nblk = ncols / 32, kb_ = item / nblk, nb = item % nblk, k0 = 64 * kb_, n0 = 32 * nb;
    { float wv[32];
#pragma unroll
      for (int i = 0; i < 32; ++i) wv[i] = W[(size_t)(k0 + 2 * i + (lane >> 5)) * ld + col0 + n0 + (lane & 31)];
#pragma unroll
      for (int i = 0; i < 32; ++i) scr[(2 * i + (lane >> 5)) * 33 + (lane & 31)] = wv[i]; }
    LDS_WAIT(); asm volatile("" ::: "memory");
    const int c = lane & 7;
#pragma unroll
    for (int j = 0; j < 4; ++j) { const int n = (lane >> 3) + 8 * j; const LAS float* s = scr + (8 * c) * 33 + n;
        float e[8];
#pragma unroll
        for (int i = 0; i < 8; ++i) e[i] = s[i * 33];
        if (kg) { float pc = 0.f, pd = 0.f;
#pragma unroll
            for (int i = 0; i < 8; ++i) { const float g = kg[k0 + 8 * c + i]; pd += e[i] * kb[k0 + 8 * c + i]; e[i] *= g; pc += e[i]; }
            pc += __shfl_xor(pc, 1); pc += __shfl_xor(pc, 2); pc += __shfl_xor(pc, 4); pd += __shfl_xor(pd, 1); pd += __shfl_xor(pd, 2); pd += __shfl_xor(pd, 4);
            if (c == 0) { cvec[kb_ * 1024 + col0 + n0 + n] = pc; dvec[kb_ * 1024 + col0 + n0 + n] = pd; } }
        if (WT) { v4u o; o.x = pk2(e[0], e[1]); o.y = pk2(e[2], e[3]); o.z = pk2(e[4], e[5]); o.w = pk2(e[6], e[7]); *(GAS v4u*)(WT + (size_t)(row0 + n0 + n) * K + k0 + 8 * c) = o; }
        if (WT8) { v2u o; o.x = pk4_fp8(e[0] * sc8, e[1] * sc8, e[2] * sc8, e[3] * sc8); o.y = pk4_fp8(e[4] * sc8, e[5] * sc8, e[6] * sc8, e[7] * sc8); *(GAS v2u*)(WT8 + (size_t)(row0 + n0 + n) * K + k0 + 8 * c) = o; } }
    LDS_WAIT(); asm volatile("" ::: "memory");
}
__device__ __forceinline__ void ln_row(const float* xrow, const float* g, const float* b, bf16* obf, float* of32, int lane) {
    const GAS f32x4* xr = (const GAS f32x4*)xrow + lane;
    f32x4 v[4]; float s = 0.f;
#pragma unroll
    for (int j = 0; j < 4; ++j) { v[j] = xr[64 * j]; s += (v[j].x + v[j].y) + (v[j].z + v[j].w); }
    const float mean = wave_sum(s) * (1.f / D); float s2 = 0.f;
#pragma unroll
    for (int j = 0; j < 4; ++j) { v[j] = v[j] - mean; s2 += (v[j].x * v[j].x + v[j].y * v[j].y) + (v[j].z * v[j].z + v[j].w * v[j].w); }
    const float rstd = 1.f / sqrtf(wave_sum(s2) * (1.f / D) + LN_EPS);
#pragma unroll
    for (int j = 0; j < 4; ++j) { const f32x4 gg = ((const GAS f32x4*)g)[lane + 64 * j], bb = ((const GAS f32x4*)b)[lane + 64 * j];
        const f32x4 y = v[j] * rstd * gg + bb;
        if (obf) ((GAS unsigned long long*)obf)[lane + 64 * j] = (unsigned long long)pk2(y.x, y.y) | ((unsigned long long)pk2(y.z, y.w) << 32);
        if (of32) ((GAS f32x4*)of32)[lane + 64 * j] = y; }
}
__device__ __forceinline__ void ln_row2(const float* xa, const float* xb, const float* g, const float* b, bf16* oa, bf16* ob, unsigned char* oa8, unsigned char* ob8, int lane) {
    const GAS f32x4* pa = (const GAS f32x4*)xa + lane; const GAS f32x4* pb = (const GAS f32x4*)xb + lane;
    f32x4 va[4], vb[4]; float sa = 0.f, sb = 0.f;
#pragma unroll
    for (int j = 0; j < 4; ++j) { va[j] = pa[64 * j]; vb[j] = pb[64 * j]; }
#pragma unroll
    for (int j = 0; j < 4; ++j) { sa += (va[j].x + va[j].y) + (va[j].z + va[j].w); sb += (vb[j].x + vb[j].y) + (vb[j].z + vb[j].w); }
    const float ma = wave_sum(sa) * (1.f / D), mb = wave_sum(sb) * (1.f / D); float qa = 0.f, qb = 0.f;
#pragma unroll
    for (int j = 0; j < 4; ++j) { va[j] = va[j] - ma; vb[j] = vb[j] - mb; qa += (va[j].x * va[j].x + va[j].y * va[j].y) + (va[j].z * va[j].z + va[j].w * va[j].w); qb += (vb[j].x * vb[j].x + vb[j].y * vb[j].y) + (vb[j].z * vb[j].z + vb[j].w * vb[j].w); }
    const float ra = 1.f / sqrtf(wave_sum(qa) * (1.f / D) + LN_EPS), rb = 1.f / sqrtf(wave_sum(qb) * (1.f / D) + LN_EPS);
#pragma unroll
    for (int j = 0; j < 4; ++j) { const f32x4 gg = ((const GAS f32x4*)g)[lane + 64 * j], bb = ((const GAS f32x4*)b)[lane + 64 * j];
        const f32x4 ya = va[j] * ra * gg + bb, yb = vb[j] * rb * gg + bb;
        ((GAS unsigned long long*)oa)[lane + 64 * j] = (unsigned long long)pk2(ya.x, ya.y) | ((unsigned long long)pk2(ya.z, ya.w) << 32);
        ((GAS unsigned long long*)ob)[lane + 64 * j] = (unsigned long long)pk2(yb.x, yb.y) | ((unsigned long long)pk2(yb.z, yb.w) << 32);
        ((GAS unsigned*)oa8)[lane + 64 * j] = pk4_fp8(ya.x, ya.y, ya.z, ya.w); ((GAS unsigned*)ob8)[lane + 64 * j] = pk4_fp8(yb.x, yb.y, yb.z, yb.w); }
}
__device__ __forceinline__ int t5_bucket(int rel) {
    const int ret = rel > 0 ? 16 : 0; const int n = rel < 0 ? -rel : rel; const float nf = (float)(n > 1 ? n : 1);
    int large = 8 + (int)(logf(nf / 8.f) / 4.852030263919617f * 8.f); large = large < 15 ? large : 15;
    return ret + (n < 8 ? n : large);
}

__device__ __forceinline__ void phase0(const Ptrs& P, LAS unsigned char* lds, int tid, int lane, int wave, int G) {
    unsigned char* ws = P.ws;
    const int gw = blockIdx.x * NWAVES + wave, NGW = G * NWAVES;
    { bf16* h0 = (bf16*)(ws + WS_H0);
      unsigned char* h08 = ws + WS_H0F8;
      for (int m = gw; m < NT; m += 2 * NGW) ln_row2(P.in[0] + (size_t)m * D, P.in[0] + (size_t)(m + NGW) * D, P.in[3], P.in[4], h0 + (size_t)m * D, h0 + (size_t)(m + NGW) * D, h08 + (size_t)m * D, h08 + (size_t)(m + NGW) * D, lane); }
    { LAS float* scr = (LAS float*)(lds + wave * 16384);
      bf16* wtin = (bf16*)(ws + WS_WTIN);
      constexpr int I_IN = 23 * 16 * 8, I_A = 8 * 32, I_B = 4 * 32, I_C = 8 * 32, I_SQ = 16 * 32;
      constexpr int NIT = I_IN + I_A + I_B + I_C + 3 * I_SQ;
      unsigned char* wf8 = ws + WS_WF8IN;
      for (int it = gw; it < NIT; it += NGW) {
          int r = it;
          if (r < I_IN) { const int j = r / 128, q = r % 128; int src;
              if (j < 6) src = ((j & 1) ? 1280 : 512) + (j >> 1) * 256; else if (j < 9) src = 2048 + (j - 6) * 256; else if (j < 11) src = 2816 + (j - 9) * 256; else src = 3328 + (j - 11) * 256;
              p0_transpose_item(P.in[5], 1024, 6400, src, nullptr, wf8, W8SC, 1024 + 256 * j, scr, q, lane, 256); continue; }
          r -= I_IN;
          if (r < I_A) { p0_transpose_item(P.in[7], 512, 1024, 0, (bf16*)(ws + WS_WTA), nullptr, 0.f, 0, scr, r, lane, 1024); continue; } r -= I_A;
          if (r < I_B) { p0_transpose_item(P.in[8], 256, 1024, 0, nullptr, ws + WS_WTB, SC_WBC, 0, scr, r, lane, 1024); continue; } r -= I_B;
          if (r < I_C) { p0_transpose_item(P.in[9], 512, 1024, 0, nullptr, ws + WS_WTC, SC_WBC, 0, scr, r, lane, 1024); continue; } r -= I_C;
          if (r < I_SQ) { p0_transpose_item(P.in[10], 1024, 1024, 0, nullptr, ws + WS_WMKVF8, W8SC, 0, scr, r, lane, 1024); continue; } r -= I_SQ;
          if (r < I_SQ) { p0_transpose_item(P.in[11], 1024, 1024, 0, (bf16*)(ws + WS_WTO), nullptr, 0.f, 0, scr, r, lane, 1024); continue; } r -= I_SQ;
          p0_transpose_item(P.in[14], 1024, 1024, 0, (bf16*)(ws + WS_WTPQ), nullptr, 0.f, 0, scr, r, lane, 1024, P.in[12], P.in[13], (float*)(ws + WS_CPART), (float*)(ws + WS_CPART) + 16 * 1024);
      } }
    __syncthreads();
    { LAS float* wt = (LAS float*)lds;
      LAS float* cs = wt + 64 * 129; LAS float* sn = cs + 128;
      if (tid < 128) { float s, c; sincospif((float)tid / 64.f, &s, &c); cs[tid] = c; sn[tid] = s; }
      bf16* wtin = (bf16*)(ws + WS_WTIN);
      unsigned char* wf8 = ws + WS_WF8IN;
      for (int it = blockIdx.x; it < 256; it += G) {
          const int g = it >> 6, k0 = (it & 63) * 16;
          __syncthreads();
          for (int idx = tid; idx < 16 * 128; idx += 512) { const int kk = idx >> 7, c = idx & 127; wt[kk * 129 + c] = P.in[5][(size_t)(k0 + kk) * 6400 + g * 128 + c]; }
          __syncthreads();
          const int cp = tid & 127, kq = tid >> 7;
          float ac[4] = {0.f, 0.f, 0.f, 0.f}, as[4] = {0.f, 0.f, 0.f, 0.f};
#pragma unroll 4
          for (int c = 0; c < 128; ++c) { const int ix = (c * cp) & 127; const float cv = cs[ix], sv = sn[ix];
#pragma unroll
              for (int i = 0; i < 4; ++i) { const float w = wt[(4 * kq + i) * 129 + c]; ac[i] += w * cv; as[i] += w * sv; } }
          { v2u o; o.x = pk2(ac[0], ac[1]); o.y = pk2(ac[2], ac[3]); *(GAS v2u*)(wtin + (size_t)(g * 256 + cp) * 1024 + k0 + 4 * kq) = o;
            v2u q; q.x = pk2(as[0], as[1]); q.y = pk2(as[2], as[3]); *(GAS v2u*)(wtin + (size_t)(g * 256 + 128 + cp) * 1024 + k0 + 4 * kq) = q; }
      }
      __syncthreads();
      { float* bi = (float*)(ws + WS_BIASIN); const float* b_in = P.in[6];
        for (int r = gw; r < 1024; r += NGW) { const int g = r >> 8, w = r & 255, cp = w & 127; const bool isin = w >= 128;
            const int i0 = (lane * cp) & 127, i1 = ((lane + 64) * cp) & 127;
            float a = b_in[g * 128 + lane] * (isin ? sn[i0] : cs[i0]) + b_in[g * 128 + 64 + lane] * (isin ? sn[i1] : cs[i1]);
            a = wave_sum(a); if (lane == 0) bi[r] = a; }
        const int gtid = blockIdx.x * 512 + tid, nth = G * 512;
        for (int r = 1024 + gtid; r < WR_END; r += nth) { const int j = (r - 1024) >> 8, w = (r - 1024) & 255; int src;
            if (j < 6) src = ((j & 1) ? 1280 : 512) + (j >> 1) * 256; else if (j < 9) src = 2048 + (j - 6) * 256; else if (j < 11) src = 2816 + (j - 9) * 256; else src = 3328 + (j - 11) * 256;
            bi[r] = b_in[src + w]; }
        float* bt = (float*)(ws + WS_BIASTAB);
        for (int r = gtid; r < 3 * 4 * 129; r += nth) { const int g = r / (4 * 129), h = (r / 129) & 3, j = r % 129; const int rel = (j - 64) << (2 * g);
            bt[(g * 4 + h) * 132 + j] = P.in[2][t5_bucket(rel) * 12 + g * 4 + h]; }
      }
    }
    { const size_t gt = (size_t)blockIdx.x * 512 + tid, NTH = (size_t)G * 512;
      const GAS f32x4* us = (const GAS f32x4*)P.in[17]; const GAS f32x4* vs = (const GAS f32x4*)P.in[18];
      GAS v2u* ud = (GAS v2u*)(ws + WS_UTAB); GAS v2u* vd = (GAS v2u*)(ws + WS_VTAB);
#if TAB_FP6
      {
        const int njobs = 2 * 16384 * 16;
        for (int job = (int)gt; job < njobs; job += (int)NTH) { const int tb = job >> 18, e = (job >> 4) & 16383, fr = job & 15;
            const float sc = tb ? FP4_SV : (TABU_FP4 ? FP4_SU : FP6_SU);
            const GAS f32x4* src = (const GAS f32x4*)((tb ? P.in[18] : P.in[17]) + (size_t)e * 1024);
            const int kq = fr & 3, sp = fr >> 2;
            f32x4 v[16];
#pragma unroll
            for (int idx = 0; idx < 16; ++idx) v[idx] = src[(tb || TABU_FP4) ? (16 * fr + idx) : (32 * (2 * sp + (idx >> 3)) + 8 * kq + (idx & 7))];
            if (tb || TABU_FP4) {
                unsigned wd4[8];
#pragma unroll
                for (int w = 0; w < 8; ++w) { unsigned acc4 = 0u;
#pragma unroll
                    for (int t = 0; t < 8; ++t) acc4 |= fp4_code(v[w * 2 + (t >> 2)][t & 3] * sc) << (4 * t);
                    wd4[w] = acc4; }
                unsigned char* dst4 = ws + (tb ? WS_VTAB : WS_UTAB) + (size_t)e * 512 + fr * 32;
#pragma unroll
                for (int p = 0; p < 2; ++p) { v4u o; o.x = wd4[4 * p]; o.y = wd4[4 * p + 1]; o.z = wd4[4 * p + 2]; o.w = wd4[4 * p + 3]; *(GAS v4u*)(dst4 + p * 16) = o; }
                continue; }
            unsigned wd[12];
#pragma unroll
            for (int h = 0; h < 4; ++h) {
                unsigned cd[16];
#pragma unroll
                for (int q4 = 0; q4 < 4; ++q4)
#pragma unroll
                    for (int t = 0; t < 4; ++t) cd[q4 * 4 + t] = fp6_code(v[h * 4 + q4][t] * sc);
                wd[h * 3 + 0] = cd[0] | (cd[1] << 6) | (cd[2] << 12) | (cd[3] << 18) | (cd[4] << 24) | ((cd[5] & 3u) << 30);
                wd[h * 3 + 1] = (cd[5] >> 2) | (cd[6] << 4) | (cd[7] << 10) | (cd[8] << 16) | (cd[9] << 22) | ((cd[10] & 15u) << 28);
                wd[h * 3 + 2] = (cd[10] >> 4) | (cd[11] << 2) | (cd[12] << 8) | (cd[13] << 14) | (cd[14] << 20) | (cd[15] << 26); }
            unsigned char* dst = ws + WS_UTAB + (size_t)e * 768 + kq * 16;
#pragma unroll
            for (int p = 0; p < 3; ++p) { v4u o; o.x = wd[4 * p]; o.y = wd[4 * p + 1]; o.z = wd[4 * p + 2]; o.w = wd[4 * p + 3]; *(GAS v4u*)(dst + (3 * sp + p) * 64) = o; } } }
#endif
      const GAS f32x4* ms = (const GAS f32x4*)P.in[1]; GAS unsigned* md = (GAS unsigned*)(ws + WS_MEMF8);
      for (size_t i = gt; i < (size_t)512 * 1024 / 4; i += NTH) { const f32x4 a = ms[i]; md[i] = pk4_fp8(a.x, a.y, a.z, a.w); }
    }
}

constexpr int FFT_PITCH = 544, FFT_BUF = 128 * FFT_PITCH;
static_assert(2 * FFT_BUF <= MISC_OFF, "FFT LDS map");
typedef short s16x4 __attribute__((ext_vector_type(4)));
__device__ __forceinline__ s16x4 tr_read(LAS unsigned char* p) { return __builtin_amdgcn_ds_read_tr16_b64_v4i16((LAS s16x4*)p); }
template <int STEP>
__device__ __forceinline__ void fft_step_mfma(const bf16* src, bf16* dst, LAS unsigned char* lds, int tid, int lane, int wave, int G) {
    const int fr = lane & 15, kq = lane >> 4, kout = 16 * wave + fr;
    bf16x8 cf[4], sf[4];
    { LAS float* tab = (LAS float*)(lds + FFT_BUF);
      __syncthreads();
      if (tid < 128) { float sn, cs; sincospif((float)tid / 64.f, &sn, &cs); tab[tid] = cs; tab[128 + tid] = sn; }
      __syncthreads();
#pragma unroll
      for (int kk = 0; kk < 4; ++kk) { v4u cw, sw; unsigned cl[8], sl[8];
#pragma unroll
          for (int j = 0; j < 8; ++j) { const int sv = 32 * kk + (j < 4 ? 4 * kq + j : 16 + 4 * kq + j - 4); const int ix = (kout * sv) & 127; cl[j] = f2bf(tab[ix]); sl[j] = f2bf(tab[128 + ix]); }
          cw.x = cl[0] | (cl[1] << 16); cw.y = cl[2] | (cl[3] << 16); cw.z = cl[4] | (cl[5] << 16); cw.w = cl[6] | (cl[7] << 16);
          sw.x = sl[0] | (sl[1] << 16); sw.y = sl[2] | (sl[3] << 16); sw.z = sl[4] | (sl[5] << 16); sw.w = sl[6] | (sl[7] << 16);
          cf[kk] = __builtin_bit_cast(bf16x8, cw); sf[kk] = __builtin_bit_cast(bf16x8, sw); } }
    v4u iw[8];
#define FFT_LOAD(UN) do { const int b_ = (UN) >> 9, f_ = ((UN) >> 2) & 127, g_ = (UN) & 3; _Pragma("unroll") for (int j = 0; j < 8; ++j) { const int c = tid + 512 * j; const int sr = c >> 5, piece = c & 31; \
            const size_t row = (STEP == 1) ? (size_t)(b_ << 14) + 128 * sr + f_ : (size_t)(b_ << 14) + 128 * f_ + sr; iw[j] = *(const GAS v4u*)(src + row * 1024 + g_ * 256 + piece * 8); } } while (0)
#define FFT_PUT(BUF) do { _Pragma("unroll") for (int j = 0; j < 8; ++j) { const int c = tid + 512 * j; *(LAS v4u*)(lds + (BUF) * FFT_BUF + (c >> 5) * FFT_PITCH + (c & 31) * 16) = iw[j]; } } while (0)
    __syncthreads();
    if (blockIdx.x < 1024) { FFT_LOAD(blockIdx.x); FFT_PUT(0); }
    __syncthreads();
    int cur = 0;
    for (int unit = blockIdx.x; unit < 1024; unit += G) {
        const int b = unit >> 9, f = (unit >> 2) & 127, g = unit & 3;
        const bool more = unit + G < 1024;
        if (more) FFT_LOAD(unit + G);
        LAS unsigned char* img = lds + cur * FFT_BUF;
        f32x4 accR[8], accI[8];
#pragma unroll
        for (int mt = 0; mt < 8; ++mt) { accR[mt] = (f32x4){0.f, 0.f, 0.f, 0.f}; accI[mt] = (f32x4){0.f, 0.f, 0.f, 0.f}; }
#pragma unroll
        for (int mt = 0; mt < 8; ++mt)
#pragma unroll
            for (int kk = 0; kk < 4; ++kk) {
                LAS unsigned char* a1 = img + (32 * kk + 4 * kq + (fr >> 2)) * FFT_PITCH + (16 * mt + 4 * (fr & 3)) * 2;
                LAS unsigned char* a2 = a1 + 16 * FFT_PITCH;
                const s16x4 r0 = tr_read(a1), r1 = tr_read(a2), i0 = tr_read(a1 + 256), i1 = tr_read(a2 + 256);
                const bf16x8 xr = __builtin_shufflevector(r0, r1, 0, 1, 2, 3, 4, 5, 6, 7), xi = __builtin_shufflevector(i0, i1, 0, 1, 2, 3, 4, 5, 6, 7);
                if (STEP == 1) {
                    v4u t = __builtin_bit_cast(v4u, xi); t.x ^= 0x80008000u; t.y ^= 0x80008000u; t.z ^= 0x80008000u; t.w ^= 0x80008000u; const bf16x8 nxi = __builtin_bit_cast(bf16x8, t);
                    accR[mt] = __builtin_amdgcn_mfma_f32_16x16x32_bf16(xr, cf[kk], accR[mt], 0, 0, 0); accR[mt] = __builtin_amdgcn_mfma_f32_16x16x32_bf16(nxi, sf[kk], accR[mt], 0, 0, 0);
                    accI[mt] = __builtin_amdgcn_mfma_f32_16x16x32_bf16(xi, cf[kk], accI[mt], 0, 0, 0); accI[mt] = __builtin_amdgcn_mfma_f32_16x16x32_bf16(xr, sf[kk], accI[mt], 0, 0, 0);
                } else {
                    accR[mt] = __builtin_amdgcn_mfma_f32_16x16x32_bf16(xr, cf[kk], accR[mt], 0, 0, 0); accR[mt] = __builtin_amdgcn_mfma_f32_16x16x32_bf16(xi, sf[kk], accR[mt], 0, 0, 0);
                }
                if (kk == 3) __builtin_amdgcn_sched_barrier(0);
            }
        if (STEP == 1) { float ws_, wc_; sincospif(-(float)(f * kout) / 8192.f, &ws_, &wc_);
            bf16* orow = dst + ((size_t)(b << 14) + kout * 128 + f) * 1024 + g * 256 + 4 * kq;
#pragma unroll
            for (int mt = 0; mt < 8; ++mt) { v2u re, im; re.x = pk2(accR[mt][0] * wc_ + accI[mt][0] * ws_, accR[mt][1] * wc_ + accI[mt][1] * ws_); re.y = pk2(accR[mt][2] * wc_ + accI[mt][2] * ws_, accR[mt][3] * wc_ + accI[mt][3] * ws_);
                im.x = pk2(accR[mt][0] * ws_ - accI[mt][0] * wc_, accR[mt][1] * ws_ - accI[mt][1] * wc_); im.y = pk2(accR[mt][2] * ws_ - accI[mt][2] * wc_, accR[mt][3] * ws_ - accI[mt][3] * wc_);
                *(GAS v2u*)(orow + 16 * mt) = re; *(GAS v2u*)(orow + 128 + 16 * mt) = im; }
        } else { const float scale = 6.905339660024878e-4f;
            bf16* orow = dst + ((size_t)(b << 14) + f + 128 * kout) * 512 + g * 128 + 4 * kq;
#pragma unroll
            for (int mt = 0; mt < 8; ++mt) { v2u re; re.x = pk2(accR[mt][0] * scale, accR[mt][1] * scale); re.y = pk2(accR[mt][2] * scale, accR[mt][3] * scale); *(GAS v2u*)(orow + 16 * mt) = re; }
        }
        if (more) FFT_PUT(cur ^ 1);
        __syncthreads();
        cur ^= 1;
    }
#undef FFT_LOAD
#undef FFT_PUT
}

typedef float f32x16 __attribute__((ext_vector_type(16)));
constexpr int DA_BT = 0, DA_K = 9216, DA_KP = 144, DA_V = DA_K + 384 * DA_KP, DA_VP = 776;
static_assert(DA_V + 64 * DA_VP <= MISC_OFF, "dil-attn LDS map");
template <int T>
__device__ __forceinline__ void dil_tile(LAS unsigned char* lds, int kr0, int r31, int hh, const LAS float* btl, const bf16x8 (&qf)[4], f32x16& o0, f32x16& o1, float& mx, float& den) {
    const LAS unsigned char* kp = lds + DA_K + (kr0 + r31) * DA_KP + 16 * hh;
    f32x16 sacc;
#pragma unroll
    for (int i = 0; i < 16; ++i) sacc[i] = 0.f;
#pragma unroll
    for (int kk = 0; kk < 4; ++kk) { const bf16x8 kf = *(const LAS bf16x8*)(kp + 32 * kk); sacc = __builtin_amdgcn_mfma_f32_32x32x16_bf16(kf, qf[kk], sacc, 0, 0, 0); }
    const LAS float* bl = btl + (32 + 32 * T + 4 * hh - r31);
    float tmax = -INFINITY;
#pragma unroll
    for (int i = 0; i < 16; ++i) { const int krow = (i & 3) + 8 * (i >> 2);
        float sv = sacc[i] * 0.18033688011112042f + bl[krow];
        if (T == 0) sv = (krow + 4 * hh >= r31) ? sv : -INFINITY;
        if (T == 4) sv = (krow + 4 * hh <= r31) ? sv : -INFINITY;
        sacc[i] = sv; tmax = fmaxf(tmax, sv); }
    tmax = fmaxf(tmax, __shfl_xor(tmax, 32));
    const float mn = fmaxf(mx, tmax), corr = __builtin_amdgcn_exp2f(mx - mn); mx = mn;
    float psum = 0.f;
#pragma unroll
    for (int i = 0; i < 16; ++i) { const float p = __builtin_amdgcn_exp2f(sacc[i] - mn); sacc[i] = p; psum += p; }
    den = den * corr + psum;
#pragma unroll
    for (int i = 0; i < 16; ++i) { o0[i] *= corr; o1[i] *= corr; }
#pragma unroll
    for (int s2 = 0; s2 < 2; ++s2) { v4u pw; pw.x = pk2(sacc[8 * s2], sacc[8 * s2 + 1]); pw.y = pk2(sacc[8 * s2 + 2], sacc[8 * s2 + 3]); pw.z = pk2(sacc[8 * s2 + 4], sacc[8 * s2 + 5]); pw.w = pk2(sacc[8 * s2 + 6], sacc[8 * s2 + 7]);
        const bf16x8 pf = __builtin_bit_cast(bf16x8, pw);
        const LAS unsigned char* vp = lds + DA_V + r31 * DA_VP + (kr0 + 16 * s2 + 4 * hh) * 2;
        const v2u lo0 = *(const LAS v2u*)vp, hi0 = *(const LAS v2u*)(vp + 16), lo1 = *(const LAS v2u*)(vp + 32 * DA_VP), hi1 = *(const LAS v2u*)(vp + 32 * DA_VP + 16);
        v4u w0, w1; w0.x = lo0.x; w0.y = lo0.y; w0.z = hi0.x; w0.w = hi0.y; w1.x = lo1.x; w1.y = lo1.y; w1.z = hi1.x; w1.w = hi1.y;
        o0 = __builtin_amdgcn_mfma_f32_32x32x16_bf16(__builtin_bit_cast(bf16x8, w0), pf, o0, 0, 0, 0);
        o1 = __builtin_amdgcn_mfma_f32_32x32x16_bf16(__builtin_bit_cast(bf16x8, w1), pf, o1, 0, 0, 0); }
}
__device__ __forceinline__ void dil_attn_lds(const bf16* qk, const bf16* vt, const float* btab_g, bf16* og, float* lse, LAS unsigned char* lds, int tid, int lane, int wave, int G) {
    LAS float* bt = (LAS float*)(lds + DA_BT);
    __syncthreads();
    for (int i = tid; i < 12 * 192; i += 512) { const int tb = i / 192, j = i - tb * 192 - 32; bt[i] = (j >= 0 && j <= 128) ? btab_g[tb * 132 + j] * 1.4426950408889634f : 0.f; }
    const int r31 = lane & 31, hh = lane >> 5;
    v4u kw[6], vw[6]; bf16x8 qn[4];
#define DIL_UNIT(U) const int blk = (U) & 63, hd = ((U) >> 6) & 3, g = ((U) >> 8) % 3, b = (U) / 768; const int sh = 2 * g, sub = 16384 >> sh; \
        const int nl0 = blk * 256, rr = nl0 >> (14 - sh), l0 = nl0 & (sub - 1); const size_t seq0 = ((size_t)g * NT + (size_t)(b << 14) + (size_t)rr * sub); \
        const bf16* qkg = qk + seq0 * 512; const bf16* vtg = vt + ((size_t)g * 256 + hd * 64) * NT + (size_t)(b << 14) + (size_t)rr * sub;
#define DIL_LOAD() do { _Pragma("unroll") for (int j = 0; j < 6; ++j) { const int c = tid + 512 * j; const int kr = c >> 3, pc = c & 7; const int lk = l0 - 64 + kr; const int lkc = lk < 0 ? 0 : (lk >= sub ? sub - 1 : lk); \
              kw[j] = *(const GAS v4u*)(qkg + (size_t)lkc * 512 + 256 + hd * 64 + pc * 8); \
              const int d = c / 48, pv = c - d * 48; const int lv = l0 - 64 + pv * 8; const int lvc = lv < 0 ? 0 : (lv >= sub ? sub - 8 : lv); \
              vw[j] = *(const GAS v4u*)(vtg + (size_t)d * NT + lvc); } \
          _Pragma("unroll") for (int kk = 0; kk < 4; ++kk) qn[kk] = *(const GAS bf16x8*)(qkg + (size_t)(l0 + 32 * wave + (lane & 31)) * 512 + hd * 64 + 16 * kk + 8 * (lane >> 5)); } while (0)
    if (blockIdx.x < 1536) { DIL_UNIT(blockIdx.x) DIL_LOAD(); }
    for (int u = blockIdx.x; u < 1536; u += G) {
        DIL_UNIT(u)
        __syncthreads();
#pragma unroll
        for (int j = 0; j < 6; ++j) { const int c = tid + 512 * j; const int kr = c >> 3, pc = c & 7;
            *(LAS v4u*)(lds + DA_K + kr * DA_KP + pc * 16) = kw[j];
            const int d = c / 48, pv = c - d * 48;
            v2u lo, hi; lo.x = vw[j].x; lo.y = vw[j].y; hi.x = vw[j].z; hi.y = vw[j].w;
            *(LAS v2u*)(lds + DA_V + d * DA_VP + pv * 16) = lo; *(LAS v2u*)(lds + DA_V + d * DA_VP + pv * 16 + 8) = hi; }
        __syncthreads();
        bf16x8 qf[4];
#pragma unroll
        for (int kk = 0; kk < 4; ++kk) qf[kk] = qn[kk];
        if (u + G < 1536) { const int un = u + G; const int blkn = un & 63, hdn = (un >> 6) & 3, gn = (un >> 8) % 3, bn = un / 768; const int shn = 2 * gn, subn = 16384 >> shn;
            const int nl0n = blkn * 256, rrn = nl0n >> (14 - shn), l0n = nl0n & (subn - 1); const size_t seq0n = ((size_t)gn * NT + (size_t)(bn << 14) + (size_t)rrn * subn);
            const bf16* qkgn = qk + seq0n * 512; const bf16* vtgn = vt + ((size_t)gn * 256 + hdn * 64) * NT + (size_t)(bn << 14) + (size_t)rrn * subn;
#pragma unroll
            for (int j = 0; j < 6; ++j) { const int c = tid + 512 * j; const int kr = c >> 3, pc = c & 7; const int lk = l0n - 64 + kr; const int lkc = lk < 0 ? 0 : (lk >= subn ? subn - 1 : lk);
                kw[j] = *(const GAS v4u*)(qkgn + (size_t)lkc * 512 + 256 + hdn * 64 + pc * 8);
                const int d = c / 48, pv = c - d * 48; const int lv = l0n - 64 + pv * 8; const int lvc = lv < 0 ? 0 : (lv >= subn ? subn - 8 : lv);
                vw[j] = *(const GAS v4u*)(vtgn + (size_t)d * NT + lvc); }
#pragma unroll
            for (int kk = 0; kk < 4; ++kk) qn[kk] = *(const GAS bf16x8*)(qkgn + (size_t)(l0n + 32 * wave + (lane & 31)) * 512 + hdn * 64 + 16 * kk + 8 * (lane >> 5)); }
        const int lq0 = l0 + 32 * wave;
        const LAS float* btl = bt + (g * 4 + hd) * 192;
        f32x16 o0, o1;
#pragma unroll
        for (int i = 0; i < 16; ++i) { o0[i] = 0.f; o1[i] = 0.f; }
        float mx = -1e30f, den = 0.f;
        if (lq0 - 64 >= 0) dil_tile<0>(lds, 32 * wave, r31, hh, btl, qf, o0, o1, mx, den);
        if (lq0 - 32 >= 0) dil_tile<1>(lds, 32 * wave + 32, r31, hh, btl, qf, o0, o1, mx, den);
        dil_tile<2>(lds, 32 * wave + 64, r31, hh, btl, qf, o0, o1, mx, den);
        if (lq0 + 32 < sub) dil_tile<3>(lds, 32 * wave + 96, r31, hh, btl, qf, o0, o1, mx, den);
        if (lq0 + 64 < sub) dil_tile<4>(lds, 32 * wave + 128, r31, hh, btl, qf, o0, o1, mx, den);
        den += __shfl_xor(den, 32);
        const float inv = 1.f / den;
        const size_t n = seq0 + lq0 + r31;
        bf16* orow = og + n * 256 + hd * 64 + 4 * hh;
#pragma unroll
        for (int q4 = 0; q4 < 4; ++q4) { v2u w0, w1; w0.x = pk2(o0[4 * q4] * inv, o0[4 * q4 + 1] * inv); w0.y = pk2(o0[4 * q4 + 2] * inv, o0[4 * q4 + 3] * inv);
            w1.x = pk2(o1[4 * q4] * inv, o1[4 * q4 + 1] * inv); w1.y = pk2(o1[4 * q4 + 2] * inv, o1[4 * q4 + 3] * inv);
            *(GAS v2u*)(orow + 8 * q4) = w0; *(GAS v2u*)(orow + 32 + 8 * q4) = w1; }
        if (hh == 0) lse[n * 4 + hd] = (mx + __builtin_amdgcn_logf(den)) * 0.6931471805599453f;
    }
    __syncthreads();
#undef DIL_UNIT
#undef DIL_LOAD
}
constexpr int MA_KP = 272, MA_VP = 520, MA_V = 256 * MA_KP;
static_assert(MA_V + 128 * MA_VP <= MISC_OFF, "mem-attn LDS map");
__device__ __forceinline__ void mem_attn_lds(const bf16* qc, const bf16* memk, const bf16* vtm, bf16* ycin, LAS unsigned char* lds, int tid, int lane, int wave, int G) {
    const int r31 = lane & 31, hh = lane >> 5;
    for (int wu = blockIdx.x; wu < 256; wu += G) {
        const int combo = wu & 7, b = combo >> 2, hd = combo & 3, chunk = wu >> 3;
        __syncthreads();
        { v4u kw[8], vw[8];
#pragma unroll
          for (int j = 0; j < 8; ++j) { const int c = tid + 512 * j; kw[j] = *(const GAS v4u*)(memk + (size_t)(b * 256 + (c >> 4)) * 512 + hd * 128 + (c & 15) * 8);
              vw[j] = *(const GAS v4u*)(vtm + (size_t)(hd * 128 + (c >> 5)) * 512 + b * 256 + (c & 31) * 8); }
#pragma unroll
          for (int j = 0; j < 8; ++j) { const int c = tid + 512 * j; *(LAS v4u*)(lds + (c >> 4) * MA_KP + (c & 15) * 16) = kw[j];
              v2u lo, hi; lo.x = vw[j].x; lo.y = vw[j].y; hi.x = vw[j].z; hi.y = vw[j].w;
              *(LAS v2u*)(lds + MA_V + (c >> 5) * MA_VP + (c & 31) * 16) = lo; *(LAS v2u*)(lds + MA_V + (c >> 5) * MA_VP + (c & 31) * 16 + 8) = hi; } }
        __syncthreads();
#pragma unroll 1
        for (int qi = 0; qi < 2; ++qi) {
            const int blk = chunk * 16 + wave * 2 + qi;
            const size_t tok = (size_t)(b << 14) + blk * 32 + r31;
            const bf16* qrow = qc + tok * 512 + hd * 128 + 8 * hh;
            bf16x8 qf[8];
#pragma unroll
            for (int kk = 0; kk < 8; ++kk) qf[kk] = *(const GAS bf16x8*)(qrow + 16 * kk);
            f32x16 o[4];
#pragma unroll
            for (int mt = 0; mt < 4; ++mt)
#pragma unroll
                for (int i = 0; i < 16; ++i) o[mt][i] = 0.f;
            float mx = -1e30f, den = 0.f;
            const LAS unsigned char* kb = lds + r31 * MA_KP + 16 * hh;
            const LAS unsigned char* vb = lds + MA_V + r31 * MA_VP + 8 * hh;
#pragma unroll 1
            for (int t = 0; t < 8; ++t) {
                f32x16 sacc;
#pragma unroll
                for (int i = 0; i < 16; ++i) sacc[i] = 0.f;
#pragma unroll
                for (int kk = 0; kk < 8; ++kk) { const bf16x8 kf = *(const LAS bf16x8*)(kb + (32 * t) * MA_KP + 32 * kk); sacc = __builtin_amdgcn_mfma_f32_32x32x16_bf16(kf, qf[kk], sacc, 0, 0, 0); }
                float tmax = -INFINITY;
#pragma unroll
                for (int i = 0; i < 16; ++i) { sacc[i] *= 0.08838834764831845f; tmax = fmaxf(tmax, sacc[i]); }
                tmax = fmaxf(tmax, __shfl_xor(tmax, 32));
                const float mn = fmaxf(mx, tmax), corr = __expf(mx - mn); mx = mn;
                float psum = 0.f;
#pragma unroll
                for (int i = 0; i < 16; ++i) { const float p = __expf(sacc[i] - mn); sacc[i] = p; psum += p; }
                den = den * corr + psum;
#pragma unroll
                for (int mt = 0; mt < 4; ++mt)
#pragma unroll
                    for (int i = 0; i < 16; ++i) o[mt][i] *= corr;
#pragma unroll
                for (int s2 = 0; s2 < 2; ++s2) { v4u pw; pw.x = pk2(sacc[8 * s2], sacc[8 * s2 + 1]); pw.y = pk2(sacc[8 * s2 + 2], sacc[8 * s2 + 3]); pw.z = pk2(sacc[8 * s2 + 4], sacc[8 * s2 + 5]); pw.w = pk2(sacc[8 * s2 + 6], sacc[8 * s2 + 7]);
                    const bf16x8 pf = __builtin_bit_cast(bf16x8, pw);
#pragma unroll
                    for (int mt = 0; mt < 4; ++mt) { const LAS unsigned char* vp = vb + (32 * mt) * MA_VP + (32 * t + 16 * s2) * 2;
                        const v2u lo = *(const LAS v2u*)vp, hi = *(const LAS v2u*)(vp + 16);
                        v4u w; w.x = lo.x; w.y = lo.y; w.z = hi.x; w.w = hi.y;
                        o[mt] = __builtin_amdgcn_mfma_f32_32x32x16_bf16(__builtin_bit_cast(bf16x8, w), pf, o[mt], 0, 0, 0); } }
            }
            den += __shfl_xor(den, 32);
            const float inv = 1.f / den;
            unsigned char* orow = (unsigned char*)ycin + tok * 512 + hd * 128 + 4 * hh; const float inv4 = inv * SC_ACT;
#pragma unroll
            for (int mt = 0; mt < 4; ++mt)
#pragma unroll
                for (int q4 = 0; q4 < 4; ++q4) *(GAS unsigned*)(orow + 32 * mt + 8 * q4) = pk4_fp8(o[mt][4 * q4] * inv4, o[mt][4 * q4 + 1] * inv4, o[mt][4 * q4 + 2] * inv4, o[mt][4 * q4 + 3] * inv4);
        }
    }
    __syncthreads();
}
__device__ __forceinline__ void combine_groups(const bf16* og, const float* lse, bf16* ob, int tid, int G) {
    for (size_t idx = (size_t)blockIdx.x * 512 + tid; idx < (size_t)NT * 32; idx += (size_t)G * 512) {
        const int t = (int)(idx >> 5), ch = (int)(idx & 31), h = ch >> 3, d0 = (ch & 7) * 8, b = t >> 14, s = t & 16383;
        float l[3]; size_t n[3];
#pragma unroll
        for (int g = 0; g < 3; ++g) { const int sh = 2 * g; n[g] = (size_t)(b << 14) + (size_t)(s & ((1 << sh) - 1)) * (16384 >> sh) + (s >> sh); l[g] = lse[((size_t)g * NT + n[g]) * 4 + h]; }
        const float mx = fmaxf(l[0], fmaxf(l[1], l[2])); float w[3], sum = 0.f;
#pragma unroll
        for (int g = 0; g < 3; ++g) { w[g] = __expf(l[g] - mx); sum += w[g]; }
        float o[8] = {0, 0, 0, 0, 0, 0, 0, 0};
#pragma unroll
        for (int g = 0; g < 3; ++g) { const float wg = w[g] / sum; const v4u v = *(const GAS v4u*)(og + ((size_t)g * NT + n[g]) * 256 + h * 64 + d0);
            o[0] += wg * bflo(v.x); o[1] += wg * bfhi(v.x); o[2] += wg * bflo(v.y); o[3] += wg * bfhi(v.y); o[4] += wg * bflo(v.z); o[5] += wg * bfhi(v.z); o[6] += wg * bflo(v.w); o[7] += wg * bfhi(v.w); }
        v2u r; r.x = pk4_fp8(o[0] * SC_ACT, o[1] * SC_ACT, o[2] * SC_ACT, o[3] * SC_ACT); r.y = pk4_fp8(o[4] * SC_ACT, o[5] * SC_ACT, o[6] * SC_ACT, o[7] * SC_ACT);
        *(GAS v2u*)((unsigned char*)ob + (size_t)t * 256 + h * 64 + d0) = r;
    }
}

template <int C> __device__ __forceinline__ unsigned dppu(unsigned v) { return (unsigned)__builtin_amdgcn_update_dpp(0, (int)v, C, 0xF, 0xF, true); }
template <int C> __device__ __forceinline__ float dppf(float v) { return __builtin_bit_cast(float, __builtin_amdgcn_update_dpp(0, __builtin_bit_cast(int, v), C, 0xF, 0xF, true)); }
__device__ __forceinline__ unsigned umax2(unsigned a, unsigned b) { return a > b ? a : b; }
__device__ __forceinline__ unsigned row_max_u(unsigned v) { v = umax2(v, dppu<0xB1>(v)); v = umax2(v, dppu<0x4E>(v)); v = umax2(v, dppu<0x141>(v)); v = umax2(v, dppu<0x140>(v)); return v; }
__device__ __forceinline__ float row_max_f(float v) { v = fmaxf(v, dppf<0xB1>(v)); v = fmaxf(v, dppf<0x4E>(v)); v = fmaxf(v, dppf<0x141>(v)); v = fmaxf(v, dppf<0x140>(v)); return v; }
__device__ __forceinline__ float row_sum_f(float v) { v += dppf<0xB1>(v); v += dppf<0x4E>(v); v += dppf<0x141>(v); v += dppf<0x140>(v); return v; }
__device__ __forceinline__ unsigned ordf(float f) { const unsigned b = __builtin_bit_cast(unsigned, f); return b ^ ((unsigned)((int)b >> 31) | 0x80000000u); }
__device__ __forceinline__ float decf(unsigned k) { const unsigned b = (k & 0x80000000u) ? (k ^ 0x80000000u) : ~k; return __builtin_bit_cast(float, b); }
__device__ __forceinline__ unsigned bperm(unsigned v, int src_lane) { return (unsigned)__builtin_amdgcn_ds_bpermute(src_lane * 4, (int)v); }
typedef __bf16 bf16x2_t __attribute__((ext_vector_type(2)));
__device__ __forceinline__ float dot2bf(unsigned a, unsigned b, float c) { return __builtin_amdgcn_fdot2_f32_bf16(__builtin_bit_cast(bf16x2_t, a), __builtin_bit_cast(bf16x2_t, b), c, false); }

__device__ __forceinline__ float gelu_as(float v) {
    const float av = fabsf(v), t = __builtin_amdgcn_rcpf(av * 0.2316418882f + 1.0f);
    float q = t * 0.5307027145f + (-0.7265760135f); q = q * t + 0.7107068705f; q = q * t + (-0.142248368f); q = q * t + 0.127414796f; q = q * t;
    const float e = __builtin_amdgcn_exp2f((v * v) * (-0.72134752044f));
    const float m = v * (q * e);
    return v < 0.f ? m : v - m;
}
constexpr int PEER_SKB = 0, PEER_EL = 36864, PEER_PTAB = PEER_EL + 32768, PEER_VB = PEER_PTAB + 256, PEER_XA = PEER_VB + 8 * 8192, PEER_WB = PEER_XA + 8 * 1024;
static_assert(PEER_WB + 8 * 64 <= MISC_OFF, "PEER LDS map");
constexpr float PEER_XS = 32.f, PEER_WS = 32.f;
typedef int v8i_p __attribute__((ext_vector_type(8)));
typedef int v2i __attribute__((ext_vector_type(2)));
__device__ __forceinline__ void peer_scores_top16(const bf16* qp, LAS unsigned char* lds, int tokb, int hf, int fr, int fq, unsigned& o0, unsigned& o1, unsigned& o2, unsigned& o3) {
    const bf16* arow = qp + (size_t)(tokb + (fr >> 3)) * 1024 + (fr & 7) * 128 + hf * 64 + 8 * fq;
    const bf16x8 a0 = *(const GAS bf16x8*)arow, a1 = *(const GAS bf16x8*)(arow + 32);
    unsigned e0[8], e1[8], e2[8], e3[8];
#pragma unroll
    for (int nb = 0; nb < 8; ++nb) {
        const LAS unsigned char* bp = lds + PEER_SKB + hf * 18432 + (fr + 16 * nb) * 144 + fq * 16;
        const bf16x8 b0 = *(const LAS bf16x8*)bp, b1 = *(const LAS bf16x8*)(bp + 64);
        f32x4 acc = (f32x4){0.f, 0.f, 0.f, 0.f};
        acc = __builtin_amdgcn_mfma_f32_16x16x32_bf16(a0, b0, acc, 0, 0, 0);
        acc = __builtin_amdgcn_mfma_f32_16x16x32_bf16(a1, b1, acc, 0, 0, 0);
        const unsigned ix = (unsigned)(127 - (fr + 16 * nb));
        e0[nb] = (ordf(acc[0]) & ~127u) | ix; e1[nb] = (ordf(acc[1]) & ~127u) | ix; e2[nb] = (ordf(acc[2]) & ~127u) | ix; e3[nb] = (ordf(acc[3]) & ~127u) | ix;
    }
    o0 = 0u; o1 = 0u; o2 = 0u; o3 = 0u;
#define PEER_CE(E, A, B) do { const unsigned hi_ = umax2(E[A], E[B]), lo_ = E[A] < E[B] ? E[A] : E[B]; E[A] = hi_; E[B] = lo_; } while (0)
#define PEER_SORT8(E) do { PEER_CE(E, 0, 1); PEER_CE(E, 2, 3); PEER_CE(E, 4, 5); PEER_CE(E, 6, 7); PEER_CE(E, 0, 2); PEER_CE(E, 1, 3); PEER_CE(E, 4, 6); PEER_CE(E, 5, 7); PEER_CE(E, 1, 2); PEER_CE(E, 5, 6); \
        PEER_CE(E, 0, 4); PEER_CE(E, 1, 5); PEER_CE(E, 2, 6); PEER_CE(E, 3, 7); PEER_CE(E, 2, 4); PEER_CE(E, 3, 5); PEER_CE(E, 1, 2); PEER_CE(E, 3, 4); PEER_CE(E, 5, 6); } while (0)
#define PEER_ROUND(E, O) do { const unsigned m = row_max_u(E[0]); const bool win = (E[0] == m); \
        E[0] = win ? E[1] : E[0]; E[1] = win ? E[2] : E[1]; E[2] = win ? E[3] : E[2]; E[3] = win ? E[4] : E[3]; E[4] = win ? E[5] : E[4]; E[5] = win ? E[6] : E[5]; E[6] = win ? E[7] : E[6]; E[7] = win ? 0u : E[7]; \
        O = (fr == r) ? m : O; } while (0)
    PEER_SORT8(e0); PEER_SORT8(e1); PEER_SORT8(e2); PEER_SORT8(e3);
#pragma unroll 1
    for (int r = 0; r < 16; ++r) { PEER_ROUND(e0, o0); PEER_ROUND(e1, o1); PEER_ROUND(e2, o2); PEER_ROUND(e3, o3); }
#undef PEER_ROUND
#undef PEER_SORT8
#undef PEER_CE
}
__device__ __forceinline__ void peer_cand(LAS unsigned char* lds, LAS unsigned char* el, unsigned ptab, unsigned L1, unsigned L2, int lane, int fr, int slot) {
    unsigned c0, c1, c2, c3;
#define PEER_CK(SL, C) do { const unsigned byte = (ptab >> (8 * SL)) & 255u; const int a = byte >> 4, b = byte & 15; \
        const unsigned k1 = bperm(L1, (lane & 48) + a), k2 = bperm(L2, (lane & 48) + b); const float sum = decf(k1 & ~127u) + decf(k2 & ~127u); \
        C = (byte != 255u) ? ((ordf(sum) & ~63u) | (unsigned)(fr * 4 + SL)) : 0u; } while (0)
    PEER_CK(0, c0); PEER_CK(1, c1); PEER_CK(2, c2); PEER_CK(3, c3);
#undef PEER_CK
    unsigned co = 0u;
#define PEER_CE2(A, B) do { const unsigned hi_ = umax2(A, B), lo_ = A < B ? A : B; A = hi_; B = lo_; } while (0)
    PEER_CE2(c0, c1); PEER_CE2(c2, c3); PEER_CE2(c0, c2); PEER_CE2(c1, c3); PEER_CE2(c1, c2);
#undef PEER_CE2
#pragma unroll 1
    for (int r = 0; r < 16; ++r) { const unsigned m = row_max_u(c0); const bool win = (c0 == m);
        c0 = win ? c1 : c0; c1 = win ? c2 : c1; c2 = win ? c3 : c2; c3 = win ? 0u : c3;
        co = (fr == r) ? m : co; }
    const unsigned pb = *(LAS unsigned char*)(lds + PEER_PTAB + (co & 63u));
    const unsigned k1 = bperm(L1, (lane & 48) + (int)(pb >> 4)), k2 = bperm(L2, (lane & 48) + (int)(pb & 15u));
    const unsigned expert = (127u - (k1 & 127u)) * 128u + (127u - (k2 & 127u));
    const float sc = decf(co & ~63u);
    const float ex = __expf(sc - row_max_f(sc));
    const float gate = ex / row_sum_f(ex);
    v2u rec; rec.x = expert; rec.y = __builtin_bit_cast(unsigned, gate);
    *(LAS v2u*)(el + slot * 8) = rec;
}
template <int sh>
__device__ __forceinline__ void peer_regroup16(const LAS unsigned char* src, LAS unsigned char* dst, int lane, int fr) {
    v2u rc[8]; unsigned c0 = 0u, c1 = 0u, c2 = 0u, c3 = 0u;
#pragma unroll
    for (int j = 0; j < 8; ++j) { rc[j] = *(const LAS v2u*)(src + (fr * 8 + j) * 8); const unsigned bk = (rc[j].x >> sh) & 15u, one = 1u << (8 * (bk & 3u)), w = bk >> 2;
        c0 += (w == 0u) ? one : 0u; c1 += (w == 1u) ? one : 0u; c2 += (w == 2u) ? one : 0u; c3 += (w == 3u) ? one : 0u; }
    unsigned i0 = c0, i1 = c1, i2 = c2, i3 = c3;
    i0 += dppu<0x111>(i0); i1 += dppu<0x111>(i1); i2 += dppu<0x111>(i2); i3 += dppu<0x111>(i3);
    i0 += dppu<0x112>(i0); i1 += dppu<0x112>(i1); i2 += dppu<0x112>(i2); i3 += dppu<0x112>(i3);
    i0 += dppu<0x114>(i0); i1 += dppu<0x114>(i1); i2 += dppu<0x114>(i2); i3 += dppu<0x114>(i3);
    i0 += dppu<0x118>(i0); i1 += dppu<0x118>(i1); i2 += dppu<0x118>(i2); i3 += dppu<0x118>(i3);
    const int l15 = (lane & 48) + 15;
    const unsigned t0 = bperm(i0, l15), t1 = bperm(i1, l15), t2 = bperm(i2, l15), t3 = bperm(i3, l15);
    const unsigned s0 = (t0 * 0x01010101u) >> 24, s1 = (t1 * 0x01010101u) >> 24, s2 = (t2 * 0x01010101u) >> 24;
    unsigned p0 = (i0 - c0) + (t0 * 0x01010100u), p1 = (i1 - c1) + (t1 * 0x01010100u) + s0 * 0x01010101u, p2 = (i2 - c2) + (t2 * 0x01010100u) + (s0 + s1) * 0x01010101u,
             p3 = (i3 - c3) + (t3 * 0x01010100u) + (s0 + s1 + s2) * 0x01010101u;
#pragma unroll
    for (int j = 0; j < 8; ++j) { const unsigned bk = (rc[j].x >> sh) & 15u, q8 = 8 * (bk & 3u), w = bk >> 2, one = 1u << q8;
        const unsigned pw = (w == 0u) ? p0 : ((w == 1u) ? p1 : ((w == 2u) ? p2 : p3));
        *(LAS v2u*)(dst + ((pw >> q8) & 255u) * 8) = rc[j];
        p0 += (w == 0u) ? one : 0u; p1 += (w == 1u) ? one : 0u; p2 += (w == 2u) ? one : 0u; p3 += (w == 3u) ? one : 0u; }
}
__device__ __forceinline__ void peer_v2(const Ptrs& P, LAS unsigned char* lds, int tid, int lane, int wave, int G) {
    unsigned char* ws = P.ws;
    const bf16* qp = (const bf16*)(ws + WS_QP); const bf16* utab = (const bf16*)(ws + WS_UTAB); const bf16* vtab = (const bf16*)(ws + WS_VTAB);
    const bf16* h1b = (const bf16*)(ws + WS_H1B);
    const int fr = lane & 15, fq = lane >> 4;
    for (int idx = tid; idx < 2 * 128 * 32; idx += 512) { const int hf = idx >> 12, k = (idx >> 5) & 127, c2 = idx & 31; const float* sk = (hf ? P.in[16] : P.in[15]) + k * 64 + c2 * 2;
        *(LAS unsigned*)(lds + PEER_SKB + hf * 18432 + k * 144 + c2 * 4) = pk2(sk[0], sk[1]); }
    if (tid < 64) { int q = 0, a = 0, b = 0; unsigned char val = 0xFF;
        for (a = 0; a < 16 && val == 0xFF; ++a) for (b = 0; b < 16 && (a + 1) * (b + 1) <= 16; ++b) { if (q == tid) { val = (unsigned char)((a << 4) | b); break; } ++q; }
        *(LAS unsigned char*)(lds + PEER_PTAB + tid) = val; }
    __syncthreads();
    LAS unsigned char* el = lds + PEER_EL + wave * 4096;
    const int lane_k = lane;
    for (int tile = blockIdx.x; tile < NT / 32; tile += G) {
        const int lane = (int)opq((unsigned)lane_k), fr = lane & 15, fq = lane >> 4; const unsigned ptab = *(LAS unsigned*)(lds + PEER_PTAB + fr * 4);
        const int tok0 = tile * 32 + wave * 4;
#pragma unroll 1
        for (int mt = 0; mt < 2; ++mt) {
            unsigned L00, L01, L02, L03, L10, L11, L12, L13;
            peer_scores_top16(qp, lds, tok0 + 2 * mt, 0, fr, fq, L00, L01, L02, L03);
            peer_scores_top16(qp, lds, tok0 + 2 * mt, 1, fr, fq, L10, L11, L12, L13);
            peer_cand(lds, el, ptab, L00, L10, lane, fr, (2 * mt + (fq >> 1)) * 128 + ((fq & 1) * 4 + 0) * 16 + fr);
            peer_cand(lds, el, ptab, L01, L11, lane, fr, (2 * mt + (fq >> 1)) * 128 + ((fq & 1) * 4 + 1) * 16 + fr);
            peer_cand(lds, el, ptab, L02, L12, lane, fr, (2 * mt + (fq >> 1)) * 128 + ((fq & 1) * 4 + 2) * 16 + fr);
            peer_cand(lds, el, ptab, L03, L13, lane, fr, (2 * mt + (fq >> 1)) * 128 + ((fq & 1) * 4 + 3) * 16 + fr);
        }
        asm volatile("s_waitcnt lgkmcnt(0)" ::: "memory");
        LAS unsigned char* vb = lds + PEER_VB + wave * 8192;
        __builtin_amdgcn_sched_barrier(0);
        peer_regroup16<6>(el + fq * 1024, vb + fq * 1024, lane, fr);
        asm volatile("s_waitcnt lgkmcnt(0)" ::: "memory"); __builtin_amdgcn_sched_barrier(0);
        peer_regroup16<10>(vb + fq * 1024, el + fq * 1024, lane, fr);
        asm volatile("s_waitcnt lgkmcnt(0)" ::: "memory"); __builtin_amdgcn_sched_barrier(0);
        const unsigned char* u6 = (const unsigned char*)utab; const unsigned char* v6 = (const unsigned char*)vtab;
        LAS unsigned char* xal = lds + PEER_XA + wave * 1024; LAS unsigned char* wbl = lds + PEER_WB + wave * 64;
        const unsigned trsw = (unsigned)(4 * (fr >> 3) + ((fr & 7) >> 1));
        const unsigned trb = (unsigned)((fr >> 3) * 1024 + (fr & 7) * 128 + (fq & 1) * 8);
        const unsigned tr00 = trb + (((unsigned)(0 + (fq >> 1) + 0) ^ trsw) & 7u) * 16u, tr01 = trb + (((unsigned)(0 + (fq >> 1) + 2) ^ trsw) & 7u) * 16u;
        const unsigned tr10 = trb + (((unsigned)(4 + (fq >> 1) + 0) ^ trsw) & 7u) * 16u, tr11 = trb + (((unsigned)(4 + (fq >> 1) + 2) ^ trsw) & 7u) * 16u;
        const int awg = 2 * (fr >> 2) + (fr & 3);
        const bool aw0 = ((fr & 3) < 2) && (awg == fq), aw1 = ((fr & 3) < 2) && (awg == fq + 4);
        const unsigned uofs = (unsigned)(fq * 64 + (fr & 3) * 16);
        const unsigned xofs = (unsigned)(128 * (fq >> 1) + 32 * (fr & 3) + 16 * (fq & 1));
        const int vsrc0 = (lane >> 3), vsrc1 = 8 + (lane >> 3);
        const unsigned vpo0 = (unsigned)((((lane & 7) ^ (0 + (lane >> 4))) & 7) * 16), vpo1 = (unsigned)((((lane & 7) ^ (4 + (lane >> 4))) & 7) * 16);
#define PEER_ULOAD(U, E) do { const unsigned ee_ = (E); \
            const unsigned i0_ = dppu<0x00>(ee_), i1_ = dppu<0x55>(ee_), i2_ = dppu<0xAA>(ee_), i3_ = dppu<0xFF>(ee_);        \
            const unsigned char* p0_ = u6 + (size_t)i0_ * 512 + uofs; const unsigned char* p1_ = u6 + (size_t)i1_ * 512 + uofs; \
            const unsigned char* p2_ = u6 + (size_t)i2_ * 512 + uofs; const unsigned char* p3_ = u6 + (size_t)i3_ * 512 + uofs; \
            U[0] = *(const GAS v4u*)p0_; U[1] = *(const GAS v4u*)(p0_ + 256); U[2] = *(const GAS v4u*)p1_; U[3] = *(const GAS v4u*)(p1_ + 256); \
            U[4] = *(const GAS v4u*)p2_; U[5] = *(const GAS v4u*)(p2_ + 256); U[6] = *(const GAS v4u*)p3_; U[7] = *(const GAS v4u*)(p3_ + 256); } while (0)
#define PEER_VDMA(E) do { const unsigned ee_ = (E); const unsigned ia_ = bperm(ee_, vsrc0), ib_ = bperm(ee_, vsrc1); \
            const unsigned char* va_ = v6 + (size_t)ia_ * 512 + vpo0; const unsigned char* vb_ = v6 + (size_t)ib_ * 512 + vpo1; \
            _Pragma("unroll") for (int l = 0; l < 4; ++l) { \
                asm volatile("s_mov_b32 m0, %1\n\ts_nop 0\n\tglobal_load_lds_dwordx4 %0, off" :: "v"(va_ + l * 128), "s"(vbaddr + (unsigned)(2 * l) * 1024u) : "memory"); \
                asm volatile("s_mov_b32 m0, %1\n\ts_nop 0\n\tglobal_load_lds_dwordx4 %0, off" :: "v"(vb_ + l * 128), "s"(vbaddr + (unsigned)(2 * l + 1) * 1024u) : "memory"); } } while (0)
        const unsigned vbaddr = (unsigned)__builtin_amdgcn_readfirstlane((int)(unsigned)(size_t)vb);
#pragma unroll 1
        for (int tq = 0; tq < 4; ++tq) {
            const int tok = tok0 + tq; const int lane_t = (int)opq((unsigned)lane);
            const LAS unsigned char* recp = el + (tq * 128 + fr) * 8;
            unsigned e_cur = *(const LAS unsigned*)recp; float g_cur = *(const LAS float*)(recp + 4);
            v4u ub[8], ub2[8];
            asm volatile("s_waitcnt lgkmcnt(0)" ::: "memory");
            PEER_ULOAD(ub, e_cur);
            PEER_VDMA(e_cur);
            float xn[16];
            { const bf16* prow = (const bf16*)(ws + WS_H0) + (size_t)tok * 1024 + lane_t * 16;
              const GAS f32x4* sp = (const GAS f32x4*)((const float*)(ws + WS_STATS4) + (size_t)tok * 8); const f32x4 sa = sp[0], sb = sp[1];
              f32x2 st; st.x = ((sa.x + sa.z) + sb.x) + sb.z; st.y = ((sa.y + sa.w) + sb.y) + sb.w;
              const float mean1 = st.x * (1.f / D), rstd1 = 1.f / sqrtf(fmaxf(st.y * (1.f / D) - mean1 * mean1, 0.f) + LN_EPS);
#pragma unroll
              for (int q8 = 0; q8 < 2; ++q8) { const v4u pw = *(const GAS v4u*)(prow + q8 * 8); f32x4 pa, pb2; unpack8(pw, pa, pb2);
#pragma unroll
                for (int hq = 0; hq < 2; ++hq) { const int q4 = q8 * 2 + hq; const f32x4 pv = hq ? pb2 : pa;
                    const f32x4 gv = *(const GAS f32x4*)(P.in[12] + lane_t * 16 + q4 * 4), bv = *(const GAS f32x4*)(P.in[13] + lane_t * 16 + q4 * 4);
                    const f32x4 xv = (pv - mean1) * rstd1 * gv + bv;
                    xn[q4 * 4] = xv.x; xn[q4 * 4 + 1] = xv.y; xn[q4 * 4 + 2] = xv.z; xn[q4 * 4 + 3] = xv.w; } } }
            { v4u xq;
#pragma unroll
              for (int c = 0; c < 4; ++c) xq[c] = pk4_fp8(__builtin_amdgcn_fmed3f(xn[4 * c] * PEER_XS, -448.f, 448.f), __builtin_amdgcn_fmed3f(xn[4 * c + 1] * PEER_XS, -448.f, 448.f),
                                                          __builtin_amdgcn_fmed3f(xn[4 * c + 2] * PEER_XS, -448.f, 448.f), __builtin_amdgcn_fmed3f(xn[4 * c + 3] * PEER_XS, -448.f, 448.f));
              *(LAS v4u*)(xal + lane * 16) = xq; }
            unsigned xnb[8];
#pragma unroll
            for (int i = 0; i < 8; ++i) xnb[i] = pk2(xn[2 * i], xn[2 * i + 1]);
            asm volatile("s_waitcnt lgkmcnt(0)" ::: "memory");
            f32x4 yacc[8];
#pragma unroll
            for (int m = 0; m < 8; ++m) yacc[m] = (f32x4){0.f, 0.f, 0.f, 0.f};
#define PEER_BATCH(BI, UC, UN, HASNEXT) do { \
                unsigned e_nx = e_cur; float g_nx = g_cur; \
                if (HASNEXT) { e_nx = *(const LAS unsigned*)(recp + ((BI) + 1) * 128); g_nx = *(const LAS float*)(recp + ((BI) + 1) * 128 + 4); PEER_ULOAD(UN, e_nx); } \
                const unsigned xo = opq(xofs);              \
                v8i_p xs0, xs1; \
                { const v4u l0 = *(const LAS v4u*)(xal + xo), h0_ = *(const LAS v4u*)(xal + xo + 256), l1 = *(const LAS v4u*)(xal + xo + 512), h1_ = *(const LAS v4u*)(xal + xo + 768); \
                  xs0[0] = (int)l0.x; xs0[1] = (int)l0.y; xs0[2] = (int)l0.z; xs0[3] = (int)l0.w; xs0[4] = (int)h0_.x; xs0[5] = (int)h0_.y; xs0[6] = (int)h0_.z; xs0[7] = (int)h0_.w; \
                  xs1[0] = (int)l1.x; xs1[1] = (int)l1.y; xs1[2] = (int)l1.z; xs1[3] = (int)l1.w; xs1[4] = (int)h1_.x; xs1[5] = (int)h1_.y; xs1[6] = (int)h1_.z; xs1[7] = (int)h1_.w; } \
                float hsum = 0.f; \
                _Pragma("unroll") for (int e4 = 0; e4 < 4; ++e4) { v8i_p b0_, b1_; \
                    b0_[0] = (int)UC[2 * e4].x; b0_[1] = (int)UC[2 * e4].y; b0_[2] = (int)UC[2 * e4].z; b0_[3] = (int)UC[2 * e4].w; b0_[4] = 0; b0_[5] = 0; b0_[6] = 0; b0_[7] = 0; \
                    b1_[0] = (int)UC[2 * e4 + 1].x; b1_[1] = (int)UC[2 * e4 + 1].y; b1_[2] = (int)UC[2 * e4 + 1].z; b1_[3] = (int)UC[2 * e4 + 1].w; b1_[4] = 0; b1_[5] = 0; b1_[6] = 0; b1_[7] = 0; \
                    f32x4 acc = (f32x4){0.f, 0.f, 0.f, 0.f}; \
                    acc = __builtin_amdgcn_mfma_scale_f32_16x16x128_f8f6f4(xs0, b0_, acc, 0, 4, 0, 0x7F7F7F7F, 0, 0x7F7F7F7F); \
                    acc = __builtin_amdgcn_mfma_scale_f32_16x16x128_f8f6f4(xs1, b1_, acc, 0, 4, 0, 0x7F7F7F7F, 0, 0x7F7F7F7F); \
                    float val = ((fr & 3) == 0) ? acc[0] : (((fr & 3) == 1) ? acc[1] : (((fr & 3) == 2) ? acc[2] : acc[3])); \
                    val += dppf<0xB1>(val); val += dppf<0x4E>(val);                                    \
                    hsum = ((fr & 3) == e4) ? val : hsum; } \
                const float h = hsum * (1.f / (PEER_XS * FP4_SU)); \
                const float wq = __builtin_amdgcn_fmed3f(g_cur * gelu_as(h) * PEER_WS, -448.f, 448.f); \
                *(LAS unsigned char*)(wbl + fr) = (unsigned char)(pk4_fp8(wq, 0.f, 0.f, 0.f) & 255u); \
                asm volatile("s_waitcnt lgkmcnt(0)" ::: "memory"); \
                const v4u W = *(const LAS v4u*)wbl; \
                v8i_p aw; aw[0] = aw0 ? (int)W.x : 0; aw[1] = aw0 ? (int)W.y : 0; aw[2] = aw0 ? (int)W.z : 0; aw[3] = aw0 ? (int)W.w : 0; \
                aw[4] = aw1 ? (int)W.x : 0; aw[5] = aw1 ? (int)W.y : 0; aw[6] = aw1 ? (int)W.z : 0; aw[7] = aw1 ? (int)W.w : 0; \
                if (HASNEXT) asm volatile("s_waitcnt vmcnt(8)" ::: "memory"); else asm volatile("s_waitcnt vmcnt(0)" ::: "memory");        \
                _Pragma("unroll") for (int m = 0; m < 8; ++m) { const v2i t0 = __builtin_amdgcn_ds_read_tr4_b64_v2i32((LAS v2i*)(vb + (m >> 1) * 2048 + ((m & 1) ? tr10 : tr00))), t1 = __builtin_amdgcn_ds_read_tr4_b64_v2i32((LAS v2i*)(vb + (m >> 1) * 2048 + ((m & 1) ? tr11 : tr01))); \
                    v8i_p bv; bv[0] = t0[0]; bv[1] = t0[1]; bv[2] = t1[0]; bv[3] = t1[1]; bv[4] = 0; bv[5] = 0; bv[6] = 0; bv[7] = 0; \
                    yacc[m] = __builtin_amdgcn_mfma_scale_f32_16x16x128_f8f6f4(aw, bv, yacc[m], 0, 4, 0, 0x7F7F7F7F, 0, 0x7F7F7F7F); } \
                asm volatile("s_waitcnt lgkmcnt(0)" ::: "memory"); \
                if (HASNEXT) PEER_VDMA(e_nx); \
                e_cur = e_nx; g_cur = g_nx; } while (0)
#pragma unroll 1
            for (int bp = 0; bp < 3; ++bp) { PEER_BATCH(2 * bp, ub, ub2, 1); PEER_BATCH(2 * bp + 1, ub2, ub, 1); }
            PEER_BATCH(6, ub, ub2, 1); PEER_BATCH(7, ub2, ub, 0);
#undef PEER_BATCH
#pragma unroll
            for (int m = 0; m < 8; ++m) { *(LAS float*)(vb + m * 512 + lane * 4) = yacc[m][0]; *(LAS float*)(vb + m * 512 + 256 + lane * 4) = yacc[m][1]; }
            asm volatile("s_waitcnt lgkmcnt(0)" ::: "memory");
            float yv[16];
#pragma unroll
            for (int q4 = 0; q4 < 4; ++q4) { const f32x4 t = *(const LAS f32x4*)(vb + lane * 64 + q4 * 16); yv[q4 * 4] = t.x; yv[q4 * 4 + 1] = t.y; yv[q4 * 4 + 2] = t.z; yv[q4 * 4 + 3] = t.w; }
            asm volatile("s_waitcnt lgkmcnt(0)" ::: "memory");
            float ssum = 0.f;
#pragma unroll
            for (int i = 0; i < 16; ++i) { yv[i] = yv[i] * (1.f / (PEER_WS * FP4_SV)) + ALPHA * ((i & 1) ? bfhi(xnb[i >> 1]) : bflo(xnb[i >> 1])); ssum += yv[i]; }
            const float mean = wave_sum(ssum) * (1.f / D);
            float s2 = 0.f;
#pragma unroll
            for (int i = 0; i < 16; ++i) { yv[i] -= mean; s2 += yv[i] * yv[i]; }
            const float rstd = 1.f / sqrtf(wave_sum(s2) * (1.f / D) + LN_EPS);
            float* orow = P.out + (size_t)tok * 1024 + lane_t * 16;
#pragma unroll
            for (int q4 = 0; q4 < 4; ++q4) { const f32x4 g0 = *(const GAS f32x4*)(P.in[19] + lane_t * 16 + q4 * 4), b0 = *(const GAS f32x4*)(P.in[20] + lane_t * 16 + q4 * 4);
                f32x4 o; o.x = yv[q4 * 4] * rstd * g0.x + b0.x; o.y = yv[q4 * 4 + 1] * rstd * g0.y + b0.y; o.z = yv[q4 * 4 + 2] * rstd * g0.z + b0.z; o.w = yv[q4 * 4 + 3] * rstd * g0.w + b0.w;
                *(GAS f32x4*)(orow + q4 * 4) = o; }
        }
        asm volatile("s_waitcnt lgkmcnt(0)" ::: "memory");
    }
}

struct Args { const float* in[21]; float* out; unsigned char* ws; int ph_lo, ph_hi; };
__global__ void __launch_bounds__(NWAVES * 64, 2) fwd_kernel(Args args) {
    extern __shared__ __attribute__((aligned(16))) unsigned char lds_raw[];
    LAS unsigned char* lds = (LAS unsigned char*)lds_raw;
    volatile LAS unsigned* MISC = (volatile LAS unsigned*)(lds + MISC_OFF);
    const int tid = threadIdx.x, lane = tid & 63, wave = __builtin_amdgcn_readfirstlane(tid >> 6);
    const int G = gridDim.x;
    Ptrs P;
#pragma unroll
    for (int i = 0; i < 21; ++i) P.in[i] = args.in[i];
    P.out = args.out; P.ws = args.ws;
    unsigned char* ws = args.ws;
    if (tid < 16) MISC[tid] = 0u;
    __syncthreads();
    XcdBarrier bar; bar.bar = (unsigned*)(ws + WS_CTL) + 4096; bar.x = 0; bar.st = nullptr;
    if (N_LAUNCHES == 1) bar = xcd_barrier_post((unsigned*)(ws + WS_CTL) + 4096, MISC + 8);
    const int lo = args.ph_lo, hi = args.ph_hi;
#ifndef PHMASK
#define PHMASK 0x1ff
#endif
#define IN(k) (((PHMASK >> (k)) & 1) && lo <= (k) && (k) < hi)
#define SEAM(k) do { if (IN(k) && IN((k) + 1)) xcd_barrier(bar); } while (0)

    if (IN(0)) { phase0(P, lds, tid, lane, wave, G); } SEAM(0);

    if (IN(1)) {
        if (blockIdx.x < 4) { const int n = blockIdx.x * 256 + (tid & 255); const float* part = (const float*)(ws + WS_CPART) + (tid >> 8) * 16 * 1024; float a = 0.f;
#pragma unroll
            for (int kb = 0; kb < 16; ++kb) a += part[kb * 1024 + n];
            ((float*)(ws + ((tid >> 8) ? WS_DVEC : WS_CVEC)))[n] = a; }
        for (int i = tid; i < WR_GATE; i += 512) ((LAS float*)(lds + RING_BYTES))[i] = ((const float*)(ws + WS_BIASIN))[i];
        __syncthreads();
        SchedP1 S{(const char*)ws, G, (int)blockIdx.x};
        EpiP1 E{(bf16*)P.out, ws, lds + RING_BYTES};
        pg8::gemm_phase<EpiP1, SchedP1, 2>(lds, S, E);
    } SEAM(1);

    if (IN(2)) {
        fft_step_mfma<1>((const bf16*)P.out, (bf16*)P.out + (size_t)NT * 1024, lds, tid, lane, wave, G);
        dil_attn_lds((const bf16*)(ws + WS_QK), (const bf16*)(ws + WS_VT), (const float*)(ws + WS_BIASTAB), (bf16*)(ws + WS_OG), (float*)(ws + WS_LSE), lds, tid, lane, wave, G);
        mem_attn_lds((const bf16*)(ws + WS_QC), (const bf16*)(ws + WS_MEMKV), (const bf16*)(ws + WS_MEMKV) + 512 * 512, (bf16*)(ws + WS_YCIN), lds, tid, lane, wave, G);
    } SEAM(2);

    if (IN(3)) {
        fft_step_mfma<2>((const bf16*)P.out + (size_t)NT * 1024, (bf16*)(ws + WS_FA), lds, tid, lane, wave, G);
        combine_groups((const bf16*)(ws + WS_OG), (const float*)(ws + WS_LSE), (bf16*)(ws + WS_OB), tid, G);
    } SEAM(3);

    if (IN(4)) {
        SchedP4 S{(const char*)ws, G, (int)blockIdx.x};
        for (int i = tid; i < 3072; i += 512) ((LAS float*)(lds + RING_BYTES))[i] = ((const float*)(ws + WS_BIASIN))[WR_GATE + i];
        __syncthreads();
        EpiP4 E{(bf16*)(ws + WS_MERGED), lds + RING_BYTES};
        pg8::gemm_phase<EpiP4, SchedP4, 2>(lds, S, E);
    } SEAM(4);

    if (IN(5)) {
        SchedPlain S{(const char*)(ws + WS_MERGED), (const char*)(ws + WS_WTO), G, (int)blockIdx.x, K_WO};
        EpiP5 E{(bf16*)(ws + WS_H0), (float*)(ws + WS_PRELN), (float*)(ws + WS_STATS4), lds + RING_BYTES};
        pg8::gemm_phase<EpiP5, SchedPlain>(lds, S, E);
    } SEAM(5);


    if (IN(7)) {
        SchedPlain S{(const char*)(ws + WS_H0), (const char*)(ws + WS_WTPQ), G, (int)blockIdx.x, K_PQ};
        EpiP7 E{(bf16*)(ws + WS_QP), (const float*)(ws + WS_STATS4), (const float*)(ws + WS_CVEC), (const float*)(ws + WS_DVEC)};
        pg8::gemm_phase<EpiP7, SchedPlain>(lds, S, E);
    } SEAM(7);

    if (IN(8)) {
        peer_v2(P, lds, tid, lane, wave, G);
    }
#undef IN
#undef SEAM
}

extern "C" void kernel_launch(void* const* d_in, const int* in_sizes, int n_in, void* d_out, int out_size, void* d_ws, size_t ws_size, hipStream_t stream) {
    static int grid = 0;
    if (grid == 0) {
        if (n_in != 21 || out_size != NT * D || ws_size < WS_END) { fprintf(stderr, "kernel_launch: unexpected shapes (n_in %d, out %d, ws %zu); nothing launched\n", n_in, out_size, ws_size); grid = -1; return; }
        int dev = 0, cus = 0, per_cu = 0;
        if (hipGetDevice(&dev) != hipSuccess || hipDeviceGetAttribute(&cus, hipDeviceAttributeMultiprocessorCount, dev) != hipSuccess) { grid = -1; return; }
        if (hipFuncSetAttribute((const void*)fwd_kernel, hipFuncAttributeMaxDynamicSharedMemorySize, LDS_BYTES) != hipSuccess) { fprintf(stderr, "kernel_launch: hipFuncSetAttribute failed\n"); grid = -1; return; }
        if (hipOccupancyMaxActiveBlocksPerMultiprocessor(&per_cu, (const void*)fwd_kernel, NWAVES * 64, LDS_BYTES) != hipSuccess || per_cu < 1) { fprintf(stderr, "kernel_launch: occupancy query says %d\n", per_cu); }
        (void)hipGetLastError();
        grid = cus;
    }
    if (grid < 0) return;
    (void)hipMemsetAsync((char*)d_ws + WS_CTL, 0, CTL_ZERO_BYTES, stream);
    Args a{};
    for (int i = 0; i < 21; ++i) a.in[i] = (const float*)d_in[i];
    a.out = (float*)d_out; a.ws = (unsigned char*)d_ws;
    if (N_LAUNCHES == 1) { a.ph_lo = 0; a.ph_hi = NPH; hipLaunchKernelGGL(fwd_kernel, dim3(grid), dim3(NWAVES * 64), LDS_BYTES, stream, a); }
    else for (int ph = 0; ph < NPH; ++ph) { a.ph_lo = ph; a.ph_hi = ph + 1; hipLaunchKernelGGL(fwd_kernel, dim3(grid), dim3(NWAVES * 64), LDS_BYTES, stream, a); }
}
```

```cpp
#include <hip/hip_runtime.h>
#include <cstdio>
#include <cstdint>

#ifndef TABU_FP4
#define TABU_FP4 1
#endif
#ifndef TABV_FP4
#define TABV_FP4 1
#endif
#ifndef TAB_FP6
#define TAB_FP6 1
#endif
static_assert(TAB_FP6 == 1, "the workspace map assumes 12 MiB fp6 expert tables");
#ifndef TAB_FP8
#define TAB_FP8 1
#endif
#ifndef N_LAUNCHES
#define N_LAUNCHES 1
#endif

#define GAS __attribute__((address_space(1)))
#define LAS __attribute__((address_space(3)))
typedef unsigned short bf16;
typedef unsigned v4u __attribute__((ext_vector_type(4)));
typedef unsigned v2u __attribute__((ext_vector_type(2)));
typedef float f32x4 __attribute__((ext_vector_type(4)));
typedef float f32x2 __attribute__((ext_vector_type(2)));
typedef short bf16x8 __attribute__((ext_vector_type(8)));

constexpr int NT = 32768, SEQ = 16384, D = 1024;
constexpr int NPH = 9;
constexpr float ALPHA = 1.189207115002721f;
constexpr float LN_EPS = 1e-5f;
constexpr int NWAVES = 8;

constexpr size_t MiB = 1u << 20;
constexpr size_t WS_CTL = 0, CTL_ZERO_BYTES = 1 * MiB;
constexpr size_t WS_CPART = 256 * 1024;
constexpr size_t WS_STATS = 512 * 1024;
constexpr size_t WS_CVEC = 768 * 1024, WS_DVEC = 772 * 1024;
constexpr size_t WS_BIASIN = 1 * MiB;
constexpr size_t WS_STATS4 = 4 * MiB;
constexpr size_t WS_BIASTAB = 1 * MiB + 64 * 1024;
constexpr size_t WS_WTIN = 2 * MiB;
constexpr size_t WS_WTA = 16 * MiB, WS_WTB = 17 * MiB, WS_WTC = 18 * MiB, WS_WTO = 19 * MiB, WS_WTPQ = 21 * MiB, WS_WTMKV = 23 * MiB;
constexpr size_t WS_MEMB = 25 * MiB, WS_MEMKV = 26 * MiB;
constexpr size_t WS_MEMF8 = 27 * MiB, WS_WMKVF8 = 28 * MiB;
constexpr size_t WS_UTAB = 32 * MiB, WS_VTAB = 44 * MiB;
constexpr size_t WS_H0F8 = 56 * MiB;
constexpr size_t WS_WF8IN = 88 * MiB;
constexpr size_t WS_H0 = 96 * MiB;
constexpr size_t WS_QK = 160 * MiB;
constexpr size_t WS_VT = 256 * MiB;
constexpr size_t WS_QC = 304 * MiB;
constexpr size_t WS_OG = 336 * MiB;
constexpr size_t WS_LSE = 384 * MiB;
constexpr size_t WS_YCIN = 386 * MiB;
constexpr size_t WS_FA = 418 * MiB;
constexpr size_t WS_OB = 450 * MiB;
constexpr size_t WS_GSCR = 466 * MiB;
constexpr size_t WS_MERGED = WS_QK;
constexpr size_t WS_PRELN = 224 * MiB;
constexpr size_t WS_H1B = WS_H0;
constexpr size_t WS_QP = WS_QK;
constexpr size_t WS_END = 498 * MiB;

constexpr int WR_A = 0, WR_QK = 1024, WR_V = 2560, WR_QC = 3328, WR_GATE = 3840, WR_END = 6912;

constexpr int RING_BYTES = 131072;
constexpr int LDS_BYTES = 155648;
constexpr int MISC_OFF = LDS_BYTES - 256;
static_assert(RING_BYTES + 3840 * 4 <= MISC_OFF, "bias copy fits the spare LDS above the GEMM stage buffers");

#define RLX_AGENT __ATOMIC_RELAXED, __HIP_MEMORY_SCOPE_AGENT
#define LDS_WAIT() asm volatile("s_waitcnt lgkmcnt(0)" ::: "memory")
#define VM_WAIT() asm volatile("s_waitcnt vmcnt(0)" ::: "memory")

__device__ __forceinline__ unsigned f2bf(float f) { unsigned u = __builtin_bit_cast(unsigned, f); return (u + 0x7fffu + ((u >> 16) & 1u)) >> 16; }
__device__ __forceinline__ unsigned pk2(float lo, float hi) { return f2bf(lo) | (f2bf(hi) << 16); }
__device__ __forceinline__ unsigned pk4_fp8(float a, float b, float c, float d) { int p = __builtin_amdgcn_cvt_pk_fp8_f32(a, b, 0, false); p = __builtin_amdgcn_cvt_pk_fp8_f32(c, d, p, true); return (unsigned)p; }
__device__ __forceinline__ float bf2f(unsigned b) { return __builtin_bit_cast(float, b << 16); }
__device__ __forceinline__ float bflo(unsigned w) { return __builtin_bit_cast(float, w << 16); }
__device__ __forceinline__ float bfhi(unsigned w) { return __builtin_bit_cast(float, w & 0xffff0000u); }
__device__ __forceinline__ float wave_sum(float v) {
#pragma unroll
    for (int o = 1; o < 64; o <<= 1) v += __shfl_xor(v, o);
    return v;
}
__device__ __forceinline__ float wave_max(float v) {
#pragma unroll
    for (int o = 1; o < 64; o <<= 1) v = fmaxf(v, __shfl_xor(v, o));
    return v;
}

#define XB_TMO      128
#define XB_XCNT(j)  (256  + 64 * (j))
#define XB_XSUB(j)  (1280 + 64 * (j))
#define XB_XGEN(j)  (2304 + 64 * (j))
#define XB_TOP      3328
#define XB_TOPGEN   3392
#define XCD_BAR_WORDS 3456
#define XB_SPIN_CAP (1u << 18)

__device__ __forceinline__ unsigned xb_ld(unsigned* p)              { return __hip_atomic_load(p, __ATOMIC_RELAXED, __HIP_MEMORY_SCOPE_AGENT); }
__device__ __forceinline__ unsigned xb_add(unsigned* p, unsigned v) { return __hip_atomic_fetch_add(p, v, __ATOMIC_RELAXED, __HIP_MEMORY_SCOPE_AGENT); }
__device__ __forceinline__ unsigned xb_xcc_id() { return (unsigned)__builtin_amdgcn_s_getreg((3 << 11) | 20) & 0xFu; }
#define XB_SPIN(cond, bar) do { unsigned _sp = 0; while (cond) { __builtin_amdgcn_s_sleep(1); \
    if ((++_sp & 255u) == 0u) { if (xb_ld(&(bar)[XB_TMO])) break; if (_sp > XB_SPIN_CAP) { atomicAdd(&(bar)[XB_TMO], 1u); break; } } } } while (0)

struct XcdBarrier {
    unsigned* bar; unsigned x;
    volatile LAS unsigned* st;
};
__device__ __forceinline__ XcdBarrier xcd_barrier_post(unsigned* bar, volatile LAS unsigned* st) {
    XcdBarrier b; b.bar = bar; b.x = xb_xcc_id(); b.st = st;
    if (threadIdx.x == 0) (void)xb_add(&bar[XB_XCNT(b.x)], 1u);
    return b;
}
__device__ __forceinline__ void xcd_barrier_complete(unsigned* bar, unsigned x, unsigned& nloc, unsigned& nx) {
    const unsigned G = gridDim.x * gridDim.y * gridDim.z;
    unsigned sum, cnt, mine, sp = 0u;
    for (;;) {
        sum = 0u; cnt = 0u; mine = 0u;
#pragma unroll
        for (unsigned j = 0; j < 16; ++j) { const unsigned c = xb_ld(&bar[XB_XCNT(j)]); sum += c; cnt += (c > 0u) ? 1u : 0u; mine = (j == x) ? c : mine; }
        if (sum == G) break;
        __builtin_amdgcn_s_sleep(1);
        if ((++sp & 255u) == 0u) { if (xb_ld(&bar[XB_TMO])) break; if (sp > XB_SPIN_CAP) { atomicAdd(&bar[XB_TMO], 1u); break; } }
    }
    nloc = mine > 0u ? mine : 1u; nx = cnt > 0u ? cnt : 1u;
}
__device__ __forceinline__ void xcd_barrier(const XcdBarrier& b) {
    asm volatile("s_waitcnt vmcnt(0)" ::: "memory");
    __syncthreads();
    if (threadIdx.x == 0) {
        unsigned* bar = b.bar;
        __builtin_amdgcn_s_waitcnt(0);
        unsigned nloc = b.st[0], nx = b.st[1];
        if (nloc == 0u) { xcd_barrier_complete(bar, b.x, nloc, nx); b.st[0] = nloc; b.st[1] = nx; }
        const unsigned old = xb_add(&bar[XB_XSUB(b.x)], 1u);
        const unsigned gen = old / nloc;
        if (old + 1u == (gen + 1u) * nloc) {
            __builtin_amdgcn_fence(__ATOMIC_RELEASE, "agent");
            asm volatile("s_waitcnt vmcnt(0)" ::: "memory");
            const unsigned og = xb_add(&bar[XB_TOP], 1u);
            const unsigned tg = og / nx;
            if (og + 1u == (tg + 1u) * nx) xb_add(&bar[XB_TOPGEN], 1u);
            else XB_SPIN(xb_ld(&bar[XB_TOPGEN]) == tg, bar);
            __builtin_amdgcn_fence(__ATOMIC_ACQUIRE, "agent");
            xb_add(&bar[XB_XGEN(b.x)], 1u);
            asm volatile("s_waitcnt vmcnt(0)" ::: "memory");
        } else {
            XB_SPIN(xb_ld(&bar[XB_XGEN(b.x)]) == gen, bar);
            __builtin_amdgcn_fence(__ATOMIC_ACQUIRE, "agent");
            asm volatile("s_waitcnt vmcnt(0)" ::: "memory");
        }
    }
    __syncthreads();
}

namespace pg8 {
constexpr int BM = 256, BK = 64, HALF = 128, HTB = HALF * BK * 2, STAGE_BYTES = 8 * HTB;
__host__ __device__ __forceinline__ int lds_byte(int r, int c) { const int st = (r >> 4) * 2 + (c >> 5), rr = r & 15, cc = c & 31, ob = rr * 64 + cc * 2; return st * 1024 + (ob ^ (((ob >> 9) & 1) << 5)); }
__host__ __device__ __forceinline__ void stage_rc(int b, int& R, int& C) { const int st = b / 1024, sb = b % 1024, swz = sb ^ (((sb >> 9) & 1) << 5); R = (st >> 1) * 16 + swz / 64; C = (st & 1) * 32 + (swz % 64) / 2; }
__host__ __device__ __forceinline__ int perm32(int rho) { const int n = rho >> 4, i = rho & 15; return 8 * (i >> 2) + 4 * n + (i & 3); }

struct GUnit { const char* a; const char* b; unsigned sa, sb; int nt; int pm, pn, kind; };

typedef int v8i __attribute__((ext_vector_type(8)));
constexpr int K_FP8 = 1 << 16;
__device__ __forceinline__ unsigned pg8_rb(unsigned ra) { asm volatile("" : "+v"(ra)); const unsigned rho = ra & 31u, n = rho >> 4, i = rho & 15u; return (ra & ~31u) + 8u * (i >> 2) + 4u * n + (i & 3u); }
template <class Epi, class Sched, int MODE = 0>
__device__ __forceinline__ void gemm_phase(LAS unsigned char* lds, const Sched& S, const Epi& E) {
    const int tid = threadIdx.x, wid = __builtin_amdgcn_readfirstlane(tid >> 6), lane = tid & 63, wr = wid >> 2, wc = wid & 3, fr = lane & 15, fq = lane >> 4;
    int R0, C0; stage_rc(tid * 16, R0, C0);
    const unsigned RA = (unsigned)R0, C2 = (unsigned)C0 * 2u;
#define RB pg8_rb(RA)
    const size_t kstep = (size_t)(BK * 2);
    const unsigned ldsw = (unsigned)wid * 1024u;
    const int aoff = lds_byte(wr * 64 + fr, fq * 8), boff = lds_byte(wc * 32 + fr, fq * 8);
#define PG8_SA(b, h) (((b) * 2 + (h)) * HTB)
#define PG8_SB(b, h) ((4 + (b) * 2 + (h)) * HTB)
#define PG8_STAGE(bufoff, gbase, RR, stride) do { const unsigned _vo = (RR) * (unsigned)(stride) + C2; const char* _g = (const char*)(gbase); \
        __builtin_amdgcn_global_load_lds((const unsigned*)(_g + _vo), (LAS unsigned*)(lds + (bufoff) + ldsw), 16, 0, 0); \
        __builtin_amdgcn_global_load_lds((const unsigned*)(_g + (size_t)64 * (stride) + _vo), (LAS unsigned*)(lds + (bufoff) + ldsw + 8192), 16, 0, 0); } while (0)
#define PG8_LDA(dst, b, h) do { _Pragma("unroll") for (int m = 0; m < 4; ++m) _Pragma("unroll") for (int k = 0; k < 2; ++k) dst[m][k] = *(const LAS bf16x8*)(lds + PG8_SA(b, h) + aoff + m * 2048 + k * 1024); } while (0)
#define PG8_LDB(dst, b, h) do { _Pragma("unroll") for (int n = 0; n < 2; ++n) _Pragma("unroll") for (int k = 0; k < 2; ++k) dst[n][k] = *(const LAS bf16x8*)(lds + PG8_SB(b, h) + boff + n * 2048 + k * 1024); } while (0)
#define PG8_CAT(lo, hi) __builtin_bit_cast(v8i, __builtin_shufflevector(lo, hi, 0, 1, 2, 3, 4, 5, 6, 7, 8, 9, 10, 11, 12, 13, 14, 15))
#define PG8_MMA_BF(ai, bj, At, Bt) do { __builtin_amdgcn_s_setprio(1); _Pragma("unroll") for (int m = 0; m < 4; ++m) _Pragma("unroll") for (int n = 0; n < 2; ++n) _Pragma("unroll") for (int k = 0; k < 2; ++k) \
        acc[ai][bj][m][n] = __builtin_amdgcn_mfma_f32_16x16x32_bf16(Bt[n][k], At[m][k], acc[ai][bj][m][n], 0, 0, 0); __builtin_amdgcn_s_setprio(0); } while (0)
#define PG8_MMA_F8(ai, bj, At, Bt) do { __builtin_amdgcn_s_setprio(1); _Pragma("unroll") for (int m = 0; m < 4; ++m) _Pragma("unroll") for (int n = 0; n < 2; ++n) \
        acc[ai][bj][m][n] = __builtin_amdgcn_mfma_scale_f32_16x16x128_f8f6f4(PG8_CAT(Bt[n][0], Bt[n][1]), PG8_CAT(At[m][0], At[m][1]), acc[ai][bj][m][n], 0, 0, 0, 0x7F7F7F7F, 0, 0x7F7F7F7F); __builtin_amdgcn_s_setprio(0); } while (0)
#define PG8_WAIT_V(n) asm volatile("s_waitcnt vmcnt(" #n ")" ::: "memory")
#define PG8_WAIT_L(n) asm volatile("s_waitcnt lgkmcnt(" #n ")" ::: "memory")
#define PG8_BAR __builtin_amdgcn_s_barrier()
#define PG8_SCHED __builtin_amdgcn_sched_barrier(0)
#define PG8_KLOOP(MMA) \
        for (int t = 0; t < nt; t += 2) { \
            const bool last = (t == nt - 2); \
            const char* a1 = cA + (size_t)(t + 1) * kstep; \
            const char* a2 = last ? nxt.a : cA + (size_t)(t + 2) * kstep; const char* b2 = last ? nxt.b : cB + (size_t)(t + 2) * kstep; \
            const unsigned sa2 = last ? nxt.sa : csa, sb2 = last ? nxt.sb : csb; const size_t hA2 = (size_t)HALF * sa2, hB2 = (size_t)HALF * sb2; \
            const char* a3 = a2 + kstep; const char* b3 = b2 + kstep; \
            PG8_LDB(B0, 0, 0); PG8_LDB(B1, 0, 1); PG8_SCHED; PG8_LDA(At, 0, 0); PG8_STAGE(PG8_SA(1, 1), a1 + hA, RA, csa); \
            PG8_WAIT_V(8); PG8_WAIT_L(0); PG8_BAR; MMA(0, 0, At, B0); MMA(0, 1, At, B1); PG8_BAR; PG8_SCHED; \
            PG8_LDA(At, 0, 1); PG8_STAGE(PG8_SB(0, 0), b2, RB, sb2); PG8_STAGE(PG8_SB(0, 1), b2 + hB2, RB, sb2); PG8_STAGE(PG8_SA(0, 0), a2, RA, sa2); \
            PG8_WAIT_V(8); PG8_WAIT_L(0); PG8_BAR; MMA(1, 0, At, B0); MMA(1, 1, At, B1); PG8_BAR; PG8_SCHED; \
            PG8_LDB(B0, 1, 0); PG8_LDB(B1, 1, 1); PG8_SCHED; PG8_LDA(At, 1, 0); PG8_STAGE(PG8_SA(0, 1), a2 + hA2, RA, sa2); \
            PG8_WAIT_V(8); PG8_WAIT_L(0); PG8_BAR; MMA(0, 0, At, B0); MMA(0, 1, At, B1); PG8_BAR; PG8_SCHED; \
            PG8_LDA(At, 1, 1); PG8_STAGE(PG8_SB(1, 0), b3, RB, sb2); PG8_STAGE(PG8_SB(1, 1), b3 + hB2, RB, sb2); PG8_STAGE(PG8_SA(1, 0), a3, RA, sa2); \
            PG8_WAIT_V(8); PG8_WAIT_L(0); PG8_BAR; MMA(1, 0, At, B0); MMA(1, 1, At, B1); PG8_BAR; PG8_SCHED; \
        }
    GUnit cur, nxt; int ui = 0;
    if (!S.next(0, cur)) return;
    f32x4 acc[2][2][4][2];
#pragma unroll
    for (int a = 0; a < 2; ++a)
#pragma unroll
        for (int b = 0; b < 2; ++b)
#pragma unroll
            for (int m = 0; m < 4; ++m)
#pragma unroll
                for (int n = 0; n < 2; ++n) acc[a][b][m][n] = (f32x4){0.f, 0.f, 0.f, 0.f};
    bf16x8 At[4][2], B0[2][2], B1[2][2];
    unsigned keep[2][2][4][2];
    {
        const char* cA = cur.a; const char* cB = cur.b; const size_t hA = (size_t)HALF * cur.sa, hB = (size_t)HALF * cur.sb;
        PG8_STAGE(PG8_SB(0, 0), cB, RB, cur.sb); PG8_STAGE(PG8_SB(0, 1), cB + hB, RB, cur.sb); PG8_STAGE(PG8_SA(0, 0), cA, RA, cur.sa); PG8_STAGE(PG8_SA(0, 1), cA + hA, RA, cur.sa);
        if (wr == 1) PG8_BAR;
        PG8_WAIT_V(2); PG8_BAR;
        PG8_STAGE(PG8_SB(1, 0), cB + kstep, RB, cur.sb); PG8_STAGE(PG8_SA(1, 0), cA + kstep, RA, cur.sa); PG8_STAGE(PG8_SB(1, 1), cB + hB + kstep, RB, cur.sb);
        PG8_WAIT_V(6); PG8_BAR;
    }
    for (;;) {
        const bool has_next = S.next(ui + 1, nxt);
        if (!has_next) { nxt = cur; }
        const char* cA = cur.a; const char* cB = cur.b; const unsigned csa = cur.sa, csb = cur.sb; const size_t hA = (size_t)HALF * csa, hB = (size_t)HALF * csb;
        const int nt = cur.nt; const bool cur_fp8 = (cur.kind & K_FP8) != 0; (void)cur_fp8;
        if (MODE == 1 || (MODE == 2 && cur_fp8)) { PG8_KLOOP(PG8_MMA_F8) } else { PG8_KLOOP(PG8_MMA_BF) }
        if (wr == 0) PG8_BAR;
        E(acc, keep, cur, wr, wc, fr, fq);
        if (!has_next) break;
#pragma unroll
        for (int a = 0; a < 2; ++a)
#pragma unroll
            for (int b = 0; b < 2; ++b)
#pragma unroll
                for (int m = 0; m < 4; ++m)
#pragma unroll
                    for (int n = 0; n < 2; ++n) acc[a][b][m][n] = (f32x4){0.f, 0.f, 0.f, 0.f};
        cur = nxt; ++ui;
        if (wr == 1) PG8_BAR;
    }
    PG8_WAIT_V(0);
    PG8_BAR;
#undef PG8_SA
#undef PG8_SB
#undef PG8_STAGE
#undef PG8_LDA
#undef PG8_LDB
#undef PG8_MMA_BF
#undef PG8_MMA_F8
#undef PG8_KLOOP
#undef RB
#undef PG8_CAT
#undef PG8_WAIT_V
#undef PG8_WAIT_L
#undef PG8_BAR
#undef PG8_SCHED
}
}
using pg8::GUnit; using pg8::K_FP8;

__device__ __forceinline__ int tok0_of(int p, int g) {
    const int n = p << 8, b = n >> 14, rem = n & 16383, sh = 2 * g;
    const int r = rem >> (14 - sh), l0 = rem & ((16384 >> sh) - 1);
    return (b << 14) + (l0 << sh) + r;
}
__device__ __forceinline__ void tile_of(int t, int nN, int& pm, int& pn) { const int nig = 8 * nN, gid = t / nig, w = t % nig; pm = gid * 8 + (w & 7); pn = w >> 3; }

struct Ptrs {
    const float* in[21]; float* out; unsigned char* ws;
};

enum { K_ZA = 0, K_QK = 1, K_VT = 2, K_QC = 3, K_MKV = 4, K_GATE = 5, K_YA = 6, K_YB = 7, K_YC = 8, K_WO = 9, K_PQ = 10 };
struct SchedP1 {
    const char* wsb; int G, c;
    static constexpr int NLONG = 512, NSHORT = 768 + 384 + 256 + 8;
    __device__ __forceinline__ bool next(int i, GUnit& u) const {
        const char* const h0b = wsb + WS_H0; const char* const wtb = wsb + WS_WTIN; const char* const h0 = wsb + WS_H0F8; const char* const wtin = wsb + WS_WF8IN; const char* const memb = wsb + WS_MEMF8; const char* const wtmkv = wsb + WS_WMKVF8;
        const int nshort = (NSHORT - c + G - 1) / G, nslots = 2 + nshort; if (i >= nslots) return false;
        const int k = (c >> 3) & 3; int pa = k % nslots, pb = (k + 4) % nslots; if (pa > pb) { const int t_ = pa; pa = pb; pb = t_; }
        int j; if (i == pa) j = 0; else if (i == pb) j = 1; else j = 2 + i - (i > pa ? 1 : 0) - (i > pb ? 1 : 0);
        const int L = j * G + c; if (L >= NLONG + NSHORT) return false;
        if (L < NLONG) { const int T = (G % 8 == 0) ? (L % 8) * (NLONG / 8) + L / 8 : L; int pm, pn; tile_of(T, 4, pm, pn);
            u.a = h0b + (size_t)pm * 256 * 2048; u.b = wtb + (size_t)(WR_A + pn * 256) * 2048; u.sa = 2048; u.sb = 2048; u.nt = 16; u.pm = pm; u.pn = pn; u.kind = K_ZA; return true; }
        const int Ls = L - NLONG; int T = (NSHORT % 8 == 0 && G % 8 == 0) ? (Ls % 8) * (NSHORT / 8) + Ls / 8 : Ls;
        u.nt = 8; u.sa = 1024; u.sb = 1024;
        if (T < 768) { const int g = T >> 8; int pm, pn; tile_of(T & 255, 2, pm, pn); u.a = h0 + (size_t)tok0_of(pm, g) * 1024; u.sa = 1024u << (2 * g);
            u.b = wtin + (size_t)(WR_QK + g * 512 + pn * 256) * 1024; u.pm = pm; u.pn = pn; u.kind = K_QK | (g << 8) | K_FP8; return true; }
        T -= 768;
        if (T < 384) { const int g = T >> 7, pn = T & 127; u.a = wtin + (size_t)(WR_V + g * 256) * 1024; u.b = h0 + (size_t)tok0_of(pn, g) * 1024; u.sb = 1024u << (2 * g);
            u.pm = 0; u.pn = pn; u.kind = K_VT | (g << 8) | K_FP8; return true; }
        T -= 384;
        if (T < 256) { int pm, pn; tile_of(T, 2, pm, pn); u.a = h0 + (size_t)pm * 256 * 1024; u.b = wtin + (size_t)(WR_QC + pn * 256) * 1024; u.pm = pm; u.pn = pn; u.kind = K_QC | K_FP8; return true; }
        T -= 256;
        if (T < 4) { const int pm = T >> 1, pn = T & 1; u.a = memb + (size_t)pm * 256 * 1024; u.b = wtmkv + (size_t)pn * 256 * 1024; u.pm = pm; u.pn = pn; u.kind = K_MKV | K_FP8; return true; }
        T -= 4;
        { const int pm = T >> 1, pn = T & 1; u.a = wtmkv + (size_t)(512 + pm * 256) * 1024; u.b = memb + (size_t)pn * 256 * 1024; u.pm = pm; u.pn = pn; u.kind = K_MKV | (1 << 8) | K_FP8; return true; }
    }
};
__device__ __forceinline__ void out_tile_of(int L, int G, int& pm, int& pn) {
    const int T = (G % 8 == 0) ? (L % 8) * 64 + L / 8 : L; tile_of(T, 4, pm, pn);
}
struct SchedP4 {
    const char* wsb; int G, c;
    __device__ __forceinline__ bool next(int i, GUnit& u) const {
        const int io = i / 6, s = i - io * 6; const int L = io * G + c; if (L >= 512) return false;
        int pm, pn; out_tile_of(L, G, pm, pn); u.pm = pm; u.pn = pn;
        if ((s & 1) == 0) { const int gi = s >> 1; u.a = wsb + WS_H0F8 + (size_t)pm * 256 * 1024; u.sa = 1024; u.b = wsb + WS_WF8IN + (size_t)(WR_GATE + gi * 1024 + pn * 256) * 1024; u.sb = 1024; u.nt = 8; u.kind = K_GATE | (gi << 8) | K_FP8; return true; }
        if (s == 1) { u.a = wsb + WS_FA + (size_t)pm * 256 * 1024; u.sa = 1024; u.b = wsb + WS_WTA + (size_t)pn * 256 * 1024; u.sb = 1024; u.nt = 8; u.kind = K_YA; return true; }
        if (s == 3) { u.a = wsb + WS_OB + (size_t)pm * 256 * 256; u.sa = 256; u.b = wsb + WS_WTB + (size_t)pn * 256 * 256; u.sb = 256; u.nt = 2; u.kind = K_YB | K_FP8; return true; }
        u.a = wsb + WS_YCIN + (size_t)pm * 256 * 512; u.sa = 512; u.b = wsb + WS_WTC + (size_t)pn * 256 * 512; u.sb = 512; u.nt = 4; u.kind = K_YC | K_FP8; return true;
    }
};
struct SchedPlain {
    const char* a; const char* b; int G, c, kind;
    __device__ __forceinline__ bool next(int i, GUnit& u) const {
        const int L = i * G + c; if (L >= 512) return false;
        int pm, pn; out_tile_of(L, G, pm, pn); u.pm = pm; u.pn = pn; u.a = a + (size_t)pm * 256 * 2048; u.b = b + (size_t)pn * 256 * 2048; u.sa = 2048; u.sb = 2048; u.nt = 16; u.kind = kind; return true;
    }
};

__device__ __forceinline__ unsigned opq(unsigned x) { asm volatile("" : "+v"(x)); return x; }
__device__ __forceinline__ v4u pack8(f32x4 v0, f32x4 v1) { v4u o; o.x = pk2(v0[0], v0[1]); o.y = pk2(v0[2], v0[3]); o.z = pk2(v1[0], v1[1]); o.w = pk2(v1[2], v1[3]); return o; }
__device__ __forceinline__ void unpack8(v4u w, f32x4& a, f32x4& b) { a[0] = bflo(w.x); a[1] = bfhi(w.x); a[2] = bflo(w.y); a[3] = bfhi(w.y); b[0] = bflo(w.z); b[1] = bfhi(w.z); b[2] = bflo(w.w); b[3] = bfhi(w.w); }
#define EPI_LOOP(ai, m, bj) _Pragma("unroll") for (int ai = 0; ai < 2; ++ai) _Pragma("unroll") for (int m = 0; m < 4; ++m) _Pragma("unroll") for (int bj = 0; bj < 2; ++bj)

constexpr float W8SC = 32.f, W8INV = 1.f / 32.f;
constexpr float SC_WBC = 16.f, SC_ACT = 4.f;
struct EpiP1 {
    bf16* za; unsigned char* wsb; const LAS unsigned char* bias;
    __device__ __forceinline__ void operator()(f32x4 (&acc)[2][2][4][2], unsigned (&keep)[2][2][4][2], const GUnit& u, int wr, int wc, int fr, int fq) const {
        bf16* const qk = (bf16*)(wsb + WS_QK); bf16* const vt = (bf16*)(wsb + WS_VT); bf16* const qc = (bf16*)(wsb + WS_QC); bf16* const memkv = (bf16*)(wsb + WS_MEMKV);
        const int kind = u.kind & 255, g = (u.kind >> 8) & 255; const float asc = (u.kind & K_FP8) ? W8INV : 1.f;
        const unsigned rl0 = opq((unsigned)(wr * 64 + fr)), cl0 = opq((unsigned)(wc * 32 + 8 * fq));
        if (kind == K_VT) {
            char* base = (char*)(vt + (size_t)g * 256 * NT + (size_t)u.pn * 256); const LAS unsigned char* bb = bias + (WR_V + g * 256) * 4;
            const unsigned lo = rl0 * (unsigned)(NT * 2) + cl0 * 2u;
#pragma unroll
            for (int ai = 0; ai < 2; ++ai)
#pragma unroll
                for (int m = 0; m < 4; ++m) { const float br = *(const LAS float*)(bb + (rl0 + ai * 128 + m * 16) * 4u);
#pragma unroll
                    for (int bj = 0; bj < 2; ++bj) *(GAS v4u*)(base + (lo + (unsigned)((ai * 128 + m * 16) * NT * 2 + bj * 256))) = pack8(acc[ai][bj][m][0] * asc + br, acc[ai][bj][m][1] * asc + br);
                    __builtin_amdgcn_sched_barrier(0); }
            return;
        }
        char* base; unsigned ldb; const LAS unsigned char* bb; bool hasb = true;
        if (kind == K_ZA) { base = (char*)(za + (size_t)u.pm * 256 * 1024 + u.pn * 256); ldb = 2048; bb = bias + (WR_A + u.pn * 256) * 4; }
        else if (kind == K_QK) { base = (char*)(qk + (size_t)g * NT * 512 + (size_t)u.pm * 256 * 512 + u.pn * 256); ldb = 1024; bb = bias + (WR_QK + g * 512 + u.pn * 256) * 4; }
        else if (kind == K_QC) { base = (char*)(qc + (size_t)u.pm * 256 * 512 + u.pn * 256); ldb = 1024; bb = bias + (WR_QC + u.pn * 256) * 4; }
        else { base = (char*)(memkv + (size_t)g * 512 * 512 + (size_t)u.pm * 256 * 512 + u.pn * 256); ldb = 1024; bb = bias; hasb = false; }
        f32x4 bv[2][2];
#pragma unroll
        for (int bj = 0; bj < 2; ++bj)
#pragma unroll
            for (int n = 0; n < 2; ++n) bv[bj][n] = hasb ? *(const LAS f32x4*)(bb + (cl0 + bj * 128 + 4 * n) * 4u) : (f32x4){0.f, 0.f, 0.f, 0.f};
        const unsigned lo = rl0 * ldb + cl0 * 2u;
#pragma unroll
        for (int ai = 0; ai < 2; ++ai)
#pragma unroll
            for (int m = 0; m < 4; ++m) {
#pragma unroll
                for (int bj = 0; bj < 2; ++bj) *(GAS v4u*)(base + (lo + (unsigned)(ai * 128 + m * 16) * ldb + (unsigned)(bj * 256))) = pack8(acc[ai][bj][m][0] * asc + bv[bj][0], acc[ai][bj][m][1] * asc + bv[bj][1]);
                __builtin_amdgcn_sched_barrier(0); }
    }
};
struct EpiP4 {
    bf16* merged; const LAS unsigned char* bias;
    __device__ __forceinline__ void operator()(f32x4 (&acc)[2][2][4][2], unsigned (&keep)[2][2][4][2], const GUnit& u, int wr, int wc, int fr, int fq) const {
        const int kind = u.kind & 255, gi = (u.kind >> 8) & 255;
        const unsigned rl0 = opq((unsigned)(wr * 64 + fr)), cl0 = opq((unsigned)(wc * 32 + 8 * fq));
        if (kind == K_GATE) {
            const LAS unsigned char* bb = bias + (gi * 1024 + u.pn * 256) * 4;
#pragma unroll
            for (int bj = 0; bj < 2; ++bj) { const f32x4 b0 = *(const LAS f32x4*)(bb + (cl0 + bj * 128) * 4u), b1 = *(const LAS f32x4*)(bb + (cl0 + bj * 128 + 4) * 4u);
#pragma unroll
                for (int ai = 0; ai < 2; ++ai)
#pragma unroll
                    for (int m = 0; m < 4; ++m)
#pragma unroll
                        for (int n = 0; n < 2; ++n) { const f32x4 v = acc[ai][bj][m][n] * W8INV + (n ? b1 : b0); unsigned pk = 0u;
#pragma unroll
                            for (int e = 0; e < 4; ++e) { const float sg = __builtin_amdgcn_rcpf(1.f + __expf(-v[e])); pk |= (unsigned)(sg * 255.f + 0.5f) << (8 * e); }
                            keep[ai][bj][m][n] = pk; } }
            return;
        }
        char* mb = (char*)(merged + (size_t)u.pm * 256 * 1024 + u.pn * 256); const unsigned mlo = rl0 * 2048u + cl0 * 2u;
        const float ysc = ((kind == K_YA) ? 1.f : 1.f / (SC_WBC * SC_ACT)) * (1.f / 255.f);
#pragma unroll
        for (int ai = 0; ai < 2; ++ai) {
            v4u pw[4][2];
            if (kind != K_YA) {
#pragma unroll
                for (int m = 0; m < 4; ++m)
#pragma unroll
                    for (int bj = 0; bj < 2; ++bj) pw[m][bj] = *(const GAS v4u*)(mb + (mlo + (unsigned)((ai * 128 + m * 16) * 2048 + bj * 256))); }
#pragma unroll
            for (int m = 0; m < 4; ++m)
#pragma unroll
                for (int bj = 0; bj < 2; ++bj) { f32x4 v[2];
#pragma unroll
                    for (int n = 0; n < 2; ++n) { const unsigned pk = keep[ai][bj][m][n];
                        v[n][0] = acc[ai][bj][m][n][0] * ((float)(pk & 255u) * ysc); v[n][1] = acc[ai][bj][m][n][1] * ((float)((pk >> 8) & 255u) * ysc);
                        v[n][2] = acc[ai][bj][m][n][2] * ((float)((pk >> 16) & 255u) * ysc); v[n][3] = acc[ai][bj][m][n][3] * ((float)(pk >> 24) * ysc); }
                    if (kind != K_YA) { f32x4 p0, p1; unpack8(pw[m][bj], p0, p1); v[0] += p0; v[1] += p1; }
                    *(GAS v4u*)(mb + (mlo + (unsigned)((ai * 128 + m * 16) * 2048 + bj * 256))) = pack8(v[0], v[1]); }
            __builtin_amdgcn_sched_barrier(0); }
    }
};
struct EpiP5 {
    bf16* h0; float* preln; float* stats; LAS unsigned char* lds_spare;
    __device__ __forceinline__ void operator()(f32x4 (&acc)[2][2][4][2], unsigned (&keep)[2][2][4][2], const GUnit& u, int wr, int wc, int fr, int fq) const {
        const unsigned rl0 = opq((unsigned)(wr * 64 + fr)), cl0 = opq((unsigned)(wc * 32 + 8 * fq));
        const size_t t0 = (size_t)u.pm * 256 * 1024 + u.pn * 256;
        char* hb = (char*)(h0 + t0);
        const unsigned hlo = rl0 * 2048u + cl0 * 2u;
#pragma unroll
        for (int ai = 0; ai < 2; ++ai) {
            v4u hw[4][2];
#pragma unroll
            for (int m = 0; m < 4; ++m)
#pragma unroll
                for (int bj = 0; bj < 2; ++bj) hw[m][bj] = *(const GAS v4u*)(hb + (hlo + (unsigned)((ai * 128 + m * 16) * 2048 + bj * 256)));
#pragma unroll
            for (int m = 0; m < 4; ++m) { float s1 = 0.f, s2 = 0.f;
#pragma unroll
                for (int bj = 0; bj < 2; ++bj) { f32x4 h0v, h1v; unpack8(hw[m][bj], h0v, h1v);
                    const f32x4 v0 = acc[ai][bj][m][0] + ALPHA * h0v, v1 = acc[ai][bj][m][1] + ALPHA * h1v;
                    *(GAS v4u*)(hb + (hlo + (unsigned)((ai * 128 + m * 16) * 2048 + bj * 256))) = pack8(v0, v1);
                    s1 += (v0[0] + v0[1]) + (v0[2] + v0[3]) + (v1[0] + v1[1]) + (v1[2] + v1[3]);
                    s2 += (v0[0] * v0[0] + v0[1] * v0[1]) + (v0[2] * v0[2] + v0[3] * v0[3]) + (v1[0] * v1[0] + v1[1] * v1[1]) + (v1[2] * v1[2] + v1[3] * v1[3]); }
                s1 += __shfl_xor(s1, 16); s1 += __shfl_xor(s1, 32); s2 += __shfl_xor(s2, 16); s2 += __shfl_xor(s2, 32);
                if (fq == 0) { f32x2 pr; pr.x = s1; pr.y = s2; *(LAS f32x2*)(lds_spare + ((ai * 128 + m * 16 + rl0) * 4 + wc) * 8) = pr; } }
            __builtin_amdgcn_sched_barrier(0); }
        asm volatile("s_waitcnt lgkmcnt(0)" ::: "memory"); __builtin_amdgcn_s_barrier(); asm volatile("" ::: "memory");
        { const int t = threadIdx.x;
          if (t < 256) { const LAS f32x2* pp = (const LAS f32x2*)(lds_spare + t * 32); f32x2 a = pp[0]; a += pp[1]; a += pp[2]; a += pp[3];
              *(GAS f32x2*)(stats + ((size_t)(u.pm * 256 + t) * 4 + u.pn) * 2) = a; } }
    }
};
struct EpiP7 {
    bf16* qp; const float* stats; const float* cvec; const float* dvec;
    __device__ __forceinline__ void operator()(f32x4 (&acc)[2][2][4][2], unsigned (&keep)[2][2][4][2], const GUnit& u, int wr, int wc, int fr, int fq) const {
        const unsigned rl0 = opq((unsigned)(wr * 64 + fr)), cl0 = opq((unsigned)(wc * 32 + 8 * fq));
        char* qb = (char*)(qp + (size_t)u.pm * 256 * 1024 + u.pn * 256); const unsigned lo = rl0 * 2048u + cl0 * 2u;
        f32x4 cv[2][2], dv[2][2];
#pragma unroll
        for (int bj = 0; bj < 2; ++bj)
#pragma unroll
            for (int n = 0; n < 2; ++n) { cv[bj][n] = *(const GAS f32x4*)(cvec + u.pn * 256 + cl0 + bj * 128 + 4 * n); dv[bj][n] = *(const GAS f32x4*)(dvec + u.pn * 256 + cl0 + bj * 128 + 4 * n); }
#pragma unroll
        for (int ai = 0; ai < 2; ++ai)
#pragma unroll
            for (int m = 0; m < 4; ++m) { const GAS f32x4* sp = (const GAS f32x4*)(stats + (size_t)(u.pm * 256 + ai * 128 + m * 16 + rl0) * 8); const f32x4 sa = sp[0], sb = sp[1];
                f32x2 st; st.x = ((sa.x + sa.z) + sb.x) + sb.z; st.y = ((sa.y + sa.w) + sb.y) + sb.w;
                const float mean = st.x * (1.f / D), rstd = 1.f / sqrtf(fmaxf(st.y * (1.f / D) - mean * mean, 0.f) + LN_EPS), mr = mean * rstd;
#pragma unroll
                for (int bj = 0; bj < 2; ++bj) *(GAS v4u*)(qb + (lo + (unsigned)((ai * 128 + m * 16) * 2048 + bj * 256))) = pack8(acc[ai][bj][m][0] * rstd - mr * cv[bj][0] + dv[bj][0], acc[ai][bj][m][1] * rstd - mr * cv[bj][1] + dv[bj][1]); }
    }
};

constexpr float FP6_SU = 60.f, FP6_SV = 3.15f;
__device__ __forceinline__ unsigned fp6_code(float v) {
    const float a = fminf(fabsf(v), 7.5f);
    const float c = a < 2.f ? rintf(a * 8.f) : (a < 4.f ? 16.f + rintf((a - 2.f) * 4.f) : 24.f + rintf((a - 4.f) * 2.f));
    return (unsigned)c | (v < 0.f ? 32u : 0u);
}
constexpr float FP4_SV = 3.36f, FP4_SU = 64.f;
__device__ __forceinline__ unsigned fp4_code(float v) {
    const float a = fminf(fabsf(v), 6.f);
    const float c = a < 2.f ? rintf(a * 2.f) : (a < 4.f ? 4.f + rintf(a - 2.f) : 6.f + rintf((a - 4.f) * 0.5f));
    return (unsigned)c | (v < 0.f ? 8u : 0u);
}
typedef unsigned v6u __attribute__((ext_vector_type(6)));
typedef float v32f __attribute__((ext_vector_type(32)));
__device__ __forceinline__ void p0_transpose_item(const float* W, int K, int ld, int col0, bf16* WT, unsigned char* WT8, float sc8, int row0, LAS float* scr, int item, int lane, int ncols,
                                                  const float* kg = nullptr, const float* kb = nullptr, float* cvec = nullptr, float* dvec = nullptr) {
    const int nblk = ncols / 32, kb_ = item / nblk, nb = item % nblk, k0 = 64 * kb_, n0 = 32 * nb;
    { float wv[32];
#pragma unroll
      for (int i = 0; i < 32; ++i) wv[i] = W[(size_t)(k0 + 2 * i + (lane >> 5)) * ld + col0 + n0 + (lane & 31)];
#pragma unroll
      for (int i = 0; i < 32; ++i) scr[(2 * i + (lane >> 5)) * 33 + (lane & 31)] = wv[i]; }
    LDS_WAIT(); asm volatile("" ::: "memory");
    const int c = lane & 7;
#pragma unroll
    for (int j = 0; j < 4; ++j) { const int n = (lane >> 3) + 8 * j; const LAS float* s = scr + (8 * c) * 33 + n;
        float e[8];
#pragma unroll
        for (int i = 0; i < 8; ++i) e[i] = s[i * 33];
        if (kg) { float pc = 0.f, pd = 0.f;
#pragma unroll
            for (int i = 0; i < 8; ++i) { const float g = kg[k0 + 8 * c + i]; pd += e[i] * kb[k0 + 8 * c + i]; e[i] *= g; pc += e[i]; }
            pc += __shfl_xor(pc, 1); pc += __shfl_xor(pc, 2); pc += __shfl_xor(pc, 4); pd += __shfl_xor(pd, 1); pd += __shfl_xor(pd, 2); pd += __shfl_xor(pd, 4);
            if (c == 0) { cvec[kb_ * 1024 + col0 + n0 + n] = pc; dvec[kb_ * 1024 + col0 + n0 + n] = pd; } }
        if (WT) { v4u o; o.x = pk2(e[0], e[1]); o.y = pk2(e[2], e[3]); o.z = pk2(e[4], e[5]); o.w = pk2(e[6], e[7]); *(GAS v4u*)(WT + (size_t)(row0 + n0 + n) * K + k0 + 8 * c) = o; }
        if (WT8) { v2u o; o.x = pk4_fp8(e[0] * sc8, e[1] * sc8, e[2] * sc8, e[3] * sc8); o.y = pk4_fp8(e[4] * sc8, e[5] * sc8, e[6] * sc8, e[7] * sc8); *(GAS v2u*)(WT8 + (size_t)(row0 + n0 + n) * K + k0 + 8 * c) = o; } }
    LDS_WAIT(); asm volatile("" ::: "memory");
}
__device__ __forceinline__ void ln_row(const float* xrow, const float* g, const float* b, bf16* obf, float* of32, int lane) {
    const GAS f32x4* xr = (const GAS f32x4*)xrow + lane;
    f32x4 v[4]; float s = 0.f;
#pragma unroll
    for (int j = 0; j < 4; ++j) { v[j] = xr[64 * j]; s += (v[j].x + v[j].y) + (v[j].z + v[j].w); }
    const float mean = wave_sum(s) * (1.f / D); float s2 = 0.f;
#pragma unroll
    for (int j = 0; j < 4; ++j) { v[j] = v[j] - mean; s2 += (v[j].x * v[j].x + v[j].y * v[j].y) + (v[j].z * v[j].z + v[j].w * v[j].w); }
    const float rstd = 1.f / sqrtf(wave_sum(s2) * (1.f / D) + LN_EPS);
#pragma unroll
    for (int j = 0; j < 4; ++j) { const f32x4 gg = ((const GAS f32x4*)g)[lane + 64 * j], bb = ((const GAS f32x4*)b)[lane + 64 * j];
        const f32x4 y = v[j] * rstd * gg + bb;
        if (obf) ((GAS unsigned long long*)obf)[lane + 64 * j] = (unsigned long long)pk2(y.x, y.y) | ((unsigned long long)pk2(y.z, y.w) << 32);
        if (of32) ((GAS f32x4*)of32)[lane + 64 * j] = y; }
}
__device__ __forceinline__ void ln_row2(const float* xa, const float* xb, const float* g, const float* b, bf16* oa, bf16* ob, unsigned char* oa8, unsigned char* ob8, int lane) {
    const GAS f32x4* pa = (const GAS f32x4*)xa + lane; const GAS f32x4* pb = (const GAS f32x4*)xb + lane;
    f32x4 va[4], vb[4]; float sa = 0.f, sb = 0.f;
#pragma unroll
    for (int j = 0; j < 4; ++j) { va[j] = pa[64 * j]; vb[j] = pb[64 * j]; }
#pragma unroll
    for (int j = 0; j < 4; ++j) { sa += (va[j].x + va[j].y) + (va[j].z + va[j].w); sb += (vb[j].x + vb[j].y) + (vb[j].z + vb[j].w); }
    const float ma = wave_sum(sa) * (1.f / D), mb = wave_sum(sb) * (1.f / D); float qa = 0.f, qb = 0.f;
#pragma unroll
    for (int j = 0; j < 4; ++j) { va[j] = va[j] - ma; vb[j] = vb[j] - mb; qa += (va[j].x * va[j].x + va[j].y * va[j].y) + (va[j].z * va[j].z + va[j].w * va[j].w); qb += (vb[j].x * vb[j].x + vb[j].y * vb[j].y) + (vb[j].z * vb[j].z + vb[j].w * vb[j].w); }
    const float ra = 1.f / sqrtf(wave_sum(qa) * (1.f / D) + LN_EPS), rb = 1.f / sqrtf(wave_sum(qb) * (1.f / D) + LN_EPS);
#pragma unroll
    for (int j = 0; j < 4; ++j) { const f32x4 gg = ((const GAS f32x4*)g)[lane + 64 * j], bb = ((const GAS f32x4*)b)[lane + 64 * j];
        const f32x4 ya = va[j] * ra * gg + bb, yb = vb[j] * rb * gg + bb;
        ((GAS unsigned long long*)oa)[lane + 64 * j] = (unsigned long long)pk2(ya.x, ya.y) | ((unsigned long long)pk2(ya.z, ya.w) << 32);
        ((GAS unsigned long long*)ob)[lane + 64 * j] = (unsigned long long)pk2(yb.x, yb.y) | ((unsigned long long)pk2(yb.z, yb.w) << 32);
        ((GAS unsigned*)oa8)[lane + 64 * j] = pk4_fp8(ya.x, ya.y, ya.z, ya.w); ((GAS unsigned*)ob8)[lane + 64 * j] = pk4_fp8(yb.x, yb.y, yb.z, yb.w); }
}
__device__ __forceinline__ int t5_bucket(int rel) {
    const int ret = rel > 0 ? 16 : 0; const int n = rel < 0 ? -rel : rel; const float nf = (float)(n > 1 ? n : 1);
    int large = 8 + (int)(logf(nf / 8.f) / 4.852030263919617f * 8.f); large = large < 15 ? large : 15;
    return ret + (n < 8 ? n : large);
}

__device__ __forceinline__ void phase0(const Ptrs& P, LAS unsigned char* lds, int tid, int lane, int wave, int G) {
    unsigned char* ws = P.ws;
    const int gw = blockIdx.x * NWAVES + wave, NGW = G * NWAVES;
    { bf16* h0 = (bf16*)(ws + WS_H0);
      unsigned char* h08 = ws + WS_H0F8;
      for (int m = gw; m < NT; m += 2 * NGW) ln_row2(P.in[0] + (size_t)m * D, P.in[0] + (size_t)(m + NGW) * D, P.in[3], P.in[4], h0 + (size_t)m * D, h0 + (size_t)(m + NGW) * D, h08 + (size_t)m * D, h08 + (size_t)(m + NGW) * D, lane); }
    { LAS float* scr = (LAS float*)(lds + wave * 16384);
      bf16* wtin = (bf16*)(ws + WS_WTIN);
      constexpr int I_IN = 23 * 16 * 8, I_A = 8 * 32, I_B = 4 * 32, I_C = 8 * 32, I_SQ = 16 * 32;
      constexpr int NIT = I_IN + I_A + I_B + I_C + 3 * I_SQ;
      unsigned char* wf8 = ws + WS_WF8IN;
      for (int it = gw; it < NIT; it += NGW) {
          int r = it;
          if (r < I_IN) { const int j = r / 128, q = r % 128; int src;
              if (j < 6) src = ((j & 1) ? 1280 : 512) + (j >> 1) * 256; else if (j < 9) src = 2048 + (j - 6) * 256; else if (j < 11) src = 2816 + (j - 9) * 256; else src = 3328 + (j - 11) * 256;
              p0_transpose_item(P.in[5], 1024, 6400, src, nullptr, wf8, W8SC, 1024 + 256 * j, scr, q, lane, 256); continue; }
          r -= I_IN;
          if (r < I_A) { p0_transpose_item(P.in[7], 512, 1024, 0, (bf16*)(ws + WS_WTA), nullptr, 0.f, 0, scr, r, lane, 1024); continue; } r -= I_A;
          if (r < I_B) { p0_transpose_item(P.in[8], 256, 1024, 0, nullptr, ws + WS_WTB, SC_WBC, 0, scr, r, lane, 1024); continue; } r -= I_B;
          if (r < I_C) { p0_transpose_item(P.in[9], 512, 1024, 0, nullptr, ws + WS_WTC, SC_WBC, 0, scr, r, lane, 1024); continue; } r -= I_C;
          if (r < I_SQ) { p0_transpose_item(P.in[10], 1024, 1024, 0, nullptr, ws + WS_WMKVF8, W8SC, 0, scr, r, lane, 1024); continue; } r -= I_SQ;
          if (r < I_SQ) { p0_transpose_item(P.in[11], 1024, 1024, 0, (bf16*)(ws + WS_WTO), nullptr, 0.f, 0, scr, r, lane, 1024); continue; } r -= I_SQ;
          p0_transpose_item(P.in[14], 1024, 1024, 0, (bf16*)(ws + WS_WTPQ), nullptr, 0.f, 0, scr, r, lane, 1024, P.in[12], P.in[13], (float*)(ws + WS_CPART), (float*)(ws + WS_CPART) + 16 * 1024);
      } }
    __syncthreads();
    { LAS float* wt = (LAS float*)lds;
      LAS float* cs = wt + 64 * 129; LAS float* sn = cs + 128;
      if (tid < 128) { float s, c; sincospif((float)tid / 64.f, &s, &c); cs[tid] = c; sn[tid] = s; }
      bf16* wtin = (bf16*)(ws + WS_WTIN);
      unsigned char* wf8 = ws + WS_WF8IN;
      for (int it = blockIdx.x; it < 256; it += G) {
          const int g = it >> 6, k0 = (it & 63) * 16;
          __syncthreads();
          for (int idx = tid; idx < 16 * 128; idx += 512) { const int kk = idx >> 7, c = idx & 127; wt[kk * 129 + c] = P.in[5][(size_t)(k0 + kk) * 6400 + g * 128 + c]; }
          __syncthreads();
          const int cp = tid & 127, kq = tid >> 7;
          float ac[4] = {0.f, 0.f, 0.f, 0.f}, as[4] = {0.f, 0.f, 0.f, 0.f};
#pragma unroll 4
          for (int c = 0; c < 128; ++c) { const int ix = (c * cp) & 127; const float cv = cs[ix], sv = sn[ix];
#pragma unroll
              for (int i = 0; i < 4; ++i) { const float w = wt[(4 * kq + i) * 129 + c]; ac[i] += w * cv; as[i] += w * sv; } }
          { v2u o; o.x = pk2(ac[0], ac[1]); o.y = pk2(ac[2], ac[3]); *(GAS v2u*)(wtin + (size_t)(g * 256 + cp) * 1024 + k0 + 4 * kq) = o;
            v2u q; q.x = pk2(as[0], as[1]); q.y = pk2(as[2], as[3]); *(GAS v2u*)(wtin + (size_t)(g * 256 + 128 + cp) * 1024 + k0 + 4 * kq) = q; }
      }
      __syncthreads();
      { float* bi = (float*)(ws + WS_BIASIN); const float* b_in = P.in[6];
        for (int r = gw; r < 1024; r += NGW) { const int g = r >> 8, w = r & 255, cp = w & 127; const bool isin = w >= 128;
            const int i0 = (lane * cp) & 127, i1 = ((lane + 64) * cp) & 127;
            float a = b_in[g * 128 + lane] * (isin ? sn[i0] : cs[i0]) + b_in[g * 128 + 64 + lane] * (isin ? sn[i1] : cs[i1]);
            a = wave_sum(a); if (lane == 0) bi[r] = a; }
        const int gtid = blockIdx.x * 512 + tid, nth = G * 512;
        for (int r = 1024 + gtid; r < WR_END; r += nth) { const int j = (r - 1024) >> 8, w = (r - 1024) & 255; int src;
            if (j < 6) src = ((j & 1) ? 1280 : 512) + (j >> 1) * 256; else if (j < 9) src = 2048 + (j - 6) * 256; else if (j < 11) src = 2816 + (j - 9) * 256; else src = 3328 + (j - 11) * 256;
            bi[r] = b_in[src + w]; }
        float* bt = (float*)(ws + WS_BIASTAB);
        for (int r = gtid; r < 3 * 4 * 129; r += nth) { const int g = r / (4 * 129), h = (r / 129) & 3, j = r % 129; const int rel = (j - 64) << (2 * g);
            bt[(g * 4 + h) * 132 + j] = P.in[2][t5_bucket(rel) * 12 + g * 4 + h]; }
      }
    }
    { const size_t gt = (size_t)blockIdx.x * 512 + tid, NTH = (size_t)G * 512;
      const GAS f32x4* us = (const GAS f32x4*)P.in[17]; const GAS f32x4* vs = (const GAS f32x4*)P.in[18];
      GAS v2u* ud = (GAS v2u*)(ws + WS_UTAB); GAS v2u* vd = (GAS v2u*)(ws + WS_VTAB);
#if TAB_FP6
      {
        const int njobs = 2 * 16384 * 16;
        for (int job = (int)gt; job < njobs; job += (int)NTH) { const int tb = job >> 18, e = (job >> 4) & 16383, fr = job & 15;
            const float sc = tb ? FP4_SV : (TABU_FP4 ? FP4_SU : FP6_SU);
            const GAS f32x4* src = (const GAS f32x4*)((tb ? P.in[18] : P.in[17]) + (size_t)e * 1024);
            const int kq = fr & 3, sp = fr >> 2;
            f32x4 v[16];
#pragma unroll
            for (int idx = 0; idx < 16; ++idx) v[idx] = src[(tb || TABU_FP4) ? (16 * fr + idx) : (32 * (2 * sp + (idx >> 3)) + 8 * kq + (idx & 7))];
            if (tb || TABU_FP4) {
                unsigned wd4[8];
#pragma unroll
                for (int w = 0; w < 8; ++w) { unsigned acc4 = 0u;
#pragma unroll
                    for (int t = 0; t < 8; ++t) acc4 |= fp4_code(v[w * 2 + (t >> 2)][t & 3] * sc) << (4 * t);
                    wd4[w] = acc4; }
                unsigned char* dst4 = ws + (tb ? WS_VTAB : WS_UTAB) + (size_t)e * 512 + fr * 32;
#pragma unroll
                for (int p = 0; p < 2; ++p) { v4u o; o.x = wd4[4 * p]; o.y = wd4[4 * p + 1]; o.z = wd4[4 * p + 2]; o.w = wd4[4 * p + 3]; *(GAS v4u*)(dst4 + p * 16) = o; }
                continue; }
            unsigned wd[12];
#pragma unroll
            for (int h = 0; h < 4; ++h) {
                unsigned cd[16];
#pragma unroll
                for (int q4 = 0; q4 < 4; ++q4)
#pragma unroll
                    for (int t = 0; t < 4; ++t) cd[q4 * 4 + t] = fp6_code(v[h * 4 + q4][t] * sc);
                wd[h * 3 + 0] = cd[0] | (cd[1] << 6) | (cd[2] << 12) | (cd[3] << 18) | (cd[4] << 24) | ((cd[5] & 3u) << 30);
                wd[h * 3 + 1] = (cd[5] >> 2) | (cd[6] << 4) | (cd[7] << 10) | (cd[8] << 16) | (cd[9] << 22) | ((cd[10] & 15u) << 28);
                wd[h * 3 + 2] = (cd[10] >> 4) | (cd[11] << 2) | (cd[12] << 8) | (cd[13] << 14) | (cd[14] << 20) | (cd[15] << 26); }
            unsigned char* dst = ws + WS_UTAB + (size_t)e * 768 + kq * 16;
#pragma unroll
            for (int p = 0; p < 3; ++p) { v4u o; o.x = wd[4 * p]; o.y = wd[4 * p + 1]; o.z = wd[4 * p + 2]; o.w = wd[4 * p + 3]; *(GAS v4u*)(dst + (3 * sp + p) * 64) = o; } } }
#endif
      const GAS f32x4* ms = (const GAS f32x4*)P.in[1]; GAS unsigned* md = (GAS unsigned*)(ws + WS_MEMF8);
      for (size_t i = gt; i < (size_t)512 * 1024 / 4; i += NTH) { const f32x4 a = ms[i]; md[i] = pk4_fp8(a.x, a.y, a.z, a.w); }
    }
}

constexpr int FFT_PITCH = 544, FFT_BUF = 128 * FFT_PITCH;
static_assert(2 * FFT_BUF <= MISC_OFF, "FFT LDS map");
typedef short s16x4 __attribute__((ext_vector_type(4)));
__device__ __forceinline__ s16x4 tr_read(LAS unsigned char* p) { return __builtin_amdgcn_ds_read_tr16_b64_v4i16((LAS s16x4*)p); }
template <int STEP>
__device__ __forceinline__ void fft_step_mfma(const bf16* src, bf16* dst, LAS unsigned char* lds, int tid, int lane, int wave, int G) {
    const int fr = lane & 15, kq = lane >> 4, kout = 16 * wave + fr;
    bf16x8 cf[4], sf[4];
    { LAS float* tab = (LAS float*)(lds + FFT_BUF);
      __syncthreads();
      if (tid < 128) { float sn, cs; sincospif((float)tid / 64.f, &sn, &cs); tab[tid] = cs; tab[128 + tid] = sn; }
      __syncthreads();
#pragma unroll
      for (int kk = 0; kk < 4; ++kk) { v4u cw, sw; unsigned cl[8], sl[8];
#pragma unroll
          for (int j = 0; j < 8; ++j) { const int sv = 32 * kk + (j < 4 ? 4 * kq + j : 16 + 4 * kq + j - 4); const int ix = (kout * sv) & 127; cl[j] = f2bf(tab[ix]); sl[j] = f2bf(tab[128 + ix]); }
          cw.x = cl[0] | (cl[1] << 16); cw.y = cl[2] | (cl[3] << 16); cw.z = cl[4] | (cl[5] << 16); cw.w = cl[6] | (cl[7] << 16);
          sw.x = sl[0] | (sl[1] << 16); sw.y = sl[2] | (sl[3] << 16); sw.z = sl[4] | (sl[5] << 16); sw.w = sl[6] | (sl[7] << 16);
          cf[kk] = __builtin_bit_cast(bf16x8, cw); sf[kk] = __builtin_bit_cast(bf16x8, sw); } }
    v4u iw[8];
#define FFT_LOAD(UN) do { const int b_ = (UN) >> 9, f_ = ((UN) >> 2) & 127, g_ = (UN) & 3; _Pragma("unroll") for (int j = 0; j < 8; ++j) { const int c = tid + 512 * j; const int sr = c >> 5, piece = c & 31; \
            const size_t row = (STEP == 1) ? (size_t)(b_ << 14) + 128 * sr + f_ : (size_t)(b_ << 14) + 128 * f_ + sr; iw[j] = *(const GAS v4u*)(src + row * 1024 + g_ * 256 + piece * 8); } } while (0)
#define FFT_PUT(BUF) do { _Pragma("unroll") for (int j = 0; j < 8; ++j) { const int c = tid + 512 * j; *(LAS v4u*)(lds + (BUF) * FFT_BUF + (c >> 5) * FFT_PITCH + (c & 31) * 16) = iw[j]; } } while (0)
    __syncthreads();
    if (blockIdx.x < 1024) { FFT_LOAD(blockIdx.x); FFT_PUT(0); }
    __syncthreads();
    int cur = 0;
    for (int unit = blockIdx.x; unit < 1024; unit += G) {
        const int b = unit >> 9, f = (unit >> 2) & 127, g = unit & 3;
        const bool more = unit + G < 1024;
        if (more) FFT_LOAD(unit + G);
        LAS unsigned char* img = lds + cur * FFT_BUF;
        f32x4 accR[8], accI[8];
#pragma unroll
        for (int mt = 0; mt < 8; ++mt) { accR[mt] = (f32x4){0.f, 0.f, 0.f, 0.f}; accI[mt] = (f32x4){0.f, 0.f, 0.f, 0.f}; }
#pragma unroll
        for (int mt = 0; mt < 8; ++mt)
#pragma unroll
            for (int kk = 0; kk < 4; ++kk) {
                LAS unsigned char* a1 = img + (32 * kk + 4 * kq + (fr >> 2)) * FFT_PITCH + (16 * mt + 4 * (fr & 3)) * 2;
                LAS unsigned char* a2 = a1 + 16 * FFT_PITCH;
                const s16x4 r0 = tr_read(a1), r1 = tr_read(a2), i0 = tr_read(a1 + 256), i1 = tr_read(a2 + 256);
                const bf16x8 xr = __builtin_shufflevector(r0, r1, 0, 1, 2, 3, 4, 5, 6, 7), xi = __builtin_shufflevector(i0, i1, 0, 1, 2, 3, 4, 5, 6, 7);
                if (STEP == 1) {
                    v4u t = __builtin_bit_cast(v4u, xi); t.x ^= 0x80008000u; t.y ^= 0x80008000u; t.z ^= 0x80008000u; t.w ^= 0x80008000u; const bf16x8 nxi = __builtin_bit_cast(bf16x8, t);
                    accR[mt] = __builtin_amdgcn_mfma_f32_16x16x32_bf16(xr, cf[kk], accR[mt], 0, 0, 0); accR[mt] = __builtin_amdgcn_mfma_f32_16x16x32_bf16(nxi, sf[kk], accR[mt], 0, 0, 0);
                    accI[mt] = __builtin_amdgcn_mfma_f32_16x16x32_bf16(xi, cf[kk], accI[mt], 0, 0, 0); accI[mt] = __builtin_amdgcn_mfma_f32_16x16x32_bf16(xr, sf[kk], accI[mt], 0, 0, 0);
                } else {
                    accR[mt] = __builtin_amdgcn_mfma_f32_16x16x32_bf16(xr, cf[kk], accR[mt], 0, 0, 0); accR[mt] = __builtin_amdgcn_mfma_f32_16x16x32_bf16(xi, sf[kk], accR[mt], 0, 0, 0);
                }
                if (kk == 3) __builtin_amdgcn_sched_barrier(0);
            }
        if (STEP == 1) { float ws_, wc_; sincospif(-(float)(f * kout) / 8192.f, &ws_, &wc_);
            bf16* orow = dst + ((size_t)(b << 14) + kout * 128 + f) * 1024 + g * 256 + 4 * kq;
#pragma unroll
            for (int mt = 0; mt < 8; ++mt) { v2u re, im; re.x = pk2(accR[mt][0] * wc_ + accI[mt][0] * ws_, accR[mt][1] * wc_ + accI[mt][1] * ws_); re.y = pk2(accR[mt][2] * wc_ + accI[mt][2] * ws_, accR[mt][3] * wc_ + accI[mt][3] * ws_);
                im.x = pk2(accR[mt][0] * ws_ - accI[mt][0] * wc_, accR[mt][1] * ws_ - accI[mt][1] * wc_); im.y = pk2(accR[mt][2] * ws_ - accI[mt][2] * wc_, accR[mt][3] * ws_ - accI[mt][3] * wc_);
                *(GAS v2u*)(orow + 16 * mt) = re; *(GAS v2u*)(orow + 128 + 16 * mt) = im; }
        } else { const float scale = 6.905339660024878e-4f;
            bf16* orow = dst + ((size_t)(b << 14) + f + 128 * kout) * 512 + g * 128 + 4 * kq;
#pragma unroll
            for (int mt = 0; mt < 8; ++mt) { v2u re; re.x = pk2(accR[mt][0] * scale, accR[mt][1] * scale); re.y = pk2(accR[mt][2] * scale, accR[mt][3] * scale); *(GAS v2u*)(orow + 16 * mt) = re; }
        }
        if (more) FFT_PUT(cur ^ 1);
        __syncthreads();
        cur ^= 1;
    }
#undef FFT_LOAD
#undef FFT_PUT
}

typedef float f32x16 __attribute__((ext_vector_type(16)));
constexpr int DA_BT = 0, DA_K = 9216, DA_KP = 144, DA_V = DA_K + 384 * DA_KP, DA_VP = 776;
static_assert(DA_V + 64 * DA_VP <= MISC_OFF, "dil-attn LDS map");
template <int T>
__device__ __forceinline__ void dil_tile(LAS unsigned char* lds, int kr0, int r31, int hh, const LAS float* btl, const bf16x8 (&qf)[4], f32x16& o0, f32x16& o1, float& mx, float& den) {
    const LAS unsigned char* kp = lds + DA_K + (kr0 + r31) * DA_KP + 16 * hh;
    f32x16 sacc;
#pragma unroll
    for (int i = 0; i < 16; ++i) sacc[i] = 0.f;
#pragma unroll
    for (int kk = 0; kk < 4; ++kk) { const bf16x8 kf = *(const LAS bf16x8*)(kp + 32 * kk); sacc = __builtin_amdgcn_mfma_f32_32x32x16_bf16(kf, qf[kk], sacc, 0, 0, 0); }
    const LAS float* bl = btl + (32 + 32 * T + 4 * hh - r31);
    float tmax = -INFINITY;
#pragma unroll
    for (int i = 0; i < 16; ++i) { const int krow = (i & 3) + 8 * (i >> 2);
        float sv = sacc[i] * 0.18033688011112042f + bl[krow];
        if (T == 0) sv = (krow + 4 * hh >= r31) ? sv : -INFINITY;
        if (T == 4) sv = (krow + 4 * hh <= r31) ? sv : -INFINITY;
        sacc[i] = sv; tmax = fmaxf(tmax, sv); }
    tmax = fmaxf(tmax, __shfl_xor(tmax, 32));
    const float mn = fmaxf(mx, tmax), corr = __builtin_amdgcn_exp2f(mx - mn); mx = mn;
    float psum = 0.f;
#pragma unroll
    for (int i = 0; i < 16; ++i) { const float p = __builtin_amdgcn_exp2f(sacc[i] - mn); sacc[i] = p; psum += p; }
    den = den * corr + psum;
#pragma unroll
    for (int i = 0; i < 16; ++i) { o0[i] *= corr; o1[i] *= corr; }
#pragma unroll
    for (int s2 = 0; s2 < 2; ++s2) { v4u pw; pw.x = pk2(sacc[8 * s2], sacc[8 * s2 + 1]); pw.y = pk2(sacc[8 * s2 + 2], sacc[8 * s2 + 3]); pw.z = pk2(sacc[8 * s2 + 4], sacc[8 * s2 + 5]); pw.w = pk2(sacc[8 * s2 + 6], sacc[8 * s2 + 7]);
        const bf16x8 pf = __builtin_bit_cast(bf16x8, pw);
        const LAS unsigned char* vp = lds + DA_V + r31 * DA_VP + (kr0 + 16 * s2 + 4 * hh) * 2;
        const v2u lo0 = *(const LAS v2u*)vp, hi0 = *(const LAS v2u*)(vp + 16), lo1 = *(const LAS v2u*)(vp + 32 * DA_VP), hi1 = *(const LAS v2u*)(vp + 32 * DA_VP + 16);
        v4u w0, w1; w0.x = lo0.x; w0.y = lo0.y; w0.z = hi0.x; w0.w = hi0.y; w1.x = lo1.x; w1.y = lo1.y; w1.z = hi1.x; w1.w = hi1.y;
        o0 = __builtin_amdgcn_mfma_f32_32x32x16_bf16(__builtin_bit_cast(bf16x8, w0), pf, o0, 0, 0, 0);
        o1 = __builtin_amdgcn_mfma_f32_32x32x16_bf16(__builtin_bit_cast(bf16x8, w1), pf, o1, 0, 0, 0); }
}
__device__ __forceinline__ void dil_attn_lds(const bf16* qk, const bf16* vt, const float* btab_g, bf16* og, float* lse, LAS unsigned char* lds, int tid, int lane, int wave, int G) {
    LAS float* bt = (LAS float*)(lds + DA_BT);
    __syncthreads();
    for (int i = tid; i < 12 * 192; i += 512) { const int tb = i / 192, j = i - tb * 192 - 32; bt[i] = (j >= 0 && j <= 128) ? btab_g[tb * 132 + j] * 1.4426950408889634f : 0.f; }
    const int r31 = lane & 31, hh = lane >> 5;
    v4u kw[6], vw[6]; bf16x8 qn[4];
#define DIL_UNIT(U) const int blk = (U) & 63, hd = ((U) >> 6) & 3, g = ((U) >> 8) % 3, b = (U) / 768; const int sh = 2 * g, sub = 16384 >> sh; \
        const int nl0 = blk * 256, rr = nl0 >> (14 - sh), l0 = nl0 & (sub - 1); const size_t seq0 = ((size_t)g * NT + (size_t)(b << 14) + (size_t)rr * sub); \
        const bf16* qkg = qk + seq0 * 512; const bf16* vtg = vt + ((size_t)g * 256 + hd * 64) * NT + (size_t)(b << 14) + (size_t)rr * sub;
#define DIL_LOAD() do { _Pragma("unroll") for (int j = 0; j < 6; ++j) { const int c = tid + 512 * j; const int kr = c >> 3, pc = c & 7; const int lk = l0 - 64 + kr; const int lkc = lk < 0 ? 0 : (lk >= sub ? sub - 1 : lk); \
              kw[j] = *(const GAS v4u*)(qkg + (size_t)lkc * 512 + 256 + hd * 64 + pc * 8); \
              const int d = c / 48, pv = c - d * 48; const int lv = l0 - 64 + pv * 8; const int lvc = lv < 0 ? 0 : (lv >= sub ? sub - 8 : lv); \
              vw[j] = *(const GAS v4u*)(vtg + (size_t)d * NT + lvc); } \
          _Pragma("unroll") for (int kk = 0; kk < 4; ++kk) qn[kk] = *(const GAS bf16x8*)(qkg + (size_t)(l0 + 32 * wave + (lane & 31)) * 512 + hd * 64 + 16 * kk + 8 * (lane >> 5)); } while (0)
    if (blockIdx.x < 1536) { DIL_UNIT(blockIdx.x) DIL_LOAD(); }
    for (int u = blockIdx.x; u < 1536; u += G) {
        DIL_UNIT(u)
        __syncthreads();
#pragma unroll
        for (int j = 0; j < 6; ++j) { const int c = tid + 512 * j; const int kr = c >> 3, pc = c & 7;
            *(LAS v4u*)(lds + DA_K + kr * DA_KP + pc * 16) = kw[j];
            const int d = c / 48, pv = c - d * 48;
            v2u lo, hi; lo.x = vw[j].x; lo.y = vw[j].y; hi.x = vw[j].z; hi.y = vw[j].w;
            *(LAS v2u*)(lds + DA_V + d * DA_VP + pv * 16) = lo; *(LAS v2u*)(lds + DA_V + d * DA_VP + pv * 16 + 8) = hi; }
        __syncthreads();
        bf16x8 qf[4];
#pragma unroll
        for (int kk = 0; kk < 4; ++kk) qf[kk] = qn[kk];
        if (u + G < 1536) { const int un = u + G; const int blkn = un & 63, hdn = (un >> 6) & 3, gn = (un >> 8) % 3, bn = un / 768; const int shn = 2 * gn, subn = 16384 >> shn;
            const int nl0n = blkn * 256, rrn = nl0n >> (14 - shn), l0n = nl0n & (subn - 1); const size_t seq0n = ((size_t)gn * NT + (size_t)(bn << 14) + (size_t)rrn * subn);
            const bf16* qkgn = qk + seq0n * 512; const bf16* vtgn = vt + ((size_t)gn * 256 + hdn * 64) * NT + (size_t)(bn << 14) + (size_t)rrn * subn;
#pragma unroll
            for (int j = 0; j < 6; ++j) { const int c = tid + 512 * j; const int kr = c >> 3, pc = c & 7; const int lk = l0n - 64 + kr; const int lkc = lk < 0 ? 0 : (lk >= subn ? subn - 1 : lk);
                kw[j] = *(const GAS v4u*)(qkgn + (size_t)lkc * 512 + 256 + hdn * 64 + pc * 8);
                const int d = c / 48, pv = c - d * 48; const int lv = l0n - 64 + pv * 8; const int lvc = lv < 0 ? 0 : (lv >= subn ? subn - 8 : lv);
                vw[j] = *(const GAS v4u*)(vtgn + (size_t)d * NT + lvc); }
#pragma unroll
            for (int kk = 0; kk < 4; ++kk) qn[kk] = *(const GAS bf16x8*)(qkgn + (size_t)(l0n + 32 * wave + (lane & 31)) * 512 + hdn * 64 + 16 * kk + 8 * (lane >> 5)); }
        const int lq0 = l0 + 32 * wave;
        const LAS float* btl = bt + (g * 4 + hd) * 192;
        f32x16 o0, o1;
#pragma unroll
        for (int i = 0; i < 16; ++i) { o0[i] = 0.f; o1[i] = 0.f; }
        float mx = -1e30f, den = 0.f;
        if (lq0 - 64 >= 0) dil_tile<0>(lds, 32 * wave, r31, hh, btl, qf, o0, o1, mx, den);
        if (lq0 - 32 >= 0) dil_tile<1>(lds, 32 * wave + 32, r31, hh, btl, qf, o0, o1, mx, den);
        dil_tile<2>(lds, 32 * wave + 64, r31, hh, btl, qf, o0, o1, mx, den);
        if (lq0 + 32 < sub) dil_tile<3>(lds, 32 * wave + 96, r31, hh, btl, qf, o0, o1, mx, den);
        if (lq0 + 64 < sub) dil_tile<4>(lds, 32 * wave + 128, r31, hh, btl, qf, o0, o1, mx, den);
        den += __shfl_xor(den, 32);
        const float inv = 1.f / den;
        const size_t n = seq0 + lq0 + r31;
        bf16* orow = og + n * 256 + hd * 64 + 4 * hh;
#pragma unroll
        for (int q4 = 0; q4 < 4; ++q4) { v2u w0, w1; w0.x = pk2(o0[4 * q4] * inv, o0[4 * q4 + 1] * inv); w0.y = pk2(o0[4 * q4 + 2] * inv, o0[4 * q4 + 3] * inv);
            w1.x = pk2(o1[4 * q4] * inv, o1[4 * q4 + 1] * inv); w1.y = pk2(o1[4 * q4 + 2] * inv, o1[4 * q4 + 3] * inv);
            *(GAS v2u*)(orow + 8 * q4) = w0; *(GAS v2u*)(orow + 32 + 8 * q4) = w1; }
        if (hh == 0) lse[n * 4 + hd] = (mx + __builtin_amdgcn_logf(den)) * 0.6931471805599453f;
    }
    __syncthreads();
#undef DIL_UNIT
#undef DIL_LOAD
}
constexpr int MA_KP = 272, MA_VP = 520, MA_V = 256 * MA_KP;
static_assert(MA_V + 128 * MA_VP <= MISC_OFF, "mem-attn LDS map");
__device__ __forceinline__ void mem_attn_lds(const bf16* qc, const bf16* memk, const bf16* vtm, bf16* ycin, LAS unsigned char* lds, int tid, int lane, int wave, int G) {
    const int r31 = lane & 31, hh = lane >> 5;
    for (int wu = blockIdx.x; wu < 256; wu += G) {
        const int combo = wu & 7, b = combo >> 2, hd = combo & 3, chunk = wu >> 3;
        __syncthreads();
        { v4u kw[8], vw[8];
#pragma unroll
          for (int j = 0; j < 8; ++j) { const int c = tid + 512 * j; kw[j] = *(const GAS v4u*)(memk + (size_t)(b * 256 + (c >> 4)) * 512 + hd * 128 + (c & 15) * 8);
              vw[j] = *(const GAS v4u*)(vtm + (size_t)(hd * 128 + (c >> 5)) * 512 + b * 256 + (c & 31) * 8); }
#pragma unroll
          for (int j = 0; j < 8; ++j) { const int c = tid + 512 * j; *(LAS v4u*)(lds + (c >> 4) * MA_KP + (c & 15) * 16) = kw[j];
              v2u lo, hi; lo.x = vw[j].x; lo.y = vw[j].y; hi.x = vw[j].z; hi.y = vw[j].w;
              *(LAS v2u*)(lds + MA_V + (c >> 5) * MA_VP + (c & 31) * 16) = lo; *(LAS v2u*)(lds + MA_V + (c >> 5) * MA_VP + (c & 31) * 16 + 8) = hi; } }
        __syncthreads();
#pragma unroll 1
        for (int qi = 0; qi < 2; ++qi) {
            const int blk = chunk * 16 + wave * 2 + qi;
            const size_t tok = (size_t)(b << 14) + blk * 32 + r31;
            const bf16* qrow = qc + tok * 512 + hd * 128 + 8 * hh;
            bf16x8 qf[8];
#pragma unroll
            for (int kk = 0; kk < 8; ++kk) qf[kk] = *(const GAS bf16x8*)(qrow + 16 * kk);
            f32x16 o[4];
#pragma unroll
            for (int mt = 0; mt < 4; ++mt)
#pragma unroll
                for (int i = 0; i < 16; ++i) o[mt][i] = 0.f;
            float mx = -1e30f, den = 0.f;
            const LAS unsigned char* kb = lds + r31 * MA_KP + 16 * hh;
            const LAS unsigned char* vb = lds + MA_V + r31 * MA_VP + 8 * hh;
#pragma unroll 1
            for (int t = 0; t < 8; ++t) {
                f32x16 sacc;
#pragma unroll
                for (int i = 0; i < 16; ++i) sacc[i] = 0.f;
#pragma unroll
                for (int kk = 0; kk < 8; ++kk) { const bf16x8 kf = *(const LAS bf16x8*)(kb + (32 * t) * MA_KP + 32 * kk); sacc = __builtin_amdgcn_mfma_f32_32x32x16_bf16(kf, qf[kk], sacc, 0, 0, 0); }
                float tmax = -INFINITY;
#pragma unroll
                for (int i = 0; i < 16; ++i) { sacc[i] *= 0.08838834764831845f; tmax = fmaxf(tmax, sacc[i]); }
                tmax = fmaxf(tmax, __shfl_xor(tmax, 32));
                const float mn = fmaxf(mx, tmax), corr = __expf(mx - mn); mx = mn;
                float psum = 0.f;
#pragma unroll
                for (int i = 0; i < 16; ++i) { const float p = __expf(sacc[i] - mn); sacc[i] = p; psum += p; }
                den = den * corr + psum;
#pragma unroll
                for (int mt = 0; mt < 4; ++mt)
#pragma unroll
                    for (int i = 0; i < 16; ++i) o[mt][i] *= corr;
#pragma unroll
                for (int s2 = 0; s2 < 2; ++s2) { v4u pw; pw.x = pk2(sacc[8 * s2], sacc[8 * s2 + 1]); pw.y = pk2(sacc[8 * s2 + 2], sacc[8 * s2 + 3]); pw.z = pk2(sacc[8 * s2 + 4], sacc[8 * s2 + 5]); pw.w = pk2(sacc[8 * s2 + 6], sacc[8 * s2 + 7]);
                    const bf16x8 pf = __builtin_bit_cast(bf16x8, pw);
#pragma unroll
                    for (int mt = 0; mt < 4; ++mt) { const LAS unsigned char* vp = vb + (32 * mt) * MA_VP + (32 * t + 16 * s2) * 2;
                        const v2u lo = *(const LAS v2u*)vp, hi = *(const LAS v2u*)(vp + 16);
                        v4u w; w.x = lo.x; w.y = lo.y; w.z = hi.x; w.w = hi.y;
                        o[mt] = __builtin_amdgcn_mfma_f32_32x32x16_bf16(__builtin_bit_cast(bf16x8, w), pf, o[mt], 0, 0, 0); } }
            }
            den += __shfl_xor(den, 32);
            const float inv = 1.f / den;
            unsigned char* orow = (unsigned char*)ycin + tok * 512 + hd * 128 + 4 * hh; const float inv4 = inv * SC_ACT;
#pragma unroll
            for (int mt = 0; mt < 4; ++mt)
#pragma unroll
                for (int q4 = 0; q4 < 4; ++q4) *(GAS unsigned*)(orow + 32 * mt + 8 * q4) = pk4_fp8(o[mt][4 * q4] * inv4, o[mt][4 * q4 + 1] * inv4, o[mt][4 * q4 + 2] * inv4, o[mt][4 * q4 + 3] * inv4);
        }
    }
    __syncthreads();
}
__device__ __forceinline__ void combine_groups(const bf16* og, const float* lse, bf16* ob, int tid, int G) {
    for (size_t idx = (size_t)blockIdx.x * 512 + tid; idx < (size_t)NT * 32; idx += (size_t)G * 512) {
        const int t = (int)(idx >> 5), ch = (int)(idx & 31), h = ch >> 3, d0 = (ch & 7) * 8, b = t >> 14, s = t & 16383;
        float l[3]; size_t n[3];
#pragma unroll
        for (int g = 0; g < 3; ++g) { const int sh = 2 * g; n[g] = (size_t)(b << 14) + (size_t)(s & ((1 << sh) - 1)) * (16384 >> sh) + (s >> sh); l[g] = lse[((size_t)g * NT + n[g]) * 4 + h]; }
        const float mx = fmaxf(l[0], fmaxf(l[1], l[2])); float w[3], sum = 0.f;
#pragma unroll
        for (int g = 0; g < 3; ++g) { w[g] = __expf(l[g] - mx); sum += w[g]; }
        float o[8] = {0, 0, 0, 0, 0, 0, 0, 0};
#pragma unroll
        for (int g = 0; g < 3; ++g) { const float wg = w[g] / sum; const v4u v = *(const GAS v4u*)(og + ((size_t)g * NT + n[g]) * 256 + h * 64 + d0);
            o[0] += wg * bflo(v.x); o[1] += wg * bfhi(v.x); o[2] += wg * bflo(v.y); o[3] += wg * bfhi(v.y); o[4] += wg * bflo(v.z); o[5] += wg * bfhi(v.z); o[6] += wg * bflo(v.w); o[7] += wg * bfhi(v.w); }
        v2u r; r.x = pk4_fp8(o[0] * SC_ACT, o[1] * SC_ACT, o[2] * SC_ACT, o[3] * SC_ACT); r.y = pk4_fp8(o[4] * SC_ACT, o[5] * SC_ACT, o[6] * SC_ACT, o[7] * SC_ACT);
        *(GAS v2u*)((unsigned char*)ob + (size_t)t * 256 + h * 64 + d0) = r;
    }
}

template <int C> __device__ __forceinline__ unsigned dppu(unsigned v) { return (unsigned)__builtin_amdgcn_update_dpp(0, (int)v, C, 0xF, 0xF, true); }
template <int C> __device__ __forceinline__ float dppf(float v) { return __builtin_bit_cast(float, __builtin_amdgcn_update_dpp(0, __builtin_bit_cast(int, v), C, 0xF, 0xF, true)); }
__device__ __forceinline__ unsigned umax2(unsigned a, unsigned b) { return a > b ? a : b; }
__device__ __forceinline__ unsigned row_max_u(unsigned v) { v = umax2(v, dppu<0xB1>(v)); v = umax2(v, dppu<0x4E>(v)); v = umax2(v, dppu<0x141>(v)); v = umax2(v, dppu<0x140>(v)); return v; }
__device__ __forceinline__ float row_max_f(float v) { v = fmaxf(v, dppf<0xB1>(v)); v = fmaxf(v, dppf<0x4E>(v)); v = fmaxf(v, dppf<0x141>(v)); v = fmaxf(v, dppf<0x140>(v)); return v; }
__device__ __forceinline__ float row_sum_f(float v) { v += dppf<0xB1>(v); v += dppf<0x4E>(v); v += dppf<0x141>(v); v += dppf<0x140>(v); return v; }
__device__ __forceinline__ unsigned ordf(float f) { const unsigned b = __builtin_bit_cast(unsigned, f); return b ^ ((unsigned)((int)b >> 31) | 0x80000000u); }
__device__ __forceinline__ float decf(unsigned k) { const unsigned b = (k & 0x80000000u) ? (k ^ 0x80000000u) : ~k; return __builtin_bit_cast(float, b); }
__device__ __forceinline__ unsigned bperm(unsigned v, int src_lane) { return (unsigned)__builtin_amdgcn_ds_bpermute(src_lane * 4, (int)v); }
typedef __bf16 bf16x2_t __attribute__((ext_vector_type(2)));
__device__ __forceinline__ float dot2bf(unsigned a, unsigned b, float c) { return __builtin_amdgcn_fdot2_f32_bf16(__builtin_bit_cast(bf16x2_t, a), __builtin_bit_cast(bf16x2_t, b), c, false); }

__device__ __forceinline__ float gelu_as(float v) {
    const float av = fabsf(v), t = __builtin_amdgcn_rcpf(av * 0.2316418882f + 1.0f);
    float q = t * 0.5307027145f + (-0.7265760135f); q = q * t + 0.7107068705f; q = q * t + (-0.142248368f); q = q * t + 0.127414796f; q = q * t;
    const float e = __builtin_amdgcn_exp2f((v * v) * (-0.72134752044f));
    const float m = v * (q * e);
    return v < 0.f ? m : v - m;
}
constexpr int PEER_SKB = 0, PEER_EL = 36864, PEER_PTAB = PEER_EL + 8 * 2048, PEER_VB = PEER_PTAB + 256, PEER_XA = PEER_VB + 8 * 8192, PEER_WB = PEER_XA + 8 * 4096;
static_assert(PEER_WB + 8 * 64 <= MISC_OFF, "PEER LDS map");
constexpr float PEER_XS = 32.f, PEER_WS = 32.f;
typedef int v8i_p __attribute__((ext_vector_type(8)));
typedef int v2i __attribute__((ext_vector_type(2)));
__device__ __forceinline__ void peer_scores_top16(const bf16* qp, LAS unsigned char* lds, int tokb, int hf, int fr, int fq, unsigned& o0, unsigned& o1, unsigned& o2, unsigned& o3) {
    const bf16* arow = qp + (size_t)(tokb + (fr >> 3)) * 1024 + (fr & 7) * 128 + hf * 64 + 8 * fq;
    const bf16x8 a0 = *(const GAS bf16x8*)arow, a1 = *(const GAS bf16x8*)(arow + 32);
    unsigned e0[8], e1[8], e2[8], e3[8];
#pragma unroll
    for (int nb = 0; nb < 8; ++nb) {
        const LAS unsigned char* bp = lds + PEER_SKB + hf * 18432 + (fr + 16 * nb) * 144 + fq * 16;
        const bf16x8 b0 = *(const LAS bf16x8*)bp, b1 = *(const LAS bf16x8*)(bp + 64);
        f32x4 acc = (f32x4){0.f, 0.f, 0.f, 0.f};
        acc = __builtin_amdgcn_mfma_f32_16x16x32_bf16(a0, b0, acc, 0, 0, 0);
        acc = __builtin_amdgcn_mfma_f32_16x16x32_bf16(a1, b1, acc, 0, 0, 0);
        const unsigned ix = (unsigned)(127 - (fr + 16 * nb));
        e0[nb] = (ordf(acc[0]) & ~127u) | ix; e1[nb] = (ordf(acc[1]) & ~127u) | ix; e2[nb] = (ordf(acc[2]) & ~127u) | ix; e3[nb] = (ordf(acc[3]) & ~127u) | ix;
    }
    o0 = 0u; o1 = 0u; o2 = 0u; o3 = 0u;
#define PEER_CE(E, A, B) do { const unsigned hi_ = umax2(E[A], E[B]), lo_ = E[A] < E[B] ? E[A] : E[B]; E[A] = hi_; E[B] = lo_; } while (0)
#define PEER_SORT8(E) do { PEER_CE(E, 0, 1); PEER_CE(E, 2, 3); PEER_CE(E, 4, 5); PEER_CE(E, 6, 7); PEER_CE(E, 0, 2); PEER_CE(E, 1, 3); PEER_CE(E, 4, 6); PEER_CE(E, 5, 7); PEER_CE(E, 1, 2); PEER_CE(E, 5, 6); \
        PEER_CE(E, 0, 4); PEER_CE(E, 1, 5); PEER_CE(E, 2, 6); PEER_CE(E, 3, 7); PEER_CE(E, 2, 4); PEER_CE(E, 3, 5); PEER_CE(E, 1, 2); PEER_CE(E, 3, 4); PEER_CE(E, 5, 6); } while (0)
#define PEER_ROUND(E, O) do { const unsigned m = row_max_u(E[0]); const bool win = (E[0] == m); \
        E[0] = win ? E[1] : E[0]; E[1] = win ? E[2] : E[1]; E[2] = win ? E[3] : E[2]; E[3] = win ? E[4] : E[3]; E[4] = win ? E[5] : E[4]; E[5] = win ? E[6] : E[5]; E[6] = win ? E[7] : E[6]; E[7] = win ? 0u : E[7]; \
        O = (fr == r) ? m : O; } while (0)
    PEER_SORT8(e0); PEER_SORT8(e1); PEER_SORT8(e2); PEER_SORT8(e3);
#pragma unroll 1
    for (int r = 0; r < 16; ++r) { PEER_ROUND(e0, o0); PEER_ROUND(e1, o1); PEER_ROUND(e2, o2); PEER_ROUND(e3, o3); }
#undef PEER_ROUND
#undef PEER_SORT8
#undef PEER_CE
}
__device__ __forceinline__ void peer_cand(LAS unsigned char* lds, LAS unsigned char* el, unsigned ptab, unsigned L1, unsigned L2, int lane, int fr, int slot) {
    unsigned c0, c1, c2, c3;
#define PEER_CK(SL, C) do { const unsigned byte = (ptab >> (8 * SL)) & 255u; const int a = byte >> 4, b = byte & 15; \
        const unsigned k1 = bperm(L1, (lane & 48) + a), k2 = bperm(L2, (lane & 48) + b); const float sum = decf(k1 & ~127u) + decf(k2 & ~127u); \
        C = (byte != 255u) ? ((ordf(sum) & ~63u) | (unsigned)(fr * 4 + SL)) : 0u; } while (0)
    PEER_CK(0, c0); PEER_CK(1, c1); PEER_CK(2, c2); PEER_CK(3, c3);
#undef PEER_CK
    unsigned co = 0u;
#define PEER_CE2(A, B) do { const unsigned hi_ = umax2(A, B), lo_ = A < B ? A : B; A = hi_; B = lo_; } while (0)
    PEER_CE2(c0, c1); PEER_CE2(c2, c3); PEER_CE2(c0, c2); PEER_CE2(c1, c3); PEER_CE2(c1, c2);
#undef PEER_CE2
#pragma unroll 1
    for (int r = 0; r < 16; ++r) { const unsigned m = row_max_u(c0); const bool win = (c0 == m);
        c0 = win ? c1 : c0; c1 = win ? c2 : c1; c2 = win ? c3 : c2; c3 = win ? 0u : c3;
        co = (fr == r) ? m : co; }
    const unsigned pb = *(LAS unsigned char*)(lds + PEER_PTAB + (co & 63u));
    const unsigned k1 = bperm(L1, (lane & 48) + (int)(pb >> 4)), k2 = bperm(L2, (lane & 48) + (int)(pb & 15u));
    const unsigned expert = (127u - (k1 & 127u)) * 128u + (127u - (k2 & 127u));
    const float sc = decf(co & ~63u);
    const float ex = __expf(sc - row_max_f(sc));
    const float gate = ex / row_sum_f(ex);
    v2u rec; rec.x = expert; rec.y = __builtin_bit_cast(unsigned, gate);
    *(LAS v2u*)(el + slot * 8) = rec;
}
template <int sh, bool PACK>
__device__ __forceinline__ void peer_regroup16(const LAS unsigned char* src, LAS unsigned char* dst, int lane, int fr) {
    v2u rc[8]; unsigned c0 = 0u, c1 = 0u, c2 = 0u, c3 = 0u;
#pragma unroll
    for (int j = 0; j < 8; ++j) { rc[j] = *(const LAS v2u*)(src + (fr * 8 + j) * 8); const unsigned bk = (rc[j].x >> sh) & 15u, one = 1u << (8 * (bk & 3u)), w = bk >> 2;
        c0 += (w == 0u) ? one : 0u; c1 += (w == 1u) ? one : 0u; c2 += (w == 2u) ? one : 0u; c3 += (w == 3u) ? one : 0u; }
    unsigned i0 = c0, i1 = c1, i2 = c2, i3 = c3;
    i0 += dppu<0x111>(i0); i1 += dppu<0x111>(i1); i2 += dppu<0x111>(i2); i3 += dppu<0x111>(i3);
    i0 += dppu<0x112>(i0); i1 += dppu<0x112>(i1); i2 += dppu<0x112>(i2); i3 += dppu<0x112>(i3);
    i0 += dppu<0x114>(i0); i1 += dppu<0x114>(i1); i2 += dppu<0x114>(i2); i3 += dppu<0x114>(i3);
    i0 += dppu<0x118>(i0); i1 += dppu<0x118>(i1); i2 += dppu<0x118>(i2); i3 += dppu<0x118>(i3);
    const int l15 = (lane & 48) + 15;
    const unsigned t0 = bperm(i0, l15), t1 = bperm(i1, l15), t2 = bperm(i2, l15), t3 = bperm(i3, l15);
    const unsigned s0 = (t0 * 0x01010101u) >> 24, s1 = (t1 * 0x01010101u) >> 24, s2 = (t2 * 0x01010101u) >> 24;
    unsigned p0 = (i0 - c0) + (t0 * 0x01010100u), p1 = (i1 - c1) + (t1 * 0x01010100u) + s0 * 0x01010101u, p2 = (i2 - c2) + (t2 * 0x01010100u) + (s0 + s1) * 0x01010101u,
             p3 = (i3 - c3) + (t3 * 0x01010100u) + (s0 + s1 + s2) * 0x01010101u;
#pragma unroll
    for (int j = 0; j < 8; ++j) { const unsigned bk = (rc[j].x >> sh) & 15u, q8 = 8 * (bk & 3u), w = bk >> 2, one = 1u << q8;
        const unsigned pw = (w == 0u) ? p0 : ((w == 1u) ? p1 : ((w == 2u) ? p2 : p3));
        if (PACK) { const unsigned gu = rc[j].y; *(LAS unsigned*)(dst + ((pw >> q8) & 255u) * 4) = (rc[j].x << 16) | ((gu + 0x7fffu + ((gu >> 16) & 1u)) >> 16); }
        else *(LAS v2u*)(dst + ((pw >> q8) & 255u) * 8) = rc[j];
        p0 += (w == 0u) ? one : 0u; p1 += (w == 1u) ? one : 0u; p2 += (w == 2u) ? one : 0u; p3 += (w == 3u) ? one : 0u; }
}
#define PEER_ULOAD(U, E) do { const unsigned ee_ = (E); \
            const unsigned i0_ = dppu<0x00>(ee_), i1_ = dppu<0x55>(ee_), i2_ = dppu<0xAA>(ee_), i3_ = dppu<0xFF>(ee_);        \
            const unsigned char* p0_ = u6 + (size_t)i0_ * 512 + uofs; const unsigned char* p1_ = u6 + (size_t)i1_ * 512 + uofs; \
            const unsigned char* p2_ = u6 + (size_t)i2_ * 512 + uofs; const unsigned char* p3_ = u6 + (size_t)i3_ * 512 + uofs; \
            U[0] = *(const GAS v4u*)p0_; U[1] = *(const GAS v4u*)(p0_ + 256); U[2] = *(const GAS v4u*)p1_; U[3] = *(const GAS v4u*)(p1_ + 256); \
            U[4] = *(const GAS v4u*)p2_; U[5] = *(const GAS v4u*)(p2_ + 256); U[6] = *(const GAS v4u*)p3_; U[7] = *(const GAS v4u*)(p3_ + 256); } while (0)
#define PEER_VDMA(E) do { const unsigned ee_ = (E); const unsigned ia_ = bperm(ee_, vsrc0), ib_ = bperm(ee_, vsrc1); \
            const unsigned char* va_ = v6 + (size_t)ia_ * 512 + vpo0; const unsigned char* vb_ = v6 + (size_t)ib_ * 512 + vpo1; \
            _Pragma("unroll") for (int l = 0; l < 4; ++l) { \
                asm volatile("s_mov_b32 m0, %1\n\ts_nop 0\n\tglobal_load_lds_dwordx4 %0, off" :: "v"(va_ + l * 128), "s"(vbaddr + (unsigned)(2 * l) * 1024u) : "memory"); \
                asm volatile("s_mov_b32 m0, %1\n\ts_nop 0\n\tglobal_load_lds_dwordx4 %0, off" :: "v"(vb_ + l * 128), "s"(vbaddr + (unsigned)(2 * l + 1) * 1024u) : "memory"); } } while (0)
#define PEER_XROW(XN, TOK, LN) do { const bf16* prow = (const bf16*)(ws + WS_H0) + (size_t)(TOK) * 1024 + (LN) * 16; \
            const GAS f32x4* sp = (const GAS f32x4*)((const float*)(ws + WS_STATS4) + (size_t)(TOK) * 8); const f32x4 sa = sp[0], sb = sp[1]; \
            f32x2 st; st.x = ((sa.x + sa.z) + sb.x) + sb.z; st.y = ((sa.y + sa.w) + sb.y) + sb.w; \
            const float mean1 = st.x * (1.f / D), rstd1 = 1.f / sqrtf(fmaxf(st.y * (1.f / D) - mean1 * mean1, 0.f) + LN_EPS); \
            _Pragma("unroll") for (int q8 = 0; q8 < 2; ++q8) { const v4u pw = *(const GAS v4u*)(prow + q8 * 8); f32x4 pa, pb2; unpack8(pw, pa, pb2); \
                _Pragma("unroll") for (int hq = 0; hq < 2; ++hq) { const int q4 = q8 * 2 + hq; const f32x4 pv = hq ? pb2 : pa; \
                    const f32x4 gv = *(const GAS f32x4*)(P.in[12] + (LN) * 16 + q4 * 4), bv = *(const GAS f32x4*)(P.in[13] + (LN) * 16 + q4 * 4); \
                    const f32x4 xv = (pv - mean1) * rstd1 * gv + bv; \
                    XN[q4 * 4] = xv.x; XN[q4 * 4 + 1] = xv.y; XN[q4 * 4 + 2] = xv.z; XN[q4 * 4 + 3] = xv.w; } } } while (0)
__device__ __forceinline__ void peer_v2(const Ptrs& P, LAS unsigned char* lds, int tid, int lane, int wave, int G) {
    unsigned char* ws = P.ws;
    const bf16* qp = (const bf16*)(ws + WS_QP); const bf16* utab = (const bf16*)(ws + WS_UTAB); const bf16* vtab = (const bf16*)(ws + WS_VTAB);
    const bf16* h1b = (const bf16*)(ws + WS_H1B);
    const int fr = lane & 15, fq = lane >> 4;
    for (int idx = tid; idx < 2 * 128 * 32; idx += 512) { const int hf = idx >> 12, k = (idx >> 5) & 127, c2 = idx & 31; const float* sk = (hf ? P.in[16] : P.in[15]) + k * 64 + c2 * 2;
        *(LAS unsigned*)(lds + PEER_SKB + hf * 18432 + k * 144 + c2 * 4) = pk2(sk[0], sk[1]); }
    if (tid < 64) { int q = 0, a = 0, b = 0; unsigned char val = 0xFF;
        for (a = 0; a < 16 && val == 0xFF; ++a) for (b = 0; b < 16 && (a + 1) * (b + 1) <= 16; ++b) { if (q == tid) { val = (unsigned char)((a << 4) | b); break; } ++q; }
        *(LAS unsigned char*)(lds + PEER_PTAB + tid) = val; }
    __syncthreads();
    LAS unsigned char* el = lds + PEER_EL + wave * 2048;
    LAS unsigned char* vb = lds + PEER_VB + wave * 8192;
    LAS unsigned char* xal = lds + PEER_XA + wave * 4096; LAS unsigned char* wbl = lds + PEER_WB + wave * 64;
    const unsigned char* u6 = (const unsigned char*)utab; const unsigned char* v6 = (const unsigned char*)vtab;
    const unsigned vbaddr = (unsigned)__builtin_amdgcn_readfirstlane((int)(unsigned)(size_t)vb);
    const int lane_k = lane;
    for (int tile = blockIdx.x; tile < NT / 32; tile += G) {
        const int lane = (int)opq((unsigned)lane_k), fr = lane & 15, fq = lane >> 4; const unsigned ptab = *(LAS unsigned*)(lds + PEER_PTAB + fr * 4);
        const int tok0 = tile * 32 + wave * 4;
#pragma unroll 1
        for (int mt = 0; mt < 2; ++mt) {
            unsigned L00, L01, L02, L03, L10, L11, L12, L13;
            peer_scores_top16(qp, lds, tok0 + 2 * mt, 0, fr, fq, L00, L01, L02, L03);
            peer_scores_top16(qp, lds, tok0 + 2 * mt, 1, fr, fq, L10, L11, L12, L13);
            peer_cand(lds, vb, ptab, L00, L10, lane, fr, (2 * mt + (fq >> 1)) * 128 + ((fq & 1) * 4 + 0) * 16 + fr);
            peer_cand(lds, vb, ptab, L01, L11, lane, fr, (2 * mt + (fq >> 1)) * 128 + ((fq & 1) * 4 + 1) * 16 + fr);
            peer_cand(lds, vb, ptab, L02, L12, lane, fr, (2 * mt + (fq >> 1)) * 128 + ((fq & 1) * 4 + 2) * 16 + fr);
            peer_cand(lds, vb, ptab, L03, L13, lane, fr, (2 * mt + (fq >> 1)) * 128 + ((fq & 1) * 4 + 3) * 16 + fr);
        }
        asm volatile("s_waitcnt lgkmcnt(0)" ::: "memory");
        __builtin_amdgcn_sched_barrier(0);
        peer_regroup16<6, false>(vb + fq * 1024, vb + 4096 + fq * 1024, lane, fr);
        asm volatile("s_waitcnt lgkmcnt(0)" ::: "memory"); __builtin_amdgcn_sched_barrier(0);
        peer_regroup16<10, true>(vb + 4096 + fq * 1024, el + fq * 512, lane, fr);
        asm volatile("s_waitcnt lgkmcnt(0)" ::: "memory"); __builtin_amdgcn_sched_barrier(0);
        const unsigned trsw = (unsigned)(4 * (fr >> 3) + ((fr & 7) >> 1));
        const unsigned trb = (unsigned)((fr >> 3) * 1024 + (fr & 7) * 128 + (fq & 1) * 8);
        const unsigned tr00 = trb + (((unsigned)(0 + (fq >> 1) + 0) ^ trsw) & 7u) * 16u, tr01 = trb + (((unsigned)(0 + (fq >> 1) + 2) ^ trsw) & 7u) * 16u;
        const unsigned tr10 = trb + (((unsigned)(4 + (fq >> 1) + 0) ^ trsw) & 7u) * 16u, tr11 = trb + (((unsigned)(4 + (fq >> 1) + 2) ^ trsw) & 7u) * 16u;
        const unsigned uofs = (unsigned)(fq * 64 + (fr & 3) * 16);
        const unsigned xofs = (unsigned)(128 * (fq >> 1) + 32 * (fr & 3) + 16 * (fq & 1));
        const int vsrc0 = (lane >> 3), vsrc1 = 8 + (lane >> 3);
        const unsigned vpo0 = (unsigned)((((lane & 7) ^ (0 + (lane >> 4))) & 7) * 16), vpo1 = (unsigned)((((lane & 7) ^ (4 + (lane >> 4))) & 7) * 16);
        const int awg = 2 * (fr >> 2) + (fr & 1);
        const bool aw00 = (((fr & 3) >> 1) == 0) && (awg == fq), aw01 = (((fr & 3) >> 1) == 0) && (awg == fq + 4), aw10 = (((fr & 3) >> 1) == 1) && (awg == fq), aw11 = (((fr & 3) >> 1) == 1) && (awg == fq + 4);
#pragma unroll 1
        for (int tq = 0; tq < 4; ++tq) { const int tok = tok0 + tq; const int lane_t = (int)opq((unsigned)lane);
            float xn[16]; PEER_XROW(xn, tok, lane_t);
            v4u xq;
#pragma unroll
            for (int c = 0; c < 4; ++c) xq[c] = pk4_fp8(__builtin_amdgcn_fmed3f(xn[4 * c] * PEER_XS, -448.f, 448.f), __builtin_amdgcn_fmed3f(xn[4 * c + 1] * PEER_XS, -448.f, 448.f),
                                                        __builtin_amdgcn_fmed3f(xn[4 * c + 2] * PEER_XS, -448.f, 448.f), __builtin_amdgcn_fmed3f(xn[4 * c + 3] * PEER_XS, -448.f, 448.f));
            *(LAS v4u*)(xal + tq * 1024 + lane_t * 16) = xq; }
        asm volatile("s_waitcnt vmcnt(0) lgkmcnt(0)" ::: "memory");
        const LAS unsigned char* recp = el + fr * 4;
        unsigned r_cur = *(const LAS unsigned*)recp;
        v4u ub[8], ub2[8];
        PEER_ULOAD(ub, r_cur >> 16);
        PEER_VDMA(r_cur >> 16);
        f32x4 yacc[2][8];
#pragma unroll
        for (int p = 0; p < 2; ++p)
#pragma unroll
            for (int m = 0; m < 8; ++m) yacc[p][m] = (f32x4){0.f, 0.f, 0.f, 0.f};
#define PEER_STEP(T, NEXTOFS, UC, UN, HASNEXT) do { \
            unsigned r_nx = r_cur; \
            if (HASNEXT) { r_nx = *(const LAS unsigned*)(recp + (NEXTOFS)); PEER_ULOAD(UN, r_nx >> 16); } \
            const unsigned xo = opq(xofs + (T) * 1024u);              \
            v8i_p xs0, xs1; \
            { const v4u l0 = *(const LAS v4u*)(xal + xo), h0_ = *(const LAS v4u*)(xal + xo + 256), l1 = *(const LAS v4u*)(xal + xo + 512), h1_ = *(const LAS v4u*)(xal + xo + 768); \
              xs0[0] = (int)l0.x; xs0[1] = (int)l0.y; xs0[2] = (int)l0.z; xs0[3] = (int)l0.w; xs0[4] = (int)h0_.x; xs0[5] = (int)h0_.y; xs0[6] = (int)h0_.z; xs0[7] = (int)h0_.w; \
              xs1[0] = (int)l1.x; xs1[1] = (int)l1.y; xs1[2] = (int)l1.z; xs1[3] = (int)l1.w; xs1[4] = (int)h1_.x; xs1[5] = (int)h1_.y; xs1[6] = (int)h1_.z; xs1[7] = (int)h1_.w; } \
            float hsum = 0.f; \
            _Pragma("unroll") for (int e4 = 0; e4 < 4; ++e4) { v8i_p b0_, b1_; \
                b0_[0] = (int)UC[2 * e4].x; b0_[1] = (int)UC[2 * e4].y; b0_[2] = (int)UC[2 * e4].z; b0_[3] = (int)UC[2 * e4].w; b0_[4] = 0; b0_[5] = 0; b0_[6] = 0; b0_[7] = 0; \
                b1_[0] = (int)UC[2 * e4 + 1].x; b1_[1] = (int)UC[2 * e4 + 1].y; b1_[2] = (int)UC[2 * e4 + 1].z; b1_[3] = (int)UC[2 * e4 + 1].w; b1_[4] = 0; b1_[5] = 0; b1_[6] = 0; b1_[7] = 0; \
                f32x4 acc = (f32x4){0.f, 0.f, 0.f, 0.f}; \
                acc = __builtin_amdgcn_mfma_scale_f32_16x16x128_f8f6f4(xs0, b0_, acc, 0, 4, 0, 0x7F7F7F7F, 0, 0x7F7F7F7F); \
                acc = __builtin_amdgcn_mfma_scale_f32_16x16x128_f8f6f4(xs1, b1_, acc, 0, 4, 0, 0x7F7F7F7F, 0, 0x7F7F7F7F); \
                float val = ((fr & 3) == 0) ? acc[0] : (((fr & 3) == 1) ? acc[1] : (((fr & 3) == 2) ? acc[2] : acc[3])); \
                val += dppf<0xB1>(val); val += dppf<0x4E>(val);                                    \
                hsum = ((fr & 3) == e4) ? val : hsum; } \
            const float h = hsum * (1.f / (PEER_XS * FP4_SU)); \
            const float wq = __builtin_amdgcn_fmed3f(bf2f(r_cur & 0xffffu) * gelu_as(h) * PEER_WS, -448.f, 448.f); \
            *(LAS unsigned char*)(wbl + fr) = (unsigned char)(pk4_fp8(wq, 0.f, 0.f, 0.f) & 255u); \
            asm volatile("s_waitcnt lgkmcnt(0)" ::: "memory"); \
            const v4u W = *(const LAS v4u*)wbl; \
            const bool a0_ = ((T) & 1) ? aw10 : aw00, a1_ = ((T) & 1) ? aw11 : aw01; \
            v8i_p aw; aw[0] = a0_ ? (int)W.x : 0; aw[1] = a0_ ? (int)W.y : 0; aw[2] = a0_ ? (int)W.z : 0; aw[3] = a0_ ? (int)W.w : 0; \
            aw[4] = a1_ ? (int)W.x : 0; aw[5] = a1_ ? (int)W.y : 0; aw[6] = a1_ ? (int)W.z : 0; aw[7] = a1_ ? (int)W.w : 0; \
            if (HASNEXT) asm volatile("s_waitcnt vmcnt(8)" ::: "memory"); else asm volatile("s_waitcnt vmcnt(0)" ::: "memory");        \
            _Pragma("unroll") for (int m = 0; m < 8; ++m) { const v2i t0 = __builtin_amdgcn_ds_read_tr4_b64_v2i32((LAS v2i*)(vb + (m >> 1) * 2048 + ((m & 1) ? tr10 : tr00))), t1 = __builtin_amdgcn_ds_read_tr4_b64_v2i32((LAS v2i*)(vb + (m >> 1) * 2048 + ((m & 1) ? tr11 : tr01))); \
                v8i_p bv; bv[0] = t0[0]; bv[1] = t0[1]; bv[2] = t1[0]; bv[3] = t1[1]; bv[4] = 0; bv[5] = 0; bv[6] = 0; bv[7] = 0; \
                yacc[(T) >> 1][m] = __builtin_amdgcn_mfma_scale_f32_16x16x128_f8f6f4(aw, bv, yacc[(T) >> 1][m], 0, 4, 0, 0x7F7F7F7F, 0, 0x7F7F7F7F); } \
            asm volatile("s_waitcnt lgkmcnt(0)" ::: "memory"); \
            if (HASNEXT) PEER_VDMA(r_nx >> 16); \
            r_cur = r_nx; } while (0)
#pragma unroll 1
        for (int b = 0; b < 7; ++b) { PEER_STEP(0, b * 64 + 512, ub, ub2, 1); PEER_STEP(1, b * 64 + 1024, ub2, ub, 1); PEER_STEP(2, b * 64 + 1536, ub, ub2, 1); PEER_STEP(3, b * 64 + 64, ub2, ub, 1); }
        PEER_STEP(0, 7 * 64 + 512, ub, ub2, 1); PEER_STEP(1, 7 * 64 + 1024, ub2, ub, 1); PEER_STEP(2, 7 * 64 + 1536, ub, ub2, 1); PEER_STEP(3, 0, ub2, ub, 0);
#undef PEER_STEP
#define PEER_EPI(T) do { const int tok = tok0 + (T); const int lane_t = (int)opq((unsigned)lane); \
            _Pragma("unroll") for (int m = 0; m < 8; ++m) { *(LAS float*)(vb + m * 512 + lane_t * 4) = yacc[(T) >> 1][m][2 * ((T) & 1)]; *(LAS float*)(vb + m * 512 + 256 + lane_t * 4) = yacc[(T) >> 1][m][2 * ((T) & 1) + 1]; } \
            float xn[16]; PEER_XROW(xn, tok, lane_t); \
            asm volatile("s_waitcnt lgkmcnt(0)" ::: "memory"); \
            float yv[16]; \
            _Pragma("unroll") for (int q4 = 0; q4 < 4; ++q4) { const f32x4 t = *(const LAS f32x4*)(vb + lane_t * 64 + q4 * 16); yv[q4 * 4] = t.x; yv[q4 * 4 + 1] = t.y; yv[q4 * 4 + 2] = t.z; yv[q4 * 4 + 3] = t.w; } \
            asm volatile("s_waitcnt lgkmcnt(0)" ::: "memory"); \
            float ssum = 0.f; \
            _Pragma("unroll") for (int i = 0; i < 16; ++i) { yv[i] = yv[i] * (1.f / (PEER_WS * FP4_SV)) + ALPHA * xn[i]; ssum += yv[i]; } \
            const float mean = wave_sum(ssum) * (1.f / D); \
            float s2 = 0.f; \
            _Pragma("unroll") for (int i = 0; i < 16; ++i) { yv[i] -= mean; s2 += yv[i] * yv[i]; } \
            const float rstd = 1.f / sqrtf(wave_sum(s2) * (1.f / D) + LN_EPS); \
            float* orow = P.out + (size_t)tok * 1024 + lane_t * 16; \
            _Pragma("unroll") for (int q4 = 0; q4 < 4; ++q4) { const f32x4 g0 = *(const GAS f32x4*)(P.in[19] + lane_t * 16 + q4 * 4), b0 = *(const GAS f32x4*)(P.in[20] + lane_t * 16 + q4 * 4); \
                f32x4 o; o.x = yv[q4 * 4] * rstd * g0.x + b0.x; o.y = yv[q4 * 4 + 1] * rstd * g0.y + b0.y; o.z = yv[q4 * 4 + 2] * rstd * g0.z + b0.z; o.w = yv[q4 * 4 + 3] * rstd * g0.w + b0.w; \
                *(GAS f32x4*)(orow + q4 * 4) = o; } } while (0)
        PEER_EPI(0); PEER_EPI(1); PEER_EPI(2); PEER_EPI(3);
#undef PEER_EPI
        asm volatile("s_waitcnt vmcnt(0) lgkmcnt(0)" ::: "memory");
    }
}

struct Args { const float* in[21]; float* out; unsigned char* ws; int ph_lo, ph_hi; };
__global__ void __launch_bounds__(NWAVES * 64, 2) fwd_kernel(Args args) {
    extern __shared__ __attribute__((aligned(16))) unsigned char lds_raw[];
    LAS unsigned char* lds = (LAS unsigned char*)lds_raw;
    volatile LAS unsigned* MISC = (volatile LAS unsigned*)(lds + MISC_OFF);
    const int tid = threadIdx.x, lane = tid & 63, wave = __builtin_amdgcn_readfirstlane(tid >> 6);
    const int G = gridDim.x;
    Ptrs P;
#pragma unroll
    for (int i = 0; i < 21; ++i) P.in[i] = args.in[i];
    P.out = args.out; P.ws = args.ws;
    unsigned char* ws = args.ws;
    if (tid < 16) MISC[tid] = 0u;
    __syncthreads();
    XcdBarrier bar; bar.bar = (unsigned*)(ws + WS_CTL) + 4096; bar.x = 0; bar.st = nullptr;
    if (N_LAUNCHES == 1) bar = xcd_barrier_post((unsigned*)(ws + WS_CTL) + 4096, MISC + 8);
    const int lo = args.ph_lo, hi = args.ph_hi;
#ifndef PHMASK
#define PHMASK 0x1ff
#endif
#define IN(k) (((PHMASK >> (k)) & 1) && lo <= (k) && (k) < hi)
#define SEAM(k) do { if (IN(k) && IN((k) + 1)) xcd_barrier(bar); } while (0)

    if (IN(0)) { phase0(P, lds, tid, lane, wave, G); } SEAM(0);

    if (IN(1)) {
        if (blockIdx.x < 4) { const int n = blockIdx.x * 256 + (tid & 255); const float* part = (const float*)(ws + WS_CPART) + (tid >> 8) * 16 * 1024; float a = 0.f;
#pragma unroll
            for (int kb = 0; kb < 16; ++kb) a += part[kb * 1024 + n];
            ((float*)(ws + ((tid >> 8) ? WS_DVEC : WS_CVEC)))[n] = a; }
        for (int i = tid; i < WR_GATE; i += 512) ((LAS float*)(lds + RING_BYTES))[i] = ((const float*)(ws + WS_BIASIN))[i];
        __syncthreads();
        SchedP1 S{(const char*)ws, G, (int)blockIdx.x};
        EpiP1 E{(bf16*)P.out, ws, lds + RING_BYTES};
        pg8::gemm_phase<EpiP1, SchedP1, 2>(lds, S, E);
    } SEAM(1);

    if (IN(2)) {
        fft_step_mfma<1>((const bf16*)P.out, (bf16*)P.out + (size_t)NT * 1024, lds, tid, lane, wave, G);
        dil_attn_lds((const bf16*)(ws + WS_QK), (const bf16*)(ws + WS_VT), (const float*)(ws + WS_BIASTAB), (bf16*)(ws + WS_OG), (float*)(ws + WS_LSE), lds, tid, lane, wave, G);
        mem_attn_lds((const bf16*)(ws + WS_QC), (const bf16*)(ws + WS_MEMKV), (const bf16*)(ws + WS_MEMKV) + 512 * 512, (bf16*)(ws + WS_YCIN), lds, tid, lane, wave, G);
    } SEAM(2);

    if (IN(3)) {
        fft_step_mfma<2>((const bf16*)P.out + (size_t)NT * 1024, (bf16*)(ws + WS_FA), lds, tid, lane, wave, G);
        combine_groups((const bf16*)(ws + WS_OG), (const float*)(ws + WS_LSE), (bf16*)(ws + WS_OB), tid, G);
    } SEAM(3);

    if (IN(4)) {
        SchedP4 S{(const char*)ws, G, (int)blockIdx.x};
        for (int i = tid; i < 3072; i += 512) ((LAS float*)(lds + RING_BYTES))[i] = ((const float*)(ws + WS_BIASIN))[WR_GATE + i];
        __syncthreads();
        EpiP4 E{(bf16*)(ws + WS_MERGED), lds + RING_BYTES};
        pg8::gemm_phase<EpiP4, SchedP4, 2>(lds, S, E);
    } SEAM(4);

    if (IN(5)) {
        SchedPlain S{(const char*)(ws + WS_MERGED), (const char*)(ws + WS_WTO), G, (int)blockIdx.x, K_WO};
        EpiP5 E{(bf16*)(ws + WS_H0), (float*)(ws + WS_PRELN), (float*)(ws + WS_STATS4), lds + RING_BYTES};
        pg8::gemm_phase<EpiP5, SchedPlain>(lds, S, E);
    } SEAM(5);


    if (IN(7)) {
        SchedPlain S{(const char*)(ws + WS_H0), (const char*)(ws + WS_WTPQ), G, (int)blockIdx.x, K_PQ};
        EpiP7 E{(bf16*)(ws + WS_QP), (const float*)(ws + WS_STATS4), (const float*)(ws + WS_CVEC), (const float*)(ws + WS_DVEC)};
        pg8::gemm_phase<EpiP7, SchedPlain>(lds, S, E);
    } SEAM(7);

    if (IN(8)) {
        peer_v2(P, lds, tid, lane, wave, G);
    }
#undef IN
#undef SEAM
}

extern "C" void kernel_launch(void* const* d_in, const int* in_sizes, int n_in, void* d_out, int out_size, void* d_ws, size_t ws_size, hipStream_t stream) {
    static int grid = 0;
    if (grid == 0) {
        if (n_in != 21 || out_size != NT * D || ws_size < WS_END) { fprintf(stderr, "kernel_launch: unexpected shapes (n_in %d, out %d, ws %zu); nothing launched\n", n_in, out_size, ws_size); grid = -1; return; }
        int dev = 0, cus = 0, per_cu = 0;
        if (hipGetDevice(&dev) != hipSuccess || hipDeviceGetAttribute(&cus, hipDeviceAttributeMultiprocessorCount, dev) != hipSuccess) { grid = -1; return; }
        if (hipFuncSetAttribute((const void*)fwd_kernel, hipFuncAttributeMaxDynamicSharedMemorySize, LDS_BYTES) != hipSuccess) { fprintf(stderr, "kernel_launch: hipFuncSetAttribute failed\n"); grid = -1; return; }
        if (hipOccupancyMaxActiveBlocksPerMultiprocessor(&per_cu, (const void*)fwd_kernel, NWAVES * 64, LDS_BYTES) != hipSuccess || per_cu < 1) { fprintf(stderr, "kernel_launch: occupancy query says %d\n", per_cu); }
        (void)hipGetLastError();
        grid = cus;
    }
    if (grid < 0) return;
    (void)hipMemsetAsync((char*)d_ws + WS_CTL, 0, CTL_ZERO_BYTES, stream);
    Args a{};
    for (int i = 0; i < 21; ++i) a.in[i] = (const float*)d_in[i];
    a.out = (float*)d_out; a.ws = (unsigned char*)d_ws;
    if (N_LAUNCHES == 1) { a.ph_lo = 0; a.ph_hi = NPH; hipLaunchKernelGGL(fwd_kernel, dim3(grid), dim3(NWAVES * 64), LDS_BYTES, stream, a); }
    else for (int ph = 0; ph < NPH; ++ph) { a.ph_lo = ph; a.ph_hi = ph + 1; hipLaunchKernelGGL(fwd_kernel, dim3(grid), dim3(NWAVES * 64), LDS_BYTES, stream, a); }
}
```

```cpp
#include <hip/hip_runtime.h>
#include <cstdio>
#include <cstdint>

#ifndef ZA_FP8
#define ZA_FP8 1
#endif
#ifndef TABU_FP4
#define TABU_FP4 1
#endif
#ifndef TABV_FP4
#define TABV_FP4 1
#endif
#ifndef TAB_FP6
#define TAB_FP6 1
#endif
static_assert(TAB_FP6 == 1, "the workspace map assumes 12 MiB fp6 expert tables");
#ifndef TAB_FP8
#define TAB_FP8 1
#endif
#ifndef N_LAUNCHES
#define N_LAUNCHES 1
#endif

#define GAS __attribute__((address_space(1)))
#define LAS __attribute__((address_space(3)))
typedef unsigned short bf16;
typedef unsigned v4u __attribute__((ext_vector_type(4)));
typedef unsigned v2u __attribute__((ext_vector_type(2)));
typedef float f32x4 __attribute__((ext_vector_type(4)));
typedef float f32x2 __attribute__((ext_vector_type(2)));
typedef short bf16x8 __attribute__((ext_vector_type(8)));

constexpr int NT = 32768, SEQ = 16384, D = 1024;
constexpr int NPH = 9;
constexpr float ALPHA = 1.189207115002721f;
constexpr float LN_EPS = 1e-5f;
constexpr int NWAVES = 8;

constexpr size_t MiB = 1u << 20;
constexpr size_t WS_CTL = 0, CTL_ZERO_BYTES = 1 * MiB;
constexpr size_t WS_CPART = 256 * 1024;
constexpr size_t WS_STATS = 512 * 1024;
constexpr size_t WS_CVEC = 768 * 1024, WS_DVEC = 772 * 1024;
constexpr size_t WS_BIASIN = 1 * MiB;
constexpr size_t WS_STATS4 = 4 * MiB;
constexpr size_t WS_BIASTAB = 1 * MiB + 64 * 1024;
constexpr size_t WS_WTIN = 2 * MiB;
constexpr size_t WS_WTA = 16 * MiB, WS_WTB = 17 * MiB, WS_WTC = 18 * MiB, WS_WTO = 19 * MiB, WS_WTPQ = 21 * MiB, WS_WTMKV = 23 * MiB;
constexpr size_t WS_MEMB = 25 * MiB, WS_MEMKV = 26 * MiB;
constexpr size_t WS_MEMF8 = 27 * MiB, WS_WMKVF8 = 28 * MiB;
constexpr size_t WS_UTAB = 32 * MiB, WS_VTAB = 44 * MiB;
constexpr size_t WS_H0F8 = 56 * MiB;
constexpr size_t WS_WF8IN = 88 * MiB;
constexpr size_t WS_H0 = 96 * MiB;
constexpr size_t WS_QK = 160 * MiB;
constexpr size_t WS_VT = 256 * MiB;
constexpr size_t WS_QC = 304 * MiB;
constexpr size_t WS_OG = 336 * MiB;
constexpr size_t WS_LSE = 384 * MiB;
constexpr size_t WS_YCIN = 386 * MiB;
constexpr size_t WS_FA = 418 * MiB;
constexpr size_t WS_OB = 450 * MiB;
constexpr size_t WS_GSCR = 466 * MiB;
constexpr size_t WS_MERGED = WS_QK;
constexpr size_t WS_PRELN = 224 * MiB;
constexpr size_t WS_H1B = WS_H0;
constexpr size_t WS_QP = WS_QK;
constexpr size_t WS_END = 498 * MiB;

constexpr int WR_A = 0, WR_QK = 1024, WR_V = 2560, WR_QC = 3328, WR_GATE = 3840, WR_END = 6912;

constexpr int RING_BYTES = 131072;
constexpr int LDS_BYTES = 155648;
constexpr int MISC_OFF = LDS_BYTES - 256;
constexpr int EPI_SCR = RING_BYTES + 3840 * 4;
static_assert(EPI_SCR + 8 * 1024 <= MISC_OFF, "bias copy and epilogue tiles fit the spare LDS above the GEMM stage buffers");

#define RLX_AGENT __ATOMIC_RELAXED, __HIP_MEMORY_SCOPE_AGENT
#define LDS_WAIT() asm volatile("s_waitcnt lgkmcnt(0)" ::: "memory")
#define VM_WAIT() asm volatile("s_waitcnt vmcnt(0)" ::: "memory")

__device__ __forceinline__ unsigned f2bf(float f) { unsigned u = __builtin_bit_cast(unsigned, f); return (u + 0x7fffu + ((u >> 16) & 1u)) >> 16; }
__device__ __forceinline__ unsigned pk2(float lo, float hi) { return f2bf(lo) | (f2bf(hi) << 16); }
__device__ __forceinline__ unsigned pk4_fp8(float a, float b, float c, float d) { int p = __builtin_amdgcn_cvt_pk_fp8_f32(a, b, 0, false); p = __builtin_amdgcn_cvt_pk_fp8_f32(c, d, p, true); return (unsigned)p; }
__device__ __forceinline__ float bf2f(unsigned b) { return __builtin_bit_cast(float, b << 16); }
__device__ __forceinline__ float bflo(unsigned w) { return __builtin_bit_cast(float, w << 16); }
__device__ __forceinline__ float bfhi(unsigned w) { return __builtin_bit_cast(float, w & 0xffff0000u); }
__device__ __forceinline__ float wave_sum(float v) {
#pragma unroll
    for (int o = 1; o < 64; o <<= 1) v += __shfl_xor(v, o);
    return v;
}
__device__ __forceinline__ float wave_max(float v) {
#pragma unroll
    for (int o = 1; o < 64; o <<= 1) v = fmaxf(v, __shfl_xor(v, o));
    return v;
}

#define XB_TMO      128
#define XB_XCNT(j)  (256  + 64 * (j))
#define XB_XSUB(j)  (1280 + 64 * (j))
#define XB_XGEN(j)  (2304 + 64 * (j))
#define XB_TOP      3328
#define XB_TOPGEN   3392
#define XCD_BAR_WORDS 3456
#define XB_SPIN_CAP (1u << 18)

__device__ __forceinline__ unsigned xb_ld(unsigned* p)              { return __hip_atomic_load(p, __ATOMIC_RELAXED, __HIP_MEMORY_SCOPE_AGENT); }
__device__ __forceinline__ unsigned xb_add(unsigned* p, unsigned v) { return __hip_atomic_fetch_add(p, v, __ATOMIC_RELAXED, __HIP_MEMORY_SCOPE_AGENT); }
__device__ __forceinline__ unsigned xb_xcc_id() { return (unsigned)__builtin_amdgcn_s_getreg((3 << 11) | 20) & 0xFu; }
#define XB_SPIN(cond, bar) do { unsigned _sp = 0; while (cond) { __builtin_amdgcn_s_sleep(1); \
    if ((++_sp & 255u) == 0u) { if (xb_ld(&(bar)[XB_TMO])) break; if (_sp > XB_SPIN_CAP) { atomicAdd(&(bar)[XB_TMO], 1u); break; } } } } while (0)

struct XcdBarrier {
    unsigned* bar; unsigned x;
    volatile LAS unsigned* st;
};
__device__ __forceinline__ XcdBarrier xcd_barrier_post(unsigned* bar, volatile LAS unsigned* st) {
    XcdBarrier b; b.bar = bar; b.x = xb_xcc_id(); b.st = st;
    if (threadIdx.x == 0) (void)xb_add(&bar[XB_XCNT(b.x)], 1u);
    return b;
}
__device__ __forceinline__ void xcd_barrier_complete(unsigned* bar, unsigned x, unsigned& nloc, unsigned& nx) {
    const unsigned G = gridDim.x * gridDim.y * gridDim.z;
    unsigned sum, cnt, mine, sp = 0u;
    for (;;) {
        sum = 0u; cnt = 0u; mine = 0u;
#pragma unroll
        for (unsigned j = 0; j < 16; ++j) { const unsigned c = xb_ld(&bar[XB_XCNT(j)]); sum += c; cnt += (c > 0u) ? 1u : 0u; mine = (j == x) ? c : mine; }
        if (sum == G) break;
        __builtin_amdgcn_s_sleep(1);
        if ((++sp & 255u) == 0u) { if (xb_ld(&bar[XB_TMO])) break; if (sp > XB_SPIN_CAP) { atomicAdd(&bar[XB_TMO], 1u); break; } }
    }
    nloc = mine > 0u ? mine : 1u; nx = cnt > 0u ? cnt : 1u;
}
__device__ __forceinline__ void xcd_barrier(const XcdBarrier& b) {
    asm volatile("s_waitcnt vmcnt(0)" ::: "memory");
    __syncthreads();
    if (threadIdx.x == 0) {
        unsigned* bar = b.bar;
        __builtin_amdgcn_s_waitcnt(0);
        unsigned nloc = b.st[0], nx = b.st[1];
        if (nloc == 0u) { xcd_barrier_complete(bar, b.x, nloc, nx); b.st[0] = nloc; b.st[1] = nx; }
        const unsigned old = xb_add(&bar[XB_XSUB(b.x)], 1u);
        const unsigned gen = old / nloc;
        if (old + 1u == (gen + 1u) * nloc) {
            __builtin_amdgcn_fence(__ATOMIC_RELEASE, "agent");
            asm volatile("s_waitcnt vmcnt(0)" ::: "memory");
            const unsigned og = xb_add(&bar[XB_TOP], 1u);
            const unsigned tg = og / nx;
            if (og + 1u == (tg + 1u) * nx) xb_add(&bar[XB_TOPGEN], 1u);
            else XB_SPIN(xb_ld(&bar[XB_TOPGEN]) == tg, bar);
            __builtin_amdgcn_fence(__ATOMIC_ACQUIRE, "agent");
            xb_add(&bar[XB_XGEN(b.x)], 1u);
            asm volatile("s_waitcnt vmcnt(0)" ::: "memory");
        } else {
            XB_SPIN(xb_ld(&bar[XB_XGEN(b.x)]) == gen, bar);
            __builtin_amdgcn_fence(__ATOMIC_ACQUIRE, "agent");
            asm volatile("s_waitcnt vmcnt(0)" ::: "memory");
        }
    }
    __syncthreads();
}

namespace pg8 {
constexpr int BM = 256, BK = 64, HALF = 128, HTB = HALF * BK * 2, STAGE_BYTES = 8 * HTB;
__host__ __device__ __forceinline__ int lds_byte(int r, int c) { const int st = (r >> 4) * 2 + (c >> 5), rr = r & 15, cc = c & 31, ob = rr * 64 + cc * 2; return st * 1024 + (ob ^ (((ob >> 9) & 1) << 5)); }
__host__ __device__ __forceinline__ void stage_rc(int b, int& R, int& C) { const int st = b / 1024, sb = b % 1024, swz = sb ^ (((sb >> 9) & 1) << 5); R = (st >> 1) * 16 + swz / 64; C = (st & 1) * 32 + (swz % 64) / 2; }
__host__ __device__ __forceinline__ int perm32(int rho) { const int n = rho >> 4, i = rho & 15; return 8 * (i >> 2) + 4 * n + (i & 3); }

struct GUnit { const char* a; const char* b; unsigned sa, sb; int nt; int pm, pn, kind; };

typedef int v8i __attribute__((ext_vector_type(8)));
constexpr int K_FP8 = 1 << 16;
__device__ __forceinline__ unsigned pg8_rb(unsigned ra) { asm volatile("" : "+v"(ra)); const unsigned rho = ra & 31u, n = rho >> 4, i = rho & 15u; return (ra & ~31u) + 8u * (i >> 2) + 4u * n + (i & 3u); }
template <class Epi, class Sched, int MODE = 0>
__device__ __forceinline__ void gemm_phase(LAS unsigned char* lds, const Sched& S, const Epi& E) {
    const int tid = threadIdx.x, wid = __builtin_amdgcn_readfirstlane(tid >> 6), lane = tid & 63, wr = wid >> 2, wc = wid & 3, fr = lane & 15, fq = lane >> 4;
    int R0, C0; stage_rc(tid * 16, R0, C0);
    const unsigned RA = (unsigned)R0, C2 = (unsigned)C0 * 2u;
#define RB pg8_rb(RA)
    const size_t kstep = (size_t)(BK * 2);
    const unsigned ldsw = (unsigned)wid * 1024u;
    const int aoff = lds_byte(wr * 64 + fr, fq * 8), boff = lds_byte(wc * 32 + fr, fq * 8);
#define PG8_SA(b, h) (((b) * 2 + (h)) * HTB)
#define PG8_SB(b, h) ((4 + (b) * 2 + (h)) * HTB)
#define PG8_STAGE(bufoff, gbase, RR, stride) do { const unsigned _vo = (RR) * (unsigned)(stride) + C2; const char* _g = (const char*)(gbase); \
        __builtin_amdgcn_global_load_lds((const unsigned*)(_g + _vo), (LAS unsigned*)(lds + (bufoff) + ldsw), 16, 0, 0); \
        __builtin_amdgcn_global_load_lds((const unsigned*)(_g + (size_t)64 * (stride) + _vo), (LAS unsigned*)(lds + (bufoff) + ldsw + 8192), 16, 0, 0); } while (0)
#define PG8_LDA(dst, b, h) do { _Pragma("unroll") for (int m = 0; m < 4; ++m) _Pragma("unroll") for (int k = 0; k < 2; ++k) dst[m][k] = *(const LAS bf16x8*)(lds + PG8_SA(b, h) + aoff + m * 2048 + k * 1024); } while (0)
#define PG8_LDB(dst, b, h) do { _Pragma("unroll") for (int n = 0; n < 2; ++n) _Pragma("unroll") for (int k = 0; k < 2; ++k) dst[n][k] = *(const LAS bf16x8*)(lds + PG8_SB(b, h) + boff + n * 2048 + k * 1024); } while (0)
#define PG8_CAT(lo, hi) __builtin_bit_cast(v8i, __builtin_shufflevector(lo, hi, 0, 1, 2, 3, 4, 5, 6, 7, 8, 9, 10, 11, 12, 13, 14, 15))
#define PG8_MMA_BF(ai, bj, At, Bt) do { __builtin_amdgcn_s_setprio(1); _Pragma("unroll") for (int m = 0; m < 4; ++m) _Pragma("unroll") for (int n = 0; n < 2; ++n) _Pragma("unroll") for (int k = 0; k < 2; ++k) \
        acc[ai][bj][m][n] = __builtin_amdgcn_mfma_f32_16x16x32_bf16(Bt[n][k], At[m][k], acc[ai][bj][m][n], 0, 0, 0); __builtin_amdgcn_s_setprio(0); } while (0)
#define PG8_MMA_F8(ai, bj, At, Bt) do { __builtin_amdgcn_s_setprio(1); _Pragma("unroll") for (int m = 0; m < 4; ++m) _Pragma("unroll") for (int n = 0; n < 2; ++n) \
        acc[ai][bj][m][n] = __builtin_amdgcn_mfma_scale_f32_16x16x128_f8f6f4(PG8_CAT(Bt[n][0], Bt[n][1]), PG8_CAT(At[m][0], At[m][1]), acc[ai][bj][m][n], 0, 0, 0, 0x7F7F7F7F, 0, 0x7F7F7F7F); __builtin_amdgcn_s_setprio(0); } while (0)
#define PG8_WAIT_V(n) asm volatile("s_waitcnt vmcnt(" #n ")" ::: "memory")
#define PG8_WAIT_L(n) asm volatile("s_waitcnt lgkmcnt(" #n ")" ::: "memory")
#define PG8_BAR __builtin_amdgcn_s_barrier()
#define PG8_SCHED __builtin_amdgcn_sched_barrier(0)
#define PG8_KLOOP(MMA) \
        for (int t = 0; t < nt; t += 2) { \
            const bool last = (t == nt - 2); \
            const char* a1 = cA + (size_t)(t + 1) * kstep; \
            const char* a2 = last ? nxt.a : cA + (size_t)(t + 2) * kstep; const char* b2 = last ? nxt.b : cB + (size_t)(t + 2) * kstep; \
            const unsigned sa2 = last ? nxt.sa : csa, sb2 = last ? nxt.sb : csb; const size_t hA2 = (size_t)HALF * sa2, hB2 = (size_t)HALF * sb2; \
            const char* a3 = a2 + kstep; const char* b3 = b2 + kstep; \
            PG8_LDB(B0, 0, 0); PG8_LDB(B1, 0, 1); PG8_SCHED; PG8_LDA(At, 0, 0); PG8_STAGE(PG8_SA(1, 1), a1 + hA, RA, csa); \
            PG8_WAIT_V(8); PG8_WAIT_L(0); PG8_BAR; MMA(0, 0, At, B0); MMA(0, 1, At, B1); PG8_BAR; PG8_SCHED; \
            PG8_LDA(At, 0, 1); PG8_STAGE(PG8_SB(0, 0), b2, RB, sb2); PG8_STAGE(PG8_SB(0, 1), b2 + hB2, RB, sb2); PG8_STAGE(PG8_SA(0, 0), a2, RA, sa2); \
            PG8_WAIT_V(8); PG8_WAIT_L(0); PG8_BAR; MMA(1, 0, At, B0); MMA(1, 1, At, B1); PG8_BAR; PG8_SCHED; \
            PG8_LDB(B0, 1, 0); PG8_LDB(B1, 1, 1); PG8_SCHED; PG8_LDA(At, 1, 0); PG8_STAGE(PG8_SA(0, 1), a2 + hA2, RA, sa2); \
            PG8_WAIT_V(8); PG8_WAIT_L(0); PG8_BAR; MMA(0, 0, At, B0); MMA(0, 1, At, B1); PG8_BAR; PG8_SCHED; \
            PG8_LDA(At, 1, 1); PG8_STAGE(PG8_SB(1, 0), b3, RB, sb2); PG8_STAGE(PG8_SB(1, 1), b3 + hB2, RB, sb2); PG8_STAGE(PG8_SA(1, 0), a3, RA, sa2); \
            PG8_WAIT_V(8); PG8_WAIT_L(0); PG8_BAR; MMA(1, 0, At, B0); MMA(1, 1, At, B1); PG8_BAR; PG8_SCHED; \
        }
    GUnit cur, nxt; int ui = 0;
    if (!S.next(0, cur)) return;
    f32x4 acc[2][2][4][2];
#pragma unroll
    for (int a = 0; a < 2; ++a)
#pragma unroll
        for (int b = 0; b < 2; ++b)
#pragma unroll
            for (int m = 0; m < 4; ++m)
#pragma unroll
                for (int n = 0; n < 2; ++n) acc[a][b][m][n] = (f32x4){0.f, 0.f, 0.f, 0.f};
    bf16x8 At[4][2], B0[2][2], B1[2][2];
    unsigned keep[2][2][4][2];
    {
        const char* cA = cur.a; const char* cB = cur.b; const size_t hA = (size_t)HALF * cur.sa, hB = (size_t)HALF * cur.sb;
        PG8_STAGE(PG8_SB(0, 0), cB, RB, cur.sb); PG8_STAGE(PG8_SB(0, 1), cB + hB, RB, cur.sb); PG8_STAGE(PG8_SA(0, 0), cA, RA, cur.sa); PG8_STAGE(PG8_SA(0, 1), cA + hA, RA, cur.sa);
        if (wr == 1) PG8_BAR;
        PG8_WAIT_V(2); PG8_BAR;
        PG8_STAGE(PG8_SB(1, 0), cB + kstep, RB, cur.sb); PG8_STAGE(PG8_SA(1, 0), cA + kstep, RA, cur.sa); PG8_STAGE(PG8_SB(1, 1), cB + hB + kstep, RB, cur.sb);
        PG8_WAIT_V(6); PG8_BAR;
    }
    for (;;) {
        const bool has_next = S.next(ui + 1, nxt);
        if (!has_next) { nxt = cur; }
        const char* cA = cur.a; const char* cB = cur.b; const unsigned csa = cur.sa, csb = cur.sb; const size_t hA = (size_t)HALF * csa, hB = (size_t)HALF * csb;
        const int nt = cur.nt; const bool cur_fp8 = (cur.kind & K_FP8) != 0; (void)cur_fp8;
        if (MODE == 1 || (MODE == 2 && cur_fp8)) { PG8_KLOOP(PG8_MMA_F8) } else { PG8_KLOOP(PG8_MMA_BF) }
        if (wr == 0) PG8_BAR;
        E(acc, keep, cur, wr, wc, fr, fq);
        if (!has_next) break;
#pragma unroll
        for (int a = 0; a < 2; ++a)
#pragma unroll
            for (int b = 0; b < 2; ++b)
#pragma unroll
                for (int m = 0; m < 4; ++m)
#pragma unroll
                    for (int n = 0; n < 2; ++n) acc[a][b][m][n] = (f32x4){0.f, 0.f, 0.f, 0.f};
        cur = nxt; ++ui;
        if (wr == 1) PG8_BAR;
    }
    PG8_WAIT_V(0);
    PG8_BAR;
#undef PG8_SA
#undef PG8_SB
#undef PG8_STAGE
#undef PG8_LDA
#undef PG8_LDB
#undef PG8_MMA_BF
#undef PG8_MMA_F8
#undef PG8_KLOOP
#undef RB
#undef PG8_CAT
#undef PG8_WAIT_V
#undef PG8_WAIT_L
#undef PG8_BAR
#undef PG8_SCHED
}
}
using pg8::GUnit; using pg8::K_FP8;

__device__ __forceinline__ int tok0_of(int p, int g) {
    const int n = p << 8, b = n >> 14, rem = n & 16383, sh = 2 * g;
    const int r = rem >> (14 - sh), l0 = rem & ((16384 >> sh) - 1);
    return (b << 14) + (l0 << sh) + r;
}
__device__ __forceinline__ void tile_of(int t, int nN, int& pm, int& pn) { const int nig = 8 * nN, gid = t / nig, w = t % nig; pm = gid * 8 + (w & 7); pn = w >> 3; }

struct Ptrs {
    const float* in[21]; float* out; unsigned char* ws;
};

enum { K_ZA = 0, K_QK = 1, K_VT = 2, K_QC = 3, K_MKV = 4, K_GATE = 5, K_YA = 6, K_YB = 7, K_YC = 8, K_WO = 9, K_PQ = 10 };
struct SchedP1 {
    const char* wsb; int G, c;
    static constexpr int NLONG = 512, NSHORT = 768 + 384 + 256 + 8;
    __device__ __forceinline__ bool next(int i, GUnit& u) const {
        const char* const h0b = wsb + WS_H0; const char* const wtb = wsb + WS_WTIN; const char* const h0 = wsb + WS_H0F8; const char* const wtin = wsb + WS_WF8IN; const char* const memb = wsb + WS_MEMF8; const char* const wtmkv = wsb + WS_WMKVF8;
        const int nshort = (NSHORT - c + G - 1) / G, nslots = 2 + nshort; if (i >= nslots) return false;
        const int k = (c >> 3) & 3; int pa = k % nslots, pb = (k + 4) % nslots; if (pa > pb) { const int t_ = pa; pa = pb; pb = t_; }
        int j; if (i == pa) j = 0; else if (i == pb) j = 1; else j = 2 + i - (i > pa ? 1 : 0) - (i > pb ? 1 : 0);
        const int L = j * G + c; if (L >= NLONG + NSHORT) return false;
        if (L < NLONG) { const int T = (G % 8 == 0) ? (L % 8) * (NLONG / 8) + L / 8 : L; int pm, pn; tile_of(T, 4, pm, pn);
            if (ZA_FP8) { u.a = h0 + (size_t)pm * 256 * 1024; u.b = wtin + (size_t)(WR_A + pn * 256) * 1024; u.sa = 1024; u.sb = 1024; u.nt = 8; u.pm = pm; u.pn = pn; u.kind = K_ZA | K_FP8; return true; }
            u.a = h0b + (size_t)pm * 256 * 2048; u.b = wtb + (size_t)(WR_A + pn * 256) * 2048; u.sa = 2048; u.sb = 2048; u.nt = 16; u.pm = pm; u.pn = pn; u.kind = K_ZA; return true; }
        const int Ls = L - NLONG; int T = (NSHORT % 8 == 0 && G % 8 == 0) ? (Ls % 8) * (NSHORT / 8) + Ls / 8 : Ls;
        u.nt = 8; u.sa = 1024; u.sb = 1024;
        if (T < 768) { const int g = T >> 8; int pm, pn; tile_of(T & 255, 2, pm, pn); u.a = h0 + (size_t)tok0_of(pm, g) * 1024; u.sa = 1024u << (2 * g);
            u.b = wtin + (size_t)(WR_QK + g * 512 + pn * 256) * 1024; u.pm = pm; u.pn = pn; u.kind = K_QK | (g << 8) | K_FP8; return true; }
        T -= 768;
        if (T < 384) { const int g = T >> 7, pn = T & 127; u.a = wtin + (size_t)(WR_V + g * 256) * 1024; u.b = h0 + (size_t)tok0_of(pn, g) * 1024; u.sb = 1024u << (2 * g);
            u.pm = 0; u.pn = pn; u.kind = K_VT | (g << 8) | K_FP8; return true; }
        T -= 384;
        if (T < 256) { int pm, pn; tile_of(T, 2, pm, pn); u.a = h0 + (size_t)pm * 256 * 1024; u.b = wtin + (size_t)(WR_QC + pn * 256) * 1024; u.pm = pm; u.pn = pn; u.kind = K_QC | K_FP8; return true; }
        T -= 256;
        if (T < 4) { const int pm = T >> 1, pn = T & 1; u.a = memb + (size_t)pm * 256 * 1024; u.b = wtmkv + (size_t)pn * 256 * 1024; u.pm = pm; u.pn = pn; u.kind = K_MKV | K_FP8; return true; }
        T -= 4;
        { const int pm = T >> 1, pn = T & 1; u.a = wtmkv + (size_t)(512 + pm * 256) * 1024; u.b = memb + (size_t)pn * 256 * 1024; u.pm = pm; u.pn = pn; u.kind = K_MKV | (1 << 8) | K_FP8; return true; }
    }
};
__device__ __forceinline__ void out_tile_of(int L, int G, int& pm, int& pn) {
    const int T = (G % 8 == 0) ? (L % 8) * 64 + L / 8 : L; tile_of(T, 4, pm, pn);
}
struct SchedP4 {
    const char* wsb; int G, c;
    __device__ __forceinline__ bool next(int i, GUnit& u) const {
        const int io = i / 6, s = i - io * 6; const int L = io * G + c; if (L >= 512) return false;
        int pm, pn; out_tile_of(L, G, pm, pn); u.pm = pm; u.pn = pn;
        if ((s & 1) == 0) { const int gi = s >> 1; u.a = wsb + WS_H0F8 + (size_t)pm * 256 * 1024; u.sa = 1024; u.b = wsb + WS_WF8IN + (size_t)(WR_GATE + gi * 1024 + pn * 256) * 1024; u.sb = 1024; u.nt = 8; u.kind = K_GATE | (gi << 8) | K_FP8; return true; }
        if (s == 1) { u.a = wsb + WS_FA + (size_t)pm * 256 * 1024; u.sa = 1024; u.b = wsb + WS_WTA + (size_t)pn * 256 * 1024; u.sb = 1024; u.nt = 8; u.kind = K_YA; return true; }
        if (s == 3) { u.a = wsb + WS_OB + (size_t)pm * 256 * 256; u.sa = 256; u.b = wsb + WS_WTB + (size_t)pn * 256 * 256; u.sb = 256; u.nt = 2; u.kind = K_YB | K_FP8; return true; }
        u.a = wsb + WS_YCIN + (size_t)pm * 256 * 512; u.sa = 512; u.b = wsb + WS_WTC + (size_t)pn * 256 * 512; u.sb = 512; u.nt = 4; u.kind = K_YC | K_FP8; return true;
    }
};
struct SchedPlain {
    const char* a; const char* b; int G, c, kind;
    __device__ __forceinline__ bool next(int i, GUnit& u) const {
        const int L = i * G + c; if (L >= 512) return false;
        int pm, pn; out_tile_of(L, G, pm, pn); u.pm = pm; u.pn = pn; u.a = a + (size_t)pm * 256 * 2048; u.b = b + (size_t)pn * 256 * 2048; u.sa = 2048; u.sb = 2048; u.nt = 16; u.kind = kind; return true;
    }
};

__device__ __forceinline__ unsigned opq(unsigned x) { asm volatile("" : "+v"(x)); return x; }
__device__ __forceinline__ v4u pack8(f32x4 v0, f32x4 v1) { v4u o; o.x = pk2(v0[0], v0[1]); o.y = pk2(v0[2], v0[3]); o.z = pk2(v1[0], v1[1]); o.w = pk2(v1[2], v1[3]); return o; }
__device__ __forceinline__ void unpack8(v4u w, f32x4& a, f32x4& b) { a[0] = bflo(w.x); a[1] = bfhi(w.x); a[2] = bflo(w.y); a[3] = bfhi(w.y); b[0] = bflo(w.z); b[1] = bfhi(w.z); b[2] = bflo(w.w); b[3] = bfhi(w.w); }
#define EPI_LOOP(ai, m, bj) _Pragma("unroll") for (int ai = 0; ai < 2; ++ai) _Pragma("unroll") for (int m = 0; m < 4; ++m) _Pragma("unroll") for (int bj = 0; bj < 2; ++bj)

constexpr float W8SC = 32.f, W8INV = 1.f / 32.f;
constexpr float SC_WBC = 16.f, SC_ACT = 4.f;
struct EpiP1 {
    bf16* za; unsigned char* wsb; const LAS unsigned char* bias;
    __device__ __forceinline__ void operator()(f32x4 (&acc)[2][2][4][2], unsigned (&keep)[2][2][4][2], const GUnit& u, int wr, int wc, int fr, int fq) const {
        bf16* const qk = (bf16*)(wsb + WS_QK); bf16* const vt = (bf16*)(wsb + WS_VT); bf16* const qc = (bf16*)(wsb + WS_QC); bf16* const memkv = (bf16*)(wsb + WS_MEMKV);
        const int kind = u.kind & 255, g = (u.kind >> 8) & 255; const float asc = (u.kind & K_FP8) ? W8INV : 1.f;
        const unsigned rl0 = opq((unsigned)(wr * 64 + fr)), cl0 = opq((unsigned)(wc * 32 + 8 * fq));
        if (kind == K_VT) {
            char* base = (char*)(vt + (size_t)g * 256 * NT + (size_t)u.pn * 256); const LAS unsigned char* bb = bias + (WR_V + g * 256) * 4;
            const unsigned lo = rl0 * (unsigned)(NT * 2) + cl0 * 2u;
#pragma unroll
            for (int ai = 0; ai < 2; ++ai)
#pragma unroll
                for (int m = 0; m < 4; ++m) { const float br = *(const LAS float*)(bb + (rl0 + ai * 128 + m * 16) * 4u);
#pragma unroll
                    for (int bj = 0; bj < 2; ++bj) *(GAS v4u*)(base + (lo + (unsigned)((ai * 128 + m * 16) * NT * 2 + bj * 256))) = pack8(acc[ai][bj][m][0] * asc + br, acc[ai][bj][m][1] * asc + br);
                    __builtin_amdgcn_sched_barrier(0); }
            return;
        }
        char* base; unsigned ldb; const LAS unsigned char* bb; bool hasb = true;
        if (kind == K_ZA) { base = (char*)(za + (size_t)u.pm * 256 * 1024 + u.pn * 256); ldb = 2048; bb = bias + (WR_A + u.pn * 256) * 4; }
        else if (kind == K_QK) { base = (char*)(qk + (size_t)g * NT * 512 + (size_t)u.pm * 256 * 512 + u.pn * 256); ldb = 1024; bb = bias + (WR_QK + g * 512 + u.pn * 256) * 4; }
        else if (kind == K_QC) { base = (char*)(qc + (size_t)u.pm * 256 * 512 + u.pn * 256); ldb = 1024; bb = bias + (WR_QC + u.pn * 256) * 4; }
        else { base = (char*)(memkv + (size_t)g * 512 * 512 + (size_t)u.pm * 256 * 512 + u.pn * 256); ldb = 1024; bb = bias; hasb = false; }
        f32x4 bv[2][2];
#pragma unroll
        for (int bj = 0; bj < 2; ++bj)
#pragma unroll
            for (int n = 0; n < 2; ++n) bv[bj][n] = hasb ? *(const LAS f32x4*)(bb + (cl0 + bj * 128 + 4 * n) * 4u) : (f32x4){0.f, 0.f, 0.f, 0.f};
        const unsigned lo = rl0 * ldb + cl0 * 2u;
#pragma unroll
        for (int ai = 0; ai < 2; ++ai)
#pragma unroll
            for (int m = 0; m < 4; ++m) {
#pragma unroll
                for (int bj = 0; bj < 2; ++bj) *(GAS v4u*)(base + (lo + (unsigned)(ai * 128 + m * 16) * ldb + (unsigned)(bj * 256))) = pack8(acc[ai][bj][m][0] * asc + bv[bj][0], acc[ai][bj][m][1] * asc + bv[bj][1]);
                __builtin_amdgcn_sched_barrier(0); }
    }
};
struct EpiP4 {
    bf16* merged; const LAS unsigned char* bias;
    __device__ __forceinline__ void operator()(f32x4 (&acc)[2][2][4][2], unsigned (&keep)[2][2][4][2], const GUnit& u, int wr, int wc, int fr, int fq) const {
        const int kind = u.kind & 255, gi = (u.kind >> 8) & 255;
        const unsigned rl0 = opq((unsigned)(wr * 64 + fr)), cl0 = opq((unsigned)(wc * 32 + 8 * fq));
        if (kind == K_GATE) {
            const LAS unsigned char* bb = bias + (gi * 1024 + u.pn * 256) * 4;
#pragma unroll
            for (int bj = 0; bj < 2; ++bj) { const f32x4 b0 = *(const LAS f32x4*)(bb + (cl0 + bj * 128) * 4u), b1 = *(const LAS f32x4*)(bb + (cl0 + bj * 128 + 4) * 4u);
#pragma unroll
                for (int ai = 0; ai < 2; ++ai)
#pragma unroll
                    for (int m = 0; m < 4; ++m)
#pragma unroll
                        for (int n = 0; n < 2; ++n) { const f32x4 v = acc[ai][bj][m][n] * W8INV + (n ? b1 : b0); unsigned pk = 0u;
#pragma unroll
                            for (int e = 0; e < 4; ++e) { const float sg = __builtin_amdgcn_rcpf(1.f + __expf(-v[e])); pk |= (unsigned)(sg * 255.f + 0.5f) << (8 * e); }
                            keep[ai][bj][m][n] = pk; } }
            return;
        }
        char* mb = (char*)(merged + (size_t)u.pm * 256 * 1024 + u.pn * 256); const unsigned mlo = rl0 * 2048u + cl0 * 2u;
        const float ysc = ((kind == K_YA) ? 1.f : 1.f / (SC_WBC * SC_ACT)) * (1.f / 255.f);
#pragma unroll
        for (int ai = 0; ai < 2; ++ai) {
            v4u pw[4][2];
            if (kind != K_YA) {
#pragma unroll
                for (int m = 0; m < 4; ++m)
#pragma unroll
                    for (int bj = 0; bj < 2; ++bj) pw[m][bj] = *(const GAS v4u*)(mb + (mlo + (unsigned)((ai * 128 + m * 16) * 2048 + bj * 256))); }
#pragma unroll
            for (int m = 0; m < 4; ++m)
#pragma unroll
                for (int bj = 0; bj < 2; ++bj) { f32x4 v[2];
#pragma unroll
                    for (int n = 0; n < 2; ++n) { const unsigned pk = keep[ai][bj][m][n];
                        v[n][0] = acc[ai][bj][m][n][0] * ((float)(pk & 255u) * ysc); v[n][1] = acc[ai][bj][m][n][1] * ((float)((pk >> 8) & 255u) * ysc);
                        v[n][2] = acc[ai][bj][m][n][2] * ((float)((pk >> 16) & 255u) * ysc); v[n][3] = acc[ai][bj][m][n][3] * ((float)(pk >> 24) * ysc); }
                    if (kind != K_YA) { f32x4 p0, p1; unpack8(pw[m][bj], p0, p1); v[0] += p0; v[1] += p1; }
                    *(GAS v4u*)(mb + (mlo + (unsigned)((ai * 128 + m * 16) * 2048 + bj * 256))) = pack8(v[0], v[1]); }
            __builtin_amdgcn_sched_barrier(0); }
    }
};
struct EpiP5 {
    bf16* h0; float* preln; float* stats; LAS unsigned char* lds_spare;
    __device__ __forceinline__ void operator()(f32x4 (&acc)[2][2][4][2], unsigned (&keep)[2][2][4][2], const GUnit& u, int wr, int wc, int fr, int fq) const {
        const unsigned rl0 = opq((unsigned)(wr * 64 + fr)), cl0 = opq((unsigned)(wc * 32 + 8 * fq));
        const size_t t0 = (size_t)u.pm * 256 * 1024 + u.pn * 256;
        char* hb = (char*)(h0 + t0);
        const unsigned hlo = rl0 * 2048u + cl0 * 2u;
#pragma unroll
        for (int ai = 0; ai < 2; ++ai) {
            v4u hw[4][2];
#pragma unroll
            for (int m = 0; m < 4; ++m)
#pragma unroll
                for (int bj = 0; bj < 2; ++bj) hw[m][bj] = *(const GAS v4u*)(hb + (hlo + (unsigned)((ai * 128 + m * 16) * 2048 + bj * 256)));
#pragma unroll
            for (int m = 0; m < 4; ++m) { float s1 = 0.f, s2 = 0.f;
#pragma unroll
                for (int bj = 0; bj < 2; ++bj) { f32x4 h0v, h1v; unpack8(hw[m][bj], h0v, h1v);
                    const f32x4 v0 = acc[ai][bj][m][0] + ALPHA * h0v, v1 = acc[ai][bj][m][1] + ALPHA * h1v;
                    *(GAS v4u*)(hb + (hlo + (unsigned)((ai * 128 + m * 16) * 2048 + bj * 256))) = pack8(v0, v1);
                    s1 += (v0[0] + v0[1]) + (v0[2] + v0[3]) + (v1[0] + v1[1]) + (v1[2] + v1[3]);
                    s2 += (v0[0] * v0[0] + v0[1] * v0[1]) + (v0[2] * v0[2] + v0[3] * v0[3]) + (v1[0] * v1[0] + v1[1] * v1[1]) + (v1[2] * v1[2] + v1[3] * v1[3]); }
                s1 += __shfl_xor(s1, 16); s1 += __shfl_xor(s1, 32); s2 += __shfl_xor(s2, 16); s2 += __shfl_xor(s2, 32);
                if (fq == 0) { f32x2 pr; pr.x = s1; pr.y = s2; *(LAS f32x2*)(lds_spare + ((ai * 128 + m * 16 + rl0) * 4 + wc) * 8) = pr; } }
            __builtin_amdgcn_sched_barrier(0); }
        asm volatile("s_waitcnt lgkmcnt(0)" ::: "memory"); __builtin_amdgcn_s_barrier(); asm volatile("" ::: "memory");
        { const int t = threadIdx.x;
          if (t < 256) { const LAS f32x2* pp = (const LAS f32x2*)(lds_spare + t * 32); f32x2 a = pp[0]; a += pp[1]; a += pp[2]; a += pp[3];
              *(GAS f32x2*)(stats + ((size_t)(u.pm * 256 + t) * 4 + u.pn) * 2) = a; } }
    }
};
struct EpiP7 {
    bf16* qp; const float* stats; const float* cvec; const float* dvec; LAS unsigned char* scr;
    __device__ __forceinline__ void operator()(f32x4 (&acc)[2][2][4][2], unsigned (&keep)[2][2][4][2], const GUnit& u, int wr, int wc, int fr, int fq) const {
        const unsigned rl0 = opq((unsigned)(wr * 64 + fr)), cl0 = opq((unsigned)(wc * 32 + 8 * fq));
        LAS unsigned char* sw = scr + (wr * 4 + wc) * 1024; const unsigned lw = opq((unsigned)(fr * 64 + fq * 16)), lrd = opq((unsigned)((fq * 16 + fr) * 16));
        const unsigned lam = opq((unsigned)(fq * 16 + fr));
        char* qb = (char*)(qp + (size_t)u.pm * 256 * 1024 + u.pn * 256); const unsigned lo = (unsigned)(wr * 64 + (lam >> 2)) * 2048u + (unsigned)(wc * 32 + 8 * (lam & 3u)) * 2u;
        f32x4 cv[2][2], dv[2][2];
#pragma unroll
        for (int bj = 0; bj < 2; ++bj)
#pragma unroll
            for (int n = 0; n < 2; ++n) { cv[bj][n] = *(const GAS f32x4*)(cvec + u.pn * 256 + cl0 + bj * 128 + 4 * n); dv[bj][n] = *(const GAS f32x4*)(dvec + u.pn * 256 + cl0 + bj * 128 + 4 * n); }
#pragma unroll
        for (int ai = 0; ai < 2; ++ai)
#pragma unroll
            for (int m = 0; m < 4; ++m) { const GAS f32x4* sp = (const GAS f32x4*)(stats + (size_t)(u.pm * 256 + ai * 128 + m * 16 + rl0) * 8); const f32x4 sa = sp[0], sb = sp[1];
                f32x2 st; st.x = ((sa.x + sa.z) + sb.x) + sb.z; st.y = ((sa.y + sa.w) + sb.y) + sb.w;
                const float mean = st.x * (1.f / D), rstd = 1.f / sqrtf(fmaxf(st.y * (1.f / D) - mean * mean, 0.f) + LN_EPS), mr = mean * rstd;
#pragma unroll
                for (int bj = 0; bj < 2; ++bj) { *(LAS v4u*)(sw + lw) = pack8(acc[ai][bj][m][0] * rstd - mr * cv[bj][0] + dv[bj][0], acc[ai][bj][m][1] * rstd - mr * cv[bj][1] + dv[bj][1]);
                    const v4u t = *(const LAS v4u*)(sw + lrd);
                    *(GAS v4u*)(qb + (lo + (unsigned)((ai * 128 + m * 16) * 2048 + bj * 256))) = t; } }
    }
};

constexpr float FP6_SU = 60.f, FP6_SV = 3.15f;
__device__ __forceinline__ unsigned fp6_code(float v) {
    const float a = fminf(fabsf(v), 7.5f);
    const float c = a < 2.f ? rintf(a * 8.f) : (a < 4.f ? 16.f + rintf((a - 2.f) * 4.f) : 24.f + rintf((a - 4.f) * 2.f));
    return (unsigned)c | (v < 0.f ? 32u : 0u);
}
constexpr float FP4_SV = 3.36f, FP4_SU = 64.f;
__device__ __forceinline__ unsigned fp4_code(float v) {
    const float a = fminf(fabsf(v), 6.f);
    const float c = a < 2.f ? rintf(a * 2.f) : (a < 4.f ? 4.f + rintf(a - 2.f) : 6.f + rintf((a - 4.f) * 0.5f));
    return (unsigned)c | (v < 0.f ? 8u : 0u);
}
typedef unsigned v6u __attribute__((ext_vector_type(6)));
typedef float v32f __attribute__((ext_vector_type(32)));
__device__ __forceinline__ void p0_transpose_item(const float* W, int K, int ld, int col0, bf16* WT, unsigned char* WT8, float sc8, int row0, LAS float* scr, int item, int lane, int ncols,
                                                  const float* kg = nullptr, const float* kb = nullptr, float* cvec = nullptr, float* dvec = nullptr) {
    const int nblk = ncols / 32, kb_ = item / nblk, nb = item % nblk, k0 = 64 * kb_, n0 = 32 * nb;
    { float wv[32];
#pragma unroll
      for (int i = 0; i < 32; ++i) wv[i] = W[(size_t)(k0 + 2 * i + (lane >> 5)) * ld + col0 + n0 + (lane & 31)];
#pragma unroll
      for (int i = 0; i < 32; ++i) scr[(2 * i + (lane >> 5)) * 33 + (lane & 31)] = wv[i]; }
    LDS_WAIT(); asm volatile("" ::: "memory");
    const int c = lane & 7;
#pragma unroll
    for (int j = 0; j < 4; ++j) { const int n = (lane >> 3) + 8 * j; const LAS float* s = scr + (8 * c) * 33 + n;
        float e[8];
#pragma unroll
        for (int i = 0; i < 8; ++i) e[i] = s[i * 33];
        if (kg) { float pc = 0.f, pd = 0.f;
#pragma unroll
            for (int i = 0; i < 8; ++i) { const float g = kg[k0 + 8 * c + i]; pd += e[i] * kb[k0 + 8 * c + i]; e[i] *= g; pc += e[i]; }
            pc += __shfl_xor(pc, 1); pc += __shfl_xor(pc, 2); pc += __shfl_xor(pc, 4); pd += __shfl_xor(pd, 1); pd += __shfl_xor(pd, 2); pd += __shfl_xor(pd, 4);
            if (c == 0) { cvec[kb_ * 1024 + col0 + n0 + n] = pc; dvec[kb_ * 1024 + col0 + n0 + n] = pd; } }
        if (WT) { v4u o; o.x = pk2(e[0], e[1]); o.y = pk2(e[2], e[3]); o.z = pk2(e[4], e[5]); o.w = pk2(e[6], e[7]); *(GAS v4u*)(WT + (size_t)(row0 + n0 + n) * K + k0 + 8 * c) = o; }
        if (WT8) { v2u o; o.x = pk4_fp8(e[0] * sc8, e[1] * sc8, e[2] * sc8, e[3] * sc8); o.y = pk4_fp8(e[4] * sc8, e[5] * sc8, e[6] * sc8, e[7] * sc8); *(GAS v2u*)(WT8 + (size_t)(row0 + n0 + n) * K + k0 + 8 * c) = o; } }
    LDS_WAIT(); asm volatile("" ::: "memory");
}
__device__ __forceinline__ void ln_row(const float* xrow, const float* g, const float* b, bf16* obf, float* of32, int lane) {
    const GAS f32x4* xr = (const GAS f32x4*)xrow + lane;
    f32x4 v[4]; float s = 0.f;
#pragma unroll
    for (int j = 0; j < 4; ++j) { v[j] = xr[64 * j]; s += (v[j].x + v[j].y) + (v[j].z + v[j].w); }
    const float mean = wave_sum(s) * (1.f / D); float s2 = 0.f;
#pragma unroll
    for (int j = 0; j < 4; ++j) { v[j] = v[j] - mean; s2 += (v[j].x * v[j].x + v[j].y * v[j].y) + (v[j].z * v[j].z + v[j].w * v[j].w); }
    const float rstd = 1.f / sqrtf(wave_sum(s2) * (1.f / D) + LN_EPS);
#pragma unroll
    for (int j = 0; j < 4; ++j) { const f32x4 gg = ((const GAS f32x4*)g)[lane + 64 * j], bb = ((const GAS f32x4*)b)[lane + 64 * j];
        const f32x4 y = v[j] * rstd * gg + bb;
        if (obf) ((GAS unsigned long long*)obf)[lane + 64 * j] = (unsigned long long)pk2(y.x, y.y) | ((unsigned long long)pk2(y.z, y.w) << 32);
        if (of32) ((GAS f32x4*)of32)[lane + 64 * j] = y; }
}
__device__ __forceinline__ void ln_row2(const float* xa, const float* xb, const float* g, const float* b, bf16* oa, bf16* ob, unsigned char* oa8, unsigned char* ob8, int lane) {
    const GAS f32x4* pa = (const GAS f32x4*)xa + lane; const GAS f32x4* pb = (const GAS f32x4*)xb + lane;
    f32x4 va[4], vb[4]; float sa = 0.f, sb = 0.f;
#pragma unroll
    for (int j = 0; j < 4; ++j) { va[j] = pa[64 * j]; vb[j] = pb[64 * j]; }
#pragma unroll
    for (int j = 0; j < 4; ++j) { sa += (va[j].x + va[j].y) + (va[j].z + va[j].w); sb += (vb[j].x + vb[j].y) + (vb[j].z + vb[j].w); }
    const float ma = wave_sum(sa) * (1.f / D), mb = wave_sum(sb) * (1.f / D); float qa = 0.f, qb = 0.f;
#pragma unroll
    for (int j = 0; j < 4; ++j) { va[j] = va[j] - ma; vb[j] = vb[j] - mb; qa += (va[j].x * va[j].x + va[j].y * va[j].y) + (va[j].z * va[j].z + va[j].w * va[j].w); qb += (vb[j].x * vb[j].x + vb[j].y * vb[j].y) + (vb[j].z * vb[j].z + vb[j].w * vb[j].w); }
    const float ra = 1.f / sqrtf(wave_sum(qa) * (1.f / D) + LN_EPS), rb = 1.f / sqrtf(wave_sum(qb) * (1.f / D) + LN_EPS);
#pragma unroll
    for (int j = 0; j < 4; ++j) { const f32x4 gg = ((const GAS f32x4*)g)[lane + 64 * j], bb = ((const GAS f32x4*)b)[lane + 64 * j];
        const f32x4 ya = va[j] * ra * gg + bb, yb = vb[j] * rb * gg + bb;
        ((GAS unsigned long long*)oa)[lane + 64 * j] = (unsigned long long)pk2(ya.x, ya.y) | ((unsigned long long)pk2(ya.z, ya.w) << 32);
        ((GAS unsigned long long*)ob)[lane + 64 * j] = (unsigned long long)pk2(yb.x, yb.y) | ((unsigned long long)pk2(yb.z, yb.w) << 32);
        ((GAS unsigned*)oa8)[lane + 64 * j] = pk4_fp8(ya.x, ya.y, ya.z, ya.w); ((GAS unsigned*)ob8)[lane + 64 * j] = pk4_fp8(yb.x, yb.y, yb.z, yb.w); }
}
__device__ __forceinline__ int t5_bucket(int rel) {
    const int ret = rel > 0 ? 16 : 0; const int n = rel < 0 ? -rel : rel; const float nf = (float)(n > 1 ? n : 1);
    int large = 8 + (int)(logf(nf / 8.f) / 4.852030263919617f * 8.f); large = large < 15 ? large : 15;
    return ret + (n < 8 ? n : large);
}

__device__ __forceinline__ void phase0(const Ptrs& P, LAS unsigned char* lds, int tid, int lane, int wave, int G) {
    unsigned char* ws = P.ws;
    const int gw = blockIdx.x * NWAVES + wave, NGW = G * NWAVES;
    { bf16* h0 = (bf16*)(ws + WS_H0);
      unsigned char* h08 = ws + WS_H0F8;
      for (int m = gw; m < NT; m += 2 * NGW) ln_row2(P.in[0] + (size_t)m * D, P.in[0] + (size_t)(m + NGW) * D, P.in[3], P.in[4], h0 + (size_t)m * D, h0 + (size_t)(m + NGW) * D, h08 + (size_t)m * D, h08 + (size_t)(m + NGW) * D, lane); }
    { LAS float* scr = (LAS float*)(lds + wave * 16384);
      bf16* wtin = (bf16*)(ws + WS_WTIN);
      constexpr int I_IN = 23 * 16 * 8, I_A = 8 * 32, I_B = 4 * 32, I_C = 8 * 32, I_SQ = 16 * 32;
      constexpr int NIT = I_IN + I_A + I_B + I_C + 3 * I_SQ;
      unsigned char* wf8 = ws + WS_WF8IN;
      for (int it = gw; it < NIT; it += NGW) {
          int r = it;
          if (r < I_IN) { const int j = r / 128, q = r % 128; int src;
              if (j < 6) src = ((j & 1) ? 1280 : 512) + (j >> 1) * 256; else if (j < 9) src = 2048 + (j - 6) * 256; else if (j < 11) src = 2816 + (j - 9) * 256; else src = 3328 + (j - 11) * 256;
              p0_transpose_item(P.in[5], 1024, 6400, src, nullptr, wf8, W8SC, 1024 + 256 * j, scr, q, lane, 256); continue; }
          r -= I_IN;
          if (r < I_A) { p0_transpose_item(P.in[7], 512, 1024, 0, (bf16*)(ws + WS_WTA), nullptr, 0.f, 0, scr, r, lane, 1024); continue; } r -= I_A;
          if (r < I_B) { p0_transpose_item(P.in[8], 256, 1024, 0, nullptr, ws + WS_WTB, SC_WBC, 0, scr, r, lane, 1024); continue; } r -= I_B;
          if (r < I_C) { p0_transpose_item(P.in[9], 512, 1024, 0, nullptr, ws + WS_WTC, SC_WBC, 0, scr, r, lane, 1024); continue; } r -= I_C;
          if (r < I_SQ) { p0_transpose_item(P.in[10], 1024, 1024, 0, nullptr, ws + WS_WMKVF8, W8SC, 0, scr, r, lane, 1024); continue; } r -= I_SQ;
          if (r < I_SQ) { p0_transpose_item(P.in[11], 1024, 1024, 0, (bf16*)(ws + WS_WTO), nullptr, 0.f, 0, scr, r, lane, 1024); continue; } r -= I_SQ;
          p0_transpose_item(P.in[14], 1024, 1024, 0, (bf16*)(ws + WS_WTPQ), nullptr, 0.f, 0, scr, r, lane, 1024, P.in[12], P.in[13], (float*)(ws + WS_CPART), (float*)(ws + WS_CPART) + 16 * 1024);
      } }
    __syncthreads();
    { LAS float* wt = (LAS float*)lds;
      LAS float* cs = wt + 64 * 129; LAS float* sn = cs + 128;
      if (tid < 128) { float s, c; sincospif((float)tid / 64.f, &s, &c); cs[tid] = c; sn[tid] = s; }
      bf16* wtin = (bf16*)(ws + WS_WTIN);
      unsigned char* wf8 = ws + WS_WF8IN;
      for (int it = blockIdx.x; it < 256; it += G) {
          const int g = it >> 6, k0 = (it & 63) * 16;
          __syncthreads();
          for (int idx = tid; idx < 16 * 128; idx += 512) { const int kk = idx >> 7, c = idx & 127; wt[kk * 129 + c] = P.in[5][(size_t)(k0 + kk) * 6400 + g * 128 + c]; }
          __syncthreads();
          const int cp = tid & 127, kq = tid >> 7;
          float ac[4] = {0.f, 0.f, 0.f, 0.f}, as[4] = {0.f, 0.f, 0.f, 0.f};
#pragma unroll 4
          for (int c = 0; c < 128; ++c) { const int ix = (c * cp) & 127; const float cv = cs[ix], sv = sn[ix];
#pragma unroll
              for (int i = 0; i < 4; ++i) { const float w = wt[(4 * kq + i) * 129 + c]; ac[i] += w * cv; as[i] += w * sv; } }
          { v2u o; o.x = pk2(ac[0], ac[1]); o.y = pk2(ac[2], ac[3]); *(GAS v2u*)(wtin + (size_t)(g * 256 + cp) * 1024 + k0 + 4 * kq) = o;
            v2u q; q.x = pk2(as[0], as[1]); q.y = pk2(as[2], as[3]); *(GAS v2u*)(wtin + (size_t)(g * 256 + 128 + cp) * 1024 + k0 + 4 * kq) = q; }
#if ZA_FP8
          *(GAS unsigned*)(wf8 + (size_t)(g * 256 + cp) * 1024 + k0 + 4 * kq) = pk4_fp8(ac[0] * W8SC, ac[1] * W8SC, ac[2] * W8SC, ac[3] * W8SC);
          *(GAS unsigned*)(wf8 + (size_t)(g * 256 + 128 + cp) * 1024 + k0 + 4 * kq) = pk4_fp8(as[0] * W8SC, as[1] * W8SC, as[2] * W8SC, as[3] * W8SC);
#endif
      }
      __syncthreads();
      { float* bi = (float*)(ws + WS_BIASIN); const float* b_in = P.in[6];
        for (int r = gw; r < 1024; r += NGW) { const int g = r >> 8, w = r & 255, cp = w & 127; const bool isin = w >= 128;
            const int i0 = (lane * cp) & 127, i1 = ((lane + 64) * cp) & 127;
            float a = b_in[g * 128 + lane] * (isin ? sn[i0] : cs[i0]) + b_in[g * 128 + 64 + lane] * (isin ? sn[i1] : cs[i1]);
            a = wave_sum(a); if (lane == 0) bi[r] = a; }
        const int gtid = blockIdx.x * 512 + tid, nth = G * 512;
        for (int r = 1024 + gtid; r < WR_END; r += nth) { const int j = (r - 1024) >> 8, w = (r - 1024) & 255; int src;
            if (j < 6) src = ((j & 1) ? 1280 : 512) + (j >> 1) * 256; else if (j < 9) src = 2048 + (j - 6) * 256; else if (j < 11) src = 2816 + (j - 9) * 256; else src = 3328 + (j - 11) * 256;
            bi[r] = b_in[src + w]; }
        float* bt = (float*)(ws + WS_BIASTAB);
        for (int r = gtid; r < 3 * 4 * 129; r += nth) { const int g = r / (4 * 129), h = (r / 129) & 3, j = r % 129; const int rel = (j - 64) << (2 * g);
            bt[(g * 4 + h) * 132 + j] = P.in[2][t5_bucket(rel) * 12 + g * 4 + h]; }
      }
    }
    { const size_t gt = (size_t)blockIdx.x * 512 + tid, NTH = (size_t)G * 512;
      const GAS f32x4* us = (const GAS f32x4*)P.in[17]; const GAS f32x4* vs = (const GAS f32x4*)P.in[18];
      GAS v2u* ud = (GAS v2u*)(ws + WS_UTAB); GAS v2u* vd = (GAS v2u*)(ws + WS_VTAB);
#if TAB_FP6
      {
        const int njobs = 2 * 16384 * 16;
        for (int job = (int)gt; job < njobs; job += (int)NTH) { const int tb = job >> 18, e = (job >> 4) & 16383, fr = job & 15;
            const float sc = tb ? FP4_SV : (TABU_FP4 ? FP4_SU : FP6_SU);
            const GAS f32x4* src = (const GAS f32x4*)((tb ? P.in[18] : P.in[17]) + (size_t)e * 1024);
            const int kq = fr & 3, sp = fr >> 2;
            f32x4 v[16];
#pragma unroll
            for (int idx = 0; idx < 16; ++idx) v[idx] = src[(tb || TABU_FP4) ? (16 * fr + idx) : (32 * (2 * sp + (idx >> 3)) + 8 * kq + (idx & 7))];
            if (tb || TABU_FP4) {
                unsigned wd4[8];
#pragma unroll
                for (int w = 0; w < 8; ++w) { unsigned acc4 = 0u;
#pragma unroll
                    for (int t = 0; t < 8; ++t) acc4 |= fp4_code(v[w * 2 + (t >> 2)][t & 3] * sc) << (4 * t);
                    wd4[w] = acc4; }
                unsigned char* dst4 = ws + (tb ? WS_VTAB : WS_UTAB) + (size_t)e * 512 + fr * 32;
#pragma unroll
                for (int p = 0; p < 2; ++p) { v4u o; o.x = wd4[4 * p]; o.y = wd4[4 * p + 1]; o.z = wd4[4 * p + 2]; o.w = wd4[4 * p + 3]; *(GAS v4u*)(dst4 + p * 16) = o; }
                continue; }
            unsigned wd[12];
#pragma unroll
            for (int h = 0; h < 4; ++h) {
                unsigned cd[16];
#pragma unroll
                for (int q4 = 0; q4 < 4; ++q4)
#pragma unroll
                    for (int t = 0; t < 4; ++t) cd[q4 * 4 + t] = fp6_code(v[h * 4 + q4][t] * sc);
                wd[h * 3 + 0] = cd[0] | (cd[1] << 6) | (cd[2] << 12) | (cd[3] << 18) | (cd[4] << 24) | ((cd[5] & 3u) << 30);
                wd[h * 3 + 1] = (cd[5] >> 2) | (cd[6] << 4) | (cd[7] << 10) | (cd[8] << 16) | (cd[9] << 22) | ((cd[10] & 15u) << 28);
                wd[h * 3 + 2] = (cd[10] >> 4) | (cd[11] << 2) | (cd[12] << 8) | (cd[13] << 14) | (cd[14] << 20) | (cd[15] << 26); }
            unsigned char* dst = ws + WS_UTAB + (size_t)e * 768 + kq * 16;
#pragma unroll
            for (int p = 0; p < 3; ++p) { v4u o; o.x = wd[4 * p]; o.y = wd[4 * p + 1]; o.z = wd[4 * p + 2]; o.w = wd[4 * p + 3]; *(GAS v4u*)(dst + (3 * sp + p) * 64) = o; } } }
#endif
      const GAS f32x4* ms = (const GAS f32x4*)P.in[1]; GAS unsigned* md = (GAS unsigned*)(ws + WS_MEMF8);
      for (size_t i = gt; i < (size_t)512 * 1024 / 4; i += NTH) { const f32x4 a = ms[i]; md[i] = pk4_fp8(a.x, a.y, a.z, a.w); }
    }
}

constexpr int FFT_PITCH = 544, FFT_BUF = 128 * FFT_PITCH;
static_assert(2 * FFT_BUF <= MISC_OFF, "FFT LDS map");
typedef short s16x4 __attribute__((ext_vector_type(4)));
__device__ __forceinline__ s16x4 tr_read(LAS unsigned char* p) { return __builtin_amdgcn_ds_read_tr16_b64_v4i16((LAS s16x4*)p); }
template <int STEP>
__device__ __forceinline__ void fft_step_mfma(const bf16* src, bf16* dst, LAS unsigned char* lds, int tid, int lane, int wave, int G) {
    const int fr = lane & 15, kq = lane >> 4, kout = 16 * wave + fr;
    bf16x8 cf[4], sf[4];
    { LAS float* tab = (LAS float*)(lds + FFT_BUF);
      __syncthreads();
      if (tid < 128) { float sn, cs; sincospif((float)tid / 64.f, &sn, &cs); tab[tid] = cs; tab[128 + tid] = sn; }
      __syncthreads();
#pragma unroll
      for (int kk = 0; kk < 4; ++kk) { v4u cw, sw; unsigned cl[8], sl[8];
#pragma unroll
          for (int j = 0; j < 8; ++j) { const int sv = 32 * kk + (j < 4 ? 4 * kq + j : 16 + 4 * kq + j - 4); const int ix = (kout * sv) & 127; cl[j] = f2bf(tab[ix]); sl[j] = f2bf(tab[128 + ix]); }
          cw.x = cl[0] | (cl[1] << 16); cw.y = cl[2] | (cl[3] << 16); cw.z = cl[4] | (cl[5] << 16); cw.w = cl[6] | (cl[7] << 16);
          sw.x = sl[0] | (sl[1] << 16); sw.y = sl[2] | (sl[3] << 16); sw.z = sl[4] | (sl[5] << 16); sw.w = sl[6] | (sl[7] << 16);
          cf[kk] = __builtin_bit_cast(bf16x8, cw); sf[kk] = __builtin_bit_cast(bf16x8, sw); } }
    v4u iw[8];
#define FFT_LOAD(UN) do { const int b_ = (UN) >> 9, f_ = ((UN) >> 2) & 127, g_ = (UN) & 3; _Pragma("unroll") for (int j = 0; j < 8; ++j) { const int c = tid + 512 * j; const int sr = c >> 5, piece = c & 31; \
            const size_t row = (STEP == 1) ? (size_t)(b_ << 14) + 128 * sr + f_ : (size_t)(b_ << 14) + 128 * f_ + sr; iw[j] = *(const GAS v4u*)(src + row * 1024 + g_ * 256 + piece * 8); } } while (0)
#define FFT_PUT(BUF) do { _Pragma("unroll") for (int j = 0; j < 8; ++j) { const int c = tid + 512 * j; *(LAS v4u*)(lds + (BUF) * FFT_BUF + (c >> 5) * FFT_PITCH + (c & 31) * 16) = iw[j]; } } while (0)
    __syncthreads();
    if (blockIdx.x < 1024) { FFT_LOAD(blockIdx.x); FFT_PUT(0); }
    __syncthreads();
    int cur = 0;
    for (int unit = blockIdx.x; unit < 1024; unit += G) {
        const int b = unit >> 9, f = (unit >> 2) & 127, g = unit & 3;
        const bool more = unit + G < 1024;
        if (more) FFT_LOAD(unit + G);
        LAS unsigned char* img = lds + cur * FFT_BUF;
        f32x4 accR[8], accI[8];
#pragma unroll
        for (int mt = 0; mt < 8; ++mt) { accR[mt] = (f32x4){0.f, 0.f, 0.f, 0.f}; accI[mt] = (f32x4){0.f, 0.f, 0.f, 0.f}; }
#pragma unroll
        for (int mt = 0; mt < 8; ++mt)
#pragma unroll
            for (int kk = 0; kk < 4; ++kk) {
                LAS unsigned char* a1 = img + (32 * kk + 4 * kq + (fr >> 2)) * FFT_PITCH + (16 * mt + 4 * (fr & 3)) * 2;
                LAS unsigned char* a2 = a1 + 16 * FFT_PITCH;
                const s16x4 r0 = tr_read(a1), r1 = tr_read(a2), i0 = tr_read(a1 + 256), i1 = tr_read(a2 + 256);
                const bf16x8 xr = __builtin_shufflevector(r0, r1, 0, 1, 2, 3, 4, 5, 6, 7), xi = __builtin_shufflevector(i0, i1, 0, 1, 2, 3, 4, 5, 6, 7);
                if (STEP == 1) {
                    v4u t = __builtin_bit_cast(v4u, xi); t.x ^= 0x80008000u; t.y ^= 0x80008000u; t.z ^= 0x80008000u; t.w ^= 0x80008000u; const bf16x8 nxi = __builtin_bit_cast(bf16x8, t);
                    accR[mt] = __builtin_amdgcn_mfma_f32_16x16x32_bf16(xr, cf[kk], accR[mt], 0, 0, 0); accR[mt] = __builtin_amdgcn_mfma_f32_16x16x32_bf16(nxi, sf[kk], accR[mt], 0, 0, 0);
                    accI[mt] = __builtin_amdgcn_mfma_f32_16x16x32_bf16(xi, cf[kk], accI[mt], 0, 0, 0); accI[mt] = __builtin_amdgcn_mfma_f32_16x16x32_bf16(xr, sf[kk], accI[mt], 0, 0, 0);
                } else {
                    accR[mt] = __builtin_amdgcn_mfma_f32_16x16x32_bf16(xr, cf[kk], accR[mt], 0, 0, 0); accR[mt] = __builtin_amdgcn_mfma_f32_16x16x32_bf16(xi, sf[kk], accR[mt], 0, 0, 0);
                }
                if (kk == 3) __builtin_amdgcn_sched_barrier(0);
            }
        if (STEP == 1) { float ws_, wc_; sincospif(-(float)(f * kout) / 8192.f, &ws_, &wc_);
            bf16* orow = dst + ((size_t)(b << 14) + kout * 128 + f) * 1024 + g * 256 + 4 * kq;
#pragma unroll
            for (int mt = 0; mt < 8; ++mt) { v2u re, im; re.x = pk2(accR[mt][0] * wc_ + accI[mt][0] * ws_, accR[mt][1] * wc_ + accI[mt][1] * ws_); re.y = pk2(accR[mt][2] * wc_ + accI[mt][2] * ws_, accR[mt][3] * wc_ + accI[mt][3] * ws_);
                im.x = pk2(accR[mt][0] * ws_ - accI[mt][0] * wc_, accR[mt][1] * ws_ - accI[mt][1] * wc_); im.y = pk2(accR[mt][2] * ws_ - accI[mt][2] * wc_, accR[mt][3] * ws_ - accI[mt][3] * wc_);
                *(GAS v2u*)(orow + 16 * mt) = re; *(GAS v2u*)(orow + 128 + 16 * mt) = im; }
        } else { const float scale = 6.905339660024878e-4f;
            bf16* orow = dst + ((size_t)(b << 14) + f + 128 * kout) * 512 + g * 128 + 4 * kq;
#pragma unroll
            for (int mt = 0; mt < 8; ++mt) { v2u re; re.x = pk2(accR[mt][0] * scale, accR[mt][1] * scale); re.y = pk2(accR[mt][2] * scale, accR[mt][3] * scale); *(GAS v2u*)(orow + 16 * mt) = re; }
        }
        if (more) FFT_PUT(cur ^ 1);
        __syncthreads();
        cur ^= 1;
    }
#undef FFT_LOAD
#undef FFT_PUT
}

typedef float f32x16 __attribute__((ext_vector_type(16)));
constexpr int DA_BT = 0, DA_K = 9216, DA_KP = 144, DA_V = DA_K + 384 * DA_KP, DA_VP = 776;
static_assert(DA_V + 64 * DA_VP <= MISC_OFF, "dil-attn LDS map");
template <int T>
__device__ __forceinline__ void dil_tile(LAS unsigned char* lds, int kr0, int r31, int hh, const LAS float* btl, const bf16x8 (&qf)[4], f32x16& o0, f32x16& o1, float& mx, float& den) {
    const LAS unsigned char* kp = lds + DA_K + (kr0 + r31) * DA_KP + 16 * hh;
    f32x16 sacc;
#pragma unroll
    for (int i = 0; i < 16; ++i) sacc[i] = 0.f;
#pragma unroll
    for (int kk = 0; kk < 4; ++kk) { const bf16x8 kf = *(const LAS bf16x8*)(kp + 32 * kk); sacc = __builtin_amdgcn_mfma_f32_32x32x16_bf16(kf, qf[kk], sacc, 0, 0, 0); }
    const LAS float* bl = btl + (32 + 32 * T + 4 * hh - r31);
    float tmax = -INFINITY;
#pragma unroll
    for (int i = 0; i < 16; ++i) { const int krow = (i & 3) + 8 * (i >> 2);
        float sv = sacc[i] * 0.18033688011112042f + bl[krow];
        if (T == 0) sv = (krow + 4 * hh >= r31) ? sv : -INFINITY;
        if (T == 4) sv = (krow + 4 * hh <= r31) ? sv : -INFINITY;
        sacc[i] = sv; tmax = fmaxf(tmax, sv); }
    tmax = fmaxf(tmax, __shfl_xor(tmax, 32));
    const float mn = fmaxf(mx, tmax), corr = __builtin_amdgcn_exp2f(mx - mn); mx = mn;
    float psum = 0.f;
#pragma unroll
    for (int i = 0; i < 16; ++i) { const float p = __builtin_amdgcn_exp2f(sacc[i] - mn); sacc[i] = p; psum += p; }
    den = den * corr + psum;
#pragma unroll
    for (int i = 0; i < 16; ++i) { o0[i] *= corr; o1[i] *= corr; }
#pragma unroll
    for (int s2 = 0; s2 < 2; ++s2) { v4u pw; pw.x = pk2(sacc[8 * s2], sacc[8 * s2 + 1]); pw.y = pk2(sacc[8 * s2 + 2], sacc[8 * s2 + 3]); pw.z = pk2(sacc[8 * s2 + 4], sacc[8 * s2 + 5]); pw.w = pk2(sacc[8 * s2 + 6], sacc[8 * s2 + 7]);
        const bf16x8 pf = __builtin_bit_cast(bf16x8, pw);
        const LAS unsigned char* vp = lds + DA_V + r31 * DA_VP + (kr0 + 16 * s2 + 4 * hh) * 2;
        const v2u lo0 = *(const LAS v2u*)vp, hi0 = *(const LAS v2u*)(vp + 16), lo1 = *(const LAS v2u*)(vp + 32 * DA_VP), hi1 = *(const LAS v2u*)(vp + 32 * DA_VP + 16);
        v4u w0, w1; w0.x = lo0.x; w0.y = lo0.y; w0.z = hi0.x; w0.w = hi0.y; w1.x = lo1.x; w1.y = lo1.y; w1.z = hi1.x; w1.w = hi1.y;
        o0 = __builtin_amdgcn_mfma_f32_32x32x16_bf16(__builtin_bit_cast(bf16x8, w0), pf, o0, 0, 0, 0);
        o1 = __builtin_amdgcn_mfma_f32_32x32x16_bf16(__builtin_bit_cast(bf16x8, w1), pf, o1, 0, 0, 0); }
}
__device__ __forceinline__ void dil_attn_lds(const bf16* qk, const bf16* vt, const float* btab_g, bf16* og, float* lse, LAS unsigned char* lds, int tid, int lane, int wave, int G) {
    LAS float* bt = (LAS float*)(lds + DA_BT);
    __syncthreads();
    for (int i = tid; i < 12 * 192; i += 512) { const int tb = i / 192, j = i - tb * 192 - 32; bt[i] = (j >= 0 && j <= 128) ? btab_g[tb * 132 + j] * 1.4426950408889634f : 0.f; }
    const int r31 = lane & 31, hh = lane >> 5;
    v4u kw[6], vw[6]; bf16x8 qn[4];
#define DIL_UNIT(U) const int blk = (U) & 63, hd = ((U) >> 6) & 3, g = ((U) >> 8) % 3, b = (U) / 768; const int sh = 2 * g, sub = 16384 >> sh; \
        const int nl0 = blk * 256, rr = nl0 >> (14 - sh), l0 = nl0 & (sub - 1); const size_t seq0 = ((size_t)g * NT + (size_t)(b << 14) + (size_t)rr * sub); \
        const bf16* qkg = qk + seq0 * 512; const bf16* vtg = vt + ((size_t)g * 256 + hd * 64) * NT + (size_t)(b << 14) + (size_t)rr * sub;
#define DIL_LOAD() do { _Pragma("unroll") for (int j = 0; j < 6; ++j) { const int c = tid + 512 * j; const int kr = c >> 3, pc = c & 7; const int lk = l0 - 64 + kr; const int lkc = lk < 0 ? 0 : (lk >= sub ? sub - 1 : lk); \
              kw[j] = *(const GAS v4u*)(qkg + (size_t)lkc * 512 + 256 + hd * 64 + pc * 8); \
              const int d = c / 48, pv = c - d * 48; const int lv = l0 - 64 + pv * 8; const int lvc = lv < 0 ? 0 : (lv >= sub ? sub - 8 : lv); \
              vw[j] = *(const GAS v4u*)(vtg + (size_t)d * NT + lvc); } \
          _Pragma("unroll") for (int kk = 0; kk < 4; ++kk) qn[kk] = *(const GAS bf16x8*)(qkg + (size_t)(l0 + 32 * wave + (lane & 31)) * 512 + hd * 64 + 16 * kk + 8 * (lane >> 5)); } while (0)
    if (blockIdx.x < 1536) { DIL_UNIT(blockIdx.x) DIL_LOAD(); }
    for (int u = blockIdx.x; u < 1536; u += G) {
        DIL_UNIT(u)
        __syncthreads();
#pragma unroll
        for (int j = 0; j < 6; ++j) { const int c = tid + 512 * j; const int kr = c >> 3, pc = c & 7;
            *(LAS v4u*)(lds + DA_K + kr * DA_KP + pc * 16) = kw[j];
            const int d = c / 48, pv = c - d * 48;
            v2u lo, hi; lo.x = vw[j].x; lo.y = vw[j].y; hi.x = vw[j].z; hi.y = vw[j].w;
            *(LAS v2u*)(lds + DA_V + d * DA_VP + pv * 16) = lo; *(LAS v2u*)(lds + DA_V + d * DA_VP + pv * 16 + 8) = hi; }
        __syncthreads();
        bf16x8 qf[4];
#pragma unroll
        for (int kk = 0; kk < 4; ++kk) qf[kk] = qn[kk];
        if (u + G < 1536) { const int un = u + G; const int blkn = un & 63, hdn = (un >> 6) & 3, gn = (un >> 8) % 3, bn = un / 768; const int shn = 2 * gn, subn = 16384 >> shn;
            const int nl0n = blkn * 256, rrn = nl0n >> (14 - shn), l0n = nl0n & (subn - 1); const size_t seq0n = ((size_t)gn * NT + (size_t)(bn << 14) + (size_t)rrn * subn);
            const bf16* qkgn = qk + seq0n * 512; const bf16* vtgn = vt + ((size_t)gn * 256 + hdn * 64) * NT + (size_t)(bn << 14) + (size_t)rrn * subn;
#pragma unroll
            for (int j = 0; j < 6; ++j) { const int c = tid + 512 * j; const int kr = c >> 3, pc = c & 7; const int lk = l0n - 64 + kr; const int lkc = lk < 0 ? 0 : (lk >= subn ? subn - 1 : lk);
                kw[j] = *(const GAS v4u*)(qkgn + (size_t)lkc * 512 + 256 + hdn * 64 + pc * 8);
                const int d = c / 48, pv = c - d * 48; const int lv = l0n - 64 + pv * 8; const int lvc = lv < 0 ? 0 : (lv >= subn ? subn - 8 : lv);
                vw[j] = *(const GAS v4u*)(vtgn + (size_t)d * NT + lvc); }
#pragma unroll
            for (int kk = 0; kk < 4; ++kk) qn[kk] = *(const GAS bf16x8*)(qkgn + (size_t)(l0n + 32 * wave + (lane & 31)) * 512 + hdn * 64 + 16 * kk + 8 * (lane >> 5)); }
        const int lq0 = l0 + 32 * wave;
        const LAS float* btl = bt + (g * 4 + hd) * 192;
        f32x16 o0, o1;
#pragma unroll
        for (int i = 0; i < 16; ++i) { o0[i] = 0.f; o1[i] = 0.f; }
        float mx = -1e30f, den = 0.f;
        if (lq0 - 64 >= 0) dil_tile<0>(lds, 32 * wave, r31, hh, btl, qf, o0, o1, mx, den);
        if (lq0 - 32 >= 0) dil_tile<1>(lds, 32 * wave + 32, r31, hh, btl, qf, o0, o1, mx, den);
        dil_tile<2>(lds, 32 * wave + 64, r31, hh, btl, qf, o0, o1, mx, den);
        if (lq0 + 32 < sub) dil_tile<3>(lds, 32 * wave + 96, r31, hh, btl, qf, o0, o1, mx, den);
        if (lq0 + 64 < sub) dil_tile<4>(lds, 32 * wave + 128, r31, hh, btl, qf, o0, o1, mx, den);
        den += __shfl_xor(den, 32);
        const float inv = 1.f / den;
        const size_t n = seq0 + lq0 + r31;
        bf16* orow = og + n * 256 + hd * 64 + 4 * hh;
#pragma unroll
        for (int q4 = 0; q4 < 4; ++q4) { v2u w0, w1; w0.x = pk2(o0[4 * q4] * inv, o0[4 * q4 + 1] * inv); w0.y = pk2(o0[4 * q4 + 2] * inv, o0[4 * q4 + 3] * inv);
            w1.x = pk2(o1[4 * q4] * inv, o1[4 * q4 + 1] * inv); w1.y = pk2(o1[4 * q4 + 2] * inv, o1[4 * q4 + 3] * inv);
            *(GAS v2u*)(orow + 8 * q4) = w0; *(GAS v2u*)(orow + 32 + 8 * q4) = w1; }
        if (hh == 0) lse[n * 4 + hd] = (mx + __builtin_amdgcn_logf(den)) * 0.6931471805599453f;
    }
    __syncthreads();
#undef DIL_UNIT
#undef DIL_LOAD
}
constexpr int MA_KP = 272, MA_VP = 520, MA_V = 256 * MA_KP;
static_assert(MA_V + 128 * MA_VP <= MISC_OFF, "mem-attn LDS map");
__device__ __forceinline__ void mem_attn_lds(const bf16* qc, const bf16* memk, const bf16* vtm, bf16* ycin, LAS unsigned char* lds, int tid, int lane, int wave, int G) {
    const int r31 = lane & 31, hh = lane >> 5;
    for (int wu = blockIdx.x; wu < 256; wu += G) {
        const int combo = wu & 7, b = combo >> 2, hd = combo & 3, chunk = wu >> 3;
        __syncthreads();
        { v4u kw[8], vw[8];
#pragma unroll
          for (int j = 0; j < 8; ++j) { const int c = tid + 512 * j; kw[j] = *(const GAS v4u*)(memk + (size_t)(b * 256 + (c >> 4)) * 512 + hd * 128 + (c & 15) * 8);
              vw[j] = *(const GAS v4u*)(vtm + (size_t)(hd * 128 + (c >> 5)) * 512 + b * 256 + (c & 31) * 8); }
#pragma unroll
          for (int j = 0; j < 8; ++j) { const int c = tid + 512 * j; *(LAS v4u*)(lds + (c >> 4) * MA_KP + (c & 15) * 16) = kw[j];
              v2u lo, hi; lo.x = vw[j].x; lo.y = vw[j].y; hi.x = vw[j].z; hi.y = vw[j].w;
              *(LAS v2u*)(lds + MA_V + (c >> 5) * MA_VP + (c & 31) * 16) = lo; *(LAS v2u*)(lds + MA_V + (c >> 5) * MA_VP + (c & 31) * 16 + 8) = hi; } }
        __syncthreads();
#pragma unroll 1
        for (int qi = 0; qi < 2; ++qi) {
            const int blk = chunk * 16 + wave * 2 + qi;
            const size_t tok = (size_t)(b << 14) + blk * 32 + r31;
            const bf16* qrow = qc + tok * 512 + hd * 128 + 8 * hh;
            bf16x8 qf[8];
#pragma unroll
            for (int kk = 0; kk < 8; ++kk) qf[kk] = *(const GAS bf16x8*)(qrow + 16 * kk);
            f32x16 o[4];
#pragma unroll
            for (int mt = 0; mt < 4; ++mt)
#pragma unroll
                for (int i = 0; i < 16; ++i) o[mt][i] = 0.f;
            float mx = -1e30f, den = 0.f;
            const LAS unsigned char* kb = lds + r31 * MA_KP + 16 * hh;
            const LAS unsigned char* vb = lds + MA_V + r31 * MA_VP + 8 * hh;
#pragma unroll 1
            for (int t = 0; t < 8; ++t) {
                f32x16 sacc;
#pragma unroll
                for (int i = 0; i < 16; ++i) sacc[i] = 0.f;
#pragma unroll
                for (int kk = 0; kk < 8; ++kk) { const bf16x8 kf = *(const LAS bf16x8*)(kb + (32 * t) * MA_KP + 32 * kk); sacc = __builtin_amdgcn_mfma_f32_32x32x16_bf16(kf, qf[kk], sacc, 0, 0, 0); }
                float tmax = -INFINITY;
#pragma unroll
                for (int i = 0; i < 16; ++i) { sacc[i] *= 0.08838834764831845f; tmax = fmaxf(tmax, sacc[i]); }
                tmax = fmaxf(tmax, __shfl_xor(tmax, 32));
                const float mn = fmaxf(mx, tmax), corr = __expf(mx - mn); mx = mn;
                float psum = 0.f;
#pragma unroll
                for (int i = 0; i < 16; ++i) { const float p = __expf(sacc[i] - mn); sacc[i] = p; psum += p; }
                den = den * corr + psum;
#pragma unroll
                for (int mt = 0; mt < 4; ++mt)
#pragma unroll
                    for (int i = 0; i < 16; ++i) o[mt][i] *= corr;
#pragma unroll
                for (int s2 = 0; s2 < 2; ++s2) { v4u pw; pw.x = pk2(sacc[8 * s2], sacc[8 * s2 + 1]); pw.y = pk2(sacc[8 * s2 + 2], sacc[8 * s2 + 3]); pw.z = pk2(sacc[8 * s2 + 4], sacc[8 * s2 + 5]); pw.w = pk2(sacc[8 * s2 + 6], sacc[8 * s2 + 7]);
                    const bf16x8 pf = __builtin_bit_cast(bf16x8, pw);
#pragma unroll
                    for (int mt = 0; mt < 4; ++mt) { const LAS unsigned char* vp = vb + (32 * mt) * MA_VP + (32 * t + 16 * s2) * 2;
                        const v2u lo = *(const LAS v2u*)vp, hi = *(const LAS v2u*)(vp + 16);
                        v4u w; w.x = lo.x; w.y = lo.y; w.z = hi.x; w.w = hi.y;
                        o[mt] = __builtin_amdgcn_mfma_f32_32x32x16_bf16(__builtin_bit_cast(bf16x8, w), pf, o[mt], 0, 0, 0); } }
            }
            den += __shfl_xor(den, 32);
            const float inv = 1.f / den;
            unsigned char* orow = (unsigned char*)ycin + tok * 512 + hd * 128 + 4 * hh; const float inv4 = inv * SC_ACT;
#pragma unroll
            for (int mt = 0; mt < 4; ++mt)
#pragma unroll
                for (int q4 = 0; q4 < 4; ++q4) *(GAS unsigned*)(orow + 32 * mt + 8 * q4) = pk4_fp8(o[mt][4 * q4] * inv4, o[mt][4 * q4 + 1] * inv4, o[mt][4 * q4 + 2] * inv4, o[mt][4 * q4 + 3] * inv4);
        }
    }
    __syncthreads();
}
__device__ __forceinline__ void combine_groups(const bf16* og, const float* lse, bf16* ob, int tid, int G) {
    for (size_t idx = (size_t)blockIdx.x * 512 + tid; idx < (size_t)NT * 32; idx += (size_t)G * 512) {
        const int t = (int)(idx >> 5), ch = (int)(idx & 31), h = ch >> 3, d0 = (ch & 7) * 8, b = t >> 14, s = t & 16383;
        float l[3]; size_t n[3];
#pragma unroll
        for (int g = 0; g < 3; ++g) { const int sh = 2 * g; n[g] = (size_t)(b << 14) + (size_t)(s & ((1 << sh) - 1)) * (16384 >> sh) + (s >> sh); l[g] = lse[((size_t)g * NT + n[g]) * 4 + h]; }
        const float mx = fmaxf(l[0], fmaxf(l[1], l[2])); float w[3], sum = 0.f;
#pragma unroll
        for (int g = 0; g < 3; ++g) { w[g] = __expf(l[g] - mx); sum += w[g]; }
        float o[8] = {0, 0, 0, 0, 0, 0, 0, 0};
#pragma unroll
        for (int g = 0; g < 3; ++g) { const float wg = w[g] / sum; const v4u v = *(const GAS v4u*)(og + ((size_t)g * NT + n[g]) * 256 + h * 64 + d0);
            o[0] += wg * bflo(v.x); o[1] += wg * bfhi(v.x); o[2] += wg * bflo(v.y); o[3] += wg * bfhi(v.y); o[4] += wg * bflo(v.z); o[5] += wg * bfhi(v.z); o[6] += wg * bflo(v.w); o[7] += wg * bfhi(v.w); }
        v2u r; r.x = pk4_fp8(o[0] * SC_ACT, o[1] * SC_ACT, o[2] * SC_ACT, o[3] * SC_ACT); r.y = pk4_fp8(o[4] * SC_ACT, o[5] * SC_ACT, o[6] * SC_ACT, o[7] * SC_ACT);
        *(GAS v2u*)((unsigned char*)ob + (size_t)t * 256 + h * 64 + d0) = r;
    }
}

template <int C> __device__ __forceinline__ unsigned dppu(unsigned v) { return (unsigned)__builtin_amdgcn_update_dpp(0, (int)v, C, 0xF, 0xF, true); }
template <int C> __device__ __forceinline__ float dppf(float v) { return __builtin_bit_cast(float, __builtin_amdgcn_update_dpp(0, __builtin_bit_cast(int, v), C, 0xF, 0xF, true)); }
__device__ __forceinline__ unsigned umax2(unsigned a, unsigned b) { return a > b ? a : b; }
__device__ __forceinline__ unsigned row_max_u(unsigned v) { v = umax2(v, dppu<0xB1>(v)); v = umax2(v, dppu<0x4E>(v)); v = umax2(v, dppu<0x141>(v)); v = umax2(v, dppu<0x140>(v)); return v; }
__device__ __forceinline__ float row_max_f(float v) { v = fmaxf(v, dppf<0xB1>(v)); v = fmaxf(v, dppf<0x4E>(v)); v = fmaxf(v, dppf<0x141>(v)); v = fmaxf(v, dppf<0x140>(v)); return v; }
__device__ __forceinline__ float row_sum_f(float v) { v += dppf<0xB1>(v); v += dppf<0x4E>(v); v += dppf<0x141>(v); v += dppf<0x140>(v); return v; }
__device__ __forceinline__ unsigned ordf(float f) { const unsigned b = __builtin_bit_cast(unsigned, f); return b ^ ((unsigned)((int)b >> 31) | 0x80000000u); }
__device__ __forceinline__ float decf(unsigned k) { const unsigned b = (k & 0x80000000u) ? (k ^ 0x80000000u) : ~k; return __builtin_bit_cast(float, b); }
__device__ __forceinline__ unsigned bperm(unsigned v, int src_lane) { return (unsigned)__builtin_amdgcn_ds_bpermute(src_lane * 4, (int)v); }
typedef __bf16 bf16x2_t __attribute__((ext_vector_type(2)));
__device__ __forceinline__ float dot2bf(unsigned a, unsigned b, float c) { return __builtin_amdgcn_fdot2_f32_bf16(__builtin_bit_cast(bf16x2_t, a), __builtin_bit_cast(bf16x2_t, b), c, false); }

__device__ __forceinline__ float gelu_as(float v) {
    const float av = fabsf(v), t = __builtin_amdgcn_rcpf(av * 0.2316418882f + 1.0f);
    float q = t * 0.5307027145f + (-0.7265760135f); q = q * t + 0.7107068705f; q = q * t + (-0.142248368f); q = q * t + 0.127414796f; q = q * t;
    const float e = __builtin_amdgcn_exp2f((v * v) * (-0.72134752044f));
    const float m = v * (q * e);
    return v < 0.f ? m : v - m;
}
constexpr int PEER_SKB = 0, PEER_EL = 36864, PEER_PTAB = PEER_EL + 8 * 2048, PEER_VB = PEER_PTAB + 256, PEER_XA = PEER_VB + 8 * 8192, PEER_WB = PEER_XA + 8 * 4096;
static_assert(PEER_WB + 8 * 64 <= MISC_OFF, "PEER LDS map");
constexpr float PEER_XS = 32.f, PEER_WS = 32.f;
typedef int v8i_p __attribute__((ext_vector_type(8)));
typedef int v2i __attribute__((ext_vector_type(2)));
__device__ __forceinline__ void peer_scores_top16(const bf16* qp, LAS unsigned char* lds, int tokb, int hf, int fr, int fq, unsigned& o0, unsigned& o1, unsigned& o2, unsigned& o3) {
    const bf16* arow = qp + (size_t)(tokb + (fr >> 3)) * 1024 + (fr & 7) * 128 + hf * 64 + 8 * fq;
    const bf16x8 a0 = *(const GAS bf16x8*)arow, a1 = *(const GAS bf16x8*)(arow + 32);
    unsigned e0[8], e1[8], e2[8], e3[8];
#pragma unroll
    for (int nb = 0; nb < 8; ++nb) {
        const LAS unsigned char* bp = lds + PEER_SKB + hf * 18432 + (fr + 16 * nb) * 144 + fq * 16;
        const bf16x8 b0 = *(const LAS bf16x8*)bp, b1 = *(const LAS bf16x8*)(bp + 64);
        f32x4 acc = (f32x4){0.f, 0.f, 0.f, 0.f};
        acc = __builtin_amdgcn_mfma_f32_16x16x32_bf16(a0, b0, acc, 0, 0, 0);
        acc = __builtin_amdgcn_mfma_f32_16x16x32_bf16(a1, b1, acc, 0, 0, 0);
        const unsigned ix = (unsigned)(127 - (fr + 16 * nb));
        e0[nb] = (ordf(acc[0]) & ~127u) | ix; e1[nb] = (ordf(acc[1]) & ~127u) | ix; e2[nb] = (ordf(acc[2]) & ~127u) | ix; e3[nb] = (ordf(acc[3]) & ~127u) | ix;
    }
    o0 = 0u; o1 = 0u; o2 = 0u; o3 = 0u;
#define PEER_CE(E, A, B) do { const unsigned hi_ = umax2(E[A], E[B]), lo_ = E[A] < E[B] ? E[A] : E[B]; E[A] = hi_; E[B] = lo_; } while (0)
#define PEER_SORT8(E) do { PEER_CE(E, 0, 1); PEER_CE(E, 2, 3); PEER_CE(E, 4, 5); PEER_CE(E, 6, 7); PEER_CE(E, 0, 2); PEER_CE(E, 1, 3); PEER_CE(E, 4, 6); PEER_CE(E, 5, 7); PEER_CE(E, 1, 2); PEER_CE(E, 5, 6); \
        PEER_CE(E, 0, 4); PEER_CE(E, 1, 5); PEER_CE(E, 2, 6); PEER_CE(E, 3, 7); PEER_CE(E, 2, 4); PEER_CE(E, 3, 5); PEER_CE(E, 1, 2); PEER_CE(E, 3, 4); PEER_CE(E, 5, 6); } while (0)
#define PEER_ROUND(E, O) do { const unsigned m = row_max_u(E[0]); const bool win = (E[0] == m); \
        E[0] = win ? E[1] : E[0]; E[1] = win ? E[2] : E[1]; E[2] = win ? E[3] : E[2]; E[3] = win ? E[4] : E[3]; E[4] = win ? E[5] : E[4]; E[5] = win ? E[6] : E[5]; E[6] = win ? E[7] : E[6]; E[7] = win ? 0u : E[7]; \
        O = (fr == r) ? m : O; } while (0)
    PEER_SORT8(e0); PEER_SORT8(e1); PEER_SORT8(e2); PEER_SORT8(e3);
#pragma unroll 1
    for (int r = 0; r < 16; ++r) { PEER_ROUND(e0, o0); PEER_ROUND(e1, o1); PEER_ROUND(e2, o2); PEER_ROUND(e3, o3); }
#undef PEER_ROUND
#undef PEER_SORT8
#undef PEER_CE
}
__device__ __forceinline__ void peer_cand(LAS unsigned char* lds, LAS unsigned char* el, unsigned ptab, unsigned L1, unsigned L2, int lane, int fr, int slot) {
    unsigned c0, c1, c2, c3;
#define PEER_CK(SL, C) do { const unsigned byte = (ptab >> (8 * SL)) & 255u; const int a = byte >> 4, b = byte & 15; \
        const unsigned k1 = bperm(L1, (lane & 48) + a), k2 = bperm(L2, (lane & 48) + b); const float sum = decf(k1 & ~127u) + decf(k2 & ~127u); \
        C = (byte != 255u) ? ((ordf(sum) & ~63u) | (unsigned)(fr * 4 + SL)) : 0u; } while (0)
    PEER_CK(0, c0); PEER_CK(1, c1); PEER_CK(2, c2); PEER_CK(3, c3);
#undef PEER_CK
    unsigned co = 0u;
#define PEER_CE2(A, B) do { const unsigned hi_ = umax2(A, B), lo_ = A < B ? A : B; A = hi_; B = lo_; } while (0)
    PEER_CE2(c0, c1); PEER_CE2(c2, c3); PEER_CE2(c0, c2); PEER_CE2(c1, c3); PEER_CE2(c1, c2);
#undef PEER_CE2
#pragma unroll 1
    for (int r = 0; r < 16; ++r) { const unsigned m = row_max_u(c0); const bool win = (c0 == m);
        c0 = win ? c1 : c0; c1 = win ? c2 : c1; c2 = win ? c3 : c2; c3 = win ? 0u : c3;
        co = (fr == r) ? m : co; }
    const unsigned pb = *(LAS unsigned char*)(lds + PEER_PTAB + (co & 63u));
    const unsigned k1 = bperm(L1, (lane & 48) + (int)(pb >> 4)), k2 = bperm(L2, (lane & 48) + (int)(pb & 15u));
    const unsigned expert = (127u - (k1 & 127u)) * 128u + (127u - (k2 & 127u));
    const float sc = decf(co & ~63u);
    const float ex = __expf(sc - row_max_f(sc));
    const float gate = ex / row_sum_f(ex);
    v2u rec; rec.x = expert; rec.y = __builtin_bit_cast(unsigned, gate);
    *(LAS v2u*)(el + slot * 8) = rec;
}
template <int sh, bool PACK>
__device__ __forceinline__ void peer_regroup16(const LAS unsigned char* src, LAS unsigned char* dst, int lane, int fr) {
    v2u rc[8]; unsigned c0 = 0u, c1 = 0u, c2 = 0u, c3 = 0u;
#pragma unroll
    for (int j = 0; j < 8; ++j) { rc[j] = *(const LAS v2u*)(src + (fr * 8 + j) * 8); const unsigned bk = (rc[j].x >> sh) & 15u, one = 1u << (8 * (bk & 3u)), w = bk >> 2;
        c0 += (w == 0u) ? one : 0u; c1 += (w == 1u) ? one : 0u; c2 += (w == 2u) ? one : 0u; c3 += (w == 3u) ? one : 0u; }
    unsigned i0 = c0, i1 = c1, i2 = c2, i3 = c3;
    i0 += dppu<0x111>(i0); i1 += dppu<0x111>(i1); i2 += dppu<0x111>(i2); i3 += dppu<0x111>(i3);
    i0 += dppu<0x112>(i0); i1 += dppu<0x112>(i1); i2 += dppu<0x112>(i2); i3 += dppu<0x112>(i3);
    i0 += dppu<0x114>(i0); i1 += dppu<0x114>(i1); i2 += dppu<0x114>(i2); i3 += dppu<0x114>(i3);
    i0 += dppu<0x118>(i0); i1 += dppu<0x118>(i1); i2 += dppu<0x118>(i2); i3 += dppu<0x118>(i3);
    const int l15 = (lane & 48) + 15;
    const unsigned t0 = bperm(i0, l15), t1 = bperm(i1, l15), t2 = bperm(i2, l15), t3 = bperm(i3, l15);
    const unsigned s0 = (t0 * 0x01010101u) >> 24, s1 = (t1 * 0x01010101u) >> 24, s2 = (t2 * 0x01010101u) >> 24;
    unsigned p0 = (i0 - c0) + (t0 * 0x01010100u), p1 = (i1 - c1) + (t1 * 0x01010100u) + s0 * 0x01010101u, p2 = (i2 - c2) + (t2 * 0x01010100u) + (s0 + s1) * 0x01010101u,
             p3 = (i3 - c3) + (t3 * 0x01010100u) + (s0 + s1 + s2) * 0x01010101u;
#pragma unroll
    for (int j = 0; j < 8; ++j) { const unsigned bk = (rc[j].x >> sh) & 15u, q8 = 8 * (bk & 3u), w = bk >> 2, one = 1u << q8;
        const unsigned pw = (w == 0u) ? p0 : ((w == 1u) ? p1 : ((w == 2u) ? p2 : p3));
        if (PACK) { const unsigned gu = rc[j].y; *(LAS unsigned*)(dst + ((pw >> q8) & 255u) * 4) = (rc[j].x << 16) | ((gu + 0x7fffu + ((gu >> 16) & 1u)) >> 16); }
        else *(LAS v2u*)(dst + ((pw >> q8) & 255u) * 8) = rc[j];
        p0 += (w == 0u) ? one : 0u; p1 += (w == 1u) ? one : 0u; p2 += (w == 2u) ? one : 0u; p3 += (w == 3u) ? one : 0u; }
}
#define PEER_ULOAD(U, E) do { const unsigned ee_ = (E); \
            const unsigned i0_ = dppu<0x00>(ee_), i1_ = dppu<0x55>(ee_), i2_ = dppu<0xAA>(ee_), i3_ = dppu<0xFF>(ee_);        \
            const unsigned char* p0_ = u6 + (size_t)i0_ * 512 + uofs; const unsigned char* p1_ = u6 + (size_t)i1_ * 512 + uofs; \
            const unsigned char* p2_ = u6 + (size_t)i2_ * 512 + uofs; const unsigned char* p3_ = u6 + (size_t)i3_ * 512 + uofs; \
            U[0] = *(const GAS v4u*)p0_; U[1] = *(const GAS v4u*)(p0_ + 256); U[2] = *(const GAS v4u*)p1_; U[3] = *(const GAS v4u*)(p1_ + 256); \
            U[4] = *(const GAS v4u*)p2_; U[5] = *(const GAS v4u*)(p2_ + 256); U[6] = *(const GAS v4u*)p3_; U[7] = *(const GAS v4u*)(p3_ + 256); } while (0)
#define PEER_VDMA(E) do { const unsigned ee_ = (E); const unsigned ia_ = bperm(ee_, vsrc0), ib_ = bperm(ee_, vsrc1); \
            const unsigned char* va_ = v6 + (size_t)ia_ * 512 + vpo0; const unsigned char* vb_ = v6 + (size_t)ib_ * 512 + vpo1; \
            _Pragma("unroll") for (int l = 0; l < 4; ++l) { \
                asm volatile("s_mov_b32 m0, %1\n\ts_nop 0\n\tglobal_load_lds_dwordx4 %0, off" :: "v"(va_ + l * 128), "s"(vbaddr + (unsigned)(2 * l) * 1024u) : "memory"); \
                asm volatile("s_mov_b32 m0, %1\n\ts_nop 0\n\tglobal_load_lds_dwordx4 %0, off" :: "v"(vb_ + l * 128), "s"(vbaddr + (unsigned)(2 * l + 1) * 1024u) : "memory"); } } while (0)
#define PEER_XLOAD(PW0, PW1, SA, SB, TOK, LN) do { const bf16* prow = (const bf16*)(ws + WS_H0) + (size_t)(TOK) * 1024 + (LN) * 16; \
            const GAS f32x4* sp = (const GAS f32x4*)((const float*)(ws + WS_STATS4) + (size_t)(TOK) * 8); SA = sp[0]; SB = sp[1]; \
            PW0 = *(const GAS v4u*)prow; PW1 = *(const GAS v4u*)(prow + 8); } while (0)
#define PEER_XCALC(XN, PW0, PW1, SA, SB, LN) do { \
            f32x2 st; st.x = ((SA.x + SA.z) + SB.x) + SB.z; st.y = ((SA.y + SA.w) + SB.y) + SB.w; \
            const float mean1 = st.x * (1.f / D), rstd1 = 1.f / sqrtf(fmaxf(st.y * (1.f / D) - mean1 * mean1, 0.f) + LN_EPS); \
            _Pragma("unroll") for (int q8 = 0; q8 < 2; ++q8) { const v4u pw = q8 ? PW1 : PW0; f32x4 pa, pb2; unpack8(pw, pa, pb2); \
                _Pragma("unroll") for (int hq = 0; hq < 2; ++hq) { const int q4 = q8 * 2 + hq; const f32x4 pv = hq ? pb2 : pa; \
                    const f32x4 gv = *(const GAS f32x4*)(P.in[12] + (LN) * 16 + q4 * 4), bv = *(const GAS f32x4*)(P.in[13] + (LN) * 16 + q4 * 4); \
                    const f32x4 xv = (pv - mean1) * rstd1 * gv + bv; \
                    XN[q4 * 4] = xv.x; XN[q4 * 4 + 1] = xv.y; XN[q4 * 4 + 2] = xv.z; XN[q4 * 4 + 3] = xv.w; } } } while (0)
__device__ __forceinline__ void peer_v2(const Ptrs& P, LAS unsigned char* lds, int tid, int lane, int wave, int G) {
    unsigned char* ws = P.ws;
    const bf16* qp = (const bf16*)(ws + WS_QP); const bf16* utab = (const bf16*)(ws + WS_UTAB); const bf16* vtab = (const bf16*)(ws + WS_VTAB);
    const bf16* h1b = (const bf16*)(ws + WS_H1B);
    const int fr = lane & 15, fq = lane >> 4;
    for (int idx = tid; idx < 2 * 128 * 32; idx += 512) { const int hf = idx >> 12, k = (idx >> 5) & 127, c2 = idx & 31; const float* sk = (hf ? P.in[16] : P.in[15]) + k * 64 + c2 * 2;
        *(LAS unsigned*)(lds + PEER_SKB + hf * 18432 + k * 144 + c2 * 4) = pk2(sk[0], sk[1]); }
    if (tid < 64) { int q = 0, a = 0, b = 0; unsigned char val = 0xFF;
        for (a = 0; a < 16 && val == 0xFF; ++a) for (b = 0; b < 16 && (a + 1) * (b + 1) <= 16; ++b) { if (q == tid) { val = (unsigned char)((a << 4) | b); break; } ++q; }
        *(LAS unsigned char*)(lds + PEER_PTAB + tid) = val; }
    __syncthreads();
    LAS unsigned char* el = lds + PEER_EL + wave * 2048;
    LAS unsigned char* vb = lds + PEER_VB + wave * 8192;
    LAS unsigned char* xal = lds + PEER_XA + wave * 4096; LAS unsigned char* wbl = lds + PEER_WB + wave * 64;
    const unsigned char* u6 = (const unsigned char*)utab; const unsigned char* v6 = (const unsigned char*)vtab;
    const unsigned vbaddr = (unsigned)__builtin_amdgcn_readfirstlane((int)(unsigned)(size_t)vb);
    const int lane_k = lane;
    for (int tile = blockIdx.x; tile < NT / 32; tile += G) {
        const int lane = (int)opq((unsigned)lane_k), fr = lane & 15, fq = lane >> 4; const unsigned ptab = *(LAS unsigned*)(lds + PEER_PTAB + fr * 4);
        const int tok0 = tile * 32 + wave * 4;
#pragma unroll 1
        for (int mt = 0; mt < 2; ++mt) {
            unsigned L00, L01, L02, L03, L10, L11, L12, L13;
            peer_scores_top16(qp, lds, tok0 + 2 * mt, 0, fr, fq, L00, L01, L02, L03);
            peer_scores_top16(qp, lds, tok0 + 2 * mt, 1, fr, fq, L10, L11, L12, L13);
            peer_cand(lds, vb, ptab, L00, L10, lane, fr, (2 * mt + (fq >> 1)) * 128 + ((fq & 1) * 4 + 0) * 16 + fr);
            peer_cand(lds, vb, ptab, L01, L11, lane, fr, (2 * mt + (fq >> 1)) * 128 + ((fq & 1) * 4 + 1) * 16 + fr);
            peer_cand(lds, vb, ptab, L02, L12, lane, fr, (2 * mt + (fq >> 1)) * 128 + ((fq & 1) * 4 + 2) * 16 + fr);
            peer_cand(lds, vb, ptab, L03, L13, lane, fr, (2 * mt + (fq >> 1)) * 128 + ((fq & 1) * 4 + 3) * 16 + fr);
        }
        asm volatile("s_waitcnt lgkmcnt(0)" ::: "memory");
        __builtin_amdgcn_sched_barrier(0);
        peer_regroup16<6, false>(vb + fq * 1024, vb + 4096 + fq * 1024, lane, fr);
        asm volatile("s_waitcnt lgkmcnt(0)" ::: "memory"); __builtin_amdgcn_sched_barrier(0);
        peer_regroup16<10, true>(vb + 4096 + fq * 1024, el + fq * 512, lane, fr);
        asm volatile("s_waitcnt lgkmcnt(0)" ::: "memory"); __builtin_amdgcn_sched_barrier(0);
        const unsigned trsw = (unsigned)(4 * (fr >> 3) + ((fr & 7) >> 1));
        const unsigned trb = (unsigned)((fr >> 3) * 1024 + (fr & 7) * 128 + (fq & 1) * 8);
        const unsigned tr00 = trb + (((unsigned)(0 + (fq >> 1) + 0) ^ trsw) & 7u) * 16u, tr01 = trb + (((unsigned)(0 + (fq >> 1) + 2) ^ trsw) & 7u) * 16u;
        const unsigned tr10 = trb + (((unsigned)(4 + (fq >> 1) + 0) ^ trsw) & 7u) * 16u, tr11 = trb + (((unsigned)(4 + (fq >> 1) + 2) ^ trsw) & 7u) * 16u;
        const unsigned uofs = (unsigned)(fq * 64 + (fr & 3) * 16);
        const unsigned xofs = (unsigned)(128 * (fq >> 1) + 32 * (fr & 3) + 16 * (fq & 1));
        const int vsrc0 = (lane >> 3), vsrc1 = 8 + (lane >> 3);
        const unsigned vpo0 = (unsigned)((((lane & 7) ^ (0 + (lane >> 4))) & 7) * 16), vpo1 = (unsigned)((((lane & 7) ^ (4 + (lane >> 4))) & 7) * 16);
        const int awg = 2 * (fr >> 2) + (fr & 1);
        const bool aw00 = (((fr & 3) >> 1) == 0) && (awg == fq), aw01 = (((fr & 3) >> 1) == 0) && (awg == fq + 4), aw10 = (((fr & 3) >> 1) == 1) && (awg == fq), aw11 = (((fr & 3) >> 1) == 1) && (awg == fq + 4);
        { const int lane_t = (int)opq((unsigned)lane);
          v4u pw0[4], pw1[4]; f32x4 sa4[4], sb4[4];
#pragma unroll
          for (int tq = 0; tq < 4; ++tq) PEER_XLOAD(pw0[tq], pw1[tq], sa4[tq], sb4[tq], tok0 + tq, lane_t);
#pragma unroll
          for (int tq = 0; tq < 4; ++tq) { float xn[16]; PEER_XCALC(xn, pw0[tq], pw1[tq], sa4[tq], sb4[tq], lane_t);
            v4u xq;
#pragma unroll
            for (int c = 0; c < 4; ++c) xq[c] = pk4_fp8(__builtin_amdgcn_fmed3f(xn[4 * c] * PEER_XS, -448.f, 448.f), __builtin_amdgcn_fmed3f(xn[4 * c + 1] * PEER_XS, -448.f, 448.f),
                                                        __builtin_amdgcn_fmed3f(xn[4 * c + 2] * PEER_XS, -448.f, 448.f), __builtin_amdgcn_fmed3f(xn[4 * c + 3] * PEER_XS, -448.f, 448.f));
            *(LAS v4u*)(xal + tq * 1024 + lane_t * 16) = xq; } }
        asm volatile("s_waitcnt vmcnt(0) lgkmcnt(0)" ::: "memory");
        const LAS unsigned char* recp = el + fr * 4;
        unsigned r_cur = *(const LAS unsigned*)recp;
        v4u ub[8], ub2[8];
        PEER_ULOAD(ub, r_cur >> 16);
        PEER_VDMA(r_cur >> 16);
        f32x4 yacc[2][8];
#pragma unroll
        for (int p = 0; p < 2; ++p)
#pragma unroll
            for (int m = 0; m < 8; ++m) yacc[p][m] = (f32x4){0.f, 0.f, 0.f, 0.f};
#define PEER_STEP(T, NEXTOFS, UC, UN, HASNEXT) do { \
            unsigned r_nx = r_cur; \
            if (HASNEXT) { r_nx = *(const LAS unsigned*)(recp + (NEXTOFS)); PEER_ULOAD(UN, r_nx >> 16); } \
            const unsigned xo = opq(xofs + (T) * 1024u);              \
            v8i_p xs0, xs1; \
            { const v4u l0 = *(const LAS v4u*)(xal + xo), h0_ = *(const LAS v4u*)(xal + xo + 256), l1 = *(const LAS v4u*)(xal + xo + 512), h1_ = *(const LAS v4u*)(xal + xo + 768); \
              xs0[0] = (int)l0.x; xs0[1] = (int)l0.y; xs0[2] = (int)l0.z; xs0[3] = (int)l0.w; xs0[4] = (int)h0_.x; xs0[5] = (int)h0_.y; xs0[6] = (int)h0_.z; xs0[7] = (int)h0_.w; \
              xs1[0] = (int)l1.x; xs1[1] = (int)l1.y; xs1[2] = (int)l1.z; xs1[3] = (int)l1.w; xs1[4] = (int)h1_.x; xs1[5] = (int)h1_.y; xs1[6] = (int)h1_.z; xs1[7] = (int)h1_.w; } \
            float hsum = 0.f; \
            _Pragma("unroll") for (int e4 = 0; e4 < 4; ++e4) { v8i_p b0_, b1_; \
                b0_[0] = (int)UC[2 * e4].x; b0_[1] = (int)UC[2 * e4].y; b0_[2] = (int)UC[2 * e4].z; b0_[3] = (int)UC[2 * e4].w; b0_[4] = 0; b0_[5] = 0; b0_[6] = 0; b0_[7] = 0; \
                b1_[0] = (int)UC[2 * e4 + 1].x; b1_[1] = (int)UC[2 * e4 + 1].y; b1_[2] = (int)UC[2 * e4 + 1].z; b1_[3] = (int)UC[2 * e4 + 1].w; b1_[4] = 0; b1_[5] = 0; b1_[6] = 0; b1_[7] = 0; \
                f32x4 acc = (f32x4){0.f, 0.f, 0.f, 0.f}; \
                acc = __builtin_amdgcn_mfma_scale_f32_16x16x128_f8f6f4(xs0, b0_, acc, 0, 4, 0, 0x7F7F7F7F, 0, 0x7F7F7F7F); \
                acc = __builtin_amdgcn_mfma_scale_f32_16x16x128_f8f6f4(xs1, b1_, acc, 0, 4, 0, 0x7F7F7F7F, 0, 0x7F7F7F7F); \
                float val = ((fr & 3) == 0) ? acc[0] : (((fr & 3) == 1) ? acc[1] : (((fr & 3) == 2) ? acc[2] : acc[3])); \
                val += dppf<0xB1>(val); val += dppf<0x4E>(val);                                    \
                hsum = ((fr & 3) == e4) ? val : hsum; } \
            const float h = hsum * (1.f / (PEER_XS * FP4_SU)); \
            const float wq = __builtin_amdgcn_fmed3f(bf2f(r_cur & 0xffffu) * gelu_as(h) * PEER_WS, -448.f, 448.f); \
            *(LAS unsigned char*)(wbl + fr) = (unsigned char)(pk4_fp8(wq, 0.f, 0.f, 0.f) & 255u); \
            asm volatile("s_waitcnt lgkmcnt(0)" ::: "memory"); \
            const v4u W = *(const LAS v4u*)wbl; \
            const bool a0_ = ((T) & 1) ? aw10 : aw00, a1_ = ((T) & 1) ? aw11 : aw01; \
            v8i_p aw; aw[0] = a0_ ? (int)W.x : 0; aw[1] = a0_ ? (int)W.y : 0; aw[2] = a0_ ? (int)W.z : 0; aw[3] = a0_ ? (int)W.w : 0; \
            aw[4] = a1_ ? (int)W.x : 0; aw[5] = a1_ ? (int)W.y : 0; aw[6] = a1_ ? (int)W.z : 0; aw[7] = a1_ ? (int)W.w : 0; \
            if (HASNEXT) asm volatile("s_waitcnt vmcnt(8)" ::: "memory"); else asm volatile("s_waitcnt vmcnt(0)" ::: "memory");        \
            _Pragma("unroll") for (int m = 0; m < 8; ++m) { const v2i t0 = __builtin_amdgcn_ds_read_tr4_b64_v2i32((LAS v2i*)(vb + (m >> 1) * 2048 + ((m & 1) ? tr10 : tr00))), t1 = __builtin_amdgcn_ds_read_tr4_b64_v2i32((LAS v2i*)(vb + (m >> 1) * 2048 + ((m & 1) ? tr11 : tr01))); \
                v8i_p bv; bv[0] = t0[0]; bv[1] = t0[1]; bv[2] = t1[0]; bv[3] = t1[1]; bv[4] = 0; bv[5] = 0; bv[6] = 0; bv[7] = 0; \
                yacc[(T) >> 1][m] = __builtin_amdgcn_mfma_scale_f32_16x16x128_f8f6f4(aw, bv, yacc[(T) >> 1][m], 0, 4, 0, 0x7F7F7F7F, 0, 0x7F7F7F7F); } \
            asm volatile("s_waitcnt lgkmcnt(0)" ::: "memory"); \
            if (HASNEXT) PEER_VDMA(r_nx >> 16); \
            r_cur = r_nx; } while (0)
#pragma unroll 1
        for (int b = 0; b < 7; ++b) { PEER_STEP(0, b * 64 + 512, ub, ub2, 1); PEER_STEP(1, b * 64 + 1024, ub2, ub, 1); PEER_STEP(2, b * 64 + 1536, ub, ub2, 1); PEER_STEP(3, b * 64 + 64, ub2, ub, 1); }
        PEER_STEP(0, 7 * 64 + 512, ub, ub2, 1); PEER_STEP(1, 7 * 64 + 1024, ub2, ub, 1); PEER_STEP(2, 7 * 64 + 1536, ub, ub2, 1); PEER_STEP(3, 0, ub2, ub, 0);
#undef PEER_STEP
        { const int lane_t = (int)opq((unsigned)lane);
          v4u pw0[4], pw1[4]; f32x4 sa4[4], sb4[4];
#pragma unroll
          for (int tq = 0; tq < 4; ++tq) PEER_XLOAD(pw0[tq], pw1[tq], sa4[tq], sb4[tq], tok0 + tq, lane_t);
#define PEER_EPI(T) do { const int tok = tok0 + (T); LAS unsigned char* yb = vb + ((T) & 1) * 4096; \
            _Pragma("unroll") for (int m = 0; m < 8; ++m) { *(LAS float*)(yb + m * 512 + lane_t * 4) = yacc[(T) >> 1][m][2 * ((T) & 1)]; *(LAS float*)(yb + m * 512 + 256 + lane_t * 4) = yacc[(T) >> 1][m][2 * ((T) & 1) + 1]; } \
            float xn[16]; PEER_XCALC(xn, pw0[T], pw1[T], sa4[T], sb4[T], lane_t); \
            float yv[16]; \
            _Pragma("unroll") for (int q4 = 0; q4 < 4; ++q4) { const f32x4 t = *(const LAS f32x4*)(yb + lane_t * 64 + q4 * 16); yv[q4 * 4] = t.x; yv[q4 * 4 + 1] = t.y; yv[q4 * 4 + 2] = t.z; yv[q4 * 4 + 3] = t.w; } \
            float ssum = 0.f; \
            _Pragma("unroll") for (int i = 0; i < 16; ++i) { yv[i] = yv[i] * (1.f / (PEER_WS * FP4_SV)) + ALPHA * xn[i]; ssum += yv[i]; } \
            const float mean = wave_sum(ssum) * (1.f / D); \
            float s2 = 0.f; \
            _Pragma("unroll") for (int i = 0; i < 16; ++i) { yv[i] -= mean; s2 += yv[i] * yv[i]; } \
            const float rstd = 1.f / sqrtf(wave_sum(s2) * (1.f / D) + LN_EPS); \
            float* orow = P.out + (size_t)tok * 1024 + lane_t * 16; \
            _Pragma("unroll") for (int q4 = 0; q4 < 4; ++q4) { const f32x4 g0 = *(const GAS f32x4*)(P.in[19] + lane_t * 16 + q4 * 4), b0 = *(const GAS f32x4*)(P.in[20] + lane_t * 16 + q4 * 4); \
                f32x4 o; o.x = yv[q4 * 4] * rstd * g0.x + b0.x; o.y = yv[q4 * 4 + 1] * rstd * g0.y + b0.y; o.z = yv[q4 * 4 + 2] * rstd * g0.z + b0.z; o.w = yv[q4 * 4 + 3] * rstd * g0.w + b0.w; \
                *(GAS f32x4*)(orow + q4 * 4) = o; } } while (0)
          PEER_EPI(0); PEER_EPI(1); PEER_EPI(2); PEER_EPI(3); }
#undef PEER_EPI
        asm volatile("s_waitcnt vmcnt(0) lgkmcnt(0)" ::: "memory");
    }
}

struct Args { const float* in[21]; float* out; unsigned char* ws; int ph_lo, ph_hi; };
__global__ void __launch_bounds__(NWAVES * 64, 2) fwd_kernel(Args args) {
    extern __shared__ __attribute__((aligned(16))) unsigned char lds_raw[];
    LAS unsigned char* lds = (LAS unsigned char*)lds_raw;
    volatile LAS unsigned* MISC = (volatile LAS unsigned*)(lds + MISC_OFF);
    const int tid = threadIdx.x, lane = tid & 63, wave = __builtin_amdgcn_readfirstlane(tid >> 6);
    const int G = gridDim.x;
    Ptrs P;
#pragma unroll
    for (int i = 0; i < 21; ++i) P.in[i] = args.in[i];
    P.out = args.out; P.ws = args.ws;
    unsigned char* ws = args.ws;
    if (tid < 16) MISC[tid] = 0u;
    __syncthreads();
    XcdBarrier bar; bar.bar = (unsigned*)(ws + WS_CTL) + 4096; bar.x = 0; bar.st = nullptr;
    if (N_LAUNCHES == 1) bar = xcd_barrier_post((unsigned*)(ws + WS_CTL) + 4096, MISC + 8);
    const int lo = args.ph_lo, hi = args.ph_hi;
#ifndef PHMASK
#define PHMASK 0x1ff
#endif
#define IN(k) (((PHMASK >> (k)) & 1) && lo <= (k) && (k) < hi)
#define SEAM(k) do { if (IN(k) && IN((k) + 1)) xcd_barrier(bar); } while (0)

    if (IN(0)) { phase0(P, lds, tid, lane, wave, G); } SEAM(0);

    if (IN(1)) {
        if (blockIdx.x < 4) { const int n = blockIdx.x * 256 + (tid & 255); const float* part = (const float*)(ws + WS_CPART) + (tid >> 8) * 16 * 1024; float a = 0.f;
#pragma unroll
            for (int kb = 0; kb < 16; ++kb) a += part[kb * 1024 + n];
            ((float*)(ws + ((tid >> 8) ? WS_DVEC : WS_CVEC)))[n] = a; }
        for (int i = tid; i < WR_GATE; i += 512) ((LAS float*)(lds + RING_BYTES))[i] = ((const float*)(ws + WS_BIASIN))[i];
        __syncthreads();
        SchedP1 S{(const char*)ws, G, (int)blockIdx.x};
        EpiP1 E{(bf16*)P.out, ws, lds + RING_BYTES};
        pg8::gemm_phase<EpiP1, SchedP1, 2>(lds, S, E);
    } SEAM(1);

    if (IN(2)) {
        fft_step_mfma<1>((const bf16*)P.out, (bf16*)P.out + (size_t)NT * 1024, lds, tid, lane, wave, G);
        dil_attn_lds((const bf16*)(ws + WS_QK), (const bf16*)(ws + WS_VT), (const float*)(ws + WS_BIASTAB), (bf16*)(ws + WS_OG), (float*)(ws + WS_LSE), lds, tid, lane, wave, G);
        mem_attn_lds((const bf16*)(ws + WS_QC), (const bf16*)(ws + WS_MEMKV), (const bf16*)(ws + WS_MEMKV) + 512 * 512, (bf16*)(ws + WS_YCIN), lds, tid, lane, wave, G);
    } SEAM(2);

    if (IN(3)) {
        fft_step_mfma<2>((const bf16*)P.out + (size_t)NT * 1024, (bf16*)(ws + WS_FA), lds, tid, lane, wave, G);
        combine_groups((const bf16*)(ws + WS_OG), (const float*)(ws + WS_LSE), (bf16*)(ws + WS_OB), tid, G);
    } SEAM(3);

    if (IN(4)) {
        SchedP4 S{(const char*)ws, G, (int)blockIdx.x};
        for (int i = tid; i < 3072; i += 512) ((LAS float*)(lds + RING_BYTES))[i] = ((const float*)(ws + WS_BIASIN))[WR_GATE + i];
        __syncthreads();
        EpiP4 E{(bf16*)(ws + WS_MERGED), lds + RING_BYTES};
        pg8::gemm_phase<EpiP4, SchedP4, 2>(lds, S, E);
    } SEAM(4);

    if (IN(5)) {
        SchedPlain S{(const char*)(ws + WS_MERGED), (const char*)(ws + WS_WTO), G, (int)blockIdx.x, K_WO};
        EpiP5 E{(bf16*)(ws + WS_H0), (float*)(ws + WS_PRELN), (float*)(ws + WS_STATS4), lds + RING_BYTES};
        pg8::gemm_phase<EpiP5, SchedPlain>(lds, S, E);
    } SEAM(5);


    if (IN(7)) {
        SchedPlain S{(const char*)(ws + WS_H0), (const char*)(ws + WS_WTPQ), G, (int)blockIdx.x, K_PQ};
        EpiP7 E{(bf16*)(ws + WS_QP), (const float*)(ws + WS_STATS4), (const float*)(ws + WS_CVEC), (const float*)(ws + WS_DVEC), lds + EPI_SCR};
        pg8::gemm_phase<EpiP7, SchedPlain>(lds, S, E);
    } SEAM(7);

    if (IN(8)) {
        peer_v2(P, lds, tid, lane, wave, G);
    }
#undef IN
#undef SEAM
}

extern "C" void kernel_launch(void* const* d_in, const int* in_sizes, int n_in, void* d_out, int out_size, void* d_ws, size_t ws_size, hipStream_t stream) {
    static int grid = 0;
    if (grid == 0) {
        if (n_in != 21 || out_size != NT * D || ws_size < WS_END) { fprintf(stderr, "kernel_launch: unexpected shapes (n_in %d, out %d, ws %zu); nothing launched\n", n_in, out_size, ws_size); grid = -1; return; }
        int dev = 0, cus = 0, per_cu = 0;
        if (hipGetDevice(&dev) != hipSuccess || hipDeviceGetAttribute(&cus, hipDeviceAttributeMultiprocessorCount, dev) != hipSuccess) { grid = -1; return; }
        if (hipFuncSetAttribute((const void*)fwd_kernel, hipFuncAttributeMaxDynamicSharedMemorySize, LDS_BYTES) != hipSuccess) { fprintf(stderr, "kernel_launch: hipFuncSetAttribute failed\n"); grid = -1; return; }
        if (hipOccupancyMaxActiveBlocksPerMultiprocessor(&per_cu, (const void*)fwd_kernel, NWAVES * 64, LDS_BYTES) != hipSuccess || per_cu < 1) { fprintf(stderr, "kernel_launch: occupancy query says %d\n", per_cu); }
        (void)hipGetLastError();
        grid = cus;
    }
    if (grid < 0) return;
    (void)hipMemsetAsync((char*)d_ws + WS_CTL, 0, CTL_ZERO_BYTES, stream);
    Args a{};
    for (int i = 0; i < 21; ++i) a.in[i] = (const float*)d_in[i];
    a.out = (float*)d_out; a.ws = (unsigned char*)d_ws;
    if (N_LAUNCHES == 1) { a.ph_lo = 0; a.ph_hi = NPH; hipLaunchKernelGGL(fwd_kernel, dim3(grid), dim3(NWAVES * 64), LDS_BYTES, stream, a); }
    else for (int ph = 0; ph < NPH; ++ph) { a.ph_lo = ph; a.ph_hi = ph + 1; hipLaunchKernelGGL(fwd_kernel, dim3(grid), dim3(NWAVES * 64), LDS_BYTES, stream, a); }
}
```

```cpp
#include <hip/hip_runtime.h>
#include <cstdio>
#include <cstdint>

#ifndef P5_FP8
#define P5_FP8 1
#endif
#ifndef YA_FP8
#define YA_FP8 1
#endif
#ifndef ZA_FP8
#define ZA_FP8 1
#endif
#ifndef TABU_FP4
#define TABU_FP4 1
#endif
#ifndef TABV_FP4
#define TABV_FP4 1
#endif
#ifndef TAB_FP6
#define TAB_FP6 1
#endif
static_assert(TAB_FP6 == 1, "the workspace map assumes 12 MiB fp6 expert tables");
static_assert(TABU_FP4 == 1 && TABV_FP4 == 1, "pack_tables writes fp4 tables");
#ifndef TABLES_IN_P4
#define TABLES_IN_P4 1
#endif
#ifndef TAB_FP8
#define TAB_FP8 1
#endif
#ifndef N_LAUNCHES
#define N_LAUNCHES 1
#endif

#define GAS __attribute__((address_space(1)))
#define LAS __attribute__((address_space(3)))
typedef unsigned short bf16;
typedef unsigned v4u __attribute__((ext_vector_type(4)));
typedef unsigned v2u __attribute__((ext_vector_type(2)));
typedef float f32x4 __attribute__((ext_vector_type(4)));
typedef float f32x2 __attribute__((ext_vector_type(2)));
typedef short bf16x8 __attribute__((ext_vector_type(8)));

constexpr int NT = 32768, SEQ = 16384, D = 1024;
constexpr int NPH = 9;
constexpr float ALPHA = 1.189207115002721f;
constexpr float LN_EPS = 1e-5f;
constexpr int NWAVES = 8;

constexpr size_t MiB = 1u << 20;
constexpr size_t WS_CTL = 0, CTL_ZERO_BYTES = 32 * 1024;
constexpr size_t WS_CPART = 256 * 1024;
constexpr size_t WS_STATS = 512 * 1024;
constexpr size_t WS_CVEC = 768 * 1024, WS_DVEC = 772 * 1024;
constexpr size_t WS_BIASIN = 1 * MiB;
constexpr size_t WS_STATS4 = 4 * MiB;
constexpr size_t WS_BIASTAB = 1 * MiB + 64 * 1024;
constexpr size_t WS_WTIN = 2 * MiB;
constexpr size_t WS_WTA = 16 * MiB, WS_WTB = 17 * MiB, WS_WTC = 18 * MiB, WS_WTO = 19 * MiB, WS_WTPQ = 21 * MiB, WS_WTMKV = 23 * MiB;
constexpr size_t WS_MEMB = 25 * MiB, WS_MEMKV = 26 * MiB;
constexpr size_t WS_MEMF8 = 27 * MiB, WS_WMKVF8 = 28 * MiB;
constexpr size_t WS_UTAB = 32 * MiB, WS_VTAB = 44 * MiB;
constexpr size_t WS_H0F8 = 56 * MiB;
constexpr size_t WS_WF8IN = 88 * MiB;
constexpr size_t WS_H0 = 96 * MiB;
constexpr size_t WS_QK = 160 * MiB;
constexpr size_t WS_VT = 256 * MiB;
constexpr size_t WS_QC = 304 * MiB;
constexpr size_t WS_OG = 336 * MiB;
constexpr size_t WS_LSE = 384 * MiB;
constexpr size_t WS_YCIN = 386 * MiB;
constexpr size_t WS_FA = 418 * MiB;
constexpr size_t WS_OB = 450 * MiB;
constexpr size_t WS_GSCR = 466 * MiB;
constexpr size_t WS_MERGED = WS_QK;
constexpr size_t WS_PRELN = 224 * MiB;
constexpr size_t WS_H1B = WS_H0;
constexpr size_t WS_QP = WS_QK;
constexpr size_t WS_END = 498 * MiB;

constexpr int WR_A = 0, WR_QK = 1024, WR_V = 2560, WR_QC = 3328, WR_GATE = 3840, WR_END = 6912;

constexpr int RING_BYTES = 131072;
constexpr int LDS_BYTES = 155648;
constexpr int MISC_OFF = LDS_BYTES - 256;
constexpr int EPI_SCR = RING_BYTES + 3840 * 4;
static_assert(EPI_SCR + 8 * 1024 <= MISC_OFF, "bias copy and epilogue tiles fit the spare LDS above the GEMM stage buffers");

#define RLX_AGENT __ATOMIC_RELAXED, __HIP_MEMORY_SCOPE_AGENT
#define LDS_WAIT() asm volatile("s_waitcnt lgkmcnt(0)" ::: "memory")
#define VM_WAIT() asm volatile("s_waitcnt vmcnt(0)" ::: "memory")

__device__ __forceinline__ unsigned f2bf(float f) { unsigned u = __builtin_bit_cast(unsigned, f); return (u + 0x7fffu + ((u >> 16) & 1u)) >> 16; }
typedef __bf16 bf16x2_hw __attribute__((ext_vector_type(2)));
__device__ __forceinline__ unsigned pk2(float lo, float hi) { f32x2 v; v.x = lo; v.y = hi; return __builtin_bit_cast(unsigned, __builtin_convertvector(v, bf16x2_hw)); }
__device__ __forceinline__ unsigned pk4_fp8(float a, float b, float c, float d) { int p = __builtin_amdgcn_cvt_pk_fp8_f32(a, b, 0, false); p = __builtin_amdgcn_cvt_pk_fp8_f32(c, d, p, true); return (unsigned)p; }
__device__ __forceinline__ float bf2f(unsigned b) { return __builtin_bit_cast(float, b << 16); }
__device__ __forceinline__ float bflo(unsigned w) { return __builtin_bit_cast(float, w << 16); }
__device__ __forceinline__ float bfhi(unsigned w) { return __builtin_bit_cast(float, w & 0xffff0000u); }
__device__ __forceinline__ float wave_sum(float v) {
#pragma unroll
    for (int o = 1; o < 64; o <<= 1) v += __shfl_xor(v, o);
    return v;
}
__device__ __forceinline__ float wave_max(float v) {
#pragma unroll
    for (int o = 1; o < 64; o <<= 1) v = fmaxf(v, __shfl_xor(v, o));
    return v;
}

#define XB_TMO      128
#define XB_XCNT(j)  (256  + 64 * (j))
#define XB_XSUB(j)  (1280 + 64 * (j))
#define XB_XGEN(j)  (2304 + 64 * (j))
#define XB_TOP      3328
#define XB_TOPGEN   3392
#define XCD_BAR_WORDS 3456
#define XB_SPIN_CAP (1u << 18)

__device__ __forceinline__ unsigned xb_ld(unsigned* p)              { return __hip_atomic_load(p, __ATOMIC_RELAXED, __HIP_MEMORY_SCOPE_AGENT); }
__device__ __forceinline__ unsigned xb_add(unsigned* p, unsigned v) { return __hip_atomic_fetch_add(p, v, __ATOMIC_RELAXED, __HIP_MEMORY_SCOPE_AGENT); }
__device__ __forceinline__ unsigned xb_xcc_id() { return (unsigned)__builtin_amdgcn_s_getreg((3 << 11) | 20) & 0xFu; }
#define XB_SPIN(cond, bar) do { unsigned _sp = 0; while (cond) { __builtin_amdgcn_s_sleep(1); \
    if ((++_sp & 255u) == 0u) { if (xb_ld(&(bar)[XB_TMO])) break; if (_sp > XB_SPIN_CAP) { atomicAdd(&(bar)[XB_TMO], 1u); break; } } } } while (0)

struct XcdBarrier {
    unsigned* bar; unsigned x;
    volatile LAS unsigned* st;
};
__device__ __forceinline__ XcdBarrier xcd_barrier_post(unsigned* bar, volatile LAS unsigned* st) {
    XcdBarrier b; b.bar = bar; b.x = xb_xcc_id(); b.st = st;
    if (threadIdx.x == 0) (void)xb_add(&bar[XB_XCNT(b.x)], 1u);
    return b;
}
__device__ __forceinline__ void xcd_barrier_complete(unsigned* bar, unsigned x, unsigned& nloc, unsigned& nx) {
    const unsigned G = gridDim.x * gridDim.y * gridDim.z;
    unsigned sum, cnt, mine, sp = 0u;
    for (;;) {
        sum = 0u; cnt = 0u; mine = 0u;
#pragma unroll
        for (unsigned j = 0; j < 16; ++j) { const unsigned c = xb_ld(&bar[XB_XCNT(j)]); sum += c; cnt += (c > 0u) ? 1u : 0u; mine = (j == x) ? c : mine; }
        if (sum == G) break;
        __builtin_amdgcn_s_sleep(1);
        if ((++sp & 255u) == 0u) { if (xb_ld(&bar[XB_TMO])) break; if (sp > XB_SPIN_CAP) { atomicAdd(&bar[XB_TMO], 1u); break; } }
    }
    nloc = mine > 0u ? mine : 1u; nx = cnt > 0u ? cnt : 1u;
}
__device__ __forceinline__ void xcd_barrier(const XcdBarrier& b) {
    asm volatile("s_waitcnt vmcnt(0)" ::: "memory");
    __syncthreads();
    if (threadIdx.x == 0) {
        unsigned* bar = b.bar;
        __builtin_amdgcn_s_waitcnt(0);
        unsigned nloc = b.st[0], nx = b.st[1];
        if (nloc == 0u) { xcd_barrier_complete(bar, b.x, nloc, nx); b.st[0] = nloc; b.st[1] = nx; }
        const unsigned old = xb_add(&bar[XB_XSUB(b.x)], 1u);
        const unsigned gen = old / nloc;
        if (old + 1u == (gen + 1u) * nloc) {
            __builtin_amdgcn_fence(__ATOMIC_RELEASE, "agent");
            asm volatile("s_waitcnt vmcnt(0)" ::: "memory");
            const unsigned og = xb_add(&bar[XB_TOP], 1u);
            const unsigned tg = og / nx;
            if (og + 1u == (tg + 1u) * nx) xb_add(&bar[XB_TOPGEN], 1u);
            else XB_SPIN(xb_ld(&bar[XB_TOPGEN]) == tg, bar);
            __builtin_amdgcn_fence(__ATOMIC_ACQUIRE, "agent");
            xb_add(&bar[XB_XGEN(b.x)], 1u);
            asm volatile("s_waitcnt vmcnt(0)" ::: "memory");
        } else {
            XB_SPIN(xb_ld(&bar[XB_XGEN(b.x)]) == gen, bar);
            __builtin_amdgcn_fence(__ATOMIC_ACQUIRE, "agent");
            asm volatile("s_waitcnt vmcnt(0)" ::: "memory");
        }
    }
    __syncthreads();
}

namespace pg8 {
constexpr int BM = 256, BK = 64, HALF = 128, HTB = HALF * BK * 2, STAGE_BYTES = 8 * HTB;
__host__ __device__ __forceinline__ int lds_byte(int r, int c) { const int st = (r >> 4) * 2 + (c >> 5), rr = r & 15, cc = c & 31, ob = rr * 64 + cc * 2; return st * 1024 + (ob ^ (((ob >> 9) & 1) << 5)); }
__host__ __device__ __forceinline__ void stage_rc(int b, int& R, int& C) { const int st = b / 1024, sb = b % 1024, swz = sb ^ (((sb >> 9) & 1) << 5); R = (st >> 1) * 16 + swz / 64; C = (st & 1) * 32 + (swz % 64) / 2; }
__host__ __device__ __forceinline__ int perm32(int rho) { const int n = rho >> 4, i = rho & 15; return 8 * (i >> 2) + 4 * n + (i & 3); }

struct GUnit { const char* a; const char* b; unsigned sa, sb; int nt; int pm, pn, kind; };

typedef int v8i __attribute__((ext_vector_type(8)));
constexpr int K_FP8 = 1 << 16;
__device__ __forceinline__ unsigned pg8_rb(unsigned ra) { asm volatile("" : "+v"(ra)); const unsigned rho = ra & 31u, n = rho >> 4, i = rho & 15u; return (ra & ~31u) + 8u * (i >> 2) + 4u * n + (i & 3u); }
template <class Epi, class Sched, int MODE = 0>
__device__ __forceinline__ void gemm_phase(LAS unsigned char* lds, const Sched& S, const Epi& E) {
    const int tid = threadIdx.x, wid = __builtin_amdgcn_readfirstlane(tid >> 6), lane = tid & 63, wr = wid >> 2, wc = wid & 3, fr = lane & 15, fq = lane >> 4;
    int R0, C0; stage_rc(tid * 16, R0, C0);
    const unsigned RA = (unsigned)R0, C2 = (unsigned)C0 * 2u;
#define RB pg8_rb(RA)
    const size_t kstep = (size_t)(BK * 2);
    const unsigned ldsw = (unsigned)wid * 1024u;
    const int aoff = lds_byte(wr * 64 + fr, fq * 8), boff = lds_byte(wc * 32 + fr, fq * 8);
#define PG8_SA(b, h) (((b) * 2 + (h)) * HTB)
#define PG8_SB(b, h) ((4 + (b) * 2 + (h)) * HTB)
#define PG8_STAGE(bufoff, gbase, RR, stride) do { const unsigned _vo = (RR) * (unsigned)(stride) + C2; const char* _g = (const char*)(gbase); \
        __builtin_amdgcn_global_load_lds((const unsigned*)(_g + _vo), (LAS unsigned*)(lds + (bufoff) + ldsw), 16, 0, 0); \
        __builtin_amdgcn_global_load_lds((const unsigned*)(_g + (size_t)64 * (stride) + _vo), (LAS unsigned*)(lds + (bufoff) + ldsw + 8192), 16, 0, 0); } while (0)
#define PG8_LDA(dst, b, h) do { _Pragma("unroll") for (int m = 0; m < 4; ++m) _Pragma("unroll") for (int k = 0; k < 2; ++k) dst[m][k] = *(const LAS bf16x8*)(lds + PG8_SA(b, h) + aoff + m * 2048 + k * 1024); } while (0)
#define PG8_LDB(dst, b, h) do { _Pragma("unroll") for (int n = 0; n < 2; ++n) _Pragma("unroll") for (int k = 0; k < 2; ++k) dst[n][k] = *(const LAS bf16x8*)(lds + PG8_SB(b, h) + boff + n * 2048 + k * 1024); } while (0)
#define PG8_CAT(lo, hi) __builtin_bit_cast(v8i, __builtin_shufflevector(lo, hi, 0, 1, 2, 3, 4, 5, 6, 7, 8, 9, 10, 11, 12, 13, 14, 15))
#define PG8_MMA_BF(ai, bj, At, Bt) do { __builtin_amdgcn_s_setprio(1); _Pragma("unroll") for (int m = 0; m < 4; ++m) _Pragma("unroll") for (int n = 0; n < 2; ++n) _Pragma("unroll") for (int k = 0; k < 2; ++k) \
        acc[ai][bj][m][n] = __builtin_amdgcn_mfma_f32_16x16x32_bf16(Bt[n][k], At[m][k], acc[ai][bj][m][n], 0, 0, 0); __builtin_amdgcn_s_setprio(0); } while (0)
#define PG8_MMA_F8(ai, bj, At, Bt) do { __builtin_amdgcn_s_setprio(1); _Pragma("unroll") for (int m = 0; m < 4; ++m) _Pragma("unroll") for (int n = 0; n < 2; ++n) \
        acc[ai][bj][m][n] = __builtin_amdgcn_mfma_scale_f32_16x16x128_f8f6f4(PG8_CAT(Bt[n][0], Bt[n][1]), PG8_CAT(At[m][0], At[m][1]), acc[ai][bj][m][n], 0, 0, 0, 0x7F7F7F7F, 0, 0x7F7F7F7F); __builtin_amdgcn_s_setprio(0); } while (0)
#define PG8_WAIT_V(n) asm volatile("s_waitcnt vmcnt(" #n ")" ::: "memory")
#define PG8_WAIT_L(n) asm volatile("s_waitcnt lgkmcnt(" #n ")" ::: "memory")
#define PG8_BAR __builtin_amdgcn_s_barrier()
#define PG8_SCHED __builtin_amdgcn_sched_barrier(0)
#define PG8_KLOOP(MMA) \
        for (int t = 0; t < nt; t += 2) { \
            const bool last = (t == nt - 2); \
            const char* a1 = cA + (size_t)(t + 1) * kstep; \
            const char* a2 = last ? nxt.a : cA + (size_t)(t + 2) * kstep; const char* b2 = last ? nxt.b : cB + (size_t)(t + 2) * kstep; \
            const unsigned sa2 = last ? nxt.sa : csa, sb2 = last ? nxt.sb : csb; const size_t hA2 = (size_t)HALF * sa2, hB2 = (size_t)HALF * sb2; \
            const char* a3 = a2 + kstep; const char* b3 = b2 + kstep; \
            PG8_LDB(B0, 0, 0); PG8_LDB(B1, 0, 1); PG8_SCHED; PG8_LDA(At, 0, 0); PG8_STAGE(PG8_SA(1, 1), a1 + hA, RA, csa); \
            PG8_WAIT_V(8); PG8_WAIT_L(0); PG8_BAR; MMA(0, 0, At, B0); MMA(0, 1, At, B1); PG8_BAR; PG8_SCHED; \
            PG8_LDA(At, 0, 1); PG8_STAGE(PG8_SB(0, 0), b2, RB, sb2); PG8_STAGE(PG8_SB(0, 1), b2 + hB2, RB, sb2); PG8_STAGE(PG8_SA(0, 0), a2, RA, sa2); \
            PG8_WAIT_V(8); PG8_WAIT_L(0); PG8_BAR; MMA(1, 0, At, B0); MMA(1, 1, At, B1); PG8_BAR; PG8_SCHED; \
            PG8_LDB(B0, 1, 0); PG8_LDB(B1, 1, 1); PG8_SCHED; PG8_LDA(At, 1, 0); PG8_STAGE(PG8_SA(0, 1), a2 + hA2, RA, sa2); \
            PG8_WAIT_V(8); PG8_WAIT_L(0); PG8_BAR; MMA(0, 0, At, B0); MMA(0, 1, At, B1); PG8_BAR; PG8_SCHED; \
            PG8_LDA(At, 1, 1); PG8_STAGE(PG8_SB(1, 0), b3, RB, sb2); PG8_STAGE(PG8_SB(1, 1), b3 + hB2, RB, sb2); PG8_STAGE(PG8_SA(1, 0), a3, RA, sa2); \
            PG8_WAIT_V(8); PG8_WAIT_L(0); PG8_BAR; MMA(1, 0, At, B0); MMA(1, 1, At, B1); PG8_BAR; PG8_SCHED; \
        }
    GUnit cur, nxt; int ui = 0;
    if (!S.next(0, cur)) return;
    f32x4 acc[2][2][4][2];
#pragma unroll
    for (int a = 0; a < 2; ++a)
#pragma unroll
        for (int b = 0; b < 2; ++b)
#pragma unroll
            for (int m = 0; m < 4; ++m)
#pragma unroll
                for (int n = 0; n < 2; ++n) acc[a][b][m][n] = (f32x4){0.f, 0.f, 0.f, 0.f};
    bf16x8 At[4][2], B0[2][2], B1[2][2];
    unsigned keep[2][2][4][2];
    {
        const char* cA = cur.a; const char* cB = cur.b; const size_t hA = (size_t)HALF * cur.sa, hB = (size_t)HALF * cur.sb;
        PG8_STAGE(PG8_SB(0, 0), cB, RB, cur.sb); PG8_STAGE(PG8_SB(0, 1), cB + hB, RB, cur.sb); PG8_STAGE(PG8_SA(0, 0), cA, RA, cur.sa); PG8_STAGE(PG8_SA(0, 1), cA + hA, RA, cur.sa);
        if (wr == 1) PG8_BAR;
        PG8_WAIT_V(2); PG8_BAR;
        PG8_STAGE(PG8_SB(1, 0), cB + kstep, RB, cur.sb); PG8_STAGE(PG8_SA(1, 0), cA + kstep, RA, cur.sa); PG8_STAGE(PG8_SB(1, 1), cB + hB + kstep, RB, cur.sb);
        PG8_WAIT_V(6); PG8_BAR;
    }
    for (;;) {
        const bool has_next = S.next(ui + 1, nxt);
        if (!has_next) { nxt = cur; }
        const char* cA = cur.a; const char* cB = cur.b; const unsigned csa = cur.sa, csb = cur.sb; const size_t hA = (size_t)HALF * csa, hB = (size_t)HALF * csb;
        const int nt = cur.nt; const bool cur_fp8 = (cur.kind & K_FP8) != 0; (void)cur_fp8;
        if (MODE == 1 || (MODE == 2 && cur_fp8)) { PG8_KLOOP(PG8_MMA_F8) } else { PG8_KLOOP(PG8_MMA_BF) }
        if (wr == 0) PG8_BAR;
        E(acc, keep, cur, wr, wc, fr, fq);
        if (!has_next) break;
#pragma unroll
        for (int a = 0; a < 2; ++a)
#pragma unroll
            for (int b = 0; b < 2; ++b)
#pragma unroll
                for (int m = 0; m < 4; ++m)
#pragma unroll
                    for (int n = 0; n < 2; ++n) acc[a][b][m][n] = (f32x4){0.f, 0.f, 0.f, 0.f};
        cur = nxt; ++ui;
        if (wr == 1) PG8_BAR;
    }
    PG8_WAIT_V(0);
    PG8_BAR;
#undef PG8_SA
#undef PG8_SB
#undef PG8_STAGE
#undef PG8_LDA
#undef PG8_LDB
#undef PG8_MMA_BF
#undef PG8_MMA_F8
#undef PG8_KLOOP
#undef RB
#undef PG8_CAT
#undef PG8_WAIT_V
#undef PG8_WAIT_L
#undef PG8_BAR
#undef PG8_SCHED
}
}
using pg8::GUnit; using pg8::K_FP8;

__device__ __forceinline__ int tok0_of(int p, int g) {
    const int n = p << 8, b = n >> 14, rem = n & 16383, sh = 2 * g;
    const int r = rem >> (14 - sh), l0 = rem & ((16384 >> sh) - 1);
    return (b << 14) + (l0 << sh) + r;
}
__device__ __forceinline__ void tile_of(int t, int nN, int& pm, int& pn) { const int nig = 8 * nN, gid = t / nig, w = t % nig; pm = gid * 8 + (w & 7); pn = w >> 3; }

struct Ptrs {
    const float* in[21]; float* out; unsigned char* ws;
};

enum { K_ZA = 0, K_QK = 1, K_VT = 2, K_QC = 3, K_MKV = 4, K_GATE = 5, K_YA = 6, K_YB = 7, K_YC = 8, K_WO = 9, K_PQ = 10 };
struct SchedP1 {
    const char* wsb; int G, c;
    static constexpr int NLONG = 512, NSHORT = 768 + 384 + 256 + 8;
    __device__ __forceinline__ bool next(int i, GUnit& u) const {
        const char* const h0b = wsb + WS_H0; const char* const wtb = wsb + WS_WTIN; const char* const h0 = wsb + WS_H0F8; const char* const wtin = wsb + WS_WF8IN; const char* const memb = wsb + WS_MEMF8; const char* const wtmkv = wsb + WS_WMKVF8;
        const int nshort = (NSHORT - c + G - 1) / G, nslots = 2 + nshort; if (i >= nslots) return false;
        const int k = (c >> 3) & 3; int pa = k % nslots, pb = (k + 4) % nslots; if (pa > pb) { const int t_ = pa; pa = pb; pb = t_; }
        int j; if (i == pa) j = 0; else if (i == pb) j = 1; else j = 2 + i - (i > pa ? 1 : 0) - (i > pb ? 1 : 0);
        const int L = j * G + c; if (L >= NLONG + NSHORT) return false;
        if (L < NLONG) { const int T = (G % 8 == 0) ? (L % 8) * (NLONG / 8) + L / 8 : L; int pm, pn; tile_of(T, 4, pm, pn);
            if (ZA_FP8) { u.a = h0 + (size_t)pm * 256 * 1024; u.b = wtin + (size_t)(WR_A + pn * 256) * 1024; u.sa = 1024; u.sb = 1024; u.nt = 8; u.pm = pm; u.pn = pn; u.kind = K_ZA | K_FP8; return true; }
            u.a = h0b + (size_t)pm * 256 * 2048; u.b = wtb + (size_t)(WR_A + pn * 256) * 2048; u.sa = 2048; u.sb = 2048; u.nt = 16; u.pm = pm; u.pn = pn; u.kind = K_ZA; return true; }
        const int Ls = L - NLONG; int T = (NSHORT % 8 == 0 && G % 8 == 0) ? (Ls % 8) * (NSHORT / 8) + Ls / 8 : Ls;
        u.nt = 8; u.sa = 1024; u.sb = 1024;
        if (T < 768) { const int g = T >> 8; int pm, pn; tile_of(T & 255, 2, pm, pn); u.a = h0 + (size_t)tok0_of(pm, g) * 1024; u.sa = 1024u << (2 * g);
            u.b = wtin + (size_t)(WR_QK + g * 512 + pn * 256) * 1024; u.pm = pm; u.pn = pn; u.kind = K_QK | (g << 8) | K_FP8; return true; }
        T -= 768;
        if (T < 384) { const int g = T >> 7, pn = T & 127; u.a = wtin + (size_t)(WR_V + g * 256) * 1024; u.b = h0 + (size_t)tok0_of(pn, g) * 1024; u.sb = 1024u << (2 * g);
            u.pm = 0; u.pn = pn; u.kind = K_VT | (g << 8) | K_FP8; return true; }
        T -= 384;
        if (T < 256) { int pm, pn; tile_of(T, 2, pm, pn); u.a = h0 + (size_t)pm * 256 * 1024; u.b = wtin + (size_t)(WR_QC + pn * 256) * 1024; u.pm = pm; u.pn = pn; u.kind = K_QC | K_FP8; return true; }
        T -= 256;
        if (T < 4) { const int pm = T >> 1, pn = T & 1; u.a = memb + (size_t)pm * 256 * 1024; u.b = wtmkv + (size_t)pn * 256 * 1024; u.pm = pm; u.pn = pn; u.kind = K_MKV | K_FP8; return true; }
        T -= 4;
        { const int pm = T >> 1, pn = T & 1; u.a = wtmkv + (size_t)(512 + pm * 256) * 1024; u.b = memb + (size_t)pn * 256 * 1024; u.pm = pm; u.pn = pn; u.kind = K_MKV | (1 << 8) | K_FP8; return true; }
    }
};
__device__ __forceinline__ void out_tile_of(int L, int G, int& pm, int& pn) {
    const int T = (G % 8 == 0) ? (L % 8) * 64 + L / 8 : L; tile_of(T, 4, pm, pn);
}
struct SchedP4 {
    const char* wsb; int G, c;
    __device__ __forceinline__ bool next(int i, GUnit& u) const {
        const int io = i / 6, s = i - io * 6; const int L = io * G + c; if (L >= 512) return false;
        int pm, pn; out_tile_of(L, G, pm, pn); u.pm = pm; u.pn = pn;
        if ((s & 1) == 0) { const int gi = s >> 1; u.a = wsb + WS_H0F8 + (size_t)pm * 256 * 1024; u.sa = 1024; u.b = wsb + WS_WF8IN + (size_t)(WR_GATE + gi * 1024 + pn * 256) * 1024; u.sb = 1024; u.nt = 8; u.kind = K_GATE | (gi << 8) | ((io != 0 ? 1 : 0) << 12) | K_FP8; return true; }
        if (s == 1) { if (YA_FP8) { u.a = wsb + WS_FA + (size_t)pm * 256 * 512; u.sa = 512; u.b = wsb + WS_WTA + (size_t)pn * 256 * 512; u.sb = 512; u.nt = 4; u.kind = K_YA | K_FP8; return true; }
            u.a = wsb + WS_FA + (size_t)pm * 256 * 1024; u.sa = 1024; u.b = wsb + WS_WTA + (size_t)pn * 256 * 1024; u.sb = 1024; u.nt = 8; u.kind = K_YA; return true; }
        if (s == 3) { u.a = wsb + WS_OB + (size_t)pm * 256 * 256; u.sa = 256; u.b = wsb + WS_WTB + (size_t)pn * 256 * 256; u.sb = 256; u.nt = 2; u.kind = K_YB | K_FP8; return true; }
        u.a = wsb + WS_YCIN + (size_t)pm * 256 * 512; u.sa = 512; u.b = wsb + WS_WTC + (size_t)pn * 256 * 512; u.sb = 512; u.nt = 4; u.kind = K_YC | K_FP8; return true;
    }
};
struct SchedPlain {
    const char* a; const char* b; int G, c, kind, esz;
    __device__ __forceinline__ bool next(int i, GUnit& u) const {
        const int L = i * G + c; if (L >= 512) return false;
        int pm, pn; out_tile_of(L, G, pm, pn); u.pm = pm; u.pn = pn; u.a = a + (size_t)pm * 256 * 1024 * esz; u.b = b + (size_t)pn * 256 * 1024 * esz; { unsigned st_ = 1024u * esz; int nt_ = 8 * esz; asm volatile("" : "+s"(st_), "+s"(nt_)); u.sa = st_; u.sb = st_; u.nt = nt_; }
        u.kind = kind | (esz == 1 ? K_FP8 : 0); return true;
    }
};
__device__ __forceinline__ unsigned opq(unsigned x) { asm volatile("" : "+v"(x)); return x; }
__device__ __forceinline__ v4u pack8(f32x4 v0, f32x4 v1) { v4u o; o.x = pk2(v0[0], v0[1]); o.y = pk2(v0[2], v0[3]); o.z = pk2(v1[0], v1[1]); o.w = pk2(v1[2], v1[3]); return o; }
__device__ __forceinline__ void unpack8(v4u w, f32x4& a, f32x4& b) { a[0] = bflo(w.x); a[1] = bfhi(w.x); a[2] = bflo(w.y); a[3] = bfhi(w.y); b[0] = bflo(w.z); b[1] = bfhi(w.z); b[2] = bflo(w.w); b[3] = bfhi(w.w); }
#define EPI_LOOP(ai, m, bj) _Pragma("unroll") for (int ai = 0; ai < 2; ++ai) _Pragma("unroll") for (int m = 0; m < 4; ++m) _Pragma("unroll") for (int bj = 0; bj < 2; ++bj)

constexpr float W8SC = 32.f, W8INV = 1.f / 32.f;
constexpr float SC_MRG = 16.f;
constexpr size_t WS_MRGF8 = 336 * MiB, WS_WTOF8 = 23 * MiB;
constexpr float SC_WBC = 16.f, SC_ACT = 4.f;
struct EpiP1 {
    bf16* za; unsigned char* wsb; const LAS unsigned char* bias;
    __device__ __forceinline__ void operator()(f32x4 (&acc)[2][2][4][2], unsigned (&keep)[2][2][4][2], const GUnit& u, int wr, int wc, int fr, int fq) const {
        bf16* const qk = (bf16*)(wsb + WS_QK); bf16* const vt = (bf16*)(wsb + WS_VT); bf16* const qc = (bf16*)(wsb + WS_QC); bf16* const memkv = (bf16*)(wsb + WS_MEMKV);
        const int kind = u.kind & 255, g = (u.kind >> 8) & 255; const float asc = (u.kind & K_FP8) ? W8INV : 1.f;
        const unsigned rl0 = opq((unsigned)(wr * 64 + fr)), cl0 = opq((unsigned)(wc * 32 + 8 * fq));
        if (kind == K_VT) {
            char* base = (char*)(vt + (size_t)g * 256 * NT + (size_t)u.pn * 256); const LAS unsigned char* bb = bias + (WR_V + g * 256) * 4;
            const unsigned lo = rl0 * (unsigned)(NT * 2) + cl0 * 2u;
#pragma unroll
            for (int ai = 0; ai < 2; ++ai)
#pragma unroll
                for (int m = 0; m < 4; ++m) { const float br = *(const LAS float*)(bb + (rl0 + ai * 128 + m * 16) * 4u);
#pragma unroll
                    for (int bj = 0; bj < 2; ++bj) *(GAS v4u*)(base + (lo + (unsigned)((ai * 128 + m * 16) * NT * 2 + bj * 256))) = pack8(acc[ai][bj][m][0] * asc + br, acc[ai][bj][m][1] * asc + br);
                    __builtin_amdgcn_sched_barrier(0); }
            return;
        }
        char* base; unsigned ldb; const LAS unsigned char* bb; bool hasb = true;
        if (kind == K_ZA) { base = (char*)(za + (size_t)u.pm * 256 * 1024 + u.pn * 256); ldb = 2048; bb = bias + (WR_A + u.pn * 256) * 4; }
        else if (kind == K_QK) { base = (char*)(qk + (size_t)g * NT * 512 + (size_t)u.pm * 256 * 512 + u.pn * 256); ldb = 1024; bb = bias + (WR_QK + g * 512 + u.pn * 256) * 4; }
        else if (kind == K_QC) { base = (char*)(qc + (size_t)u.pm * 256 * 512 + u.pn * 256); ldb = 1024; bb = bias + (WR_QC + u.pn * 256) * 4; }
        else { base = (char*)(memkv + (size_t)g * 512 * 512 + (size_t)u.pm * 256 * 512 + u.pn * 256); ldb = 1024; bb = bias; hasb = false; }
        f32x4 bv[2][2];
#pragma unroll
        for (int bj = 0; bj < 2; ++bj)
#pragma unroll
            for (int n = 0; n < 2; ++n) bv[bj][n] = hasb ? *(const LAS f32x4*)(bb + (cl0 + bj * 128 + 4 * n) * 4u) : (f32x4){0.f, 0.f, 0.f, 0.f};
        const unsigned lo = rl0 * ldb + cl0 * 2u;
#pragma unroll
        for (int ai = 0; ai < 2; ++ai)
#pragma unroll
            for (int m = 0; m < 4; ++m) {
#pragma unroll
                for (int bj = 0; bj < 2; ++bj) *(GAS v4u*)(base + (lo + (unsigned)(ai * 128 + m * 16) * ldb + (unsigned)(bj * 256))) = pack8(acc[ai][bj][m][0] * asc + bv[bj][0], acc[ai][bj][m][1] * asc + bv[bj][1]);
                __builtin_amdgcn_sched_barrier(0); }
    }
};
__device__ __forceinline__ void pack_tables(const float* ut, const float* vt, unsigned char* ws, int first, int stride);
struct EpiP4 {
    bf16* merged; const LAS unsigned char* bias; const float* ut; const float* vt; unsigned char* wsp; int G, c; unsigned char* mf8;
    __device__ __forceinline__ void operator()(f32x4 (&acc)[2][2][4][2], unsigned (&keep)[2][2][4][2], const GUnit& u, int wr, int wc, int fr, int fq) const {
        const int kind = u.kind & 255, gi = (u.kind >> 8) & 15;
        const unsigned rl0 = opq((unsigned)(wr * 64 + fr)), cl0 = opq((unsigned)(wc * 32 + 8 * fq));
        if (kind == K_GATE) {
            const LAS unsigned char* bb = bias + (gi * 1024 + u.pn * 256) * 4;
#pragma unroll
            for (int bj = 0; bj < 2; ++bj) { const f32x4 nb0 = *(const LAS f32x4*)(bb + (cl0 + bj * 128) * 4u) * -1.44269504f, nb1 = *(const LAS f32x4*)(bb + (cl0 + bj * 128 + 4) * 4u) * -1.44269504f;
#pragma unroll
                for (int ai = 0; ai < 2; ++ai)
#pragma unroll
                    for (int m = 0; m < 4; ++m)
#pragma unroll
                        for (int n = 0; n < 2; ++n) {
                            const f32x4 t = acc[ai][bj][m][n] * (-W8INV * 1.44269504f) + (n ? nb1 : nb0); f32x4 d; unsigned pk = 0u;
#pragma unroll
                            for (int e = 0; e < 4; ++e) d[e] = __builtin_amdgcn_exp2f(t[e]);
                            d = d * (1.f / 255.f) + (1.f / 255.f);
#pragma unroll
                            for (int e = 0; e < 4; ++e) d[e] = __builtin_amdgcn_rcpf(d[e]);
                            d = d + 0.25f;
#pragma unroll
                            for (int e = 0; e < 4; ++e) pk = __builtin_amdgcn_cvt_pk_u8_f32(d[e], e, pk);
                            keep[ai][bj][m][n] = pk; } }
            if (TABLES_IN_P4 && ((u.kind >> 12) & 1) == 0 && gi == c % 3) pack_tables(ut, vt, wsp, c * 512 + (int)opq((unsigned)threadIdx.x), G * 512);
            return;
        }
        char* mb = (char*)(merged + (size_t)u.pm * 256 * 1024 + u.pn * 256); const unsigned mlo = rl0 * 2048u + cl0 * 2u;
        const float ysc = ((kind == K_YA && !YA_FP8) ? 1.f : 1.f / (SC_WBC * SC_ACT)) * (1.f / 255.f);
        char* fb = (char*)(mf8 + (size_t)u.pm * 256 * 1024 + u.pn * 256);
#pragma unroll
        for (int ai = 0; ai < 2; ++ai) {
            v4u pw[4][2];
            if (kind != K_YA) {
#pragma unroll
                for (int m = 0; m < 4; ++m)
#pragma unroll
                    for (int bj = 0; bj < 2; ++bj) pw[m][bj] = *(const GAS v4u*)(mb + (mlo + (unsigned)((ai * 128 + m * 16) * 2048 + bj * 256))); }
#pragma unroll
            for (int m = 0; m < 4; ++m)
#pragma unroll
                for (int bj = 0; bj < 2; ++bj) { f32x4 v[2];
#pragma unroll
                    for (int n = 0; n < 2; ++n) { const unsigned pk = keep[ai][bj][m][n];
                        v[n][0] = acc[ai][bj][m][n][0] * ((float)(pk & 255u) * ysc); v[n][1] = acc[ai][bj][m][n][1] * ((float)((pk >> 8) & 255u) * ysc);
                        v[n][2] = acc[ai][bj][m][n][2] * ((float)((pk >> 16) & 255u) * ysc); v[n][3] = acc[ai][bj][m][n][3] * ((float)(pk >> 24) * ysc); }
                    if (kind != K_YA) { f32x4 p0, p1; unpack8(pw[m][bj], p0, p1); v[0] += p0; v[1] += p1; }
                    if (P5_FP8 && kind == K_YC) { v2u o8; o8.x = pk4_fp8(__builtin_amdgcn_fmed3f(v[0][0] * SC_MRG, -448.f, 448.f), __builtin_amdgcn_fmed3f(v[0][1] * SC_MRG, -448.f, 448.f), __builtin_amdgcn_fmed3f(v[0][2] * SC_MRG, -448.f, 448.f), __builtin_amdgcn_fmed3f(v[0][3] * SC_MRG, -448.f, 448.f));
                        o8.y = pk4_fp8(__builtin_amdgcn_fmed3f(v[1][0] * SC_MRG, -448.f, 448.f), __builtin_amdgcn_fmed3f(v[1][1] * SC_MRG, -448.f, 448.f), __builtin_amdgcn_fmed3f(v[1][2] * SC_MRG, -448.f, 448.f), __builtin_amdgcn_fmed3f(v[1][3] * SC_MRG, -448.f, 448.f));
                        *(GAS v2u*)(fb + ((mlo >> 1) + (unsigned)((ai * 128 + m * 16) * 1024 + bj * 128))) = o8; }
                    else *(GAS v4u*)(mb + (mlo + (unsigned)((ai * 128 + m * 16) * 2048 + bj * 256))) = pack8(v[0], v[1]); }
            __builtin_amdgcn_sched_barrier(0); }
    }
};
struct EpiP5 {
    bf16* h0; float* preln; float* stats; LAS unsigned char* lds_spare;
    __device__ __forceinline__ void operator()(f32x4 (&acc)[2][2][4][2], unsigned (&keep)[2][2][4][2], const GUnit& u, int wr, int wc, int fr, int fq) const {
        const unsigned rl0 = opq((unsigned)(wr * 64 + fr)), cl0 = opq((unsigned)(wc * 32 + 8 * fq));
        const size_t t0 = (size_t)u.pm * 256 * 1024 + u.pn * 256;
        char* hb = (char*)(h0 + t0);
        const unsigned hlo = rl0 * 2048u + cl0 * 2u;
#pragma unroll
        for (int ai = 0; ai < 2; ++ai) {
            v4u hw[4][2];
#pragma unroll
            for (int m = 0; m < 4; ++m)
#pragma unroll
                for (int bj = 0; bj < 2; ++bj) hw[m][bj] = *(const GAS v4u*)(hb + (hlo + (unsigned)((ai * 128 + m * 16) * 2048 + bj * 256)));
#pragma unroll
            for (int m = 0; m < 4; ++m) { float s1 = 0.f, s2 = 0.f;
#pragma unroll
                for (int bj = 0; bj < 2; ++bj) { f32x4 h0v, h1v; unpack8(hw[m][bj], h0v, h1v);
                    constexpr float asc5 = P5_FP8 ? 1.f / (SC_MRG * W8SC) : 1.f;
                    const f32x4 v0 = acc[ai][bj][m][0] * asc5 + ALPHA * h0v, v1 = acc[ai][bj][m][1] * asc5 + ALPHA * h1v;
                    *(GAS v4u*)(hb + (hlo + (unsigned)((ai * 128 + m * 16) * 2048 + bj * 256))) = pack8(v0, v1);
                    s1 += (v0[0] + v0[1]) + (v0[2] + v0[3]) + (v1[0] + v1[1]) + (v1[2] + v1[3]);
                    s2 += (v0[0] * v0[0] + v0[1] * v0[1]) + (v0[2] * v0[2] + v0[3] * v0[3]) + (v1[0] * v1[0] + v1[1] * v1[1]) + (v1[2] * v1[2] + v1[3] * v1[3]); }
                s1 += __shfl_xor(s1, 16); s1 += __shfl_xor(s1, 32); s2 += __shfl_xor(s2, 16); s2 += __shfl_xor(s2, 32);
                if (fq == 0) { f32x2 pr; pr.x = s1; pr.y = s2; *(LAS f32x2*)(lds_spare + ((ai * 128 + m * 16 + rl0) * 4 + wc) * 8) = pr; } }
            __builtin_amdgcn_sched_barrier(0); }
        asm volatile("s_waitcnt lgkmcnt(0)" ::: "memory"); __builtin_amdgcn_s_barrier(); asm volatile("" ::: "memory");
        { const int t = threadIdx.x;
          if (t < 256) { const LAS f32x2* pp = (const LAS f32x2*)(lds_spare + t * 32); f32x2 a = pp[0]; a += pp[1]; a += pp[2]; a += pp[3];
              *(GAS f32x2*)(stats + ((size_t)(u.pm * 256 + t) * 4 + u.pn) * 2) = a; } }
    }
};
struct EpiP7 {
    bf16* qp; const float* stats; const float* cvec; const float* dvec; LAS unsigned char* scr;
    __device__ __forceinline__ void operator()(f32x4 (&acc)[2][2][4][2], unsigned (&keep)[2][2][4][2], const GUnit& u, int wr, int wc, int fr, int fq) const {
        const unsigned rl0 = opq((unsigned)(wr * 64 + fr)), cl0 = opq((unsigned)(wc * 32 + 8 * fq));
        LAS unsigned char* sw = scr + (wr * 4 + wc) * 1024; const unsigned lw = opq((unsigned)(fr * 64 + fq * 16)), lrd = opq((unsigned)((fq * 16 + fr) * 16));
        const unsigned lam = opq((unsigned)(fq * 16 + fr));
        char* qb = (char*)(qp + (size_t)u.pm * 256 * 1024 + u.pn * 256); const unsigned lo = (unsigned)(wr * 64 + (lam >> 2)) * 2048u + (unsigned)(wc * 32 + 8 * (lam & 3u)) * 2u;
        f32x4 cv[2][2], dv[2][2];
#pragma unroll
        for (int bj = 0; bj < 2; ++bj)
#pragma unroll
            for (int n = 0; n < 2; ++n) { cv[bj][n] = *(const GAS f32x4*)(cvec + u.pn * 256 + cl0 + bj * 128 + 4 * n); dv[bj][n] = *(const GAS f32x4*)(dvec + u.pn * 256 + cl0 + bj * 128 + 4 * n); }
#pragma unroll
        for (int ai = 0; ai < 2; ++ai)
#pragma unroll
            for (int m = 0; m < 4; ++m) { const GAS f32x4* sp = (const GAS f32x4*)(stats + (size_t)(u.pm * 256 + ai * 128 + m * 16 + rl0) * 8); const f32x4 sa = sp[0], sb = sp[1];
                f32x2 st; st.x = ((sa.x + sa.z) + sb.x) + sb.z; st.y = ((sa.y + sa.w) + sb.y) + sb.w;
                const float mean = st.x * (1.f / D), rstd = 1.f / sqrtf(fmaxf(st.y * (1.f / D) - mean * mean, 0.f) + LN_EPS), mr = mean * rstd;
#pragma unroll
                for (int bj = 0; bj < 2; ++bj) { *(LAS v4u*)(sw + lw) = pack8(acc[ai][bj][m][0] * rstd - mr * cv[bj][0] + dv[bj][0], acc[ai][bj][m][1] * rstd - mr * cv[bj][1] + dv[bj][1]);
                    const v4u t = *(const LAS v4u*)(sw + lrd);
                    *(GAS v4u*)(qb + (lo + (unsigned)((ai * 128 + m * 16) * 2048 + bj * 256))) = t; } }
    }
};

constexpr float FP6_SU = 60.f, FP6_SV = 3.15f;
__device__ __forceinline__ unsigned fp6_code(float v) {
    const float a = fminf(fabsf(v), 7.5f);
    const float c = a < 2.f ? rintf(a * 8.f) : (a < 4.f ? 16.f + rintf((a - 2.f) * 4.f) : 24.f + rintf((a - 4.f) * 2.f));
    return (unsigned)c | (v < 0.f ? 32u : 0u);
}
constexpr float FP4_SV = 3.36f, FP4_SU = 64.f;
__device__ __forceinline__ unsigned fp4_code(float v) {
    const float a = fminf(fabsf(v), 6.f);
    const float c = a < 2.f ? rintf(a * 2.f) : (a < 4.f ? 4.f + rintf(a - 2.f) : 6.f + rintf((a - 4.f) * 0.5f));
    return (unsigned)c | (v < 0.f ? 8u : 0u);
}
typedef unsigned v6u __attribute__((ext_vector_type(6)));
typedef float v32f __attribute__((ext_vector_type(32)));
__device__ __forceinline__ void p0_transpose_item(const float* W, int K, int ld, int col0, bf16* WT, unsigned char* WT8, float sc8, int row0, LAS float* scr, int item, int lane, int ncols,
                                                  const float* kg = nullptr, const float* kb = nullptr, float* cvec = nullptr, float* dvec = nullptr) {
    const int nblk = ncols / 32, kb_ = item / nblk, nb = item % nblk, k0 = 64 * kb_, n0 = 32 * nb;
    { float wv[32];
#pragma unroll
      for (int i = 0; i < 32; ++i) wv[i] = W[(size_t)(k0 + 2 * i + (lane >> 5)) * ld + col0 + n0 + (lane & 31)];
#pragma unroll
      for (int i = 0; i < 32; ++i) scr[(2 * i + (lane >> 5)) * 33 + (lane & 31)] = wv[i]; }
    LDS_WAIT(); asm volatile("" ::: "memory");
    const int c = lane & 7;
#pragma unroll
    for (int j = 0; j < 4; ++j) { const int n = (lane >> 3) + 8 * j; const LAS float* s = scr + (8 * c) * 33 + n;
        float e[8];
#pragma unroll
        for (int i = 0; i < 8; ++i) e[i] = s[i * 33];
        if (kg) { float pc = 0.f, pd = 0.f;
#pragma unroll
            for (int i = 0; i < 8; ++i) { const float g = kg[k0 + 8 * c + i]; pd += e[i] * kb[k0 + 8 * c + i]; e[i] *= g; pc += e[i]; }
            pc += __shfl_xor(pc, 1); pc += __shfl_xor(pc, 2); pc += __shfl_xor(pc, 4); pd += __shfl_xor(pd, 1); pd += __shfl_xor(pd, 2); pd += __shfl_xor(pd, 4);
            if (c == 0) { cvec[kb_ * 1024 + col0 + n0 + n] = pc; dvec[kb_ * 1024 + col0 + n0 + n] = pd; } }
        if (WT) { v4u o; o.x = pk2(e[0], e[1]); o.y = pk2(e[2], e[3]); o.z = pk2(e[4], e[5]); o.w = pk2(e[6], e[7]); *(GAS v4u*)(WT + (size_t)(row0 + n0 + n) * K + k0 + 8 * c) = o; }
        if (WT8) { v2u o; o.x = pk4_fp8(e[0] * sc8, e[1] * sc8, e[2] * sc8, e[3] * sc8); o.y = pk4_fp8(e[4] * sc8, e[5] * sc8, e[6] * sc8, e[7] * sc8); *(GAS v2u*)(WT8 + (size_t)(row0 + n0 + n) * K + k0 + 8 * c) = o; } }
    LDS_WAIT(); asm volatile("" ::: "memory");
}
__device__ __forceinline__ void ln_row(const float* xrow, const float* g, const float* b, bf16* obf, float* of32, int lane) {
    const GAS f32x4* xr = (const GAS f32x4*)xrow + lane;
    f32x4 v[4]; float s = 0.f;
#pragma unroll
    for (int j = 0; j < 4; ++j) { v[j] = xr[64 * j]; s += (v[j].x + v[j].y) + (v[j].z + v[j].w); }
    const float mean = wave_sum(s) * (1.f / D); float s2 = 0.f;
#pragma unroll
    for (int j = 0; j < 4; ++j) { v[j] = v[j] - mean; s2 += (v[j].x * v[j].x + v[j].y * v[j].y) + (v[j].z * v[j].z + v[j].w * v[j].w); }
    const float rstd = 1.f / sqrtf(wave_sum(s2) * (1.f / D) + LN_EPS);
#pragma unroll
    for (int j = 0; j < 4; ++j) { const f32x4 gg = ((const GAS f32x4*)g)[lane + 64 * j], bb = ((const GAS f32x4*)b)[lane + 64 * j];
        const f32x4 y = v[j] * rstd * gg + bb;
        if (obf) ((GAS unsigned long long*)obf)[lane + 64 * j] = (unsigned long long)pk2(y.x, y.y) | ((unsigned long long)pk2(y.z, y.w) << 32);
        if (of32) ((GAS f32x4*)of32)[lane + 64 * j] = y; }
}
__device__ __forceinline__ void ln_row2(const float* xa, const float* xb, const float* g, const float* b, bf16* oa, bf16* ob, unsigned char* oa8, unsigned char* ob8, int lane) {
    const GAS f32x4* pa = (const GAS f32x4*)xa + lane; const GAS f32x4* pb = (const GAS f32x4*)xb + lane;
    f32x4 va[4], vb[4]; float sa = 0.f, sb = 0.f;
#pragma unroll
    for (int j = 0; j < 4; ++j) { va[j] = pa[64 * j]; vb[j] = pb[64 * j]; }
#pragma unroll
    for (int j = 0; j < 4; ++j) { sa += (va[j].x + va[j].y) + (va[j].z + va[j].w); sb += (vb[j].x + vb[j].y) + (vb[j].z + vb[j].w); }
    const float ma = wave_sum(sa) * (1.f / D), mb = wave_sum(sb) * (1.f / D); float qa = 0.f, qb = 0.f;
#pragma unroll
    for (int j = 0; j < 4; ++j) { va[j] = va[j] - ma; vb[j] = vb[j] - mb; qa += (va[j].x * va[j].x + va[j].y * va[j].y) + (va[j].z * va[j].z + va[j].w * va[j].w); qb += (vb[j].x * vb[j].x + vb[j].y * vb[j].y) + (vb[j].z * vb[j].z + vb[j].w * vb[j].w); }
    const float ra = 1.f / sqrtf(wave_sum(qa) * (1.f / D) + LN_EPS), rb = 1.f / sqrtf(wave_sum(qb) * (1.f / D) + LN_EPS);
#pragma unroll
    for (int j = 0; j < 4; ++j) { const f32x4 gg = ((const GAS f32x4*)g)[lane + 64 * j], bb = ((const GAS f32x4*)b)[lane + 64 * j];
        const f32x4 ya = va[j] * ra * gg + bb, yb = vb[j] * rb * gg + bb;
        ((GAS unsigned long long*)oa)[lane + 64 * j] = (unsigned long long)pk2(ya.x, ya.y) | ((unsigned long long)pk2(ya.z, ya.w) << 32);
        ((GAS unsigned long long*)ob)[lane + 64 * j] = (unsigned long long)pk2(yb.x, yb.y) | ((unsigned long long)pk2(yb.z, yb.w) << 32);
        ((GAS unsigned*)oa8)[lane + 64 * j] = pk4_fp8(ya.x, ya.y, ya.z, ya.w); ((GAS unsigned*)ob8)[lane + 64 * j] = pk4_fp8(yb.x, yb.y, yb.z, yb.w); }
}
__device__ __forceinline__ int t5_bucket(int rel) {
    const int ret = rel > 0 ? 16 : 0; const int n = rel < 0 ? -rel : rel; const float nf = (float)(n > 1 ? n : 1);
    int large = 8 + (int)(logf(nf / 8.f) / 4.852030263919617f * 8.f); large = large < 15 ? large : 15;
    return ret + (n < 8 ? n : large);
}

__device__ __forceinline__ void pack_tables(const float* ut, const float* vt, unsigned char* ws, int first, int stride) {
    const int njobs = 2 * 16384 * 32;
#define FP4_W(O, V, SC, W) do { const f32x4 a_ = V[2 * (W)] * SC, b_ = V[2 * (W) + 1] * SC; unsigned q_ = 0u; \
            q_ = __builtin_amdgcn_cvt_scalef32_pk_fp4_f32(q_, a_[0], a_[1], 1.0f, 0); q_ = __builtin_amdgcn_cvt_scalef32_pk_fp4_f32(q_, a_[2], a_[3], 1.0f, 1); \
            q_ = __builtin_amdgcn_cvt_scalef32_pk_fp4_f32(q_, b_[0], b_[1], 1.0f, 2); q_ = __builtin_amdgcn_cvt_scalef32_pk_fp4_f32(q_, b_[2], b_[3], 1.0f, 3); O[W] = q_; } while (0)
    for (int job = first; job < njobs; job += 2 * stride) { int jb = job + stride; jb = jb < njobs ? jb : job;
        const int tb = job >> 19, e = (job >> 5) & 16383, fr = job & 31, tb2 = jb >> 19, e2 = (jb >> 5) & 16383, fr2 = jb & 31;
        const float sc = tb ? FP4_SV : FP4_SU, sc2 = tb2 ? FP4_SV : FP4_SU;
        const GAS f32x4* src = (const GAS f32x4*)((tb ? vt : ut) + (size_t)e * 1024); const GAS f32x4* src2 = (const GAS f32x4*)((tb2 ? vt : ut) + (size_t)e2 * 1024);
        f32x4 v[8], v2[8];
#pragma unroll
        for (int idx = 0; idx < 8; ++idx) v[idx] = src[8 * fr + idx];
#pragma unroll
        for (int idx = 0; idx < 8; ++idx) v2[idx] = src2[8 * fr2 + idx];
        v4u o, o2;
        FP4_W(o, v, sc, 0); FP4_W(o, v, sc, 1); FP4_W(o, v, sc, 2); FP4_W(o, v, sc, 3);
        *(GAS v4u*)(ws + (tb ? WS_VTAB : WS_UTAB) + (size_t)e * 512 + fr * 16) = o;
        FP4_W(o2, v2, sc2, 0); FP4_W(o2, v2, sc2, 1); FP4_W(o2, v2, sc2, 2); FP4_W(o2, v2, sc2, 3);
        *(GAS v4u*)(ws + (tb2 ? WS_VTAB : WS_UTAB) + (size_t)e2 * 512 + fr2 * 16) = o2; }
#undef FP4_W
}
__device__ __forceinline__ void phase0(const Ptrs& P, LAS unsigned char* lds, int tid, int lane, int wave, int G) {
    unsigned char* ws = P.ws;
    const int gw = blockIdx.x * NWAVES + wave, NGW = G * NWAVES;
    float pre[4] = {0.f, 0.f, 0.f, 0.f};
    if (blockIdx.x < 256) { const int g = blockIdx.x >> 6, k0 = (blockIdx.x & 63) * 16;
#pragma unroll
        for (int j = 0; j < 4; ++j) { const int idx = tid + 512 * j, kk = idx >> 7, c = idx & 127; pre[j] = P.in[5][(size_t)(k0 + kk) * 6400 + g * 128 + c]; } }
    { bf16* h0 = (bf16*)(ws + WS_H0);
      unsigned char* h08 = ws + WS_H0F8;
      for (int m = gw; m < NT; m += 2 * NGW) ln_row2(P.in[0] + (size_t)m * D, P.in[0] + (size_t)(m + NGW) * D, P.in[3], P.in[4], h0 + (size_t)m * D, h0 + (size_t)(m + NGW) * D, h08 + (size_t)m * D, h08 + (size_t)(m + NGW) * D, lane); }
    { LAS float* scr = (LAS float*)(lds + wave * 16384);
      bf16* wtin = (bf16*)(ws + WS_WTIN);
      constexpr int I_IN = 23 * 16 * 8, I_A = 8 * 32, I_B = 4 * 32, I_C = 8 * 32, I_SQ = 16 * 32;
      constexpr int NIT = I_IN + I_A + I_B + I_C + 3 * I_SQ;
      unsigned char* wf8 = ws + WS_WF8IN;
      for (int it = gw; it < NIT; it += NGW) {
          int r = it;
          if (r < I_IN) { const int j = r / 128, q = r % 128; int src;
              if (j < 6) src = ((j & 1) ? 1280 : 512) + (j >> 1) * 256; else if (j < 9) src = 2048 + (j - 6) * 256; else if (j < 11) src = 2816 + (j - 9) * 256; else src = 3328 + (j - 11) * 256;
              p0_transpose_item(P.in[5], 1024, 6400, src, nullptr, wf8, W8SC, 1024 + 256 * j, scr, q, lane, 256); continue; }
          r -= I_IN;
          if (r < I_A) { p0_transpose_item(P.in[7], 512, 1024, 0, YA_FP8 ? nullptr : (bf16*)(ws + WS_WTA), YA_FP8 ? ws + WS_WTA : nullptr, SC_WBC, 0, scr, r, lane, 1024); continue; } r -= I_A;
          if (r < I_B) { p0_transpose_item(P.in[8], 256, 1024, 0, nullptr, ws + WS_WTB, SC_WBC, 0, scr, r, lane, 1024); continue; } r -= I_B;
          if (r < I_C) { p0_transpose_item(P.in[9], 512, 1024, 0, nullptr, ws + WS_WTC, SC_WBC, 0, scr, r, lane, 1024); continue; } r -= I_C;
          if (r < I_SQ) { p0_transpose_item(P.in[10], 1024, 1024, 0, nullptr, ws + WS_WMKVF8, W8SC, 0, scr, r, lane, 1024); continue; } r -= I_SQ;
          if (r < I_SQ) { p0_transpose_item(P.in[11], 1024, 1024, 0, P5_FP8 ? nullptr : (bf16*)(ws + WS_WTO), P5_FP8 ? ws + WS_WTOF8 : nullptr, W8SC, 0, scr, r, lane, 1024); continue; } r -= I_SQ;
          p0_transpose_item(P.in[14], 1024, 1024, 0, (bf16*)(ws + WS_WTPQ), nullptr, 0.f, 0, scr, r, lane, 1024, P.in[12], P.in[13], (float*)(ws + WS_CPART), (float*)(ws + WS_CPART) + 16 * 1024);
      } }
    __syncthreads();
    { LAS float* wt = (LAS float*)lds;
      LAS float* cs = wt + 64 * 129; LAS float* sn = cs + 128; LAS f32x2* cs2 = (LAS f32x2*)(sn + 128);
      if (tid < 128) { float s, c; sincospif((float)tid / 64.f, &s, &c); cs[tid] = c; sn[tid] = s; f32x2 t; t.x = c; t.y = s; cs2[tid] = t; }
      bf16* wtin = (bf16*)(ws + WS_WTIN);
      unsigned char* wf8 = ws + WS_WF8IN;
      for (int it = blockIdx.x; it < 256; it += G) {
          const int g = it >> 6, k0 = (it & 63) * 16;
          __syncthreads();
          if (it == (int)blockIdx.x) {
#pragma unroll
              for (int j = 0; j < 4; ++j) { const int idx = tid + 512 * j, kk = idx >> 7, c = idx & 127; wt[c * 20 + kk] = pre[j]; } }
          else for (int idx = tid; idx < 16 * 128; idx += 512) { const int kk = idx >> 7, c = idx & 127; wt[c * 20 + kk] = P.in[5][(size_t)(k0 + kk) * 6400 + g * 128 + c]; }
          __syncthreads();
          const int cp = tid & 127, kq = tid >> 7;
          float ac[4] = {0.f, 0.f, 0.f, 0.f}, as[4] = {0.f, 0.f, 0.f, 0.f};
#pragma unroll 4
          for (int c = 0; c < 128; ++c) { const int ix = (c * cp) & 127; const f32x2 t = cs2[ix]; const float cv = t.x, sv = t.y; const f32x4 w4 = *(const LAS f32x4*)(wt + c * 20 + 4 * kq);
#pragma unroll
              for (int i = 0; i < 4; ++i) { const float w = w4[i]; ac[i] += w * cv; as[i] += w * sv; } }
          { v2u o; o.x = pk2(ac[0], ac[1]); o.y = pk2(ac[2], ac[3]); *(GAS v2u*)(wtin + (size_t)(g * 256 + cp) * 1024 + k0 + 4 * kq) = o;
            v2u q; q.x = pk2(as[0], as[1]); q.y = pk2(as[2], as[3]); *(GAS v2u*)(wtin + (size_t)(g * 256 + 128 + cp) * 1024 + k0 + 4 * kq) = q; }
#if ZA_FP8
          *(GAS unsigned*)(wf8 + (size_t)(g * 256 + cp) * 1024 + k0 + 4 * kq) = pk4_fp8(ac[0] * W8SC, ac[1] * W8SC, ac[2] * W8SC, ac[3] * W8SC);
          *(GAS unsigned*)(wf8 + (size_t)(g * 256 + 128 + cp) * 1024 + k0 + 4 * kq) = pk4_fp8(as[0] * W8SC, as[1] * W8SC, as[2] * W8SC, as[3] * W8SC);
#endif
      }
      __syncthreads();
      { float* bi = (float*)(ws + WS_BIASIN); const float* b_in = P.in[6];
        for (int r = gw; r < 1024; r += NGW) { const int g = r >> 8, w = r & 255, cp = w & 127; const bool isin = w >= 128;
            const int i0 = (lane * cp) & 127, i1 = ((lane + 64) * cp) & 127;
            float a = b_in[g * 128 + lane] * (isin ? sn[i0] : cs[i0]) + b_in[g * 128 + 64 + lane] * (isin ? sn[i1] : cs[i1]);
            a = wave_sum(a); if (lane == 0) bi[r] = a; }
        const int gtid = blockIdx.x * 512 + tid, nth = G * 512;
        for (int r = 1024 + gtid; r < WR_END; r += nth) { const int j = (r - 1024) >> 8, w = (r - 1024) & 255; int src;
            if (j < 6) src = ((j & 1) ? 1280 : 512) + (j >> 1) * 256; else if (j < 9) src = 2048 + (j - 6) * 256; else if (j < 11) src = 2816 + (j - 9) * 256; else src = 3328 + (j - 11) * 256;
            bi[r] = b_in[src + w]; }
        float* bt = (float*)(ws + WS_BIASTAB);
        for (int r = gtid; r < 3 * 4 * 129; r += nth) { const int g = r / (4 * 129), h = (r / 129) & 3, j = r % 129; const int rel = (j - 64) << (2 * g);
            bt[(g * 4 + h) * 132 + j] = P.in[2][t5_bucket(rel) * 12 + g * 4 + h]; }
      }
    }
    { const size_t gt = (size_t)blockIdx.x * 512 + tid, NTH = (size_t)G * 512;
      if (!TABLES_IN_P4) pack_tables((const float*)P.in[17], (const float*)P.in[18], ws, (int)gt, (int)NTH);
      const GAS f32x4* ms = (const GAS f32x4*)P.in[1]; GAS unsigned* md = (GAS unsigned*)(ws + WS_MEMF8);
      for (size_t i = gt; i < (size_t)512 * 1024 / 4; i += NTH) { const f32x4 a = ms[i]; md[i] = pk4_fp8(a.x, a.y, a.z, a.w); }
    }
}

constexpr int FFT_PITCH = 544, FFT_BUF = 128 * FFT_PITCH;
static_assert(2 * FFT_BUF <= MISC_OFF, "FFT LDS map");
typedef short s16x4 __attribute__((ext_vector_type(4)));
__device__ __forceinline__ s16x4 tr_read(LAS unsigned char* p) { return __builtin_amdgcn_ds_read_tr16_b64_v4i16((LAS s16x4*)p); }
template <int STEP>
__device__ __forceinline__ void fft_step_mfma(const bf16* src, bf16* dst, LAS unsigned char* lds, int tid, int lane, int wave, int G) {
    const int fr = lane & 15, kq = lane >> 4, kout = 16 * wave + fr;
    bf16x8 cf[4], sf[4];
    { LAS float* tab = (LAS float*)(lds + FFT_BUF);
      __syncthreads();
      if (tid < 128) { float sn, cs; sincospif((float)tid / 64.f, &sn, &cs); tab[tid] = cs; tab[128 + tid] = sn; }
      __syncthreads();
#pragma unroll
      for (int kk = 0; kk < 4; ++kk) { v4u cw, sw; float cl[8], sl[8];
#pragma unroll
          for (int j = 0; j < 8; ++j) { const int sv = 32 * kk + (j < 4 ? 4 * kq + j : 16 + 4 * kq + j - 4); const int ix = (kout * sv) & 127; cl[j] = tab[ix]; sl[j] = tab[128 + ix]; }
          cw.x = pk2(cl[0], cl[1]); cw.y = pk2(cl[2], cl[3]); cw.z = pk2(cl[4], cl[5]); cw.w = pk2(cl[6], cl[7]);
          sw.x = pk2(sl[0], sl[1]); sw.y = pk2(sl[2], sl[3]); sw.z = pk2(sl[4], sl[5]); sw.w = pk2(sl[6], sl[7]);
          cf[kk] = __builtin_bit_cast(bf16x8, cw); sf[kk] = __builtin_bit_cast(bf16x8, sw); } }
    v4u iw[8];
#define FFT_LOAD(UN) do { const int b_ = (UN) >> 9, f_ = ((UN) >> 2) & 127, g_ = (UN) & 3; _Pragma("unroll") for (int j = 0; j < 8; ++j) { const int c = tid + 512 * j; const int sr = c >> 5, piece = c & 31; \
            const size_t row = (STEP == 1) ? (size_t)(b_ << 14) + 128 * sr + f_ : (size_t)(b_ << 14) + 128 * f_ + sr; iw[j] = *(const GAS v4u*)(src + row * 1024 + g_ * 256 + piece * 8); } } while (0)
#define FFT_PUT(BUF) do { _Pragma("unroll") for (int j = 0; j < 8; ++j) { const int c = tid + 512 * j; *(LAS v4u*)(lds + (BUF) * FFT_BUF + (c >> 5) * FFT_PITCH + (c & 31) * 16) = iw[j]; } } while (0)
    __syncthreads();
    if (blockIdx.x < 1024) { FFT_LOAD(blockIdx.x); FFT_PUT(0); }
    __syncthreads();
    int cur = 0;
    for (int unit = blockIdx.x; unit < 1024; unit += G) {
        const int b = unit >> 9, f = (unit >> 2) & 127, g = unit & 3;
        const bool more = unit + G < 1024;
        if (more) FFT_LOAD(unit + G);
        LAS unsigned char* img = lds + cur * FFT_BUF;
        f32x4 accR[8], accI[8];
#pragma unroll
        for (int mt = 0; mt < 8; ++mt) { accR[mt] = (f32x4){0.f, 0.f, 0.f, 0.f}; accI[mt] = (f32x4){0.f, 0.f, 0.f, 0.f}; }
#pragma unroll
        for (int mt = 0; mt < 8; ++mt)
#pragma unroll
            for (int kk = 0; kk < 4; ++kk) {
                LAS unsigned char* a1 = img + (32 * kk + 4 * kq + (fr >> 2)) * FFT_PITCH + (16 * mt + 4 * (fr & 3)) * 2;
                LAS unsigned char* a2 = a1 + 16 * FFT_PITCH;
                const s16x4 r0 = tr_read(a1), r1 = tr_read(a2), i0 = tr_read(a1 + 256), i1 = tr_read(a2 + 256);
                const bf16x8 xr = __builtin_shufflevector(r0, r1, 0, 1, 2, 3, 4, 5, 6, 7), xi = __builtin_shufflevector(i0, i1, 0, 1, 2, 3, 4, 5, 6, 7);
                if (STEP == 1) {
                    v4u t = __builtin_bit_cast(v4u, xi); t.x ^= 0x80008000u; t.y ^= 0x80008000u; t.z ^= 0x80008000u; t.w ^= 0x80008000u; const bf16x8 nxi = __builtin_bit_cast(bf16x8, t);
                    accR[mt] = __builtin_amdgcn_mfma_f32_16x16x32_bf16(xr, cf[kk], accR[mt], 0, 0, 0); accR[mt] = __builtin_amdgcn_mfma_f32_16x16x32_bf16(nxi, sf[kk], accR[mt], 0, 0, 0);
                    accI[mt] = __builtin_amdgcn_mfma_f32_16x16x32_bf16(xi, cf[kk], accI[mt], 0, 0, 0); accI[mt] = __builtin_amdgcn_mfma_f32_16x16x32_bf16(xr, sf[kk], accI[mt], 0, 0, 0);
                } else {
                    accR[mt] = __builtin_amdgcn_mfma_f32_16x16x32_bf16(xr, cf[kk], accR[mt], 0, 0, 0); accR[mt] = __builtin_amdgcn_mfma_f32_16x16x32_bf16(xi, sf[kk], accR[mt], 0, 0, 0);
                }
                if (kk == 3) __builtin_amdgcn_sched_barrier(0);
            }
        if (STEP == 1) { float ws_, wc_; sincospif(-(float)(f * kout) / 8192.f, &ws_, &wc_);
            bf16* orow = dst + ((size_t)(b << 14) + kout * 128 + f) * 1024 + g * 256 + 4 * kq;
#pragma unroll
            for (int mt = 0; mt < 8; ++mt) { v2u re, im; re.x = pk2(accR[mt][0] * wc_ + accI[mt][0] * ws_, accR[mt][1] * wc_ + accI[mt][1] * ws_); re.y = pk2(accR[mt][2] * wc_ + accI[mt][2] * ws_, accR[mt][3] * wc_ + accI[mt][3] * ws_);
                im.x = pk2(accR[mt][0] * ws_ - accI[mt][0] * wc_, accR[mt][1] * ws_ - accI[mt][1] * wc_); im.y = pk2(accR[mt][2] * ws_ - accI[mt][2] * wc_, accR[mt][3] * ws_ - accI[mt][3] * wc_);
                *(GAS v2u*)(orow + 16 * mt) = re; *(GAS v2u*)(orow + 128 + 16 * mt) = im; }
        } else { const float scale = 6.905339660024878e-4f;
            bf16* orow = dst + ((size_t)(b << 14) + f + 128 * kout) * 512 + g * 128 + 4 * kq;
#pragma unroll
            for (int mt = 0; mt < 8; ++mt) {
                if (YA_FP8) { const float s8 = scale * SC_ACT; *(GAS unsigned*)((unsigned char*)dst + ((size_t)(b << 14) + f + 128 * kout) * 512 + g * 128 + 4 * kq + 16 * mt) = pk4_fp8(__builtin_amdgcn_fmed3f(accR[mt][0] * s8, -448.f, 448.f), __builtin_amdgcn_fmed3f(accR[mt][1] * s8, -448.f, 448.f), __builtin_amdgcn_fmed3f(accR[mt][2] * s8, -448.f, 448.f), __builtin_amdgcn_fmed3f(accR[mt][3] * s8, -448.f, 448.f)); }
                else { v2u re; re.x = pk2(accR[mt][0] * scale, accR[mt][1] * scale); re.y = pk2(accR[mt][2] * scale, accR[mt][3] * scale); *(GAS v2u*)(orow + 16 * mt) = re; } }
        }
        if (more) FFT_PUT(cur ^ 1);
        __syncthreads();
        cur ^= 1;
    }
#undef FFT_LOAD
#undef FFT_PUT
}

typedef float f32x16 __attribute__((ext_vector_type(16)));
constexpr int DA_BT = 0, DA_K = 9216, DA_KP = 144, DA_V = DA_K + 384 * DA_KP, DA_VP = 776;
static_assert(DA_V + 64 * DA_VP <= MISC_OFF, "dil-attn LDS map");
template <int T>
__device__ __forceinline__ void dil_tile(LAS unsigned char* lds, int kr0, int r31, int hh, const LAS float* btl, const bf16x8 (&qf)[4], f32x16& o0, f32x16& o1, float& mx, float& den) {
    const LAS unsigned char* kp = lds + DA_K + (kr0 + r31) * DA_KP + 16 * hh;
    f32x16 sacc;
#pragma unroll
    for (int i = 0; i < 16; ++i) sacc[i] = 0.f;
#pragma unroll
    for (int kk = 0; kk < 4; ++kk) { const bf16x8 kf = *(const LAS bf16x8*)(kp + 32 * kk); sacc = __builtin_amdgcn_mfma_f32_32x32x16_bf16(kf, qf[kk], sacc, 0, 0, 0); }
    const LAS float* bl = btl + (32 + 32 * T + 4 * hh - r31);
    float tmax = -INFINITY;
#pragma unroll
    for (int i = 0; i < 16; ++i) { const int krow = (i & 3) + 8 * (i >> 2);
        float sv = sacc[i] * 0.18033688011112042f + bl[krow];
        if (T == 0) sv = (krow + 4 * hh >= r31) ? sv : -INFINITY;
        if (T == 4) sv = (krow + 4 * hh <= r31) ? sv : -INFINITY;
        sacc[i] = sv; tmax = fmaxf(tmax, sv); }
    tmax = fmaxf(tmax, __shfl_xor(tmax, 32));
    const bool grow = __builtin_amdgcn_ballot_w64(tmax > mx) != 0ull;
    const float mn = fmaxf(mx, tmax); float corr = 1.f;
    if (grow) corr = __builtin_amdgcn_exp2f(mx - mn);
    mx = mn;
    float psum = 0.f;
#pragma unroll
    for (int i = 0; i < 16; ++i) { const float p = __builtin_amdgcn_exp2f(sacc[i] - mn); sacc[i] = p; psum += p; }
    den = den * corr + psum;
    if (grow) {
#pragma unroll
        for (int i = 0; i < 16; ++i) { o0[i] *= corr; o1[i] *= corr; } }
#pragma unroll
    for (int s2 = 0; s2 < 2; ++s2) { v4u pw; pw.x = pk2(sacc[8 * s2], sacc[8 * s2 + 1]); pw.y = pk2(sacc[8 * s2 + 2], sacc[8 * s2 + 3]); pw.z = pk2(sacc[8 * s2 + 4], sacc[8 * s2 + 5]); pw.w = pk2(sacc[8 * s2 + 6], sacc[8 * s2 + 7]);
        const bf16x8 pf = __builtin_bit_cast(bf16x8, pw);
        const LAS unsigned char* vp = lds + DA_V + r31 * DA_VP + (kr0 + 16 * s2 + 4 * hh) * 2;
        const v2u lo0 = *(const LAS v2u*)vp, hi0 = *(const LAS v2u*)(vp + 16), lo1 = *(const LAS v2u*)(vp + 32 * DA_VP), hi1 = *(const LAS v2u*)(vp + 32 * DA_VP + 16);
        v4u w0, w1; w0.x = lo0.x; w0.y = lo0.y; w0.z = hi0.x; w0.w = hi0.y; w1.x = lo1.x; w1.y = lo1.y; w1.z = hi1.x; w1.w = hi1.y;
        o0 = __builtin_amdgcn_mfma_f32_32x32x16_bf16(__builtin_bit_cast(bf16x8, w0), pf, o0, 0, 0, 0);
        o1 = __builtin_amdgcn_mfma_f32_32x32x16_bf16(__builtin_bit_cast(bf16x8, w1), pf, o1, 0, 0, 0); }
}
__device__ __forceinline__ void dil_attn_lds(const bf16* qk, const bf16* vt, const float* btab_g, bf16* og, float* lse, LAS unsigned char* lds, int tid, int lane, int wave, int G) {
    LAS float* bt = (LAS float*)(lds + DA_BT);
    __syncthreads();
    for (int i = tid; i < 12 * 192; i += 512) { const int tb = i / 192, j = i - tb * 192 - 32; bt[i] = (j >= 0 && j <= 128) ? btab_g[tb * 132 + j] * 1.4426950408889634f : 0.f; }
    const int r31 = lane & 31, hh = lane >> 5;
    v4u kw[6], vw[6]; bf16x8 qn[4];
#define DIL_UNIT(U) const int blk = (U) & 63, hd = ((U) >> 6) & 3, g = ((U) >> 8) % 3, b = (U) / 768; const int sh = 2 * g, sub = 16384 >> sh; \
        const int nl0 = blk * 256, rr = nl0 >> (14 - sh), l0 = nl0 & (sub - 1); const size_t seq0 = ((size_t)g * NT + (size_t)(b << 14) + (size_t)rr * sub); \
        const bf16* qkg = qk + seq0 * 512; const bf16* vtg = vt + ((size_t)g * 256 + hd * 64) * NT + (size_t)(b << 14) + (size_t)rr * sub;
#define DIL_LOAD() do { _Pragma("unroll") for (int j = 0; j < 6; ++j) { const int c = tid + 512 * j; const int kr = c >> 3, pc = c & 7; const int lk = l0 - 64 + kr; const int lkc = lk < 0 ? 0 : (lk >= sub ? sub - 1 : lk); \
              kw[j] = *(const GAS v4u*)(qkg + (size_t)lkc * 512 + 256 + hd * 64 + pc * 8); \
              const int d = c / 48, pv = c - d * 48; const int lv = l0 - 64 + pv * 8; const int lvc = lv < 0 ? 0 : (lv >= sub ? sub - 8 : lv); \
              vw[j] = *(const GAS v4u*)(vtg + (size_t)d * NT + lvc); } \
          _Pragma("unroll") for (int kk = 0; kk < 4; ++kk) qn[kk] = *(const GAS bf16x8*)(qkg + (size_t)(l0 + 32 * wave + (lane & 31)) * 512 + hd * 64 + 16 * kk + 8 * (lane >> 5)); } while (0)
    if (blockIdx.x < 1536) { DIL_UNIT(blockIdx.x) DIL_LOAD(); }
    for (int u = blockIdx.x; u < 1536; u += G) {
        DIL_UNIT(u)
        __syncthreads();
#pragma unroll
        for (int j = 0; j < 6; ++j) { const int c = tid + 512 * j; const int kr = c >> 3, pc = c & 7;
            *(LAS v4u*)(lds + DA_K + kr * DA_KP + pc * 16) = kw[j];
            const int d = c / 48, pv = c - d * 48;
            v2u lo, hi; lo.x = vw[j].x; lo.y = vw[j].y; hi.x = vw[j].z; hi.y = vw[j].w;
            *(LAS v2u*)(lds + DA_V + d * DA_VP + pv * 16) = lo; *(LAS v2u*)(lds + DA_V + d * DA_VP + pv * 16 + 8) = hi; }
        __syncthreads();
        bf16x8 qf[4];
#pragma unroll
        for (int kk = 0; kk < 4; ++kk) qf[kk] = qn[kk];
        if (u + G < 1536) { const int un = u + G; const int blkn = un & 63, hdn = (un >> 6) & 3, gn = (un >> 8) % 3, bn = un / 768; const int shn = 2 * gn, subn = 16384 >> shn;
            const int nl0n = blkn * 256, rrn = nl0n >> (14 - shn), l0n = nl0n & (subn - 1); const size_t seq0n = ((size_t)gn * NT + (size_t)(bn << 14) + (size_t)rrn * subn);
            const bf16* qkgn = qk + seq0n * 512; const bf16* vtgn = vt + ((size_t)gn * 256 + hdn * 64) * NT + (size_t)(bn << 14) + (size_t)rrn * subn;
#pragma unroll
            for (int j = 0; j < 6; ++j) { const int c = tid + 512 * j; const int kr = c >> 3, pc = c & 7; const int lk = l0n - 64 + kr; const int lkc = lk < 0 ? 0 : (lk >= subn ? subn - 1 : lk);
                kw[j] = *(const GAS v4u*)(qkgn + (size_t)lkc * 512 + 256 + hdn * 64 + pc * 8);
                const int d = c / 48, pv = c - d * 48; const int lv = l0n - 64 + pv * 8; const int lvc = lv < 0 ? 0 : (lv >= subn ? subn - 8 : lv);
                vw[j] = *(const GAS v4u*)(vtgn + (size_t)d * NT + lvc); }
#pragma unroll
            for (int kk = 0; kk < 4; ++kk) qn[kk] = *(const GAS bf16x8*)(qkgn + (size_t)(l0n + 32 * wave + (lane & 31)) * 512 + hdn * 64 + 16 * kk + 8 * (lane >> 5)); }
        const int lq0 = l0 + 32 * wave;
        const LAS float* btl = bt + (g * 4 + hd) * 192;
        f32x16 o0, o1;
#pragma unroll
        for (int i = 0; i < 16; ++i) { o0[i] = 0.f; o1[i] = 0.f; }
        float mx = -1e30f, den = 0.f;
        if (lq0 - 64 >= 0) dil_tile<0>(lds, 32 * wave, r31, hh, btl, qf, o0, o1, mx, den);
        if (lq0 - 32 >= 0) dil_tile<1>(lds, 32 * wave + 32, r31, hh, btl, qf, o0, o1, mx, den);
        dil_tile<2>(lds, 32 * wave + 64, r31, hh, btl, qf, o0, o1, mx, den);
        if (lq0 + 32 < sub) dil_tile<3>(lds, 32 * wave + 96, r31, hh, btl, qf, o0, o1, mx, den);
        if (lq0 + 64 < sub) dil_tile<4>(lds, 32 * wave + 128, r31, hh, btl, qf, o0, o1, mx, den);
        den += __shfl_xor(den, 32);
        const float inv = 1.f / den;
        const size_t n = seq0 + lq0 + r31;
        bf16* orow = og + n * 256 + hd * 64 + 4 * hh;
#pragma unroll
        for (int q4 = 0; q4 < 4; ++q4) { v2u w0, w1; w0.x = pk2(o0[4 * q4] * inv, o0[4 * q4 + 1] * inv); w0.y = pk2(o0[4 * q4 + 2] * inv, o0[4 * q4 + 3] * inv);
            w1.x = pk2(o1[4 * q4] * inv, o1[4 * q4 + 1] * inv); w1.y = pk2(o1[4 * q4 + 2] * inv, o1[4 * q4 + 3] * inv);
            *(GAS v2u*)(orow + 8 * q4) = w0; *(GAS v2u*)(orow + 32 + 8 * q4) = w1; }
        if (hh == 0) lse[n * 4 + hd] = (mx + __builtin_amdgcn_logf(den)) * 0.6931471805599453f;
    }
    __syncthreads();
#undef DIL_UNIT
#undef DIL_LOAD
}
constexpr int MA_KP = 272, MA_VP = 520, MA_V = 256 * MA_KP;
static_assert(MA_V + 128 * MA_VP <= MISC_OFF, "mem-attn LDS map");
__device__ __forceinline__ void mem_attn_lds(const bf16* qc, const bf16* memk, const bf16* vtm, bf16* ycin, LAS unsigned char* lds, int tid, int lane, int wave, int G) {
    const int r31 = lane & 31, hh = lane >> 5;
    for (int wu = blockIdx.x; wu < 256; wu += G) {
        const int combo = wu & 7, b = combo >> 2, hd = combo & 3, chunk = wu >> 3;
        __syncthreads();
        { v4u kw[8], vw[8];
#pragma unroll
          for (int j = 0; j < 8; ++j) { const int c = tid + 512 * j; kw[j] = *(const GAS v4u*)(memk + (size_t)(b * 256 + (c >> 4)) * 512 + hd * 128 + (c & 15) * 8);
              vw[j] = *(const GAS v4u*)(vtm + (size_t)(hd * 128 + (c >> 5)) * 512 + b * 256 + (c & 31) * 8); }
#pragma unroll
          for (int j = 0; j < 8; ++j) { const int c = tid + 512 * j; *(LAS v4u*)(lds + (c >> 4) * MA_KP + (c & 15) * 16) = kw[j];
              v2u lo, hi; lo.x = vw[j].x; lo.y = vw[j].y; hi.x = vw[j].z; hi.y = vw[j].w;
              *(LAS v2u*)(lds + MA_V + (c >> 5) * MA_VP + (c & 31) * 16) = lo; *(LAS v2u*)(lds + MA_V + (c >> 5) * MA_VP + (c & 31) * 16 + 8) = hi; } }
        __syncthreads();
#pragma unroll 1
        for (int qi = 0; qi < 2; ++qi) {
            const int blk = chunk * 16 + wave * 2 + qi;
            const size_t tok = (size_t)(b << 14) + blk * 32 + r31;
            const bf16* qrow = qc + tok * 512 + hd * 128 + 8 * hh;
            bf16x8 qf[8];
#pragma unroll
            for (int kk = 0; kk < 8; ++kk) qf[kk] = *(const GAS bf16x8*)(qrow + 16 * kk);
            f32x16 o[4];
#pragma unroll
            for (int mt = 0; mt < 4; ++mt)
#pragma unroll
                for (int i = 0; i < 16; ++i) o[mt][i] = 0.f;
            float mx = -1e30f, den = 0.f;
            const LAS unsigned char* kb = lds + r31 * MA_KP + 16 * hh;
            const LAS unsigned char* vb = lds + MA_V + r31 * MA_VP + 8 * hh;
#pragma unroll 1
            for (int t = 0; t < 8; ++t) {
                f32x16 sacc;
#pragma unroll
                for (int i = 0; i < 16; ++i) sacc[i] = 0.f;
#pragma unroll
                for (int kk = 0; kk < 8; ++kk) { const bf16x8 kf = *(const LAS bf16x8*)(kb + (32 * t) * MA_KP + 32 * kk); sacc = __builtin_amdgcn_mfma_f32_32x32x16_bf16(kf, qf[kk], sacc, 0, 0, 0); }
                float tmax = -INFINITY;
#pragma unroll
                for (int i = 0; i < 16; ++i) { sacc[i] *= 0.12751743f; tmax = fmaxf(tmax, sacc[i]); }
                tmax = fmaxf(tmax, __shfl_xor(tmax, 32));
                const bool grow = __builtin_amdgcn_ballot_w64(tmax > mx) != 0ull;
                const float mn = fmaxf(mx, tmax); float corr = 1.f;
                if (grow) corr = __builtin_amdgcn_exp2f(mx - mn);
                mx = mn;
                float psum = 0.f;
#pragma unroll
                for (int i = 0; i < 16; ++i) { const float p = __builtin_amdgcn_exp2f(sacc[i] - mn); sacc[i] = p; psum += p; }
                den = den * corr + psum;
                if (grow) {
#pragma unroll
                    for (int mt = 0; mt < 4; ++mt)
#pragma unroll
                        for (int i = 0; i < 16; ++i) o[mt][i] *= corr; }
#pragma unroll
                for (int s2 = 0; s2 < 2; ++s2) { v4u pw; pw.x = pk2(sacc[8 * s2], sacc[8 * s2 + 1]); pw.y = pk2(sacc[8 * s2 + 2], sacc[8 * s2 + 3]); pw.z = pk2(sacc[8 * s2 + 4], sacc[8 * s2 + 5]); pw.w = pk2(sacc[8 * s2 + 6], sacc[8 * s2 + 7]);
                    const bf16x8 pf = __builtin_bit_cast(bf16x8, pw);
#pragma unroll
                    for (int mt = 0; mt < 4; ++mt) { const LAS unsigned char* vp = vb + (32 * mt) * MA_VP + (32 * t + 16 * s2) * 2;
                        const v2u lo = *(const LAS v2u*)vp, hi = *(const LAS v2u*)(vp + 16);
                        v4u w; w.x = lo.x; w.y = lo.y; w.z = hi.x; w.w = hi.y;
                        o[mt] = __builtin_amdgcn_mfma_f32_32x32x16_bf16(__builtin_bit_cast(bf16x8, w), pf, o[mt], 0, 0, 0); } }
            }
            den += __shfl_xor(den, 32);
            const float inv = 1.f / den;
            unsigned char* orow = (unsigned char*)ycin + tok * 512 + hd * 128 + 4 * hh; const float inv4 = inv * SC_ACT;
#pragma unroll
            for (int mt = 0; mt < 4; ++mt)
#pragma unroll
                for (int q4 = 0; q4 < 4; ++q4) *(GAS unsigned*)(orow + 32 * mt + 8 * q4) = pk4_fp8(o[mt][4 * q4] * inv4, o[mt][4 * q4 + 1] * inv4, o[mt][4 * q4 + 2] * inv4, o[mt][4 * q4 + 3] * inv4);
        }
    }
    __syncthreads();
}
__device__ __forceinline__ void combine_groups(const bf16* og, const float* lse, bf16* ob, int tid, int G) {
    for (size_t idx = (size_t)blockIdx.x * 512 + tid; idx < (size_t)NT * 32; idx += (size_t)G * 512) {
        const int t = (int)(idx >> 5), ch = (int)(idx & 31), h = ch >> 3, d0 = (ch & 7) * 8, b = t >> 14, s = t & 16383;
        float l[3]; size_t n[3];
#pragma unroll
        for (int g = 0; g < 3; ++g) { const int sh = 2 * g; n[g] = (size_t)(b << 14) + (size_t)(s & ((1 << sh) - 1)) * (16384 >> sh) + (s >> sh); l[g] = lse[((size_t)g * NT + n[g]) * 4 + h]; }
        const float mx = fmaxf(l[0], fmaxf(l[1], l[2])); float w[3], sum = 0.f;
#pragma unroll
        for (int g = 0; g < 3; ++g) { w[g] = __expf(l[g] - mx); sum += w[g]; }
        float o[8] = {0, 0, 0, 0, 0, 0, 0, 0};
#pragma unroll
        for (int g = 0; g < 3; ++g) { const float wg = w[g] / sum; const v4u v = *(const GAS v4u*)(og + ((size_t)g * NT + n[g]) * 256 + h * 64 + d0);
            o[0] += wg * bflo(v.x); o[1] += wg * bfhi(v.x); o[2] += wg * bflo(v.y); o[3] += wg * bfhi(v.y); o[4] += wg * bflo(v.z); o[5] += wg * bfhi(v.z); o[6] += wg * bflo(v.w); o[7] += wg * bfhi(v.w); }
        v2u r; r.x = pk4_fp8(o[0] * SC_ACT, o[1] * SC_ACT, o[2] * SC_ACT, o[3] * SC_ACT); r.y = pk4_fp8(o[4] * SC_ACT, o[5] * SC_ACT, o[6] * SC_ACT, o[7] * SC_ACT);
        *(GAS v2u*)((unsigned char*)ob + (size_t)t * 256 + h * 64 + d0) = r;
    }
}

template <int C> __device__ __forceinline__ unsigned dppu(unsigned v) { return (unsigned)__builtin_amdgcn_update_dpp(0, (int)v, C, 0xF, 0xF, true); }
template <int C> __device__ __forceinline__ float dppf(float v) { return __builtin_bit_cast(float, __builtin_amdgcn_update_dpp(0, __builtin_bit_cast(int, v), C, 0xF, 0xF, true)); }
__device__ __forceinline__ unsigned umax2(unsigned a, unsigned b) { return a > b ? a : b; }
__device__ __forceinline__ unsigned row_max_u(unsigned v) { v = umax2(v, dppu<0xB1>(v)); v = umax2(v, dppu<0x4E>(v)); v = umax2(v, dppu<0x141>(v)); v = umax2(v, dppu<0x140>(v)); return v; }
__device__ __forceinline__ float row_max_f(float v) { v = fmaxf(v, dppf<0xB1>(v)); v = fmaxf(v, dppf<0x4E>(v)); v = fmaxf(v, dppf<0x141>(v)); v = fmaxf(v, dppf<0x140>(v)); return v; }
__device__ __forceinline__ float row_sum_f(float v) { v += dppf<0xB1>(v); v += dppf<0x4E>(v); v += dppf<0x141>(v); v += dppf<0x140>(v); return v; }
__device__ __forceinline__ unsigned ordf(float f) { const unsigned b = __builtin_bit_cast(unsigned, f); return b ^ ((unsigned)((int)b >> 31) | 0x80000000u); }
__device__ __forceinline__ float decf(unsigned k) { const unsigned b = (k & 0x80000000u) ? (k ^ 0x80000000u) : ~k; return __builtin_bit_cast(float, b); }
__device__ __forceinline__ unsigned bperm(unsigned v, int src_lane) { return (unsigned)__builtin_amdgcn_ds_bpermute(src_lane * 4, (int)v); }
typedef __bf16 bf16x2_t __attribute__((ext_vector_type(2)));
__device__ __forceinline__ float dot2bf(unsigned a, unsigned b, float c) { return __builtin_amdgcn_fdot2_f32_bf16(__builtin_bit_cast(bf16x2_t, a), __builtin_bit_cast(bf16x2_t, b), c, false); }

__device__ __forceinline__ float gelu_as(float v) {
    const float av = fabsf(v), t = __builtin_amdgcn_rcpf(av * 0.2316418882f + 1.0f);
    float q = t * 0.5307027145f + (-0.7265760135f); q = q * t + 0.7107068705f; q = q * t + (-0.142248368f); q = q * t + 0.127414796f; q = q * t;
    const float e = __builtin_amdgcn_exp2f((v * v) * (-0.72134752044f));
    const float m = v * (q * e);
    return v < 0.f ? m : v - m;
}
constexpr int PEER_SKB = 0, PEER_EL = 36864, PEER_PTAB = PEER_EL + 8 * 2048, PEER_VB = PEER_PTAB + 256, PEER_XA = PEER_VB + 8 * 8192, PEER_WB = PEER_XA + 8 * 4096;
static_assert(PEER_WB + 8 * 64 <= MISC_OFF, "PEER LDS map");
constexpr float PEER_XS = 32.f, PEER_WS = 32.f;
typedef int v8i_p __attribute__((ext_vector_type(8)));
typedef int v2i __attribute__((ext_vector_type(2)));
__device__ __forceinline__ void peer_scores_top16(const bf16* qp, LAS unsigned char* lds, LAS unsigned char* sl, LAS unsigned char* sl3, int tokb, int hf, int fr, int fq, unsigned& o0, unsigned& o1, unsigned& o2, unsigned& o3) {
    const bf16* arow = qp + (size_t)tokb * 1024 + (fr & 7) * 128 + hf * 64 + 8 * fq;
    const bf16x8 a0 = *(const GAS bf16x8*)arow, a1 = *(const GAS bf16x8*)(arow + 32);
    unsigned e0[8], e1[8], e2[8], e3[8];
#pragma unroll
    for (int nb = 0; nb < 8; ++nb) {
        const LAS unsigned char* bp = lds + PEER_SKB + hf * 18432 + (fr + 16 * nb) * 144 + fq * 16;
        const bf16x8 b0 = *(const LAS bf16x8*)bp, b1 = *(const LAS bf16x8*)(bp + 64);
        f32x4 acc = (f32x4){0.f, 0.f, 0.f, 0.f};
        acc = __builtin_amdgcn_mfma_f32_16x16x32_bf16(a0, b0, acc, 0, 0, 0);
        acc = __builtin_amdgcn_mfma_f32_16x16x32_bf16(a1, b1, acc, 0, 0, 0);
        const unsigned ix = (unsigned)(127 - (fr + 16 * nb));
        e0[nb] = (ordf(acc[0]) & ~127u) | ix; e1[nb] = (ordf(acc[1]) & ~127u) | ix; e2[nb] = (ordf(acc[2]) & ~127u) | ix; e3[nb] = (ordf(acc[3]) & ~127u) | ix;
    }
    o0 = 0u; o1 = 0u; o2 = 0u; o3 = 0u;
#define PEER_CE(E, A, B) do { const unsigned hi_ = umax2(E[A], E[B]), lo_ = E[A] < E[B] ? E[A] : E[B]; E[A] = hi_; E[B] = lo_; } while (0)
#define PEER_SORT8(E) do { PEER_CE(E, 0, 1); PEER_CE(E, 2, 3); PEER_CE(E, 4, 5); PEER_CE(E, 6, 7); PEER_CE(E, 0, 2); PEER_CE(E, 1, 3); PEER_CE(E, 4, 6); PEER_CE(E, 5, 7); PEER_CE(E, 1, 2); PEER_CE(E, 5, 6); \
        PEER_CE(E, 0, 4); PEER_CE(E, 1, 5); PEER_CE(E, 2, 6); PEER_CE(E, 3, 7); PEER_CE(E, 2, 4); PEER_CE(E, 3, 5); PEER_CE(E, 1, 2); PEER_CE(E, 3, 4); PEER_CE(E, 5, 6); } while (0)
    PEER_SORT8(e0); PEER_SORT8(e1); PEER_SORT8(e2); PEER_SORT8(e3);
    const unsigned lo36 = (unsigned)(fq * 16 + fr) * 36u;
    LAS unsigned char* q0 = sl + lo36; LAS unsigned char* q1 = sl + 2304 + lo36; LAS unsigned char* q2 = sl + 4608 + lo36; LAS unsigned char* q3 = sl3 + lo36;
#pragma unroll
    for (int p = 0; p < 8; ++p) { *(LAS unsigned*)(q0 + 4 * p) = e0[p]; *(LAS unsigned*)(q1 + 4 * p) = e1[p]; *(LAS unsigned*)(q2 + 4 * p) = e2[p]; *(LAS unsigned*)(q3 + 4 * p) = e3[p]; }
    *(LAS unsigned*)(q0 + 32) = 0u; *(LAS unsigned*)(q1 + 32) = 0u; *(LAS unsigned*)(q2 + 32) = 0u; *(LAS unsigned*)(q3 + 32) = 0u;
    unsigned h0 = e0[0], h1 = e1[0], h2 = e2[0], h3 = e3[0];
#define PEER_ROUND(H, Q, O) do { const unsigned m = row_max_u(H); Q += (H == m) ? 4 : 0; H = *(const LAS unsigned*)Q; O = (fr == r) ? m : O; } while (0)
#pragma unroll 1
    for (int r = 0; r < 16; ++r) { PEER_ROUND(h0, q0, o0); PEER_ROUND(h1, q1, o1); PEER_ROUND(h2, q2, o2); PEER_ROUND(h3, q3, o3); }
#undef PEER_ROUND
#undef PEER_SORT8
#undef PEER_CE
}
__device__ __forceinline__ void peer_cand(LAS unsigned char* lds, LAS unsigned char* el, unsigned ptab, unsigned L1, unsigned L2, int lane, int fr, int slot) {
    unsigned c0, c1, c2, c3;
#define PEER_CK(SL, C) do { const unsigned byte = (ptab >> (8 * SL)) & 255u; const int a = byte >> 4, b = byte & 15; \
        const unsigned k1 = bperm(L1, (lane & 48) + a), k2 = bperm(L2, (lane & 48) + b); const float sum = decf(k1 & ~127u) + decf(k2 & ~127u); \
        C = (byte != 255u) ? ((ordf(sum) & ~63u) | (unsigned)(fr * 4 + SL)) : 0u; } while (0)
    PEER_CK(0, c0); PEER_CK(1, c1); PEER_CK(2, c2); PEER_CK(3, c3);
#undef PEER_CK
    unsigned co = 0u;
#define PEER_CE2(A, B) do { const unsigned hi_ = umax2(A, B), lo_ = A < B ? A : B; A = hi_; B = lo_; } while (0)
    PEER_CE2(c0, c1); PEER_CE2(c2, c3); PEER_CE2(c0, c2); PEER_CE2(c1, c3); PEER_CE2(c1, c2);
#undef PEER_CE2
#pragma unroll 1
    for (int r = 0; r < 16; ++r) { const unsigned m = row_max_u(c0); const bool win = (c0 == m);
        c0 = win ? c1 : c0; c1 = win ? c2 : c1; c2 = win ? c3 : c2; c3 = win ? 0u : c3;
        co = (fr == r) ? m : co; }
    const unsigned pb = *(LAS unsigned char*)(lds + PEER_PTAB + (co & 63u));
    const unsigned k1 = bperm(L1, (lane & 48) + (int)(pb >> 4)), k2 = bperm(L2, (lane & 48) + (int)(pb & 15u));
    const unsigned expert = (127u - (k1 & 127u)) * 128u + (127u - (k2 & 127u));
    const float sc = decf(co & ~63u);
    const float ex = __expf(sc - row_max_f(sc));
    const float gate = ex / row_sum_f(ex);
    v2u rec; rec.x = expert; rec.y = __builtin_bit_cast(unsigned, gate);
    *(LAS v2u*)(el + slot * 8) = rec;
}
template <int sh, bool PACK>
__device__ __forceinline__ void peer_regroup16(const LAS unsigned char* src, LAS unsigned char* dst, int lane, int fr) {
    v2u rc[8]; unsigned c0 = 0u, c1 = 0u, c2 = 0u, c3 = 0u;
#pragma unroll
    for (int j = 0; j < 8; ++j) { rc[j] = *(const LAS v2u*)(src + (fr * 8 + j) * 8); const unsigned bk = (rc[j].x >> sh) & 15u, one = 1u << (8 * (bk & 3u)), w = bk >> 2;
        c0 += (w == 0u) ? one : 0u; c1 += (w == 1u) ? one : 0u; c2 += (w == 2u) ? one : 0u; c3 += (w == 3u) ? one : 0u; }
    unsigned i0 = c0, i1 = c1, i2 = c2, i3 = c3;
    i0 += dppu<0x111>(i0); i1 += dppu<0x111>(i1); i2 += dppu<0x111>(i2); i3 += dppu<0x111>(i3);
    i0 += dppu<0x112>(i0); i1 += dppu<0x112>(i1); i2 += dppu<0x112>(i2); i3 += dppu<0x112>(i3);
    i0 += dppu<0x114>(i0); i1 += dppu<0x114>(i1); i2 += dppu<0x114>(i2); i3 += dppu<0x114>(i3);
    i0 += dppu<0x118>(i0); i1 += dppu<0x118>(i1); i2 += dppu<0x118>(i2); i3 += dppu<0x118>(i3);
    const int l15 = (lane & 48) + 15;
    const unsigned t0 = bperm(i0, l15), t1 = bperm(i1, l15), t2 = bperm(i2, l15), t3 = bperm(i3, l15);
    const unsigned s0 = (t0 * 0x01010101u) >> 24, s1 = (t1 * 0x01010101u) >> 24, s2 = (t2 * 0x01010101u) >> 24;
    unsigned p0 = (i0 - c0) + (t0 * 0x01010100u), p1 = (i1 - c1) + (t1 * 0x01010100u) + s0 * 0x01010101u, p2 = (i2 - c2) + (t2 * 0x01010100u) + (s0 + s1) * 0x01010101u,
             p3 = (i3 - c3) + (t3 * 0x01010100u) + (s0 + s1 + s2) * 0x01010101u;
#pragma unroll
    for (int j = 0; j < 8; ++j) { const unsigned bk = (rc[j].x >> sh) & 15u, q8 = 8 * (bk & 3u), w = bk >> 2, one = 1u << q8;
        const unsigned pw = (w == 0u) ? p0 : ((w == 1u) ? p1 : ((w == 2u) ? p2 : p3));
        if (PACK) { const unsigned gu = rc[j].y; *(LAS unsigned*)(dst + ((pw >> q8) & 255u) * 4) = (rc[j].x << 16) | ((gu + 0x7fffu + ((gu >> 16) & 1u)) >> 16); }
        else *(LAS v2u*)(dst + ((pw >> q8) & 255u) * 8) = rc[j];
        p0 += (w == 0u) ? one : 0u; p1 += (w == 1u) ? one : 0u; p2 += (w == 2u) ? one : 0u; p3 += (w == 3u) ? one : 0u; }
}
#define PEER_ULOAD(U, E) do { const unsigned ee_ = (E); \
            const unsigned i0_ = dppu<0x00>(ee_), i1_ = dppu<0x55>(ee_), i2_ = dppu<0xAA>(ee_), i3_ = dppu<0xFF>(ee_);        \
            const unsigned char* p0_ = u6 + (size_t)i0_ * 512 + uofs; const unsigned char* p1_ = u6 + (size_t)i1_ * 512 + uofs; \
            const unsigned char* p2_ = u6 + (size_t)i2_ * 512 + uofs; const unsigned char* p3_ = u6 + (size_t)i3_ * 512 + uofs; \
            U[0] = *(const GAS v4u*)p0_; U[1] = *(const GAS v4u*)(p0_ + 256); U[2] = *(const GAS v4u*)p1_; U[3] = *(const GAS v4u*)(p1_ + 256); \
            U[4] = *(const GAS v4u*)p2_; U[5] = *(const GAS v4u*)(p2_ + 256); U[6] = *(const GAS v4u*)p3_; U[7] = *(const GAS v4u*)(p3_ + 256); } while (0)
#define PEER_VDMA(E) do { const unsigned ee_ = (E); const unsigned ia_ = bperm(ee_, vsrc0), ib_ = bperm(ee_, vsrc1); \
            const unsigned char* va_ = v6 + (size_t)ia_ * 512 + vpo0; const unsigned char* vb_ = v6 + (size_t)ib_ * 512 + vpo1; \
            _Pragma("unroll") for (int l = 0; l < 4; ++l) { \
                asm volatile("s_mov_b32 m0, %1\n\ts_nop 0\n\tglobal_load_lds_dwordx4 %0, off" :: "v"(va_ + l * 128), "s"(vbaddr + (unsigned)(2 * l) * 1024u) : "memory"); \
                asm volatile("s_mov_b32 m0, %1\n\ts_nop 0\n\tglobal_load_lds_dwordx4 %0, off" :: "v"(vb_ + l * 128), "s"(vbaddr + (unsigned)(2 * l + 1) * 1024u) : "memory"); } } while (0)
#define PEER_XLOAD(PW0, PW1, SA, SB, TOK, LN) do { const bf16* prow = (const bf16*)(ws + WS_H0) + (size_t)(TOK) * 1024 + (LN) * 16; \
            const GAS f32x4* sp = (const GAS f32x4*)((const float*)(ws + WS_STATS4) + (size_t)(TOK) * 8); SA = sp[0]; SB = sp[1]; \
            PW0 = *(const GAS v4u*)prow; PW1 = *(const GAS v4u*)(prow + 8); } while (0)
#define PEER_XCALC(XN, PW0, PW1, SA, SB, GV, BV) do { \
            f32x2 st; st.x = ((SA.x + SA.z) + SB.x) + SB.z; st.y = ((SA.y + SA.w) + SB.y) + SB.w; \
            const float mean1 = st.x * (1.f / D), rstd1 = 1.f / sqrtf(fmaxf(st.y * (1.f / D) - mean1 * mean1, 0.f) + LN_EPS); \
            _Pragma("unroll") for (int q8 = 0; q8 < 2; ++q8) { const v4u pw = q8 ? PW1 : PW0; f32x4 pa, pb2; unpack8(pw, pa, pb2); \
                _Pragma("unroll") for (int hq = 0; hq < 2; ++hq) { const int q4 = q8 * 2 + hq; const f32x4 pv = hq ? pb2 : pa; \
                    const f32x4 xv = (pv - mean1) * rstd1 * GV[q4] + BV[q4]; \
                    XN[q4 * 4] = xv.x; XN[q4 * 4 + 1] = xv.y; XN[q4 * 4 + 2] = xv.z; XN[q4 * 4 + 3] = xv.w; } } } while (0)
#define PEER_LNPAR(GV, BV, GI, BI, LN) do { _Pragma("unroll") for (int q4 = 0; q4 < 4; ++q4) { GV[q4] = *(const GAS f32x4*)(P.in[GI] + (LN) * 16 + q4 * 4); BV[q4] = *(const GAS f32x4*)(P.in[BI] + (LN) * 16 + q4 * 4); } } while (0)
__device__ __forceinline__ void peer_v2(const Ptrs& P, LAS unsigned char* lds, int tid, int lane, int wave, int G) {
    unsigned char* ws = P.ws;
    const bf16* qp = (const bf16*)(ws + WS_QP); const bf16* utab = (const bf16*)(ws + WS_UTAB); const bf16* vtab = (const bf16*)(ws + WS_VTAB);
    const bf16* h1b = (const bf16*)(ws + WS_H1B);
    const int fr = lane & 15, fq = lane >> 4;
    for (int idx = tid; idx < 2 * 128 * 32; idx += 512) { const int hf = idx >> 12, k = (idx >> 5) & 127, c2 = idx & 31; const float* sk = (hf ? P.in[16] : P.in[15]) + k * 64 + c2 * 2;
        *(LAS unsigned*)(lds + PEER_SKB + hf * 18432 + k * 144 + c2 * 4) = pk2(sk[0], sk[1]); }
    if (tid < 64) { int q = 0, a = 0, b = 0; unsigned char val = 0xFF;
        for (a = 0; a < 16 && val == 0xFF; ++a) for (b = 0; b < 16 && (a + 1) * (b + 1) <= 16; ++b) { if (q == tid) { val = (unsigned char)((a << 4) | b); break; } ++q; }
        *(LAS unsigned char*)(lds + PEER_PTAB + tid) = val; }
    __syncthreads();
    LAS unsigned char* el = lds + PEER_EL + wave * 2048;
    LAS unsigned char* vb = lds + PEER_VB + wave * 8192;
    LAS unsigned char* xal = lds + PEER_XA + wave * 4096; LAS unsigned char* wbl = lds + PEER_WB + wave * 64;
    const unsigned char* u6 = (const unsigned char*)utab; const unsigned char* v6 = (const unsigned char*)vtab;
    const unsigned vbaddr = (unsigned)__builtin_amdgcn_readfirstlane((int)(unsigned)(size_t)vb);
    const int lane_k = lane;
    const int ni = 4 * ((NT / 32 - (int)blockIdx.x + G - 1) / G);
    const bool late = (blockIdx.x & 1) != 0; const int rot = 0;
#define PEER_TOK(I) (((int)blockIdx.x + ((I) >> 2) * G) * 32 + wave * 4 + ((I) & 3))
    for (int i0 = 0; i0 < ni; ) {
        const int nch = (late && (i0 == 0 || ni - i0 < 4)) ? 2 : 4;
        const bool four = nch == 4;
        const int lane = (int)opq((unsigned)lane_k), fr = lane & 15, fq = lane >> 4; const unsigned ptab = *(LAS unsigned*)(lds + PEER_PTAB + fr * 4);
        int tokv[4];
#pragma unroll
        for (int tq = 0; tq < 4; ++tq) { const int ii = (i0 + tq < ni) ? i0 + tq : ni - 1; tokv[tq] = PEER_TOK(ii); }
        const int ia = i0 + (fr >> 3), ib = (i0 + 2 + (fr >> 3) < ni) ? i0 + 2 + (fr >> 3) : ni - 1;
        const int tokA = PEER_TOK(ia), tokB = PEER_TOK(ib);
        { unsigned A00, A01, A02, A03, A10, A11, A12, A13, B00 = 0u, B01 = 0u, B02 = 0u, B03 = 0u, B10 = 0u, B11 = 0u, B12 = 0u, B13 = 0u;
          peer_scores_top16(qp, lds, vb, xal, tokA, 0, fr, fq, A00, A01, A02, A03);
          peer_scores_top16(qp, lds, vb, xal, tokA, 1, fr, fq, A10, A11, A12, A13);
          if (four) { peer_scores_top16(qp, lds, vb, xal, tokB, 0, fr, fq, B00, B01, B02, B03);
                      peer_scores_top16(qp, lds, vb, xal, tokB, 1, fr, fq, B10, B11, B12, B13); }
          asm volatile("s_waitcnt lgkmcnt(0)" ::: "memory");
          peer_cand(lds, vb, ptab, A00, A10, lane, fr, (0 + (fq >> 1)) * 128 + ((fq & 1) * 4 + 0) * 16 + fr);
          peer_cand(lds, vb, ptab, A01, A11, lane, fr, (0 + (fq >> 1)) * 128 + ((fq & 1) * 4 + 1) * 16 + fr);
          peer_cand(lds, vb, ptab, A02, A12, lane, fr, (0 + (fq >> 1)) * 128 + ((fq & 1) * 4 + 2) * 16 + fr);
          peer_cand(lds, vb, ptab, A03, A13, lane, fr, (0 + (fq >> 1)) * 128 + ((fq & 1) * 4 + 3) * 16 + fr);
          if (four) {
          peer_cand(lds, vb, ptab, B00, B10, lane, fr, (2 + (fq >> 1)) * 128 + ((fq & 1) * 4 + 0) * 16 + fr);
          peer_cand(lds, vb, ptab, B01, B11, lane, fr, (2 + (fq >> 1)) * 128 + ((fq & 1) * 4 + 1) * 16 + fr);
          peer_cand(lds, vb, ptab, B02, B12, lane, fr, (2 + (fq >> 1)) * 128 + ((fq & 1) * 4 + 2) * 16 + fr);
          peer_cand(lds, vb, ptab, B03, B13, lane, fr, (2 + (fq >> 1)) * 128 + ((fq & 1) * 4 + 3) * 16 + fr); } }
        asm volatile("s_waitcnt lgkmcnt(0)" ::: "memory");
        __builtin_amdgcn_sched_barrier(0);
        peer_regroup16<6, false>(vb + fq * 1024, vb + 4096 + fq * 1024, lane, fr);
        asm volatile("s_waitcnt lgkmcnt(0)" ::: "memory"); __builtin_amdgcn_sched_barrier(0);
        peer_regroup16<10, true>(vb + 4096 + fq * 1024, el + fq * 512, lane, fr);
        asm volatile("s_waitcnt lgkmcnt(0)" ::: "memory"); __builtin_amdgcn_sched_barrier(0);
        const unsigned trsw = (unsigned)(4 * (fr >> 3) + ((fr & 7) >> 1));
        const unsigned trb = (unsigned)((fr >> 3) * 1024 + (fr & 7) * 128 + (fq & 1) * 8);
        const unsigned tr00 = trb + (((unsigned)(0 + (fq >> 1) + 0) ^ trsw) & 7u) * 16u, tr01 = trb + (((unsigned)(0 + (fq >> 1) + 2) ^ trsw) & 7u) * 16u;
        const unsigned tr10 = trb + (((unsigned)(4 + (fq >> 1) + 0) ^ trsw) & 7u) * 16u, tr11 = trb + (((unsigned)(4 + (fq >> 1) + 2) ^ trsw) & 7u) * 16u;
        const unsigned uofs = (unsigned)(fq * 64 + (fr & 3) * 16);
        const unsigned xofs = (unsigned)(128 * (fq >> 1) + 32 * (fr & 3) + 16 * (fq & 1));
        const int vsrc0 = (lane >> 3), vsrc1 = 8 + (lane >> 3);
        const unsigned vpo0 = (unsigned)((((lane & 7) ^ (0 + (lane >> 4))) & 7) * 16), vpo1 = (unsigned)((((lane & 7) ^ (4 + (lane >> 4))) & 7) * 16);
        const int awg = 2 * (fr >> 2) + (fr & 1);
        const bool aw00 = (((fr & 3) >> 1) == 0) && (awg == fq), aw01 = (((fr & 3) >> 1) == 0) && (awg == fq + 4), aw10 = (((fr & 3) >> 1) == 1) && (awg == fq), aw11 = (((fr & 3) >> 1) == 1) && (awg == fq + 4);
        { const int lane_t = (int)opq((unsigned)lane);
          v4u pw0[4], pw1[4]; f32x4 sa4[4], sb4[4];
#pragma unroll
          for (int tq = 0; tq < 4; ++tq) PEER_XLOAD(pw0[tq], pw1[tq], sa4[tq], sb4[tq], tokv[tq], lane_t);
          f32x4 g1v[4], b1v[4]; PEER_LNPAR(g1v, b1v, 12, 13, lane_t);
#pragma unroll
          for (int tq = 0; tq < 4; ++tq) { float xn[16]; PEER_XCALC(xn, pw0[tq], pw1[tq], sa4[tq], sb4[tq], g1v, b1v);
            v4u xq;
#pragma unroll
            for (int c = 0; c < 4; ++c) xq[c] = pk4_fp8(__builtin_amdgcn_fmed3f(xn[4 * c] * PEER_XS, -448.f, 448.f), __builtin_amdgcn_fmed3f(xn[4 * c + 1] * PEER_XS, -448.f, 448.f),
                                                        __builtin_amdgcn_fmed3f(xn[4 * c + 2] * PEER_XS, -448.f, 448.f), __builtin_amdgcn_fmed3f(xn[4 * c + 3] * PEER_XS, -448.f, 448.f));
            *(LAS v4u*)(xal + tq * 1024 + lane_t * 16) = xq; } }
        asm volatile("s_waitcnt vmcnt(0) lgkmcnt(0)" ::: "memory");
        const LAS unsigned char* recp = el + fr * 4;
        unsigned r_cur = *(const LAS unsigned*)(recp + rot * 64);
        v4u ub[8], ub2[8];
        PEER_ULOAD(ub, r_cur >> 16);
        PEER_VDMA(r_cur >> 16);
        f32x4 yacc[2][8];
#pragma unroll
        for (int p = 0; p < 2; ++p)
#pragma unroll
            for (int m = 0; m < 8; ++m) yacc[p][m] = (f32x4){0.f, 0.f, 0.f, 0.f};
#define PEER_STEP(T, NEXTOFS, UC, UN, HASNEXT) do { \
            unsigned r_nx = r_cur; \
            if (HASNEXT) { r_nx = *(const LAS unsigned*)(recp + (NEXTOFS)); PEER_ULOAD(UN, r_nx >> 16); } \
            const unsigned xo = opq(xofs + (T) * 1024u);              \
            v8i_p xs0, xs1; \
            { const v4u l0 = *(const LAS v4u*)(xal + xo), h0_ = *(const LAS v4u*)(xal + xo + 256), l1 = *(const LAS v4u*)(xal + xo + 512), h1_ = *(const LAS v4u*)(xal + xo + 768); \
              xs0[0] = (int)l0.x; xs0[1] = (int)l0.y; xs0[2] = (int)l0.z; xs0[3] = (int)l0.w; xs0[4] = (int)h0_.x; xs0[5] = (int)h0_.y; xs0[6] = (int)h0_.z; xs0[7] = (int)h0_.w; \
              xs1[0] = (int)l1.x; xs1[1] = (int)l1.y; xs1[2] = (int)l1.z; xs1[3] = (int)l1.w; xs1[4] = (int)h1_.x; xs1[5] = (int)h1_.y; xs1[6] = (int)h1_.z; xs1[7] = (int)h1_.w; } \
            float hsum = 0.f; \
            _Pragma("unroll") for (int e4 = 0; e4 < 4; ++e4) { v8i_p b0_, b1_; \
                b0_[0] = (int)UC[2 * e4].x; b0_[1] = (int)UC[2 * e4].y; b0_[2] = (int)UC[2 * e4].z; b0_[3] = (int)UC[2 * e4].w; b0_[4] = 0; b0_[5] = 0; b0_[6] = 0; b0_[7] = 0; \
                b1_[0] = (int)UC[2 * e4 + 1].x; b1_[1] = (int)UC[2 * e4 + 1].y; b1_[2] = (int)UC[2 * e4 + 1].z; b1_[3] = (int)UC[2 * e4 + 1].w; b1_[4] = 0; b1_[5] = 0; b1_[6] = 0; b1_[7] = 0; \
                f32x4 acc = (f32x4){0.f, 0.f, 0.f, 0.f}; \
                acc = __builtin_amdgcn_mfma_scale_f32_16x16x128_f8f6f4(xs0, b0_, acc, 0, 4, 0, 0x7F7F7F7F, 0, 0x7F7F7F7F); \
                acc = __builtin_amdgcn_mfma_scale_f32_16x16x128_f8f6f4(xs1, b1_, acc, 0, 4, 0, 0x7F7F7F7F, 0, 0x7F7F7F7F); \
                float val = ((fr & 3) == 0) ? acc[0] : (((fr & 3) == 1) ? acc[1] : (((fr & 3) == 2) ? acc[2] : acc[3])); \
                val += dppf<0xB1>(val); val += dppf<0x4E>(val);                                    \
                hsum = ((fr & 3) == e4) ? val : hsum; } \
            const float h = hsum * (1.f / (PEER_XS * FP4_SU)); \
            const float wq = __builtin_amdgcn_fmed3f(bf2f(r_cur & 0xffffu) * gelu_as(h) * PEER_WS, -448.f, 448.f); \
            *(LAS unsigned char*)(wbl + fr) = (unsigned char)(pk4_fp8(wq, 0.f, 0.f, 0.f) & 255u); \
            asm volatile("s_waitcnt lgkmcnt(0)" ::: "memory"); \
            const v4u W = *(const LAS v4u*)wbl; \
            const bool a0_ = ((T) & 1) ? aw10 : aw00, a1_ = ((T) & 1) ? aw11 : aw01; \
            v8i_p aw; aw[0] = a0_ ? (int)W.x : 0; aw[1] = a0_ ? (int)W.y : 0; aw[2] = a0_ ? (int)W.z : 0; aw[3] = a0_ ? (int)W.w : 0; \
            aw[4] = a1_ ? (int)W.x : 0; aw[5] = a1_ ? (int)W.y : 0; aw[6] = a1_ ? (int)W.z : 0; aw[7] = a1_ ? (int)W.w : 0; \
            if (HASNEXT) asm volatile("s_waitcnt vmcnt(8)" ::: "memory"); else asm volatile("s_waitcnt vmcnt(0)" ::: "memory");        \
            _Pragma("unroll") for (int m = 0; m < 8; ++m) { const v2i t0 = __builtin_amdgcn_ds_read_tr4_b64_v2i32((LAS v2i*)(vb + (m >> 1) * 2048 + ((m & 1) ? tr10 : tr00))), t1 = __builtin_amdgcn_ds_read_tr4_b64_v2i32((LAS v2i*)(vb + (m >> 1) * 2048 + ((m & 1) ? tr11 : tr01))); \
                v8i_p bv; bv[0] = t0[0]; bv[1] = t0[1]; bv[2] = t1[0]; bv[3] = t1[1]; bv[4] = 0; bv[5] = 0; bv[6] = 0; bv[7] = 0; \
                yacc[(T) >> 1][m] = __builtin_amdgcn_mfma_scale_f32_16x16x128_f8f6f4(aw, bv, yacc[(T) >> 1][m], 0, 4, 0, 0x7F7F7F7F, 0, 0x7F7F7F7F); } \
            asm volatile("s_waitcnt lgkmcnt(0)" ::: "memory"); \
            if (HASNEXT) PEER_VDMA(r_nx >> 16); \
            r_cur = r_nx; } while (0)
        if (four) {
#pragma unroll 1
            for (int bi = 0; bi < 7; ++bi) { const int b = (bi + rot) & 7, bn = (bi + 1 + rot) & 7;
                PEER_STEP(0, b * 64 + 512, ub, ub2, 1); PEER_STEP(1, b * 64 + 1024, ub2, ub, 1); PEER_STEP(2, b * 64 + 1536, ub, ub2, 1); PEER_STEP(3, bn * 64, ub2, ub, 1); }
            { const int b = (7 + rot) & 7; PEER_STEP(0, b * 64 + 512, ub, ub2, 1); PEER_STEP(1, b * 64 + 1024, ub2, ub, 1); PEER_STEP(2, b * 64 + 1536, ub, ub2, 1); PEER_STEP(3, 0, ub2, ub, 0); }
        } else {
#pragma unroll 1
            for (int bi = 0; bi < 7; ++bi) { const int b = (bi + rot) & 7, bn = (bi + 1 + rot) & 7;
                PEER_STEP(0, b * 64 + 512, ub, ub2, 1); PEER_STEP(1, bn * 64, ub2, ub, 1); }
            { const int b = (7 + rot) & 7; PEER_STEP(0, b * 64 + 512, ub, ub2, 1); PEER_STEP(1, 0, ub2, ub, 0); }
        }
#undef PEER_STEP
        { const int lane_t = (int)opq((unsigned)lane);
          v4u pw0[4], pw1[4]; f32x4 sa4[4], sb4[4];
#pragma unroll
          for (int tq = 0; tq < 4; ++tq) PEER_XLOAD(pw0[tq], pw1[tq], sa4[tq], sb4[tq], tokv[tq], lane_t);
          f32x4 g1v[4], b1v[4], g2v[4], b2v[4]; PEER_LNPAR(g1v, b1v, 12, 13, lane_t); PEER_LNPAR(g2v, b2v, 19, 20, lane_t);
#define PEER_EPI(T) do { const int tok = tokv[T]; LAS unsigned char* yb = vb + ((T) & 1) * 4096; \
            _Pragma("unroll") for (int m = 0; m < 8; ++m) { *(LAS float*)(yb + m * 512 + lane_t * 4) = yacc[(T) >> 1][m][2 * ((T) & 1)]; *(LAS float*)(yb + m * 512 + 256 + lane_t * 4) = yacc[(T) >> 1][m][2 * ((T) & 1) + 1]; } \
            float xn[16]; PEER_XCALC(xn, pw0[T], pw1[T], sa4[T], sb4[T], g1v, b1v); \
            float yv[16]; \
            _Pragma("unroll") for (int q4 = 0; q4 < 4; ++q4) { const f32x4 t = *(const LAS f32x4*)(yb + lane_t * 64 + q4 * 16); yv[q4 * 4] = t.x; yv[q4 * 4 + 1] = t.y; yv[q4 * 4 + 2] = t.z; yv[q4 * 4 + 3] = t.w; } \
            float ssum = 0.f; \
            _Pragma("unroll") for (int i = 0; i < 16; ++i) { yv[i] = yv[i] * (1.f / (PEER_WS * FP4_SV)) + ALPHA * xn[i]; ssum += yv[i]; } \
            const float mean = wave_sum(ssum) * (1.f / D); \
            float s2 = 0.f; \
            _Pragma("unroll") for (int i = 0; i < 16; ++i) { yv[i] -= mean; s2 += yv[i] * yv[i]; } \
            const float rstd = 1.f / sqrtf(wave_sum(s2) * (1.f / D) + LN_EPS); \
            float* orow = P.out + (size_t)tok * 1024 + lane_t * 16; \
            _Pragma("unroll") for (int q4 = 0; q4 < 4; ++q4) { const f32x4 g0 = g2v[q4], b0 = b2v[q4]; \
                f32x4 o; o.x = yv[q4 * 4] * rstd * g0.x + b0.x; o.y = yv[q4 * 4 + 1] * rstd * g0.y + b0.y; o.z = yv[q4 * 4 + 2] * rstd * g0.z + b0.z; o.w = yv[q4 * 4 + 3] * rstd * g0.w + b0.w; \
                *(GAS f32x4*)(orow + q4 * 4) = o; } } while (0)
          PEER_EPI(0); PEER_EPI(1); if (four) { PEER_EPI(2); PEER_EPI(3); } }
#undef PEER_EPI
        asm volatile("s_waitcnt vmcnt(0) lgkmcnt(0)" ::: "memory");
        i0 += nch;
    }
#undef PEER_TOK
}

struct Args { const float* in[21]; float* out; unsigned char* ws; int ph_lo, ph_hi; };
__global__ void __launch_bounds__(NWAVES * 64, 2) fwd_kernel(Args args) {
    extern __shared__ __attribute__((aligned(16))) unsigned char lds_raw[];
    LAS unsigned char* lds = (LAS unsigned char*)lds_raw;
    volatile LAS unsigned* MISC = (volatile LAS unsigned*)(lds + MISC_OFF);
    const int tid = threadIdx.x, lane = tid & 63, wave = __builtin_amdgcn_readfirstlane(tid >> 6);
    const int G = gridDim.x;
    Ptrs P;
#pragma unroll
    for (int i = 0; i < 21; ++i) P.in[i] = args.in[i];
    P.out = args.out; P.ws = args.ws;
    unsigned char* ws = args.ws;
    if (tid < 16) MISC[tid] = 0u;
    __syncthreads();
    XcdBarrier bar; bar.bar = (unsigned*)(ws + WS_CTL) + 4096; bar.x = 0; bar.st = nullptr;
    if (N_LAUNCHES == 1) bar = xcd_barrier_post((unsigned*)(ws + WS_CTL) + 4096, MISC + 8);
    const int lo = args.ph_lo, hi = args.ph_hi;
#ifndef PHMASK
#define PHMASK 0x1ff
#endif
#define IN(k) (((PHMASK >> (k)) & 1) && lo <= (k) && (k) < hi)
#define SEAM(k) do { if (IN(k) && IN((k) + 1)) xcd_barrier(bar); } while (0)

    if (IN(0)) { phase0(P, lds, tid, lane, wave, G); } SEAM(0);

    if (IN(1)) {
        if (blockIdx.x < 4) { const int n = blockIdx.x * 256 + (tid & 255); const float* part = (const float*)(ws + WS_CPART) + (tid >> 8) * 16 * 1024; float a = 0.f;
#pragma unroll
            for (int kb = 0; kb < 16; ++kb) a += part[kb * 1024 + n];
            ((float*)(ws + ((tid >> 8) ? WS_DVEC : WS_CVEC)))[n] = a; }
        for (int i = tid; i < WR_GATE; i += 512) ((LAS float*)(lds + RING_BYTES))[i] = ((const float*)(ws + WS_BIASIN))[i];
        __syncthreads();
        SchedP1 S{(const char*)ws, G, (int)blockIdx.x};
        EpiP1 E{(bf16*)P.out, ws, lds + RING_BYTES};
        pg8::gemm_phase<EpiP1, SchedP1, ZA_FP8 ? 1 : 2>(lds, S, E);
    } SEAM(1);

    if (IN(2)) {
        if ((blockIdx.x & 1) == 0) fft_step_mfma<1>((const bf16*)P.out, (bf16*)P.out + (size_t)NT * 1024, lds, tid, lane, wave, G);
        dil_attn_lds((const bf16*)(ws + WS_QK), (const bf16*)(ws + WS_VT), (const float*)(ws + WS_BIASTAB), (bf16*)(ws + WS_OG), (float*)(ws + WS_LSE), lds, tid, lane, wave, G);
        mem_attn_lds((const bf16*)(ws + WS_QC), (const bf16*)(ws + WS_MEMKV), (const bf16*)(ws + WS_MEMKV) + 512 * 512, (bf16*)(ws + WS_YCIN), lds, tid, lane, wave, G);
        if ((blockIdx.x & 1) != 0) { __syncthreads(); fft_step_mfma<1>((const bf16*)P.out, (bf16*)P.out + (size_t)NT * 1024, lds, tid, lane, wave, G); }
    } SEAM(2);

    if (IN(3)) {
        fft_step_mfma<2>((const bf16*)P.out + (size_t)NT * 1024, (bf16*)(ws + WS_FA), lds, tid, lane, wave, G);
        combine_groups((const bf16*)(ws + WS_OG), (const float*)(ws + WS_LSE), (bf16*)(ws + WS_OB), tid, G);
    } SEAM(3);

    if (IN(4)) {
        SchedP4 S{(const char*)ws, G, (int)blockIdx.x};
        for (int i = tid; i < 3072; i += 512) ((LAS float*)(lds + RING_BYTES))[i] = ((const float*)(ws + WS_BIASIN))[WR_GATE + i];
        __syncthreads();
        EpiP4 E{(bf16*)(ws + WS_MERGED), lds + RING_BYTES, P.in[17], P.in[18], ws, G, (int)blockIdx.x, ws + WS_MRGF8};
        pg8::gemm_phase<EpiP4, SchedP4, YA_FP8 ? 1 : 2>(lds, S, E);
    } SEAM(4);

    if (IN(5)) {
        SchedPlain S{(const char*)(ws + (P5_FP8 ? WS_MRGF8 : WS_MERGED)), (const char*)(ws + (P5_FP8 ? WS_WTOF8 : WS_WTO)), G, (int)blockIdx.x, K_WO, P5_FP8 ? 1 : 2};
        EpiP5 E{(bf16*)(ws + WS_H0), (float*)(ws + WS_PRELN), (float*)(ws + WS_STATS4), lds + RING_BYTES};
        pg8::gemm_phase<EpiP5, SchedPlain, P5_FP8 ? 1 : 0>(lds, S, E);
    } SEAM(5);


    if (IN(7)) {
        SchedPlain S{(const char*)(ws + WS_H0), (const char*)(ws + WS_WTPQ), G, (int)blockIdx.x, K_PQ, 2};
        EpiP7 E{(bf16*)(ws + WS_QP), (const float*)(ws + WS_STATS4), (const float*)(ws + WS_CVEC), (const float*)(ws + WS_DVEC), lds + EPI_SCR};
        pg8::gemm_phase<EpiP7, SchedPlain>(lds, S, E);
    } SEAM(7);

    if (IN(8)) {
        peer_v2(P, lds, tid, lane, wave, G);
    }
#undef IN
#undef SEAM
}

extern "C" void kernel_launch(void* const* d_in, const int* in_sizes, int n_in, void* d_out, int out_size, void* d_ws, size_t ws_size, hipStream_t stream) {
    static int grid = 0;
    if (grid == 0) {
        if (n_in != 21 || out_size != NT * D || ws_size < WS_END) { fprintf(stderr, "kernel_launch: unexpected shapes (n_in %d, out %d, ws %zu); nothing launched\n", n_in, out_size, ws_size); grid = -1; return; }
        int dev = 0, cus = 0, per_cu = 0;
        if (hipGetDevice(&dev) != hipSuccess || hipDeviceGetAttribute(&cus, hipDeviceAttributeMultiprocessorCount, dev) != hipSuccess) { grid = -1; return; }
        if (hipFuncSetAttribute((const void*)fwd_kernel, hipFuncAttributeMaxDynamicSharedMemorySize, LDS_BYTES) != hipSuccess) { fprintf(stderr, "kernel_launch: hipFuncSetAttribute failed\n"); grid = -1; return; }
        if (hipOccupancyMaxActiveBlocksPerMultiprocessor(&per_cu, (const void*)fwd_kernel, NWAVES * 64, LDS_BYTES) != hipSuccess || per_cu < 1) { fprintf(stderr, "kernel_launch: occupancy query says %d\n", per_cu); }
        (void)hipGetLastError();
        grid = cus;
    }
    if (grid < 0) return;
    (void)hipMemsetAsync((char*)d_ws + WS_CTL, 0, CTL_ZERO_BYTES, stream);
    Args a{};
    for (int i = 0; i < 21; ++i) a.in[i] = (const float*)d_in[i];
    a.out = (float*)d_out; a.ws = (unsigned char*)d_ws;
    if (N_LAUNCHES == 1) { a.ph_lo = 0; a.ph_hi = NPH; hipLaunchKernelGGL(fwd_kernel, dim3(grid), dim3(NWAVES * 64), LDS_BYTES, stream, a); }
    else for (int ph = 0; ph < NPH; ++ph) { a.ph_lo = ph; a.ph_hi = ph + 1; hipLaunchKernelGGL(fwd_kernel, dim3(grid), dim3(NWAVES * 64), LDS_BYTES, stream, a); }
}
```
